# Optimizing an MI355X kernel written in HIP

```python
import math
import jax
import jax.numpy as jnp
from jax import lax
import numpy as np

D_MODEL = 1024
BATCH = 8
SEQ = 2048
DEPTH = 2

GRID_W = 64
CTX_LEN = 256

ATTN_QK_DIM = 64
ATTN_V_DIM = 2 * ATTN_QK_DIM
ATTN_WIDTH = D_MODEL // 2
ATTN_HEADS = ATTN_WIDTH // ATTN_V_DIM
QK_WIDTH = ATTN_HEADS * ATTN_QK_DIM
FOURIER_WIDTH = D_MODEL // 4
FOURIER_GROUPS = 4
FOURIER_GROUP_DIM = FOURIER_WIDTH // FOURIER_GROUPS
CONV_WIDTH = D_MODEL // 4
CONV_GROUPS = 4
CONV_GROUP_DIM = CONV_WIDTH // CONV_GROUPS
CONV_K = 31
MIX_WIDTH = ATTN_WIDTH + FOURIER_WIDTH + CONV_WIDTH
IN_WIDTH = 4 * QK_WIDTH + ATTN_WIDTH + FOURIER_WIDTH + 2 * CONV_WIDTH
D_FF = -(-8 * D_MODEL // (3 * 256)) * 256
Q_BLOCK = 128
ROPE_BASE = 10000.0
EPS = 1e-6

kernel_name = "hybrid_diffattn_fnet_conformer_dit"


def rms_norm(x, g):
    xf = x.astype(jnp.float32)
    y = xf * lax.rsqrt(jnp.mean(xf * xf, axis=-1, keepdims=True) + EPS)
    return (y * g.astype(jnp.float32)).astype(x.dtype)


def axial_rope_tables(rows):
    row = jnp.repeat(jnp.arange(rows, dtype=jnp.float32), GRID_W)
    col = jnp.tile(jnp.arange(GRID_W, dtype=jnp.float32), rows)
    n_freq = ATTN_QK_DIM // 4
    inv_freq = ROPE_BASE ** (-jnp.arange(n_freq, dtype=jnp.float32) / n_freq)
    ang = jnp.concatenate([row[:, None] * inv_freq, col[:, None] * inv_freq], axis=-1)
    return jnp.cos(ang), jnp.sin(ang)


def apply_axial_rope(x, cos, sin):
    b, n, h, d = x.shape
    xr = x.reshape(b, n, h, 2, 2, d // 4)
    x1, x2 = xr[..., 0, :], xr[..., 1, :]
    cs = cos.reshape(1, n, 1, 2, d // 4).astype(x.dtype)
    sn = sin.reshape(1, n, 1, 2, d // 4).astype(x.dtype)
    out = jnp.stack([x1 * cs - x2 * sn, x2 * cs + x1 * sn], axis=-2)
    return out.reshape(b, n, h, d)


def diff_attention(q1, q2, k1, k2, v, lam):
    scale = ATTN_QK_DIM ** -0.5
    s1 = jnp.einsum('bhqd,bhkd->bhqk', q1, k1, preferred_element_type=jnp.float32) * scale
    s2 = jnp.einsum('bhqd,bhkd->bhqk', q2, k2, preferred_element_type=jnp.float32) * scale
    p = jax.nn.softmax(s1, axis=-1) - lam * jax.nn.softmax(s2, axis=-1)
    return jnp.einsum('bhqk,bhkv->bhqv', p.astype(v.dtype), v)


def blocked_diff_attention(q1, q2, k1, k2, v, lam):
    b, h, n, dk = q1.shape
    nblk = n // Q_BLOCK
    def to_blocks(q):
        return q.reshape(b, h, nblk, Q_BLOCK, dk).transpose(2, 0, 1, 3, 4)
    out = lax.map(lambda qs: diff_attention(qs[0], qs[1], k1, k2, v, lam), (to_blocks(q1), to_blocks(q2)))
    return out.transpose(1, 2, 0, 3, 4).reshape(b, h, n, ATTN_V_DIM)


def fourier_mix(u, w_f):
    b, n, _ = u.shape
    ug = u.astype(jnp.float32).reshape(b, n, FOURIER_GROUPS, FOURIER_GROUP_DIM)
    f = jnp.fft.fftn(ug, axes=(1, 3), norm='ortho').real.astype(u.dtype)
    y = jnp.einsum('bngc,gcd->bngd', f, w_f)
    return y.reshape(b, n, FOURIER_WIDTH)


def conformer_conv(u, conv_w, conv_b, ln_g, ln_b, w_pw2):
    b, n, _ = u.shape
    a, gate = jnp.split(u, 2, axis=-1)
    z = a * jax.nn.sigmoid(gate)
    z = lax.conv_general_dilated(z, conv_w[:, None, :].astype(z.dtype), window_strides=(1,),
                                 padding=[(CONV_K // 2, CONV_K // 2)],
                                 dimension_numbers=('NWC', 'WIO', 'NWC'),
                                 feature_group_count=CONV_WIDTH) + conv_b
    zf = z.astype(jnp.float32).reshape(b, n, CONV_GROUPS, CONV_GROUP_DIM)
    mu = jnp.mean(zf, axis=-1, keepdims=True)
    var = jnp.mean(jnp.square(zf - mu), axis=-1, keepdims=True)
    zn = ((zf - mu) * lax.rsqrt(var + EPS)).reshape(b, n, CONV_WIDTH)
    zn = zn * ln_g.astype(jnp.float32) + ln_b.astype(jnp.float32)
    return jax.nn.silu(zn).astype(u.dtype) @ w_pw2


def hybrid_mixer(h_lat, h_ctx, cos, sin, w_in, lq1, lk1, lq2, lk2, subln_g, w_fourier,
                 conv_w, conv_b, ln_g, ln_b, w_conv_out, w_out, layer_idx, need_ctx_out):
    lam_init = 0.8 - 0.6 * math.exp(-0.3 * layer_idx)
    lam = (jnp.exp(jnp.sum(lq1.astype(jnp.float32) * lk1.astype(jnp.float32)))
           - jnp.exp(jnp.sum(lq2.astype(jnp.float32) * lk2.astype(jnp.float32))) + lam_init)
    split_at = (QK_WIDTH, 2 * QK_WIDTH, 3 * QK_WIDTH, 4 * QK_WIDTH, 4 * QK_WIDTH + ATTN_WIDTH,
                4 * QK_WIDTH + ATTN_WIDTH + FOURIER_WIDTH)

    def project(h):
        return jnp.split(h @ w_in, split_at, axis=-1)

    def heads(t, dh):
        b, n, _ = t.shape
        return t.reshape(b, n, ATTN_HEADS, dh)

    def plain(t, dh):
        return heads(t, dh).transpose(0, 2, 1, 3)

    def rope(t):
        return apply_axial_rope(heads(t, ATTN_QK_DIM), cos, sin).transpose(0, 2, 1, 3)

    q1l, q2l, k1l, k2l, vl, ufl, ucl = project(h_lat)
    q1c, q2c, k1c, k2c, vc, ufc, ucc = project(h_ctx)
    k1_ctx, k2_ctx, v_ctx = plain(k1c, ATTN_QK_DIM), plain(k2c, ATTN_QK_DIM), plain(vc, ATTN_V_DIM)
    k1_all = jnp.concatenate([k1_ctx, rope(k1l)], axis=2)
    k2_all = jnp.concatenate([k2_ctx, rope(k2l)], axis=2)
    v_all = jnp.concatenate([v_ctx, plain(vl, ATTN_V_DIM)], axis=2)
    o_lat = blocked_diff_attention(rope(q1l), rope(q2l), k1_all, k2_all, v_all, lam)

    def finish(o_attn, uf, uc):
        o = rms_norm(o_attn, subln_g) * (1.0 - lam_init)
        b, h, n, dv = o.shape
        o = o.transpose(0, 2, 1, 3).reshape(b, n, h * dv)
        yf = fourier_mix(uf, w_fourier)
        yc = conformer_conv(uc, conv_w, conv_b, ln_g, ln_b, w_conv_out)
        return jnp.concatenate([o, yf, yc], axis=-1) @ w_out

    y_lat = finish(o_lat, ufl, ucl)
    y_ctx = None
    if need_ctx_out:
        o_ctx = diff_attention(plain(q1c, ATTN_QK_DIM), plain(q2c, ATTN_QK_DIM), k1_ctx, k2_ctx, v_ctx, lam)
        y_ctx = finish(o_ctx, ufc, ucc)
    return y_lat, y_ctx


def swiglu(h, w1, w3, w2):
    return (jax.nn.silu(h @ w1) * (h @ w3)) @ w2


def setup_inputs(seed: int = 0) -> dict:
    key = jax.random.key(seed)
    ks = jax.random.split(key, 25)
    f32 = jnp.float32
    D = D_MODEL

    def nrm(k, shape, s):
        return jax.random.normal(k, shape, f32) * s

    return {
        'x': nrm(ks[0], (BATCH, SEQ, D), 1.0),
        'c': nrm(ks[1], (BATCH, D), 1.0),
        'ctx': nrm(ks[2], (BATCH, CTX_LEN, D), 1.0),
        'c_ctx': nrm(ks[3], (D,), 1.0),
        'w_ada': nrm(ks[4], (DEPTH, D, 6 * D), 0.5 * D ** -0.5),
        'b_ada': nrm(ks[5], (DEPTH, 6 * D), 0.02),
        'norm1_g': 1.0 + nrm(ks[6], (DEPTH, D), 0.05),
        'norm2_g': 1.0 + nrm(ks[7], (DEPTH, D), 0.05),
        'w_in': nrm(ks[8], (DEPTH, D, IN_WIDTH), D ** -0.5),
        'lam_q1': nrm(ks[9], (DEPTH, ATTN_QK_DIM), 0.1),
        'lam_k1': nrm(ks[10], (DEPTH, ATTN_QK_DIM), 0.1),
        'lam_q2': nrm(ks[11], (DEPTH, ATTN_QK_DIM), 0.1),
        'lam_k2': nrm(ks[12], (DEPTH, ATTN_QK_DIM), 0.1),
        'subln_g': 1.0 + nrm(ks[13], (DEPTH, ATTN_V_DIM), 0.05),
        'w_fourier': nrm(ks[14], (DEPTH, FOURIER_GROUPS, FOURIER_GROUP_DIM, FOURIER_GROUP_DIM), FOURIER_GROUP_DIM ** -0.5),
        'conv_w': nrm(ks[15], (DEPTH, CONV_K, CONV_WIDTH), CONV_K ** -0.5),
        'conv_b': nrm(ks[16], (DEPTH, CONV_WIDTH), 0.02),
        'conv_ln_g': 1.0 + nrm(ks[17], (DEPTH, CONV_WIDTH), 0.05),
        'conv_ln_b': nrm(ks[18], (DEPTH, CONV_WIDTH), 0.02),
        'w_conv_out': nrm(ks[19], (DEPTH, CONV_WIDTH, CONV_WIDTH), CONV_WIDTH ** -0.5),
        'w_out': nrm(ks[20], (DEPTH, MIX_WIDTH, D), MIX_WIDTH ** -0.5),
        'w_ffn1': nrm(ks[21], (DEPTH, D, D_FF), D ** -0.5),
        'w_ffn3': nrm(ks[22], (DEPTH, D, D_FF), D ** -0.5),
        'w_ffn2': nrm(ks[23], (DEPTH, D_FF, D), D_FF ** -0.5),
        'final_g': 1.0 + nrm(ks[24], (D,), 0.05),
    }


def reference(x, c, ctx, c_ctx, w_ada, b_ada, norm1_g, norm2_g, w_in, lam_q1, lam_k1, lam_q2, lam_k2,
              subln_g, w_fourier, conv_w, conv_b, conv_ln_g, conv_ln_b, w_conv_out, w_out,
              w_ffn1, w_ffn3, w_ffn2, final_g):
    n_lat = x.shape[1]
    rows = n_lat // GRID_W
    cos, sin = axial_rope_tables(rows)
    for l in range(DEPTH):
        last = l == DEPTH - 1
        mod_lat = (jax.nn.silu(c) @ w_ada[l] + b_ada[l])[:, None, :]
        mod_ctx = (jax.nn.silu(c_ctx) @ w_ada[l] + b_ada[l])[None, None, :]
        sh1, sc1, g1, sh2, sc2, g2 = jnp.split(mod_lat, 6, axis=-1)
        csh1, csc1, cg1, csh2, csc2, cg2 = jnp.split(mod_ctx, 6, axis=-1)
        h_lat = rms_norm(x, norm1_g[l]) * (1.0 + sc1) + sh1
        h_ctx = rms_norm(ctx, norm1_g[l]) * (1.0 + csc1) + csh1
        y_lat, y_ctx = hybrid_mixer(h_lat, h_ctx, cos, sin, w_in[l], lam_q1[l], lam_k1[l], lam_q2[l], lam_k2[l],
                                    subln_g[l], w_fourier[l], conv_w[l], conv_b[l], conv_ln_g[l], conv_ln_b[l],
                                    w_conv_out[l], w_out[l], l, not last)
        x = x + g1 * y_lat
        h_lat = rms_norm(x, norm2_g[l]) * (1.0 + sc2) + sh2
        x = x + g2 * swiglu(h_lat, w_ffn1[l], w_ffn3[l], w_ffn2[l])
        if not last:
            ctx = ctx + cg1 * y_ctx
            h_ctx = rms_norm(ctx, norm2_g[l]) * (1.0 + csc2) + csh2
            ctx = ctx + cg2 * swiglu(h_ctx, w_ffn1[l], w_ffn3[l], w_ffn2[l])
    return rms_norm(x, final_g)
```

```cpp
#include <hip/hip_runtime.h>
#include <hip/hip_cooperative_groups.h>
#include <cstdint>
#include <cstdio>
namespace cg = cooperative_groups;
#ifndef PROBE
#define PROBE 0
#endif

#define LAS __attribute__((address_space(3)))
typedef unsigned short bf16_t;
typedef short bf16x8 __attribute__((ext_vector_type(8)));
typedef float f32x4 __attribute__((ext_vector_type(4)));
typedef float f32x16 __attribute__((ext_vector_type(16)));
typedef unsigned u32x4 __attribute__((ext_vector_type(4)));
typedef unsigned u32x2 __attribute__((ext_vector_type(2)));

constexpr int NB = 8, SEQ = 2048, DM = 1024, CTXL = 256, NLAT = NB * SEQ, NCTX = NB * CTXL, MTOT = NLAT + NCTX;
constexpr int INW = 2560, INW_SRC = 2304, DFF = 2816, N13 = 2 * DFF, KCAT = CTXL + SEQ;
constexpr float EPSV = 1e-6f;
constexpr float QSCALE = 0.125f * 1.4426950408889634f;
constexpr int LDS_BYTES = 147456;
constexpr int XCD_BAR_WORDS_C = 3456;

constexpr size_t MiB = 1u << 20;
constexpr size_t WS_WIN = 0, WS_WOUT = 10 * MiB, WS_W13 = 14 * MiB, WS_W2 = 36 * MiB, WS_WSM = 47 * MiB, WS_DFTL = 48 * MiB, WS_DFTC = 64 * MiB;
constexpr size_t WS_MOD = 64 * MiB + 256 * 1024, WS_ROPE = 64 * MiB + 768 * 1024, WS_XCTX = 65 * MiB, WS_H = 73 * MiB, WS_R = 109 * MiB;
constexpr size_t WS_Q1 = WS_R, WS_Q2 = WS_R + 9 * MiB, WS_K1 = WS_R + 18 * MiB, WS_K2 = WS_R + 27 * MiB, WS_VT = WS_R + 36 * MiB, WS_TTL = WS_R + 54 * MiB,
                 WS_TTC = WS_R + 70 * MiB, WS_UC = WS_R + 72 * MiB, WS_MIX = WS_R + 90 * MiB, WS_ACT = WS_R, WS_END = WS_R + 131 * MiB;
constexpr size_t MOD_BYTES = 2 * 9 * 6144 * 4;
constexpr int WSM_L = 256 * 512 + 256 * 256;
constexpr size_t WS_BAR = 64 * MiB + 704 * 1024, ZERO_BYTES = WS_BAR + XCD_BAR_WORDS_C * 4 - WS_MOD;

struct Params {
    const float *x, *c, *ctx, *c_ctx, *w_ada, *b_ada, *norm1_g, *norm2_g, *w_in, *lam_q1, *lam_k1, *lam_q2, *lam_k2, *subln_g, *w_fourier, *conv_w, *conv_b,
        *conv_ln_g, *conv_ln_b, *w_conv_out, *w_out, *w_ffn1, *w_ffn3, *w_ffn2, *final_g;
    float* out; unsigned char* ws;
};

__device__ __forceinline__ unsigned cvt_pk_bf16(float lo, float hi) { unsigned r; asm("v_cvt_pk_bf16_f32 %0, %1, %2" : "=v"(r) : "v"(lo), "v"(hi)); return r; }
__device__ __forceinline__ u32x2 pack4(f32x4 v) { u32x2 w; w.x = cvt_pk_bf16(v[0], v[1]); w.y = cvt_pk_bf16(v[2], v[3]); return w; }
__device__ __forceinline__ bf16_t f2bf(float v) { return (bf16_t)(cvt_pk_bf16(v, 0.f) & 0xffffu); }
__device__ __forceinline__ float wave_sum(float v) {
#pragma unroll
    for (int o = 1; o < 64; o <<= 1) v += __shfl_xor(v, o);
    return v;
}
__device__ __forceinline__ int fresh_tid() { int t = threadIdx.x; asm volatile("" : "+v"(t)); return t; }
__device__ __forceinline__ float max3f(float a, float b, float c) { float r; asm("v_max3_f32 %0, %1, %2, %3" : "=v"(r) : "v"(a), "v"(b), "v"(c)); return r; }
__device__ __forceinline__ float sigmoidf_(float v) { return __builtin_amdgcn_rcpf(1.f + __expf(-v)); }


#define XB_TMO      128
#define XB_XCNT(j)  (256  + 64 * (j))
#define XB_XSUB(j)  (1280 + 64 * (j))
#define XB_XGEN(j)  (2304 + 64 * (j))
#define XB_TOP      3328
#define XB_TOPGEN   3392
#define XCD_BAR_WORDS 3456
#define XB_SPIN_CAP (1u << 18)
__device__ __forceinline__ unsigned xb_ld(unsigned* p)              { return __hip_atomic_load(p, __ATOMIC_RELAXED, __HIP_MEMORY_SCOPE_AGENT); }
__device__ __forceinline__ unsigned xb_add(unsigned* p, unsigned v) { return __hip_atomic_fetch_add(p, v, __ATOMIC_RELAXED, __HIP_MEMORY_SCOPE_AGENT); }
__device__ __forceinline__ unsigned xb_xcc_id() { return (unsigned)__builtin_amdgcn_s_getreg((3 << 11) | 20) & 0xFu; }
#define XB_SPIN(cond, bar) do { unsigned _sp = 0; while (cond) { __builtin_amdgcn_s_sleep(1); \
    if ((++_sp & 255u) == 0u) { if (xb_ld(&(bar)[XB_TMO])) break; if (_sp > XB_SPIN_CAP) { atomicAdd(&(bar)[XB_TMO], 1u); break; } } } } while (0)
struct XcdBarrier { unsigned* bar; unsigned x; volatile LAS unsigned* st; };
__device__ __forceinline__ XcdBarrier xcd_barrier_post(unsigned* bar, volatile LAS unsigned* st) {
    XcdBarrier b; b.bar = bar; b.x = xb_xcc_id(); b.st = st;
    if (threadIdx.x == 0) (void)xb_add(&bar[XB_XCNT(b.x)], 1u);
    return b;
}
__device__ __forceinline__ void xcd_barrier_complete(unsigned* bar, unsigned x, unsigned& nloc, unsigned& nx) {
    const unsigned G = gridDim.x * gridDim.y * gridDim.z;
    unsigned sum, cnt, mine, sp = 0u;
    for (;;) {
        sum = 0u; cnt = 0u; mine = 0u;
#pragma unroll
        for (unsigned j = 0; j < 16; ++j) { const unsigned c = xb_ld(&bar[XB_XCNT(j)]); sum += c; cnt += (c > 0u) ? 1u : 0u; mine = (j == x) ? c : mine; }
        if (sum == G) break;
        __builtin_amdgcn_s_sleep(1);
        if ((++sp & 255u) == 0u) { if (xb_ld(&bar[XB_TMO])) break; if (sp > XB_SPIN_CAP) { atomicAdd(&bar[XB_TMO], 1u); break; } }
    }
    nloc = mine > 0u ? mine : 1u; nx = cnt > 0u ? cnt : 1u;
}
__device__ __forceinline__ void xcd_barrier(const XcdBarrier& b) {
    asm volatile("s_waitcnt vmcnt(0)" ::: "memory");
    __syncthreads();
    if (threadIdx.x == 0) {
        unsigned* bar = b.bar;
        __builtin_amdgcn_s_waitcnt(0);
        unsigned nloc = b.st[0], nx = b.st[1];
        if (nloc == 0u) { xcd_barrier_complete(bar, b.x, nloc, nx); b.st[0] = nloc; b.st[1] = nx; }
        const unsigned old = xb_add(&bar[XB_XSUB(b.x)], 1u);
        const unsigned gen = old / nloc;
        if (old + 1u == (gen + 1u) * nloc) {
            __builtin_amdgcn_fence(__ATOMIC_RELEASE, "agent");
            asm volatile("s_waitcnt vmcnt(0)" ::: "memory");
            const unsigned og = xb_add(&bar[XB_TOP], 1u);
            const unsigned tg = og / nx;
            if (og + 1u == (tg + 1u) * nx) xb_add(&bar[XB_TOPGEN], 1u);
            else XB_SPIN(xb_ld(&bar[XB_TOPGEN]) == tg, bar);
            __builtin_amdgcn_fence(__ATOMIC_ACQUIRE, "agent");
            xb_add(&bar[XB_XGEN(b.x)], 1u);
            asm volatile("s_waitcnt vmcnt(0)" ::: "memory");
        } else {
            XB_SPIN(xb_ld(&bar[XB_XGEN(b.x)]) == gen, bar);
            __builtin_amdgcn_fence(__ATOMIC_ACQUIRE, "agent");
            asm volatile("s_waitcnt vmcnt(0)" ::: "memory");
        }
    }
    __syncthreads();
}

namespace pg8 {
constexpr int BM = 256, BK = 64, HALF = 128, HTB = HALF * BK * 2, STAGE_BYTES = 8 * HTB, NXCD = 8, WGM = 2;
__host__ __device__ __forceinline__ int lds_byte(int r, int c) { const int st = (r >> 4) * 2 + (c >> 5), rr = r & 15, cc = c & 31, ob = rr * 64 + cc * 2; return st * 1024 + (ob ^ (((ob >> 9) & 1) << 5)); }
__host__ __device__ __forceinline__ void stage_rc(int b, int& R, int& C) { const int st = b / 1024, sb = b % 1024, swz = sb ^ (((sb >> 9) & 1) << 5); R = (st >> 1) * 16 + swz / 64; C = (st & 1) * 32 + (swz % 64) / 2; }

struct Unit { int pm, pn, k0, nt, flags; };
struct Gemm { const bf16_t* A; const bf16_t* Bt; int M, N, K, lda, ldb, a_pn_off; };

struct StaticOrder {
    int nM, nN, nwg, G, c;
    __host__ __device__ void init(int M, int N, int G_, int c_) { nM = M / BM; nN = N / BM; nwg = nM * nN; G = G_; c = c_; }
    __host__ __device__ __forceinline__ bool next(int i, Unit& u) const {
        const long L = (long)i * G + c; if (L >= nwg) return false;
        int wgid = (int)L; { const int q = nwg / NXCD, r = nwg % NXCD, xcd = wgid % NXCD, off = wgid / NXCD; wgid = (xcd < r ? xcd * (q + 1) : r * (q + 1) + (xcd - r) * q) + off; }
        const int nig = WGM * nN, gid = wgid / nig, fm = gid * WGM, gsz = (nM - fm) < WGM ? (nM - fm) : WGM;
        u.pm = fm + ((wgid % nig) % gsz); u.pn = (wgid % nig) / gsz; u.k0 = 0; u.nt = -1; u.flags = 0; return true;
    }
};
struct OffsetOrder {
    int nN, nwg, G, cc;
    __host__ __device__ void init(int M, int N, int G_, int c_, int off) { nN = N / BM; nwg = (M / BM) * nN; G = G_; cc = ((c_ - off) % G_ + G_) % G_; }
    __host__ __device__ __forceinline__ bool next(int i, Unit& u) const { const long L = (long)i * G + cc; if (L >= nwg) return false; u.pm = (int)L / nN; u.pn = (int)L % nN; u.k0 = 0; u.nt = -1; u.flags = 0; return true; }
};

struct CtxSplitOrder {
    StaticOrder lat; int nN, ntf;
    __host__ __device__ void init(int N, int K, int G_, int c_) { lat.init(NLAT, N, G_, c_); nN = N / BM; ntf = K / BK; }
    __host__ __device__ __forceinline__ bool next(int i, Unit& u) const {
        const long L = (long)i * lat.G + lat.c;
        int pm, pn, k0 = 0, ntq = -1, fl = 0;
        if (L < lat.nwg) {
            int wgid = (int)L; { const int q = lat.nwg / NXCD, r = lat.nwg % NXCD, xcd = wgid % NXCD, off = wgid / NXCD; wgid = (xcd < r ? xcd * (q + 1) : r * (q + 1) + (xcd - r) * q) + off; }
            const int nig = WGM * lat.nN, gid = wgid / nig, fm = gid * WGM, gsz = (lat.nM - fm) < WGM ? (lat.nM - fm) : WGM;
            pm = fm + ((wgid % nig) % gsz); pn = (wgid % nig) / gsz;
        } else {
            const int s = (int)(L - lat.nwg); if (s >= (NCTX / BM) * nN * 4) return false;
            const int cu_ = s >> 2, q = s & 3, base = (ntf / 8) * 2, extra = (ntf - 4 * base) / 2;
            pm = NLAT / BM + cu_ / nN; pn = cu_ % nN; ntq = base + (q < extra ? 2 : 0); k0 = (q * base + 2 * (q < extra ? q : extra)) * BK; fl = 1 | (q << 1);
        }
        u.pm = pm; u.pn = pn; u.k0 = k0; u.nt = ntq; u.flags = fl; return true;
    }
};

template <class Epi, class Sched, bool ALIGN_EPI>
__device__ __forceinline__ void gemm_phase(LAS unsigned char* lds, const Gemm g, const Sched& S, const Epi& E) {
    const int tid = fresh_tid(), wid = __builtin_amdgcn_readfirstlane(tid >> 6), lane = tid & 63, wr = wid >> 2, wc = wid & 3, fr = lane & 15, fq = lane >> 4;
    const int K = g.K, nt = K / BK;
    unsigned voffA[2], voffB[2];
#pragma unroll
    for (int i = 0; i < 2; ++i) { int R, C; stage_rc(tid * 16 + i * 8192, R, C);
        voffA[i] = (unsigned)(R * g.lda + C) * 2u; voffB[i] = (unsigned)(R * g.ldb + C) * 2u; }
    const size_t kstep = (size_t)(BK * 2);
    const size_t hstepA = (size_t)HALF * g.lda * 2, hstepB = (size_t)HALF * g.ldb * 2;
    const size_t tstepA = 2 * hstepA, tstepB = 2 * hstepB;
    const unsigned ldsw = (unsigned)wid * 1024u;
    const int aoff = lds_byte(wr * 64 + fr, fq * 8), boff = lds_byte(wc * 32 + fr, fq * 8);
#define PG8_SA(b, h) (((b) * 2 + (h)) * HTB)
#define PG8_SB(b, h) ((4 + (b) * 2 + (h)) * HTB)
#define PG8_STAGE(bufoff, gbase, voff) do { _Pragma("unroll") for (int _i = 0; _i < 2; ++_i) \
        __builtin_amdgcn_global_load_lds((const unsigned*)((const char*)(gbase) + (voff)[_i]), (LAS unsigned*)(lds + (bufoff) + ldsw + _i * 8192), 16, 0, 0); } while (0)
#define PG8_LDA(dst, b, h) do { _Pragma("unroll") for (int m = 0; m < 4; ++m) _Pragma("unroll") for (int k = 0; k < 2; ++k) dst[m][k] = *(const LAS bf16x8*)(lds + PG8_SA(b, h) + aoff + m * 2048 + k * 1024); } while (0)
#define PG8_LDB(dst, b, h) do { _Pragma("unroll") for (int n = 0; n < 2; ++n) _Pragma("unroll") for (int k = 0; k < 2; ++k) dst[n][k] = *(const LAS bf16x8*)(lds + PG8_SB(b, h) + boff + n * 2048 + k * 1024); } while (0)
#define PG8_MMA(ai, bj, At, Bt) do { __builtin_amdgcn_s_setprio(1); _Pragma("unroll") for (int m = 0; m < 4; ++m) _Pragma("unroll") for (int n = 0; n < 2; ++n) _Pragma("unroll") for (int k = 0; k < 2; ++k) \
        acc[ai][bj][m][n] = __builtin_amdgcn_mfma_f32_16x16x32_bf16(Bt[n][k], At[m][k], acc[ai][bj][m][n], 0, 0, 0); __builtin_amdgcn_s_setprio(0); } while (0)
#define PG8_WAIT_V(n) asm volatile("s_waitcnt vmcnt(" #n ")" ::: "memory")
#define PG8_WAIT_L(n) asm volatile("s_waitcnt lgkmcnt(" #n ")" ::: "memory")
#define PG8_BAR __builtin_amdgcn_s_barrier()
#define PG8_SCHED __builtin_amdgcn_sched_barrier(0)
    Unit cur, nxt; int ui = 0;
    if (!S.next(0, cur)) return;
    f32x4 acc[2][2][4][2];
#pragma unroll
    for (int a = 0; a < 2; ++a)
#pragma unroll
        for (int b = 0; b < 2; ++b)
#pragma unroll
            for (int m = 0; m < 4; ++m)
#pragma unroll
                for (int n = 0; n < 2; ++n) acc[a][b][m][n] = (f32x4){0.f, 0.f, 0.f, 0.f};
    bf16x8 At[4][2], B0[2][2], B1[2][2];
    const char* cA = (const char*)g.A + (size_t)cur.pm * tstepA + (size_t)cur.pn * g.a_pn_off * 2 + (size_t)cur.k0 * 2; const char* cB = (const char*)g.Bt + (size_t)cur.pn * tstepB + (size_t)cur.k0 * 2;
    PG8_STAGE(PG8_SB(0, 0), cB, voffB); PG8_STAGE(PG8_SB(0, 1), cB + hstepB, voffB); PG8_STAGE(PG8_SA(0, 0), cA, voffA); PG8_STAGE(PG8_SA(0, 1), cA + hstepA, voffA);
    if (wr == 1) PG8_BAR;
    PG8_WAIT_V(2); PG8_BAR;
    PG8_STAGE(PG8_SB(1, 0), cB + kstep, voffB); PG8_STAGE(PG8_SA(1, 0), cA + kstep, voffA); PG8_STAGE(PG8_SB(1, 1), cB + hstepB + kstep, voffB);
    PG8_WAIT_V(6); PG8_BAR;
    for (;;) {
        const bool has_next = S.next(ui + 1, nxt);
        const char* nA = has_next ? (const char*)g.A + (size_t)nxt.pm * tstepA + (size_t)nxt.pn * g.a_pn_off * 2 + (size_t)nxt.k0 * 2 : cA; const char* nB = has_next ? (const char*)g.Bt + (size_t)nxt.pn * tstepB + (size_t)nxt.k0 * 2 : cB;
        const int ntc = cur.nt < 0 ? nt : cur.nt;
        for (int t = 0; t < ntc; t += 2) {
            const bool last = (t == ntc - 2);
            const char* a1 = cA + (size_t)(t + 1) * kstep;
            const char* a2 = last ? nA : cA + (size_t)(t + 2) * kstep; const char* b2 = last ? nB : cB + (size_t)(t + 2) * kstep;
            const char* a3 = a2 + kstep; const char* b3 = b2 + kstep;
            PG8_LDB(B0, 0, 0); PG8_LDB(B1, 0, 1); PG8_SCHED; PG8_LDA(At, 0, 0); PG8_STAGE(PG8_SA(1, 1), a1 + hstepA, voffA);
            PG8_WAIT_V(8); PG8_WAIT_L(0); PG8_BAR; PG8_MMA(0, 0, At, B0); PG8_MMA(0, 1, At, B1); PG8_BAR; PG8_SCHED;
            PG8_LDA(At, 0, 1); PG8_STAGE(PG8_SB(0, 0), b2, voffB); PG8_STAGE(PG8_SB(0, 1), b2 + hstepB, voffB); PG8_STAGE(PG8_SA(0, 0), a2, voffA);
            PG8_WAIT_V(8); PG8_WAIT_L(0); PG8_BAR; PG8_MMA(1, 0, At, B0); PG8_MMA(1, 1, At, B1); PG8_BAR; PG8_SCHED;
            PG8_LDB(B0, 1, 0); PG8_LDB(B1, 1, 1); PG8_SCHED; PG8_LDA(At, 1, 0); PG8_STAGE(PG8_SA(0, 1), a2 + hstepA, voffA);
            PG8_WAIT_V(8); PG8_WAIT_L(0); PG8_BAR; PG8_MMA(0, 0, At, B0); PG8_MMA(0, 1, At, B1); PG8_BAR; PG8_SCHED;
            PG8_LDA(At, 1, 1); PG8_STAGE(PG8_SB(1, 0), b3, voffB); PG8_STAGE(PG8_SB(1, 1), b3 + hstepB, voffB); PG8_STAGE(PG8_SA(1, 0), a3, voffA);
            PG8_WAIT_V(8); PG8_WAIT_L(0); PG8_BAR; PG8_MMA(1, 0, At, B0); PG8_MMA(1, 1, At, B1); PG8_BAR; PG8_SCHED;
        }
        if constexpr (ALIGN_EPI) { if (wr == 0) PG8_BAR; }
        E(acc, cur, wr, wc, fr, fq);
        if (!has_next) break;
#pragma unroll
        for (int a = 0; a < 2; ++a)
#pragma unroll
            for (int b = 0; b < 2; ++b)
#pragma unroll
                for (int m = 0; m < 4; ++m)
#pragma unroll
                    for (int n = 0; n < 2; ++n) acc[a][b][m][n] = (f32x4){0.f, 0.f, 0.f, 0.f};
        cur = nxt; cA = nA; cB = nB; ++ui;
        if constexpr (ALIGN_EPI) { if (wr == 1) PG8_BAR; }
    }
    PG8_WAIT_V(0);
    if constexpr (!ALIGN_EPI) { if (wr == 0) PG8_BAR; }
    PG8_BAR;
#undef PG8_SA
#undef PG8_SB
#undef PG8_STAGE
#undef PG8_LDA
#undef PG8_LDB
#undef PG8_MMA
#undef PG8_WAIT_V
#undef PG8_WAIT_L
#undef PG8_BAR
#undef PG8_SCHED
}
}

typedef f32x4 Acc[2][2][4][2];

struct EpiInProj {
    bf16_t *Q1, *Q2, *K1c, *K2c, *VT, *TTl, *TTc, *UC; const float* rope;
    __device__ __forceinline__ void operator()(const Acc& acc, const pg8::Unit& u, int wr, int wc, int fr, int fq) const {
        const int pn = u.pn; const bool lat = u.pm < 64;
#pragma unroll
        for (int ai = 0; ai < 2; ++ai)
#pragma unroll
            for (int m = 0; m < 4; ++m) {
                const int row = u.pm * 256 + ai * 128 + wr * 64 + m * 16 + fr;
                int b, t; if (lat) { b = row >> 11; t = row & 2047; } else { const int rc = row - NLAT; b = rc >> 8; t = rc & 255; }
                const int pos = lat ? CTXL + t : t;
                if (pn < 4) {
                    bf16_t* dst;
                    if (pn == 0) dst = Q1 + (size_t)row * 256; else if (pn == 1) dst = Q2 + (size_t)row * 256;
                    else if (pn == 2) dst = K1c + ((size_t)b * KCAT + pos) * 256; else dst = K2c + ((size_t)b * KCAT + pos) * 256;
                    const float scale = pn < 2 ? QSCALE : 1.f;
                    f32x4 cs = {1.f, 1.f, 1.f, 1.f}, sn = {0.f, 0.f, 0.f, 0.f};
                    if (lat) { const int p = (wc & 1) ? (t & 63) : (t >> 6); cs = *(const f32x4*)(rope + p * 16 + 4 * fq); sn = *(const f32x4*)(rope + 1024 + p * 16 + 4 * fq); }
#pragma unroll
                    for (int bj = 0; bj < 2; ++bj) {
                        const f32x4 x1 = acc[ai][bj][m][0], x2 = acc[ai][bj][m][1];
                        const f32x4 o1 = (x1 * cs - x2 * sn) * scale, o2 = (x2 * cs + x1 * sn) * scale;
                        const int col = bj * 128 + wc * 32 + 4 * fq;
                        *(u32x2*)(dst + col) = pack4(o1); *(u32x2*)(dst + col + 16) = pack4(o2);
                    }
                } else if (pn < 6) {
#pragma unroll
                    for (int bj = 0; bj < 2; ++bj)
#pragma unroll
                        for (int n = 0; n < 2; ++n) {
                            bf16_t* dst = VT + ((size_t)(b * 4 + (pn - 4) * 2 + bj) * 128 + wc * 32 + n * 16 + 4 * fq) * KCAT + pos;
                            const f32x4 v = acc[ai][bj][m][n];
                            dst[0] = f2bf(v[0]); dst[KCAT] = f2bf(v[1]); dst[2 * KCAT] = f2bf(v[2]); dst[3 * KCAT] = f2bf(v[3]);
                        }
                } else if (pn < 8) {
                    const int s = pn - 6;
#pragma unroll
                    for (int bj = 0; bj < 2; ++bj)
#pragma unroll
                        for (int n = 0; n < 2; ++n) {
                            const int jf = bj * 128 + wc * 32 + n * 16 + 4 * fq;
                            const f32x4 v = acc[ai][bj][m][n];
                            if (lat) { bf16_t* dst = TTl + (((size_t)b * 256 + jf) * 2 + s) * SEQ + t; dst[0] = f2bf(v[0]); dst[2 * SEQ] = f2bf(v[1]); dst[4 * SEQ] = f2bf(v[2]); dst[6 * SEQ] = f2bf(v[3]); }
                            else { bf16_t* dst = TTc + (((size_t)b * 256 + jf) * 2 + s) * CTXL + t; dst[0] = f2bf(v[0]); dst[2 * CTXL] = f2bf(v[1]); dst[4 * CTXL] = f2bf(v[2]); dst[6 * CTXL] = f2bf(v[3]); }
                        }
                } else {
                    bf16_t* dst = UC + (size_t)row * 512 + (pn - 8) * 256 + wc * 32 + 4 * fq;
#pragma unroll
                    for (int bj = 0; bj < 2; ++bj)
#pragma unroll
                        for (int n = 0; n < 2; ++n) *(u32x2*)(dst + bj * 128 + n * 16) = pack4(acc[ai][bj][m][n]);
                }
            }
    }
};

struct EpiRes {
    const float* xin_lat; const float* xin_ctx; float* xout_lat; float* xout_ctx; const float* mod; int goff; float* pb;
    __device__ __forceinline__ void operator()(const Acc& acc, const pg8::Unit& u, int wr, int wc, int fr, int fq) const {
        const int tile0 = u.pm * 256, colb = u.pn * 256 + wc * 32 + 4 * fq, rloc = wr * 64 + fr;
        if (u.flags & 1) {
            float* pq = pb + ((size_t)(u.flags >> 1) * NCTX + (tile0 - NLAT) + rloc) * DM + colb;
#pragma unroll
            for (int ai = 0; ai < 2; ++ai)
#pragma unroll
                for (int m = 0; m < 4; ++m)
#pragma unroll
                    for (int bj = 0; bj < 2; ++bj)
#pragma unroll
                        for (int n = 0; n < 2; ++n) *(f32x4*)(pq + (size_t)(ai * 128 + m * 16) * DM + bj * 128 + n * 16) = acc[ai][bj][m][n];
            return;
        }
        const bool lat = tile0 < NLAT;
        const float* xi = (lat ? xin_lat + (size_t)tile0 * DM : xin_ctx + (size_t)(tile0 - NLAT) * DM) + (size_t)rloc * DM + colb;
        float* xo = (lat ? xout_lat + (size_t)tile0 * DM : xout_ctx + (size_t)(tile0 - NLAT) * DM) + (size_t)rloc * DM + colb;
        const float* gp = mod + (lat ? (tile0 >> 11) : 8) * 6144 + goff + colb;
        f32x4 gt[2][2];
#pragma unroll
        for (int bj = 0; bj < 2; ++bj)
#pragma unroll
            for (int n = 0; n < 2; ++n) gt[bj][n] = *(const f32x4*)(gp + bj * 128 + n * 16);
        f32x4 xv[2][2][2];
#define ER_LOAD(buf, g_) do { const float* xp_ = xi + (size_t)(((g_) >> 2) * 128 + ((g_) & 3) * 16) * DM; \
            _Pragma("unroll") for (int bj = 0; bj < 2; ++bj) _Pragma("unroll") for (int n = 0; n < 2; ++n) xv[buf][bj][n] = *(const f32x4*)(xp_ + bj * 128 + n * 16); } while (0)
        ER_LOAD(0, 0);
#pragma unroll
        for (int g_ = 0; g_ < 8; ++g_) {
            if (g_ + 1 < 8) ER_LOAD((g_ + 1) & 1, g_ + 1);
            float* xq = xo + (size_t)((g_ >> 2) * 128 + (g_ & 3) * 16) * DM;
#pragma unroll
            for (int bj = 0; bj < 2; ++bj)
#pragma unroll
                for (int n = 0; n < 2; ++n) *(f32x4*)(xq + bj * 128 + n * 16) = xv[g_ & 1][bj][n] + gt[bj][n] * acc[g_ >> 2][bj][g_ & 3][n];
        }
#undef ER_LOAD
    }
};

struct EpiFfn13 {
    bf16_t* ACT;
    __device__ __forceinline__ void operator()(const Acc& acc, const pg8::Unit& u, int wr, int wc, int fr, int fq) const {
#pragma unroll
        for (int ai = 0; ai < 2; ++ai)
#pragma unroll
            for (int m = 0; m < 4; ++m) {
                const int row = u.pm * 256 + ai * 128 + wr * 64 + m * 16 + fr;
#pragma unroll
                for (int bj = 0; bj < 2; ++bj) {
                    const f32x4 a = acc[ai][bj][m][0], b = acc[ai][bj][m][1]; f32x4 o;
#pragma unroll
                    for (int j = 0; j < 4; ++j) o[j] = a[j] * sigmoidf_(a[j]) * b[j];
                    *(u32x2*)(ACT + (size_t)row * DFF + 16 * (8 * u.pn + 4 * bj + wc) + 4 * fq) = pack4(o);
                }
            }
    }
};

struct EpiMix {
    bf16_t* out; int pitch, col0, tok_base, tok_pn_step, col_pn_step;
    __device__ __forceinline__ void operator()(const Acc& acc, const pg8::Unit& u, int wr, int wc, int fr, int fq) const {
#pragma unroll
        for (int ai = 0; ai < 2; ++ai)
#pragma unroll
            for (int m = 0; m < 4; ++m) {
                const int row = u.pm * 256 + ai * 128 + wr * 64 + m * 16 + fr;
                bf16_t* dst = out + (size_t)(tok_base + u.pn * tok_pn_step + row) * pitch + col0 + u.pn * col_pn_step + wc * 32 + 4 * fq;
#pragma unroll
                for (int bj = 0; bj < 2; ++bj)
#pragma unroll
                    for (int n = 0; n < 2; ++n) *(u32x2*)(dst + bj * 128 + n * 16) = pack4(acc[ai][bj][m][n]);
            }
    }
};

namespace att {
constexpr int VP = 144, OFF_K1 = 0, OFF_K2 = 8192, OFF_VT = 16384, BUFSZ = 16384 + 128 * VP;
struct Args { const bf16_t *Q1, *Q2, *K1c, *K2c, *VT; bf16_t* MIXA; const float* subln; float lam, omli; };

__device__ __forceinline__ void attn_unit(LAS unsigned char* lds, const Args& A, int b, int h, int qrow0, int nkt) {
    const int tid = fresh_tid(), lane = tid & 63, r32 = lane & 31, hi = lane >> 5;
    const int wid = __builtin_amdgcn_readfirstlane(tid >> 6), map = wid >> 2, qg = wid & 3;
    const bf16_t* Qm = map ? A.Q2 : A.Q1;
    bf16x8 qf[4];
    { const bf16_t* qp = Qm + (size_t)(qrow0 + qg * 32 + r32) * 256 + h * 64 + hi * 8;
#pragma unroll
      for (int d0 = 0; d0 < 4; ++d0) qf[d0] = *(const bf16x8*)(qp + d0 * 16); }
    const int key_s = tid >> 3, ch_s = tid & 7;
    const bf16_t* k1src = A.K1c + ((size_t)b * KCAT + key_s) * 256 + h * 64 + ch_s * 8;
    const bf16_t* k2src = A.K2c + ((size_t)b * KCAT + key_s) * 256 + h * 64 + ch_s * 8;
    const bf16_t* vsrc = A.VT + ((size_t)(b * 4 + h) * 128 + key_s) * KCAT + ch_s * 8;
    const int kdst = key_s * 128 + ((ch_s ^ ((key_s >> 1) & 7)) << 4), vdst = key_s * VP + 32 * (ch_s >> 1) + 8 * (ch_s & 1);
    u32x4 rk1[2], rk2[2], rv0[2], rv1[2];
#define ATT_LOAD(set, t) do { rk1[set] = *(const u32x4*)(k1src + (size_t)(t) * 64 * 256); rk2[set] = *(const u32x4*)(k2src + (size_t)(t) * 64 * 256); \
        rv0[set] = *(const u32x4*)(vsrc + (t) * 64); rv1[set] = *(const u32x4*)(vsrc + (size_t)64 * KCAT + (t) * 64); } while (0)
#define ATT_STORE(set, buf) do { LAS unsigned char* bb_ = lds + (buf) * BUFSZ; *(LAS u32x4*)(bb_ + OFF_K1 + kdst) = rk1[set]; *(LAS u32x4*)(bb_ + OFF_K2 + kdst) = rk2[set]; \
        *(LAS u32x2*)(bb_ + OFF_VT + vdst) = (u32x2){rv0[set].x, rv0[set].y}; *(LAS u32x2*)(bb_ + OFF_VT + vdst + 16) = (u32x2){rv0[set].z, rv0[set].w}; \
        *(LAS u32x2*)(bb_ + OFF_VT + 64 * VP + vdst) = (u32x2){rv1[set].x, rv1[set].y}; *(LAS u32x2*)(bb_ + OFF_VT + 64 * VP + vdst + 16) = (u32x2){rv1[set].z, rv1[set].w}; } while (0)
    constexpr float THR = 6.f;
    float mrun = 0.f, lrun = 0.f;
    f32x16 O[4];
#pragma unroll
    for (int i = 0; i < 4; ++i)
#pragma unroll
        for (int r = 0; r < 16; ++r) O[i][r] = 0.f;
    ATT_LOAD(0, 0); ATT_STORE(0, 0); __syncthreads();
    ATT_LOAD(1, 1);
    for (int t0 = 0; t0 < nkt; t0 += 2) {
#pragma unroll
      for (int tt = 0; tt < 2; ++tt) {
        const int t = t0 + tt, cur = tt;
        if (t + 2 < nkt) ATT_LOAD(tt, t + 2);
        LAS unsigned char* base = lds + cur * BUFSZ;
        LAS unsigned char* kb = base + (map ? OFF_K2 : OFF_K1) + r32 * 128;
        f32x16 s0, s1;
#pragma unroll
        for (int r = 0; r < 16; ++r) { s0[r] = -mrun; s1[r] = -mrun; }
#pragma unroll
        for (int d0 = 0; d0 < 4; ++d0) {
            const int chunk = ((2 * d0 + hi) ^ ((r32 >> 1) & 7)) << 4;
            const bf16x8 a0 = *(const LAS bf16x8*)(kb + chunk), a1 = *(const LAS bf16x8*)(kb + 32 * 128 + chunk);
            s0 = __builtin_amdgcn_mfma_f32_32x32x16_bf16(a0, qf[d0], s0, 0, 0, 0);
            s1 = __builtin_amdgcn_mfma_f32_32x32x16_bf16(a1, qf[d0], s1, 0, 0, 0);
        }
        asm volatile("s_nop 15\n\ts_nop 4" : "+v"(s0), "+v"(s1));
        LAS unsigned char* vb = base + OFF_VT + r32 * VP + 16 * hi;
        u32x4 vf[2][4];
#define ATT_LDV(slot, c) do { _Pragma("unroll") for (int dblk = 0; dblk < 4; ++dblk) { \
            vf[slot][dblk] = *(const LAS u32x4*)(vb + dblk * 32 * VP + 32 * (c)); } } while (0)
        ATT_LDV(0, 0);
        __builtin_amdgcn_sched_barrier(0);
        float rm = max3f(s0[0], s0[1], s1[0]), rm2 = max3f(s0[2], s0[3], s1[1]);
        rm = max3f(rm, s1[2], s1[3]);
#pragma unroll
        for (int r = 4; r < 16; r += 4) { rm = max3f(rm, s0[r], s0[r + 1]); rm2 = max3f(rm2, s0[r + 2], s0[r + 3]); rm = max3f(rm, s1[r], s1[r + 1]); rm2 = max3f(rm2, s1[r + 2], s1[r + 3]); }
        rm = fmaxf(rm, rm2);
        rm = fmaxf(rm, __shfl_xor(rm, 32));
        const bool need = (t == 0) || (rm > THR);
        if (__any(need)) {
            const float dlt = need ? rm : 0.f, alpha = (t == 0) ? 1.f : __builtin_amdgcn_exp2f(-dlt);
            mrun += dlt; lrun *= alpha;
            s0 = s0 - dlt; s1 = s1 - dlt;
#pragma unroll
            for (int i = 0; i < 4; ++i)
#pragma unroll
                for (int r = 0; r < 16; ++r) O[i][r] *= alpha;
        }
#pragma unroll
        for (int r = 0; r < 16; ++r) { s0[r] = __builtin_amdgcn_exp2f(s0[r]); s1[r] = __builtin_amdgcn_exp2f(s1[r]); }
        { const f32x16 t16 = s0 + s1;
          typedef float f32x8 __attribute__((ext_vector_type(8)));
          const f32x8 t8 = t16.lo + t16.hi; const f32x4 t4 = t8.lo + t8.hi;
          lrun += (t4[0] + t4[1]) + (t4[2] + t4[3]); }
        bf16x8 P[4];
        { u32x4 w;
          w.x = cvt_pk_bf16(s0[0], s0[1]); w.y = cvt_pk_bf16(s0[2], s0[3]); w.z = cvt_pk_bf16(s0[4], s0[5]); w.w = cvt_pk_bf16(s0[6], s0[7]); P[0] = __builtin_bit_cast(bf16x8, w);
          w.x = cvt_pk_bf16(s0[8], s0[9]); w.y = cvt_pk_bf16(s0[10], s0[11]); w.z = cvt_pk_bf16(s0[12], s0[13]); w.w = cvt_pk_bf16(s0[14], s0[15]); P[1] = __builtin_bit_cast(bf16x8, w);
          w.x = cvt_pk_bf16(s1[0], s1[1]); w.y = cvt_pk_bf16(s1[2], s1[3]); w.z = cvt_pk_bf16(s1[4], s1[5]); w.w = cvt_pk_bf16(s1[6], s1[7]); P[2] = __builtin_bit_cast(bf16x8, w);
          w.x = cvt_pk_bf16(s1[8], s1[9]); w.y = cvt_pk_bf16(s1[10], s1[11]); w.z = cvt_pk_bf16(s1[12], s1[13]); w.w = cvt_pk_bf16(s1[14], s1[15]); P[3] = __builtin_bit_cast(bf16x8, w); }
        __builtin_amdgcn_sched_barrier(0);
        ATT_LDV(1, 1);
        __builtin_amdgcn_sched_barrier(0);
#pragma unroll
        for (int dblk = 0; dblk < 4; ++dblk) O[dblk] = __builtin_amdgcn_mfma_f32_32x32x16_bf16(__builtin_bit_cast(bf16x8, vf[0][dblk]), P[0], O[dblk], 0, 0, 0);
        __builtin_amdgcn_sched_barrier(0);
        ATT_LDV(0, 2);
        __builtin_amdgcn_sched_barrier(0);
#pragma unroll
        for (int dblk = 0; dblk < 4; ++dblk) O[dblk] = __builtin_amdgcn_mfma_f32_32x32x16_bf16(__builtin_bit_cast(bf16x8, vf[1][dblk]), P[1], O[dblk], 0, 0, 0);
        __builtin_amdgcn_sched_barrier(0);
        ATT_LDV(1, 3);
        __builtin_amdgcn_sched_barrier(0);
#pragma unroll
        for (int dblk = 0; dblk < 4; ++dblk) O[dblk] = __builtin_amdgcn_mfma_f32_32x32x16_bf16(__builtin_bit_cast(bf16x8, vf[0][dblk]), P[2], O[dblk], 0, 0, 0);
        __builtin_amdgcn_sched_barrier(0);
#pragma unroll
        for (int dblk = 0; dblk < 4; ++dblk) O[dblk] = __builtin_amdgcn_mfma_f32_32x32x16_bf16(__builtin_bit_cast(bf16x8, vf[1][dblk]), P[3], O[dblk], 0, 0, 0);
#undef ATT_LDV
        if (t + 1 < nkt) ATT_STORE(tt ^ 1, tt ^ 1);
        asm volatile("s_waitcnt lgkmcnt(0)" ::: "memory"); __builtin_amdgcn_s_barrier(); asm volatile("" ::: "memory");
      }
    }
#undef ATT_LOAD
#undef ATT_STORE
    lrun += __shfl_xor(lrun, 32);
    const float inv = 1.f / lrun;
    LAS float* ex = (LAS float*)lds + qg * 4096;
    if (map == 1) {
#pragma unroll
        for (int i = 0; i < 4; ++i)
#pragma unroll
            for (int r = 0; r < 16; ++r) ex[(i * 16 + r) * 64 + lane] = O[i][r] * inv;
    }
    __syncthreads();
    if (map == 0) {
        float ss = 0.f;
#pragma unroll
        for (int i = 0; i < 4; ++i)
#pragma unroll
            for (int r = 0; r < 16; ++r) { const float o = O[i][r] * inv - A.lam * ex[(i * 16 + r) * 64 + lane]; O[i][r] = o; ss += o * o; }
        ss += __shfl_xor(ss, 32);
        const float rstd = __builtin_amdgcn_rsqf(ss * (1.f / 128.f) + EPSV) * A.omli;
        bf16_t* dst = A.MIXA + (size_t)(qrow0 + qg * 32 + r32) * DM + h * 128 + 4 * hi;
#pragma unroll
        for (int i = 0; i < 4; ++i)
#pragma unroll
            for (int rq = 0; rq < 4; ++rq) {
                const int d0 = 32 * i + 8 * rq;
                const f32x4 gg = *(const f32x4*)(A.subln + d0 + 4 * hi);
                f32x4 v = {O[i][4 * rq] * rstd * gg[0], O[i][4 * rq + 1] * rstd * gg[1], O[i][4 * rq + 2] * rstd * gg[2], O[i][4 * rq + 3] * rstd * gg[3]};
                *(u32x2*)(dst + d0) = pack4(v);
            }
    }
    __syncthreads();
}
}

__device__ __forceinline__ void conv_item(const Params& p, LAS unsigned char* lds, int l, int item, const bf16_t* UC, bf16_t* MIXA) {
    const int tid = fresh_tid(), lane = tid & 63, wid = tid >> 6, g = wid & 3, th = wid >> 2;
    const int ch = g * 64 + lane;
    int rowbase, t0, L;
    if (item < 256) { rowbase = (item >> 5) * SEQ; t0 = (item & 31) * 64; L = SEQ; }
    else { const int j = item - 256; rowbase = NLAT + (j >> 2) * CTXL; t0 = (j & 3) * 64; L = CTXL; }
    LAS float* zl = (LAS float*)lds;
    {
        u32x4 av[6], gv[6];
#pragma unroll
        for (int it = 0; it < 6; ++it) {
            int idx = tid + it * 512; idx = idx < 94 * 32 ? idx : 94 * 32 - 1;
            const int pr = idx >> 5, c8 = idx & 31; int pp = t0 - 15 + pr; pp = pp < 0 ? 0 : (pp >= L ? L - 1 : pp);
            const bf16_t* up = UC + (size_t)(rowbase + pp) * 512 + c8 * 8;
            av[it] = *(const u32x4*)up; gv[it] = *(const u32x4*)(up + 256);
        }
#pragma unroll
        for (int it = 0; it < 6; ++it) {
            const int idx = tid + it * 512;
            const int pr = idx >> 5, c8 = idx & 31, pp = t0 - 15 + pr;
            const float msk = (pp >= 0 && pp < L) ? 1.f : 0.f;
            f32x4 z0, z1;
#pragma unroll
            for (int q = 0; q < 4; ++q) {
                const float a_lo = __uint_as_float(av[it][q] << 16), a_hi = __uint_as_float(av[it][q] & 0xffff0000u);
                const float g_lo = __uint_as_float(gv[it][q] << 16), g_hi = __uint_as_float(gv[it][q] & 0xffff0000u);
                const float zlo = a_lo * sigmoidf_(g_lo) * msk, zhi = a_hi * sigmoidf_(g_hi) * msk;
                if (q < 2) { z0[2 * q] = zlo; z0[2 * q + 1] = zhi; } else { z1[2 * (q - 2)] = zlo; z1[2 * (q - 2) + 1] = zhi; }
            }
            if (idx < 94 * 32) { *(LAS f32x4*)(zl + pr * 256 + c8 * 8) = z0; *(LAS f32x4*)(zl + pr * 256 + c8 * 8 + 4) = z1; }
        }
    }
    __syncthreads();
    const int ts = t0 + th * 32;
    float w[31];
#pragma unroll
    for (int k = 0; k < 31; ++k) w[k] = p.conv_w[(size_t)l * 31 * 256 + k * 256 + ch];
    float o[32];
    const float bias = p.conv_b[l * 256 + ch];
    const LAS float* zp = zl + (th * 32) * 256 + ch;
    float z[62];
#pragma unroll
    for (int jj = 0; jj < 62; ++jj) z[jj] = zp[jj * 256];
#pragma unroll
    for (int i = 0; i < 32; ++i) {
        float acc = bias;
#pragma unroll
        for (int k = 0; k < 31; ++k) acc += w[k] * z[i + k];
        o[i] = acc;
    }
    const float lg = p.conv_ln_g[l * 256 + ch], lb = p.conv_ln_b[l * 256 + ch];
#pragma unroll
    for (int i = 0; i < 32; ++i) {
        const float mu = wave_sum(o[i]) * (1.f / 64.f);
        const float d = o[i] - mu;
        const float var = wave_sum(d * d) * (1.f / 64.f);
        const float zn = d * __builtin_amdgcn_rsqf(var + EPSV) * lg + lb;
        MIXA[(size_t)(rowbase + ts + i) * DM + 768 + ch] = f2bf(zn * sigmoidf_(zn));
    }
    __syncthreads();
}

__device__ __forceinline__ int drow_map(int mode, int n) {
    if (mode == 0) return n;
    if (mode == 1) return n < 1792 ? n : n + 256;
    if (mode == 2) return 32 * (n >> 4) + (n & 15);
    return 32 * (n >> 4) + 16 + (n & 15);
}
__device__ __forceinline__ void transpose_item(const float* W, int ldw, int K, bf16_t* WT, int mode, LAS float* scr, int kb, int nb, int lane) {
    const int k0 = 64 * kb, n0 = 32 * nb;
#pragma unroll 8
    for (int i = 0; i < 32; ++i) { const int kk = 2 * i + (lane >> 5); scr[kk * 33 + (lane & 31)] = W[(size_t)(k0 + kk) * ldw + n0 + (lane & 31)]; }
    asm volatile("s_waitcnt lgkmcnt(0)" ::: "memory");
    const int c = lane & 7;
#pragma unroll
    for (int j = 0; j < 4; ++j) { const int n = (lane >> 3) + 8 * j; const LAS float* s = scr + (8 * c) * 33 + n;
        u32x4 o; o.x = cvt_pk_bf16(s[0 * 33], s[1 * 33]); o.y = cvt_pk_bf16(s[2 * 33], s[3 * 33]); o.z = cvt_pk_bf16(s[4 * 33], s[5 * 33]); o.w = cvt_pk_bf16(s[6 * 33], s[7 * 33]);
        *(u32x4*)(WT + (size_t)drow_map(mode, n0 + n) * K + k0 + 8 * c) = o; }
    asm volatile("s_waitcnt lgkmcnt(0)" ::: "memory");
}

__device__ __forceinline__ void prep_phase(const Params& p, LAS unsigned char* lds) {
    const int tid = fresh_tid(), lane = tid & 63, wave = tid >> 6, G = gridDim.x;
    const int gw = blockIdx.x * 8 + wave, NGW = G * 8;
    const int gt = blockIdx.x * 512 + tid, NGT = G * 512;
    unsigned char* ws = p.ws;
    LAS float* tab = (LAS float*)(lds + 73728);
    LAS float* t64c = tab + 2048; LAS float* t64s = t64c + 64;
    for (int m = tid; m < 2048; m += 512) tab[m] = cospif((float)m * (1.f / 1024.f));
    if (tid < 64) { t64c[tid] = cospif((float)tid * (1.f / 32.f)); t64s[tid] = sinpif((float)tid * (1.f / 32.f)); }
    __syncthreads();
    if (gt < 1024) { const int pos = gt >> 4, f = gt & 15; const float inv = powf(10000.f, -(float)f / 16.f); const float ang = (float)pos * inv;
        float* rope = (float*)(ws + WS_ROPE); rope[gt] = cosf(ang); rope[1024 + gt] = sinf(ang); }
    {
        LAS float* scr = (LAS float*)(lds + wave * 8448);
        constexpr int I_IN = 16 * 72, I_OUT = 16 * 32, I_F1 = 16 * 88, I_F2 = 44 * 32, I_L = I_IN + I_OUT + 2 * I_F1 + I_F2;
        for (int it = gw; it < 2 * I_L; it += NGW) {
            const int l = it / I_L; int r = it % I_L;
            if (r < I_IN) { const int kb = r / 72, nb = r % 72; if (nb >= 48 && nb < 56) continue;
                transpose_item(p.w_in + (size_t)l * DM * INW_SRC, INW_SRC, DM, (bf16_t*)(ws + WS_WIN) + (size_t)l * INW * DM, 1, scr, kb, nb, lane); continue; }
            r -= I_IN;
            if (r < I_OUT) { transpose_item(p.w_out + (size_t)l * DM * DM, DM, DM, (bf16_t*)(ws + WS_WOUT) + (size_t)l * DM * DM, 0, scr, r / 32, r % 32, lane); continue; }
            r -= I_OUT;
            if (r < I_F1) { transpose_item(p.w_ffn1 + (size_t)l * DM * DFF, DFF, DM, (bf16_t*)(ws + WS_W13) + (size_t)l * N13 * DM, 2, scr, r / 88, r % 88, lane); continue; }
            r -= I_F1;
            if (r < I_F1) { transpose_item(p.w_ffn3 + (size_t)l * DM * DFF, DFF, DM, (bf16_t*)(ws + WS_W13) + (size_t)l * N13 * DM, 3, scr, r / 88, r % 88, lane); continue; }
            r -= I_F1;
            transpose_item(p.w_ffn2 + (size_t)l * DFF * DM, DM, DFF, (bf16_t*)(ws + WS_W2) + (size_t)l * DM * DFF, 0, scr, r / 32, r % 32, lane);
        }
    }
    {
        const float tcl = cospif((float)lane * (1.f / 32.f)), tsl = sinpif((float)lane * (1.f / 32.f));
        for (int it = gw; it < 2 * 4 * 16 * 16; it += NGW) {
            const int l = it >> 10, g = (it >> 8) & 3, kbk = (it >> 4) & 15, lqg = it & 15;
            const int k = kbk * 64 + lane;
            const float* wr_ = p.w_in + (size_t)l * DM * INW_SRC + (size_t)k * INW_SRC + 1536 + g * 64;
            float wv[64];
#pragma unroll
            for (int c4 = 0; c4 < 16; ++c4) { const f32x4 v = *(const f32x4*)(wr_ + 4 * c4); wv[4 * c4] = v[0]; wv[4 * c4 + 1] = v[1]; wv[4 * c4 + 2] = v[2]; wv[4 * c4 + 3] = v[3]; }
            bf16_t* wt = (bf16_t*)(ws + WS_WIN) + (size_t)l * INW * DM;
#pragma unroll 1
            for (int li = 0; li < 4; ++li) {
                const int lq = __builtin_amdgcn_readfirstlane(lqg * 4 + li);
                float ac = 0.f, as = 0.f;
#pragma unroll
                for (int c = 0; c < 64; ++c) {
                    const int m = (lq * c) & 63;
                    const float ct = __int_as_float(__builtin_amdgcn_readlane(__float_as_int(tcl), m)), st = __int_as_float(__builtin_amdgcn_readlane(__float_as_int(tsl), m));
                    ac += wv[c] * ct; as += wv[c] * st;
                }
                wt[(size_t)(1536 + g * 64 + lq) * DM + k] = f2bf(ac);
                wt[(size_t)(1536 + 256 + g * 64 + lq) * DM + k] = f2bf(as);
            }
        }
    }
    for (int e = gt; e < 2 * WSM_L; e += NGT) {
        const int l = e / WSM_L, r = e % WSM_L; float v;
        if (r < 256 * 512) { const int n = r >> 9, k = r & 255; const int g = n >> 6, d = n & 63, g2 = k >> 6, c = k & 63; v = (g == g2) ? p.w_fourier[(((size_t)l * 4 + g) * 64 + c) * 64 + d] : 0.f; }
        else { const int r2 = r - 256 * 512, n = r2 >> 8, k = r2 & 255; v = p.w_conv_out[((size_t)l * 256 + k) * 256 + n]; }
        ((bf16_t*)(ws + WS_WSM))[e] = f2bf(v);
    }
    {
        const float nl = 1.f / sqrtf(2048.f * 64.f), nc = 1.f / 128.f;
        for (int e = gt; e < 2048 * 4096 / 8; e += NGT) {
            const int k = e >> 9, col0 = (e & 511) * 8, s = col0 >> 11; float v[8];
#pragma unroll
            for (int j = 0; j < 8; ++j) { const int n = (col0 + j) & 2047, m = (k * n) & 2047; v[j] = s ? -tab[(m - 512) & 2047] * nl : tab[m] * nl; }
            u32x4 o; o.x = cvt_pk_bf16(v[0], v[1]); o.y = cvt_pk_bf16(v[2], v[3]); o.z = cvt_pk_bf16(v[4], v[5]); o.w = cvt_pk_bf16(v[6], v[7]);
            *(u32x4*)((bf16_t*)(ws + WS_DFTL) + (size_t)e * 8) = o;
        }
        for (int e = gt; e < 256 * 512 / 8; e += NGT) {
            const int k = e >> 6, col0 = (e & 63) * 8, s = col0 >> 8; float v[8];
#pragma unroll
            for (int j = 0; j < 8; ++j) { const int n = (col0 + j) & 255, m = ((k * n) & 255) * 8; v[j] = s ? -tab[(m - 512) & 2047] * nc : tab[m] * nc; }
            u32x4 o; o.x = cvt_pk_bf16(v[0], v[1]); o.y = cvt_pk_bf16(v[2], v[3]); o.z = cvt_pk_bf16(v[4], v[5]); o.w = cvt_pk_bf16(v[6], v[7]);
            *(u32x4*)((bf16_t*)(ws + WS_DFTC) + (size_t)e * 8) = o;
        }
    }
    for (int it = gw; it < 2 * 96 * 8; it += NGW) {
        const int l = it / 768, r = it % 768, cgp = r >> 3, kc = r & 7;
        const int col = cgp * 64 + lane, k0 = kc * 128;
        float sv[9][2];
#pragma unroll
        for (int b = 0; b < 9; ++b)
#pragma unroll
            for (int hh = 0; hh < 2; ++hh) { const int k = k0 + hh * 64 + lane; const float cv = (b < 8) ? p.c[b * DM + k] : p.c_ctx[k]; sv[b][hh] = cv * sigmoidf_(cv); }
        float ac[9];
#pragma unroll
        for (int b = 0; b < 9; ++b) ac[b] = 0.f;
        const float* wp = p.w_ada + ((size_t)l * DM + k0) * 6144 + col;
#pragma unroll
        for (int hh = 0; hh < 2; ++hh) {
#pragma unroll 8
            for (int kk = 0; kk < 64; ++kk) {
                const float wv = wp[(size_t)(hh * 64 + kk) * 6144];
#pragma unroll
                for (int b = 0; b < 9; ++b) ac[b] += __int_as_float(__builtin_amdgcn_readlane(__float_as_int(sv[b][hh]), kk)) * wv;
            }
        }
        const float bias = (kc == 0) ? p.b_ada[l * 6144 + col] : 0.f;
        float* mod = (float*)(ws + WS_MOD) + (size_t)l * 9 * 6144;
#pragma unroll
        for (int b = 0; b < 9; ++b) atomicAdd(mod + b * 6144 + col, ac[b] + bias);
    }
}

__device__ __forceinline__ void norm_phase(const float* xlat, const float* xctx, const float* gvec, const float* mod, int sh_off, int sc_off, bf16_t* H, int nrows,
                                           const float* part, const float* pgate, float* xctx_out) {
    const int tid = fresh_tid(), lane = tid & 63, gw = blockIdx.x * 8 + (tid >> 6), NGW = gridDim.x * 8;
    f32x4 vn[4];
#define NORM_LOADX(dst, r_) do { const int r__ = (r_); const float* xr_ = r__ < NLAT ? xlat + (size_t)r__ * DM : xctx + (size_t)(r__ - NLAT) * DM; \
        _Pragma("unroll") for (int j = 0; j < 4; ++j) dst[j] = *(const f32x4*)(xr_ + 4 * lane + 256 * j); } while (0)
    if (gw < nrows) NORM_LOADX(vn, gw);
    for (int row = gw; row < nrows; row += NGW) {
        const int bb = row < NLAT ? row >> 11 : 8;
        f32x4 v[4]; float ss = 0.f;
#pragma unroll
        for (int j = 0; j < 4; ++j) v[j] = vn[j];
        if (row + NGW < nrows) NORM_LOADX(vn, row + NGW);
        const float* mp = mod + bb * 6144;
        f32x4 gg[4], sc[4], sh[4];
#pragma unroll
        for (int j = 0; j < 4; ++j) { const int col = 4 * lane + 256 * j; gg[j] = *(const f32x4*)(gvec + col); sc[j] = *(const f32x4*)(mp + sc_off + col); sh[j] = *(const f32x4*)(mp + sh_off + col); }
        if (part != nullptr && row >= NLAT) {
#pragma unroll
            for (int j = 0; j < 4; ++j) {
                const size_t o = (size_t)(row - NLAT) * DM + 4 * lane + 256 * j;
                const f32x4 ps = (*(const f32x4*)(part + o) + *(const f32x4*)(part + (size_t)NCTX * DM + o)) + (*(const f32x4*)(part + (size_t)2 * NCTX * DM + o) + *(const f32x4*)(part + (size_t)3 * NCTX * DM + o));
                v[j] = v[j] + *(const f32x4*)(pgate + 4 * lane + 256 * j) * ps;
                *(f32x4*)(xctx_out + o) = v[j];
            }
        }
#pragma unroll
        for (int j = 0; j < 4; ++j) ss += (v[j][0] * v[j][0] + v[j][1] * v[j][1]) + (v[j][2] * v[j][2] + v[j][3] * v[j][3]);
        const float rstd = __builtin_amdgcn_rsqf(wave_sum(ss) * (1.f / DM) + EPSV);
#pragma unroll
        for (int j = 0; j < 4; ++j) {
            const int col = 4 * lane + 256 * j;
            const f32x4 y = (v[j] * rstd) * gg[j];
            const f32x4 hv = y * (sc[j] + 1.f) + sh[j];
            *(u32x2*)(H + (size_t)row * DM + col) = pack4(hv);
        }
    }
#undef NORM_LOADX
}

__global__ void __launch_bounds__(512, 2) fwd_kernel(Params p) {
    extern __shared__ __attribute__((aligned(16))) unsigned char lds_raw[];
    LAS unsigned char* lds = (LAS unsigned char*)lds_raw;
    cg::grid_group grid = cg::this_grid();
    const int G = gridDim.x, cu = blockIdx.x;
    unsigned char* ws = p.ws;
    bf16_t* H = (bf16_t*)(ws + WS_H);
    bf16_t* Q1 = (bf16_t*)(ws + WS_Q1); bf16_t* Q2 = (bf16_t*)(ws + WS_Q2); bf16_t* K1c = (bf16_t*)(ws + WS_K1); bf16_t* K2c = (bf16_t*)(ws + WS_K2);
    bf16_t* VT = (bf16_t*)(ws + WS_VT); bf16_t* TTl = (bf16_t*)(ws + WS_TTL); bf16_t* TTc = (bf16_t*)(ws + WS_TTC); bf16_t* UC = (bf16_t*)(ws + WS_UC);
    bf16_t* MIXA = (bf16_t*)(ws + WS_MIX); bf16_t* ACT = (bf16_t*)(ws + WS_ACT);
    float* PB1 = (float*)(ws + WS_R); float* PB2 = (float*)(ws + WS_R + 99 * MiB);
    bf16_t* FP = (bf16_t*)(ws + WS_H);
    float* XL = p.out; float* XC = (float*)(ws + WS_XCTX);
    const float* rope = (const float*)(ws + WS_ROPE);

    volatile LAS unsigned* bst = (volatile LAS unsigned*)(lds + LDS_BYTES - 64);
    if (threadIdx.x < 2) bst[threadIdx.x] = 0u;
    __syncthreads();
    const XcdBarrier xbar = xcd_barrier_post((unsigned*)(ws + WS_BAR), bst);
#define GSYNC() xcd_barrier(xbar)

    prep_phase(p, lds);
    grid.sync();

#pragma unroll 1
    for (int l = 0; l < 2; ++l) {
        const float* mod = (const float*)(ws + WS_MOD) + (size_t)l * 9 * 6144;
        const float* xin_l = l == 0 ? p.x : XL; const float* xin_c = l == 0 ? p.ctx : XC;
        const int mrows = l == 0 ? MTOT : NLAT;
        if (PROBE == 3) { for (int rep = 0; rep < 8; ++rep) GSYNC(); }
        norm_phase(xin_l, xin_c, p.norm1_g + l * DM, mod, 0, 1024, H, MTOT, l == 1 ? PB2 : nullptr, (const float*)(ws + WS_MOD) + 8 * 6144 + 5120, XC);
        GSYNC();
        for (int rep = 0; rep < (PROBE == 4 ? 2 : 1); ++rep) {
            if (rep) GSYNC();
            pg8::Gemm g{H, (const bf16_t*)(ws + WS_WIN) + (size_t)l * INW * DM, MTOT, INW, DM, DM, DM, 0};
            pg8::StaticOrder S; S.init(MTOT, INW, G, cu);
            EpiInProj E{Q1, Q2, K1c, K2c, VT, TTl, TTc, UC, rope};
            pg8::gemm_phase<EpiInProj, pg8::StaticOrder, true>(lds, g, S, E);
        }
        GSYNC();
        for (int rep = 0; rep < (PROBE == 1 ? 2 : 1); ++rep) {
            if (rep) GSYNC();
            const float li = 0.8f - 0.6f * __expf(-0.3f * (float)l);
            float lam;
            { const int lane = fresh_tid() & 63;
              const float s1 = wave_sum(p.lam_q1[l * 64 + lane] * p.lam_k1[l * 64 + lane]), s2 = wave_sum(p.lam_q2[l * 64 + lane] * p.lam_k2[l * 64 + lane]);
              lam = expf(s1) - expf(s2) + li; }
            att::Args A{Q1, Q2, K1c, K2c, VT, MIXA, p.subln_g + l * 128, lam, 1.f - li};
            const int n_att = 512 + (l == 0 ? 64 : 0);
            for (int u = cu; u < n_att; u += G) {
                if (u < 512) att::attn_unit(lds, A, u >> 6, (u >> 4) & 3, (u >> 6) * SEQ + (u & 15) * 128, 36);
                else { const int v = u - 512; att::attn_unit(lds, A, v >> 3, (v >> 1) & 3, NLAT + (v >> 3) * CTXL + (v & 1) * 128, 4); }
            }
#pragma unroll 1
            for (int hf = 0; hf < 2; ++hf) {
                pg8::Gemm g{(const bf16_t*)(ws + WS_DFTL) + hf * 2048, TTl + hf * 2048, 2048, 2048, 2048, 4096, 4096, 0};
                pg8::OffsetOrder S; S.init(2048, 2048, G, cu, 64 + 64 * hf);
                EpiMix E{FP, 512, hf * 256, 0, SEQ, 0};
                pg8::gemm_phase<EpiMix, pg8::OffsetOrder, true>(lds, g, S, E);
            }
            if (l == 0) {
#pragma unroll 1
                for (int hf = 0; hf < 2; ++hf) {
                    pg8::Gemm g{(const bf16_t*)(ws + WS_DFTC) + hf * 256, TTc + hf * 256, 256, 2048, 256, 512, 512, 0};
                    pg8::OffsetOrder S; S.init(256, 2048, G, cu, 192 + 8 * hf);
                    EpiMix E{FP, 512, hf * 256, NLAT, CTXL, 0};
                    pg8::gemm_phase<EpiMix, pg8::OffsetOrder, true>(lds, g, S, E);
                }
            }
            const int n_conv = l == 0 ? 288 : 256;
            if (G == 256) {
                const int sidx = cu < 64 ? cu : (cu >= 192 ? cu - 128 : -1);
                if (sidx >= 0) for (int it = sidx; it < n_conv; it += 128) conv_item(p, lds, l, it, UC, MIXA);
            } else for (int it = cu; it < n_conv; it += G) conv_item(p, lds, l, it, UC, MIXA);
        }
        GSYNC();
        {
            const bf16_t* wsm = (const bf16_t*)(ws + WS_WSM) + (size_t)l * WSM_L;
            {
                pg8::Gemm g{FP, wsm, mrows, 256, 512, 512, 512, 0};
                pg8::OffsetOrder S; S.init(mrows, 256, G, cu, 0);
                EpiMix E{MIXA, DM, 512, 0, 0, 0};
                pg8::gemm_phase<EpiMix, pg8::OffsetOrder, true>(lds, g, S, E);
            }
            {
                pg8::Gemm g{MIXA + 768, wsm + 256 * 512, mrows, 256, 256, DM, 256, 0};
                pg8::OffsetOrder S; S.init(mrows, 256, G, cu, 72);
                EpiMix E{MIXA, DM, 768, 0, 0, 0};
                pg8::gemm_phase<EpiMix, pg8::OffsetOrder, true>(lds, g, S, E);
            }
        }
        GSYNC();
        {
            pg8::Gemm g{MIXA, (const bf16_t*)(ws + WS_WOUT) + (size_t)l * DM * DM, mrows, DM, DM, DM, DM, 0};
            EpiRes E{xin_l, xin_c, XL, XC, mod, 2048, PB1};
            if (l == 0) { pg8::CtxSplitOrder S; S.init(DM, DM, G, cu); pg8::gemm_phase<EpiRes, pg8::CtxSplitOrder, true>(lds, g, S, E); }
            else { pg8::StaticOrder S; S.init(mrows, DM, G, cu); pg8::gemm_phase<EpiRes, pg8::StaticOrder, true>(lds, g, S, E); }
        }
        GSYNC();
        norm_phase(XL, l == 0 ? p.ctx : XC, p.norm2_g + l * DM, mod, 3072, 4096, H, mrows, l == 0 ? PB1 : nullptr, mod + 8 * 6144 + 2048, XC);
        GSYNC();
        for (int rep = 0; rep < (PROBE == 2 ? 2 : 1); ++rep) {
            if (rep) GSYNC();
            pg8::Gemm g{H, (const bf16_t*)(ws + WS_W13) + (size_t)l * N13 * DM, mrows, N13, DM, DM, DM, 0};
            pg8::StaticOrder S; S.init(mrows, N13, G, cu);
            EpiFfn13 E{ACT};
            pg8::gemm_phase<EpiFfn13, pg8::StaticOrder, true>(lds, g, S, E);
        }
        GSYNC();
        {
            pg8::Gemm g{ACT, (const bf16_t*)(ws + WS_W2) + (size_t)l * DM * DFF, mrows, DM, DFF, DFF, DFF, 0};
            EpiRes E{XL, XC, XL, XC, mod, 5120, PB2};
            if (l == 0) { pg8::CtxSplitOrder S; S.init(DM, DFF, G, cu); pg8::gemm_phase<EpiRes, pg8::CtxSplitOrder, true>(lds, g, S, E); }
            else { pg8::StaticOrder S; S.init(mrows, DM, G, cu); pg8::gemm_phase<EpiRes, pg8::StaticOrder, true>(lds, g, S, E); }
        }
        GSYNC();
    }
    {
        const int tid = fresh_tid(), lane = tid & 63, gw = blockIdx.x * 8 + (tid >> 6), NGW = gridDim.x * 8;
        f32x4 gg[4], vn[4];
#pragma unroll
        for (int j = 0; j < 4; ++j) { gg[j] = *(const f32x4*)(p.final_g + 4 * lane + 256 * j); vn[j] = *(const f32x4*)(XL + (size_t)gw * DM + 4 * lane + 256 * j); }
        for (int row = gw; row < NLAT; row += NGW) {
            float* xr = XL + (size_t)row * DM;
            f32x4 v[4]; float ss = 0.f;
#pragma unroll
            for (int j = 0; j < 4; ++j) { v[j] = vn[j]; ss += (v[j][0] * v[j][0] + v[j][1] * v[j][1]) + (v[j][2] * v[j][2] + v[j][3] * v[j][3]); }
            if (row + NGW < NLAT) {
#pragma unroll
                for (int j = 0; j < 4; ++j) vn[j] = *(const f32x4*)(xr + (size_t)NGW * DM + 4 * lane + 256 * j);
            }
            const float rstd = __builtin_amdgcn_rsqf(wave_sum(ss) * (1.f / DM) + EPSV);
#pragma unroll
            for (int j = 0; j < 4; ++j) { const int col = 4 * lane + 256 * j; *(f32x4*)(xr + col) = (v[j] * rstd) * gg[j]; }
        }
    }
}

extern "C" void kernel_launch(void* const* d_in, const int* in_sizes, int n_in, void* d_out, int out_size, void* d_ws, size_t ws_size, hipStream_t stream) {
    static int grid_blocks = 0;
    if (grid_blocks == 0) {
        if (n_in != 25 || ws_size < WS_END) { fprintf(stderr, "kernel_launch: unexpected n_in %d / ws %zu\n", n_in, ws_size); grid_blocks = -1; return; }
        int dev = 0, cus = 0, per_cu = 0;
        (void)hipGetDevice(&dev);
        (void)hipDeviceGetAttribute(&cus, hipDeviceAttributeMultiprocessorCount, dev);
        if (hipFuncSetAttribute((const void*)fwd_kernel, hipFuncAttributeMaxDynamicSharedMemorySize, LDS_BYTES) != hipSuccess) fprintf(stderr, "kernel_launch: hipFuncSetAttribute failed\n");
        if (hipOccupancyMaxActiveBlocksPerMultiprocessor(&per_cu, (const void*)fwd_kernel, 512, LDS_BYTES) != hipSuccess || per_cu < 1) { fprintf(stderr, "kernel_launch: occupancy query gave %d\n", per_cu); per_cu = 1; }
        (void)hipGetLastError();
        grid_blocks = cus * per_cu;
    }
    if (grid_blocks < 0) return;
    Params p{};
    const float** pp = (const float**)&p;
    for (int i = 0; i < 25; ++i) pp[i] = (const float*)d_in[i];
    p.out = (float*)d_out; p.ws = (unsigned char*)d_ws;
    (void)hipMemsetAsync((unsigned char*)d_ws + WS_MOD, 0, ZERO_BYTES, stream);
    void* args[] = {&p};
    hipError_t e = hipLaunchCooperativeKernel((const void*)fwd_kernel, dim3(grid_blocks), dim3(512), args, LDS_BYTES, stream);
    if (e != hipSuccess) fprintf(stderr, "cooperative launch failed: %s (grid %d)\n", hipGetErrorString(e), grid_blocks);
}
```

```cpp
#include <hip/hip_runtime.h>
#include <hip/hip_cooperative_groups.h>
#include <cstdint>
#include <cstdio>
namespace cg = cooperative_groups;
#ifndef PROBE
#define PROBE 0
#endif

#define LAS __attribute__((address_space(3)))
typedef unsigned short bf16_t;
typedef short bf16x8 __attribute__((ext_vector_type(8)));
typedef float f32x4 __attribute__((ext_vector_type(4)));
typedef float f32x16 __attribute__((ext_vector_type(16)));
typedef unsigned u32x4 __attribute__((ext_vector_type(4)));
typedef unsigned u32x2 __attribute__((ext_vector_type(2)));

constexpr int NB = 8, SEQ = 2048, DM = 1024, CTXL = 256, NLAT = NB * SEQ, NCTX = NB * CTXL, MTOT = NLAT + NCTX;
constexpr int INW = 2560, INW_SRC = 2304, DFF = 2816, N13 = 2 * DFF, KCAT = CTXL + SEQ;
constexpr float EPSV = 1e-6f;
constexpr float QSCALE = 0.125f * 1.4426950408889634f;
constexpr int LDS_BYTES = 147456;
constexpr int XCD_BAR_WORDS_C = 3456;

constexpr size_t MiB = 1u << 20;
constexpr size_t WS_WIN = 0, WS_WOUT = 10 * MiB, WS_W13 = 14 * MiB, WS_W2 = 36 * MiB, WS_WSM = 47 * MiB, WS_DFTL = 48 * MiB, WS_DFTC = 64 * MiB;
constexpr size_t WS_MOD = 64 * MiB + 256 * 1024, WS_ROPE = 64 * MiB + 768 * 1024, WS_XCTX = 65 * MiB, WS_H = 73 * MiB, WS_R = 109 * MiB;
constexpr size_t WS_Q1 = WS_R, WS_Q2 = WS_R + 9 * MiB, WS_K1 = WS_R + 18 * MiB, WS_K2 = WS_R + 27 * MiB, WS_VT = WS_R + 36 * MiB, WS_TTL = WS_R + 54 * MiB,
                 WS_TTC = WS_R + 70 * MiB, WS_UC = WS_R + 72 * MiB, WS_MIX = WS_R + 90 * MiB, WS_ACT = WS_R, WS_END = WS_R + 131 * MiB;
constexpr size_t MOD_BYTES = 2 * 9 * 6144 * 4;
constexpr int WSM_L = 256 * 512 + 256 * 256;
constexpr size_t WS_BAR = 64 * MiB + 704 * 1024, ZERO_BYTES = WS_BAR + XCD_BAR_WORDS_C * 4 - WS_MOD;

struct Params {
    const float *x, *c, *ctx, *c_ctx, *w_ada, *b_ada, *norm1_g, *norm2_g, *w_in, *lam_q1, *lam_k1, *lam_q2, *lam_k2, *subln_g, *w_fourier, *conv_w, *conv_b,
        *conv_ln_g, *conv_ln_b, *w_conv_out, *w_out, *w_ffn1, *w_ffn3, *w_ffn2, *final_g;
    float* out; unsigned char* ws;
};

__device__ __forceinline__ unsigned cvt_pk_bf16(float lo, float hi) { unsigned r; asm("v_cvt_pk_bf16_f32 %0, %1, %2" : "=v"(r) : "v"(lo), "v"(hi)); return r; }
__device__ __forceinline__ u32x2 pack4(f32x4 v) { u32x2 w; w.x = cvt_pk_bf16(v[0], v[1]); w.y = cvt_pk_bf16(v[2], v[3]); return w; }
__device__ __forceinline__ bf16_t f2bf(float v) { return (bf16_t)(cvt_pk_bf16(v, 0.f) & 0xffffu); }
__device__ __forceinline__ float wave_sum(float v) {
#pragma unroll
    for (int o = 1; o < 64; o <<= 1) v += __shfl_xor(v, o);
    return v;
}
__device__ __forceinline__ int fresh_tid() { int t = threadIdx.x; asm volatile("" : "+v"(t)); return t; }
__device__ __forceinline__ float max3f(float a, float b, float c) { float r; asm("v_max3_f32 %0, %1, %2, %3" : "=v"(r) : "v"(a), "v"(b), "v"(c)); return r; }
__device__ __forceinline__ float sigmoidf_(float v) { return __builtin_amdgcn_rcpf(1.f + __expf(-v)); }


#define XB_TMO      128
#define XB_XCNT(j)  (256  + 64 * (j))
#define XB_XSUB(j)  (1280 + 64 * (j))
#define XB_XGEN(j)  (2304 + 64 * (j))
#define XB_TOP      3328
#define XB_TOPGEN   3392
#define XCD_BAR_WORDS 3456
#define XB_SPIN_CAP (1u << 18)
__device__ __forceinline__ unsigned xb_ld(unsigned* p)              { return __hip_atomic_load(p, __ATOMIC_RELAXED, __HIP_MEMORY_SCOPE_AGENT); }
__device__ __forceinline__ unsigned xb_add(unsigned* p, unsigned v) { return __hip_atomic_fetch_add(p, v, __ATOMIC_RELAXED, __HIP_MEMORY_SCOPE_AGENT); }
__device__ __forceinline__ unsigned xb_xcc_id() { return (unsigned)__builtin_amdgcn_s_getreg((3 << 11) | 20) & 0xFu; }
#define XB_SPIN(cond, bar) do { unsigned _sp = 0; while (cond) { __builtin_amdgcn_s_sleep(1); \
    if ((++_sp & 255u) == 0u) { if (xb_ld(&(bar)[XB_TMO])) break; if (_sp > XB_SPIN_CAP) { atomicAdd(&(bar)[XB_TMO], 1u); break; } } } } while (0)
struct XcdBarrier { unsigned* bar; unsigned x; volatile LAS unsigned* st; };
__device__ __forceinline__ XcdBarrier xcd_barrier_post(unsigned* bar, volatile LAS unsigned* st) {
    XcdBarrier b; b.bar = bar; b.x = xb_xcc_id(); b.st = st;
    if (threadIdx.x == 0) (void)xb_add(&bar[XB_XCNT(b.x)], 1u);
    return b;
}
__device__ __forceinline__ void xcd_barrier_complete(unsigned* bar, unsigned x, unsigned& nloc, unsigned& nx) {
    const unsigned G = gridDim.x * gridDim.y * gridDim.z;
    unsigned sum, cnt, mine, sp = 0u;
    for (;;) {
        sum = 0u; cnt = 0u; mine = 0u;
#pragma unroll
        for (unsigned j = 0; j < 16; ++j) { const unsigned c = xb_ld(&bar[XB_XCNT(j)]); sum += c; cnt += (c > 0u) ? 1u : 0u; mine = (j == x) ? c : mine; }
        if (sum == G) break;
        __builtin_amdgcn_s_sleep(1);
        if ((++sp & 255u) == 0u) { if (xb_ld(&bar[XB_TMO])) break; if (sp > XB_SPIN_CAP) { atomicAdd(&bar[XB_TMO], 1u); break; } }
    }
    nloc = mine > 0u ? mine : 1u; nx = cnt > 0u ? cnt : 1u;
}
__device__ __forceinline__ void xcd_barrier(const XcdBarrier& b) {
    asm volatile("s_waitcnt vmcnt(0)" ::: "memory");
    __syncthreads();
    if (threadIdx.x == 0) {
        unsigned* bar = b.bar;
        __builtin_amdgcn_s_waitcnt(0);
        unsigned nloc = b.st[0], nx = b.st[1];
        if (nloc == 0u) { xcd_barrier_complete(bar, b.x, nloc, nx); b.st[0] = nloc; b.st[1] = nx; }
        const unsigned old = xb_add(&bar[XB_XSUB(b.x)], 1u);
        const unsigned gen = old / nloc;
        if (old + 1u == (gen + 1u) * nloc) {
            __builtin_amdgcn_fence(__ATOMIC_RELEASE, "agent");
            asm volatile("s_waitcnt vmcnt(0)" ::: "memory");
            const unsigned og = xb_add(&bar[XB_TOP], 1u);
            const unsigned tg = og / nx;
            if (og + 1u == (tg + 1u) * nx) xb_add(&bar[XB_TOPGEN], 1u);
            else XB_SPIN(xb_ld(&bar[XB_TOPGEN]) == tg, bar);
            __builtin_amdgcn_fence(__ATOMIC_ACQUIRE, "agent");
            xb_add(&bar[XB_XGEN(b.x)], 1u);
            asm volatile("s_waitcnt vmcnt(0)" ::: "memory");
        } else {
            XB_SPIN(xb_ld(&bar[XB_XGEN(b.x)]) == gen, bar);
            __builtin_amdgcn_fence(__ATOMIC_ACQUIRE, "agent");
            asm volatile("s_waitcnt vmcnt(0)" ::: "memory");
        }
    }
    __syncthreads();
}

namespace pg8 {
constexpr int BM = 256, BK = 64, HALF = 128, HTB = HALF * BK * 2, STAGE_BYTES = 8 * HTB, NXCD = 8, WGM = 8;
__host__ __device__ __forceinline__ int lds_byte(int r, int c) { const int st = (r >> 4) * 2 + (c >> 5), rr = r & 15, cc = c & 31, ob = rr * 64 + cc * 2; return st * 1024 + (ob ^ (((ob >> 9) & 1) << 5)); }
__host__ __device__ __forceinline__ void stage_rc(int b, int& R, int& C) { const int st = b / 1024, sb = b % 1024, swz = sb ^ (((sb >> 9) & 1) << 5); R = (st >> 1) * 16 + swz / 64; C = (st & 1) * 32 + (swz % 64) / 2; }

struct Unit { int pm, pn, k0, nt, flags; };
struct Gemm { const bf16_t* A; const bf16_t* Bt; int M, N, K, lda, ldb, a_pn_off; };

struct StaticOrder {
    int nM, nN, nwg, G, c;
    __host__ __device__ void init(int M, int N, int G_, int c_) { nM = M / BM; nN = N / BM; nwg = nM * nN; G = G_; c = c_; }
    __host__ __device__ __forceinline__ bool next(int i, Unit& u) const {
        const long L = (long)i * G + c; if (L >= nwg) return false;
        int wgid = (int)L; { const int q = nwg / NXCD, r = nwg % NXCD, xcd = wgid % NXCD, off = wgid / NXCD; wgid = (xcd < r ? xcd * (q + 1) : r * (q + 1) + (xcd - r) * q) + off; }
        const int nig = WGM * nN, gid = wgid / nig, fm = gid * WGM, gsz = (nM - fm) < WGM ? (nM - fm) : WGM;
        u.pm = fm + ((wgid % nig) % gsz); u.pn = (wgid % nig) / gsz; u.k0 = 0; u.nt = -1; u.flags = 0; return true;
    }
};
struct OffsetOrder {
    int nN, nwg, G, cc;
    __host__ __device__ void init(int M, int N, int G_, int c_, int off) { nN = N / BM; nwg = (M / BM) * nN; G = G_; cc = ((c_ - off) % G_ + G_) % G_; }
    __host__ __device__ __forceinline__ bool next(int i, Unit& u) const { const long L = (long)i * G + cc; if (L >= nwg) return false; u.pm = (int)L / nN; u.pn = (int)L % nN; u.k0 = 0; u.nt = -1; u.flags = 0; return true; }
};

struct CtxSplitOrder {
    StaticOrder lat; int nN, ntf;
    __host__ __device__ void init(int N, int K, int G_, int c_) { lat.init(NLAT, N, G_, c_); nN = N / BM; ntf = K / BK; }
    __host__ __device__ __forceinline__ bool next(int i, Unit& u) const {
        const long L = (long)i * lat.G + lat.c;
        int pm, pn, k0 = 0, ntq = -1, fl = 0;
        if (L < lat.nwg) {
            int wgid = (int)L; { const int q = lat.nwg / NXCD, r = lat.nwg % NXCD, xcd = wgid % NXCD, off = wgid / NXCD; wgid = (xcd < r ? xcd * (q + 1) : r * (q + 1) + (xcd - r) * q) + off; }
            const int nig = WGM * lat.nN, gid = wgid / nig, fm = gid * WGM, gsz = (lat.nM - fm) < WGM ? (lat.nM - fm) : WGM;
            pm = fm + ((wgid % nig) % gsz); pn = (wgid % nig) / gsz;
        } else {
            const int s = (int)(L - lat.nwg); if (s >= (NCTX / BM) * nN * 4) return false;
            const int cu_ = s >> 2, q = s & 3, base = (ntf / 8) * 2, extra = (ntf - 4 * base) / 2;
            pm = NLAT / BM + cu_ / nN; pn = cu_ % nN; ntq = base + (q < extra ? 2 : 0); k0 = (q * base + 2 * (q < extra ? q : extra)) * BK; fl = 1 | (q << 1);
        }
        u.pm = pm; u.pn = pn; u.k0 = k0; u.nt = ntq; u.flags = fl; return true;
    }
};

template <class Epi, class Sched, bool ALIGN_EPI>
__device__ __forceinline__ void gemm_phase(LAS unsigned char* lds, const Gemm g, const Sched& S, const Epi& E) {
    const int tid = fresh_tid(), wid = __builtin_amdgcn_readfirstlane(tid >> 6), lane = tid & 63, wr = wid >> 2, wc = wid & 3, fr = lane & 15, fq = lane >> 4;
    const int K = g.K, nt = K / BK;
    unsigned voffA[2], voffB[2];
#pragma unroll
    for (int i = 0; i < 2; ++i) { int R, C; stage_rc(tid * 16 + i * 8192, R, C);
        voffA[i] = (unsigned)(R * g.lda + C) * 2u; voffB[i] = (unsigned)(R * g.ldb + C) * 2u; }
    const size_t kstep = (size_t)(BK * 2);
    const size_t hstepA = (size_t)HALF * g.lda * 2, hstepB = (size_t)HALF * g.ldb * 2;
    const size_t tstepA = 2 * hstepA, tstepB = 2 * hstepB;
    const unsigned ldsw = (unsigned)wid * 1024u;
    const int aoff = lds_byte(wr * 64 + fr, fq * 8), boff = lds_byte(wc * 32 + fr, fq * 8);
#define PG8_SA(b, h) (((b) * 2 + (h)) * HTB)
#define PG8_SB(b, h) ((4 + (b) * 2 + (h)) * HTB)
#define PG8_STAGE(bufoff, gbase, voff) do { _Pragma("unroll") for (int _i = 0; _i < 2; ++_i) \
        __builtin_amdgcn_global_load_lds((const unsigned*)((const char*)(gbase) + (voff)[_i]), (LAS unsigned*)(lds + (bufoff) + ldsw + _i * 8192), 16, 0, 0); } while (0)
#define PG8_LDA(dst, b, h) do { _Pragma("unroll") for (int m = 0; m < 4; ++m) _Pragma("unroll") for (int k = 0; k < 2; ++k) dst[m][k] = *(const LAS bf16x8*)(lds + PG8_SA(b, h) + aoff + m * 2048 + k * 1024); } while (0)
#define PG8_LDB(dst, b, h) do { _Pragma("unroll") for (int n = 0; n < 2; ++n) _Pragma("unroll") for (int k = 0; k < 2; ++k) dst[n][k] = *(const LAS bf16x8*)(lds + PG8_SB(b, h) + boff + n * 2048 + k * 1024); } while (0)
#define PG8_MMA(ai, bj, At, Bt) do { __builtin_amdgcn_s_setprio(1); _Pragma("unroll") for (int m = 0; m < 4; ++m) _Pragma("unroll") for (int n = 0; n < 2; ++n) _Pragma("unroll") for (int k = 0; k < 2; ++k) \
        acc[ai][bj][m][n] = __builtin_amdgcn_mfma_f32_16x16x32_bf16(Bt[n][k], At[m][k], acc[ai][bj][m][n], 0, 0, 0); __builtin_amdgcn_s_setprio(0); } while (0)
#define PG8_WAIT_V(n) asm volatile("s_waitcnt vmcnt(" #n ")" ::: "memory")
#define PG8_WAIT_L(n) asm volatile("s_waitcnt lgkmcnt(" #n ")" ::: "memory")
#define PG8_BAR __builtin_amdgcn_s_barrier()
#define PG8_SCHED __builtin_amdgcn_sched_barrier(0)
    Unit cur, nxt; int ui = 0;
    if (!S.next(0, cur)) return;
    f32x4 acc[2][2][4][2];
#pragma unroll
    for (int a = 0; a < 2; ++a)
#pragma unroll
        for (int b = 0; b < 2; ++b)
#pragma unroll
            for (int m = 0; m < 4; ++m)
#pragma unroll
                for (int n = 0; n < 2; ++n) acc[a][b][m][n] = (f32x4){0.f, 0.f, 0.f, 0.f};
    bf16x8 At[4][2], B0[2][2], B1[2][2];
    const char* cA = (const char*)g.A + (size_t)cur.pm * tstepA + (size_t)cur.pn * g.a_pn_off * 2 + (size_t)cur.k0 * 2; const char* cB = (const char*)g.Bt + (size_t)cur.pn * tstepB + (size_t)cur.k0 * 2;
    PG8_STAGE(PG8_SB(0, 0), cB, voffB); PG8_STAGE(PG8_SB(0, 1), cB + hstepB, voffB); PG8_STAGE(PG8_SA(0, 0), cA, voffA); PG8_STAGE(PG8_SA(0, 1), cA + hstepA, voffA);
    if (wr == 1) PG8_BAR;
    PG8_WAIT_V(2); PG8_BAR;
    PG8_STAGE(PG8_SB(1, 0), cB + kstep, voffB); PG8_STAGE(PG8_SA(1, 0), cA + kstep, voffA); PG8_STAGE(PG8_SB(1, 1), cB + hstepB + kstep, voffB);
    PG8_WAIT_V(6); PG8_BAR;
    for (;;) {
        const bool has_next = S.next(ui + 1, nxt);
        const char* nA = has_next ? (const char*)g.A + (size_t)nxt.pm * tstepA + (size_t)nxt.pn * g.a_pn_off * 2 + (size_t)nxt.k0 * 2 : cA; const char* nB = has_next ? (const char*)g.Bt + (size_t)nxt.pn * tstepB + (size_t)nxt.k0 * 2 : cB;
        const int ntc = cur.nt < 0 ? nt : cur.nt;
        for (int t = 0; t < ntc; t += 2) {
            const bool last = (t == ntc - 2);
            const char* a1 = cA + (size_t)(t + 1) * kstep;
            const char* a2 = last ? nA : cA + (size_t)(t + 2) * kstep; const char* b2 = last ? nB : cB + (size_t)(t + 2) * kstep;
            const char* a3 = a2 + kstep; const char* b3 = b2 + kstep;
            PG8_LDB(B0, 0, 0); PG8_LDB(B1, 0, 1); PG8_SCHED; PG8_LDA(At, 0, 0); PG8_STAGE(PG8_SA(1, 1), a1 + hstepA, voffA);
            PG8_WAIT_V(8); PG8_WAIT_L(0); PG8_BAR; PG8_MMA(0, 0, At, B0); PG8_MMA(0, 1, At, B1); PG8_BAR; PG8_SCHED;
            PG8_LDA(At, 0, 1); PG8_STAGE(PG8_SB(0, 0), b2, voffB); PG8_STAGE(PG8_SB(0, 1), b2 + hstepB, voffB); PG8_STAGE(PG8_SA(0, 0), a2, voffA);
            PG8_WAIT_V(8); PG8_WAIT_L(0); PG8_BAR; PG8_MMA(1, 0, At, B0); PG8_MMA(1, 1, At, B1); PG8_BAR; PG8_SCHED;
            PG8_LDB(B0, 1, 0); PG8_LDB(B1, 1, 1); PG8_SCHED; PG8_LDA(At, 1, 0); PG8_STAGE(PG8_SA(0, 1), a2 + hstepA, voffA);
            PG8_WAIT_V(8); PG8_WAIT_L(0); PG8_BAR; PG8_MMA(0, 0, At, B0); PG8_MMA(0, 1, At, B1); PG8_BAR; PG8_SCHED;
            PG8_LDA(At, 1, 1); PG8_STAGE(PG8_SB(1, 0), b3, voffB); PG8_STAGE(PG8_SB(1, 1), b3 + hstepB, voffB); PG8_STAGE(PG8_SA(1, 0), a3, voffA);
            PG8_WAIT_V(8); PG8_WAIT_L(0); PG8_BAR; PG8_MMA(1, 0, At, B0); PG8_MMA(1, 1, At, B1); PG8_BAR; PG8_SCHED;
        }
        if constexpr (ALIGN_EPI) { if (wr == 0) PG8_BAR; }
        E(acc, cur, wr, wc, fr, fq);
        if (!has_next) break;
#pragma unroll
        for (int a = 0; a < 2; ++a)
#pragma unroll
            for (int b = 0; b < 2; ++b)
#pragma unroll
                for (int m = 0; m < 4; ++m)
#pragma unroll
                    for (int n = 0; n < 2; ++n) acc[a][b][m][n] = (f32x4){0.f, 0.f, 0.f, 0.f};
        cur = nxt; cA = nA; cB = nB; ++ui;
        if constexpr (ALIGN_EPI) { if (wr == 1) PG8_BAR; }
    }
    PG8_WAIT_V(0);
    if constexpr (!ALIGN_EPI) { if (wr == 0) PG8_BAR; }
    PG8_BAR;
#undef PG8_SA
#undef PG8_SB
#undef PG8_STAGE
#undef PG8_LDA
#undef PG8_LDB
#undef PG8_MMA
#undef PG8_WAIT_V
#undef PG8_WAIT_L
#undef PG8_BAR
#undef PG8_SCHED
}
}

typedef f32x4 Acc[2][2][4][2];

struct EpiInProj {
    bf16_t *Q1, *Q2, *K1c, *K2c, *VT, *TTl, *TTc, *UC; const float* rope;
    __device__ __forceinline__ void operator()(const Acc& acc, const pg8::Unit& u, int wr, int wc, int fr, int fq) const {
        const int pn = u.pn; const bool lat = u.pm < 64;
#pragma unroll
        for (int ai = 0; ai < 2; ++ai)
#pragma unroll
            for (int m = 0; m < 4; ++m) {
                const int row = u.pm * 256 + ai * 128 + wr * 64 + m * 16 + fr;
                int b, t; if (lat) { b = row >> 11; t = row & 2047; } else { const int rc = row - NLAT; b = rc >> 8; t = rc & 255; }
                const int pos = lat ? CTXL + t : t;
                if (pn < 4) {
                    bf16_t* dst;
                    if (pn == 0) dst = Q1 + (size_t)row * 256; else if (pn == 1) dst = Q2 + (size_t)row * 256;
                    else if (pn == 2) dst = K1c + ((size_t)b * KCAT + pos) * 256; else dst = K2c + ((size_t)b * KCAT + pos) * 256;
                    const float scale = pn < 2 ? QSCALE : 1.f;
                    f32x4 cs = {1.f, 1.f, 1.f, 1.f}, sn = {0.f, 0.f, 0.f, 0.f};
                    if (lat) { const int p = (wc & 1) ? (t & 63) : (t >> 6); cs = *(const f32x4*)(rope + p * 16 + 4 * fq); sn = *(const f32x4*)(rope + 1024 + p * 16 + 4 * fq); }
#pragma unroll
                    for (int bj = 0; bj < 2; ++bj) {
                        const f32x4 x1 = acc[ai][bj][m][0], x2 = acc[ai][bj][m][1];
                        const f32x4 o1 = (x1 * cs - x2 * sn) * scale, o2 = (x2 * cs + x1 * sn) * scale;
                        const int col = bj * 128 + wc * 32 + 4 * fq;
                        *(u32x2*)(dst + col) = pack4(o1); *(u32x2*)(dst + col + 16) = pack4(o2);
                    }
                } else if (pn < 6) {
#pragma unroll
                    for (int bj = 0; bj < 2; ++bj)
#pragma unroll
                        for (int n = 0; n < 2; ++n) {
                            bf16_t* dst = VT + ((size_t)(b * 4 + (pn - 4) * 2 + bj) * 128 + wc * 32 + n * 16 + 4 * fq) * KCAT + pos;
                            const f32x4 v = acc[ai][bj][m][n];
                            dst[0] = f2bf(v[0]); dst[KCAT] = f2bf(v[1]); dst[2 * KCAT] = f2bf(v[2]); dst[3 * KCAT] = f2bf(v[3]);
                        }
                } else if (pn < 8) {
                    const int s = pn - 6;
#pragma unroll
                    for (int bj = 0; bj < 2; ++bj)
#pragma unroll
                        for (int n = 0; n < 2; ++n) {
                            const int jf = bj * 128 + wc * 32 + n * 16 + 4 * fq;
                            const f32x4 v = acc[ai][bj][m][n];
                            if (lat) { bf16_t* dst = TTl + (((size_t)b * 256 + jf) * 2 + s) * SEQ + t; dst[0] = f2bf(v[0]); dst[2 * SEQ] = f2bf(v[1]); dst[4 * SEQ] = f2bf(v[2]); dst[6 * SEQ] = f2bf(v[3]); }
                            else { bf16_t* dst = TTc + (((size_t)b * 256 + jf) * 2 + s) * CTXL + t; dst[0] = f2bf(v[0]); dst[2 * CTXL] = f2bf(v[1]); dst[4 * CTXL] = f2bf(v[2]); dst[6 * CTXL] = f2bf(v[3]); }
                        }
                } else {
                    bf16_t* dst = UC + (size_t)row * 512 + (pn - 8) * 256 + wc * 32 + 4 * fq;
#pragma unroll
                    for (int bj = 0; bj < 2; ++bj)
#pragma unroll
                        for (int n = 0; n < 2; ++n) *(u32x2*)(dst + bj * 128 + n * 16) = pack4(acc[ai][bj][m][n]);
                }
            }
    }
};

struct EpiRes {
    const float* xin_lat; const float* xin_ctx; float* xout_lat; float* xout_ctx; const float* mod; int goff; float* pb;
    __device__ __forceinline__ void operator()(const Acc& acc, const pg8::Unit& u, int wr, int wc, int fr, int fq) const {
        const int tile0 = u.pm * 256, colb = u.pn * 256 + wc * 32 + 4 * fq, rloc = wr * 64 + fr;
        if (u.flags & 1) {
            float* pq = pb + ((size_t)(u.flags >> 1) * NCTX + (tile0 - NLAT) + rloc) * DM + colb;
#pragma unroll
            for (int ai = 0; ai < 2; ++ai)
#pragma unroll
                for (int m = 0; m < 4; ++m)
#pragma unroll
                    for (int bj = 0; bj < 2; ++bj)
#pragma unroll
                        for (int n = 0; n < 2; ++n) *(f32x4*)(pq + (size_t)(ai * 128 + m * 16) * DM + bj * 128 + n * 16) = acc[ai][bj][m][n];
            return;
        }
        const bool lat = tile0 < NLAT;
        const float* xi = (lat ? xin_lat + (size_t)tile0 * DM : xin_ctx + (size_t)(tile0 - NLAT) * DM) + (size_t)rloc * DM + colb;
        float* xo = (lat ? xout_lat + (size_t)tile0 * DM : xout_ctx + (size_t)(tile0 - NLAT) * DM) + (size_t)rloc * DM + colb;
        const float* gp = mod + (lat ? (tile0 >> 11) : 8) * 6144 + goff + colb;
        f32x4 gt[2][2];
#pragma unroll
        for (int bj = 0; bj < 2; ++bj)
#pragma unroll
            for (int n = 0; n < 2; ++n) gt[bj][n] = *(const f32x4*)(gp + bj * 128 + n * 16);
        f32x4 xv[2][2][2];
#define ER_LOAD(buf, g_) do { const float* xp_ = xi + (size_t)(((g_) >> 2) * 128 + ((g_) & 3) * 16) * DM; \
            _Pragma("unroll") for (int bj = 0; bj < 2; ++bj) _Pragma("unroll") for (int n = 0; n < 2; ++n) xv[buf][bj][n] = *(const f32x4*)(xp_ + bj * 128 + n * 16); } while (0)
        ER_LOAD(0, 0);
#pragma unroll
        for (int g_ = 0; g_ < 8; ++g_) {
            if (g_ + 1 < 8) ER_LOAD((g_ + 1) & 1, g_ + 1);
            float* xq = xo + (size_t)((g_ >> 2) * 128 + (g_ & 3) * 16) * DM;
#pragma unroll
            for (int bj = 0; bj < 2; ++bj)
#pragma unroll
                for (int n = 0; n < 2; ++n) *(f32x4*)(xq + bj * 128 + n * 16) = xv[g_ & 1][bj][n] + gt[bj][n] * acc[g_ >> 2][bj][g_ & 3][n];
        }
#undef ER_LOAD
    }
};

struct EpiFfn13 {
    bf16_t* ACT;
    __device__ __forceinline__ void operator()(const Acc& acc, const pg8::Unit& u, int wr, int wc, int fr, int fq) const {
#pragma unroll
        for (int ai = 0; ai < 2; ++ai)
#pragma unroll
            for (int m = 0; m < 4; ++m) {
                const int row = u.pm * 256 + ai * 128 + wr * 64 + m * 16 + fr;
                u32x4 w;
#pragma unroll
                for (int bj = 0; bj < 2; ++bj) {
                    const f32x4 a = acc[ai][bj][m][0], b = acc[ai][bj][m][1]; f32x4 o;
#pragma unroll
                    for (int j = 0; j < 4; ++j) o[j] = a[j] * sigmoidf_(a[j]) * b[j];
                    const u32x2 pk = pack4(o);
                    if (bj == 0) { w.x = pk.x; w.y = pk.y; } else { w.z = pk.x; w.w = pk.y; }
                }
                *(u32x4*)(ACT + (size_t)row * DFF + 128 * u.pn + 32 * wc + 8 * fq) = w;
            }
    }
};

struct EpiMix {
    bf16_t* out; int pitch, col0, tok_base, tok_pn_step, col_pn_step;
    __device__ __forceinline__ void operator()(const Acc& acc, const pg8::Unit& u, int wr, int wc, int fr, int fq) const {
#pragma unroll
        for (int ai = 0; ai < 2; ++ai)
#pragma unroll
            for (int m = 0; m < 4; ++m) {
                const int row = u.pm * 256 + ai * 128 + wr * 64 + m * 16 + fr;
                bf16_t* dst = out + (size_t)(tok_base + u.pn * tok_pn_step + row) * pitch + col0 + u.pn * col_pn_step + wc * 32 + 4 * fq;
#pragma unroll
                for (int bj = 0; bj < 2; ++bj)
#pragma unroll
                    for (int n = 0; n < 2; ++n) *(u32x2*)(dst + bj * 128 + n * 16) = pack4(acc[ai][bj][m][n]);
            }
    }
};

namespace att {
constexpr int VP = 144, OFF_K1 = 0, OFF_K2 = 8192, OFF_VT = 16384, BUFSZ = 16384 + 128 * VP;
struct Args { const bf16_t *Q1, *Q2, *K1c, *K2c, *VT; bf16_t* MIXA; const float* subln; float lam, omli; };

__device__ __forceinline__ void attn_unit(LAS unsigned char* lds, const Args& A, int b, int h, int qrow0, int nkt) {
    const int tid = fresh_tid(), lane = tid & 63, r32 = lane & 31, hi = lane >> 5;
    const int wid = __builtin_amdgcn_readfirstlane(tid >> 6), map = wid >> 2, qg = wid & 3;
    const bf16_t* Qm = map ? A.Q2 : A.Q1;
    bf16x8 qf[4];
    { const bf16_t* qp = Qm + (size_t)(qrow0 + qg * 32 + r32) * 256 + h * 64 + hi * 8;
#pragma unroll
      for (int d0 = 0; d0 < 4; ++d0) qf[d0] = *(const bf16x8*)(qp + d0 * 16); }
    const int key_s = tid >> 3, ch_s = tid & 7;
    const bf16_t* k1src = A.K1c + ((size_t)b * KCAT + key_s) * 256 + h * 64 + ch_s * 8;
    const bf16_t* k2src = A.K2c + ((size_t)b * KCAT + key_s) * 256 + h * 64 + ch_s * 8;
    const bf16_t* vsrc = A.VT + ((size_t)(b * 4 + h) * 128 + key_s) * KCAT + ch_s * 8;
    const int kdst = key_s * 128 + ((ch_s ^ ((key_s >> 1) & 7)) << 4), vdst = key_s * VP + 32 * (ch_s >> 1) + 8 * (ch_s & 1);
    u32x4 rk1[2], rk2[2], rv0[2], rv1[2];
#define ATT_LOAD(set, t) do { rk1[set] = *(const u32x4*)(k1src + (size_t)(t) * 64 * 256); rk2[set] = *(const u32x4*)(k2src + (size_t)(t) * 64 * 256); \
        rv0[set] = *(const u32x4*)(vsrc + (t) * 64); rv1[set] = *(const u32x4*)(vsrc + (size_t)64 * KCAT + (t) * 64); } while (0)
#define ATT_STORE(set, buf) do { LAS unsigned char* bb_ = lds + (buf) * BUFSZ; *(LAS u32x4*)(bb_ + OFF_K1 + kdst) = rk1[set]; *(LAS u32x4*)(bb_ + OFF_K2 + kdst) = rk2[set]; \
        *(LAS u32x2*)(bb_ + OFF_VT + vdst) = (u32x2){rv0[set].x, rv0[set].y}; *(LAS u32x2*)(bb_ + OFF_VT + vdst + 16) = (u32x2){rv0[set].z, rv0[set].w}; \
        *(LAS u32x2*)(bb_ + OFF_VT + 64 * VP + vdst) = (u32x2){rv1[set].x, rv1[set].y}; *(LAS u32x2*)(bb_ + OFF_VT + 64 * VP + vdst + 16) = (u32x2){rv1[set].z, rv1[set].w}; } while (0)
    constexpr float THR = 6.f;
    float mrun = 0.f, lrun = 0.f;
    f32x16 O[4];
#pragma unroll
    for (int i = 0; i < 4; ++i)
#pragma unroll
        for (int r = 0; r < 16; ++r) O[i][r] = 0.f;
    ATT_LOAD(0, 0); ATT_STORE(0, 0); __syncthreads();
    ATT_LOAD(1, 1);
    for (int t0 = 0; t0 < nkt; t0 += 2) {
#pragma unroll
      for (int tt = 0; tt < 2; ++tt) {
        const int t = t0 + tt, cur = tt;
        if (t + 2 < nkt) ATT_LOAD(tt, t + 2);
        LAS unsigned char* base = lds + cur * BUFSZ;
        LAS unsigned char* kb = base + (map ? OFF_K2 : OFF_K1) + r32 * 128;
        f32x16 s0, s1;
#pragma unroll
        for (int r = 0; r < 16; ++r) { s0[r] = -mrun; s1[r] = -mrun; }
#pragma unroll
        for (int d0 = 0; d0 < 4; ++d0) {
            const int chunk = ((2 * d0 + hi) ^ ((r32 >> 1) & 7)) << 4;
            const bf16x8 a0 = *(const LAS bf16x8*)(kb + chunk), a1 = *(const LAS bf16x8*)(kb + 32 * 128 + chunk);
            s0 = __builtin_amdgcn_mfma_f32_32x32x16_bf16(a0, qf[d0], s0, 0, 0, 0);
            s1 = __builtin_amdgcn_mfma_f32_32x32x16_bf16(a1, qf[d0], s1, 0, 0, 0);
        }
        asm volatile("s_nop 15\n\ts_nop 4" : "+v"(s0), "+v"(s1));
        LAS unsigned char* vb = base + OFF_VT + r32 * VP + 16 * hi;
        u32x4 vf[2][4];
#define ATT_LDV(slot, c) do { _Pragma("unroll") for (int dblk = 0; dblk < 4; ++dblk) { \
            vf[slot][dblk] = *(const LAS u32x4*)(vb + dblk * 32 * VP + 32 * (c)); } } while (0)
        ATT_LDV(0, 0);
        __builtin_amdgcn_sched_barrier(0);
        float rm = max3f(s0[0], s0[1], s1[0]), rm2 = max3f(s0[2], s0[3], s1[1]);
        rm = max3f(rm, s1[2], s1[3]);
#pragma unroll
        for (int r = 4; r < 16; r += 4) { rm = max3f(rm, s0[r], s0[r + 1]); rm2 = max3f(rm2, s0[r + 2], s0[r + 3]); rm = max3f(rm, s1[r], s1[r + 1]); rm2 = max3f(rm2, s1[r + 2], s1[r + 3]); }
        rm = fmaxf(rm, rm2);
        rm = fmaxf(rm, __shfl_xor(rm, 32));
        const bool need = (t == 0) || (rm > THR);
        if (__any(need)) {
            const float dlt = need ? rm : 0.f, alpha = (t == 0) ? 1.f : __builtin_amdgcn_exp2f(-dlt);
            mrun += dlt; lrun *= alpha;
            s0 = s0 - dlt; s1 = s1 - dlt;
#pragma unroll
            for (int i = 0; i < 4; ++i)
#pragma unroll
                for (int r = 0; r < 16; ++r) O[i][r] *= alpha;
        }
#pragma unroll
        for (int r = 0; r < 16; ++r) { s0[r] = __builtin_amdgcn_exp2f(s0[r]); s1[r] = __builtin_amdgcn_exp2f(s1[r]); }
        { const f32x16 t16 = s0 + s1;
          typedef float f32x8 __attribute__((ext_vector_type(8)));
          const f32x8 t8 = t16.lo + t16.hi; const f32x4 t4 = t8.lo + t8.hi;
          lrun += (t4[0] + t4[1]) + (t4[2] + t4[3]); }
        bf16x8 P[4];
        { u32x4 w;
          w.x = cvt_pk_bf16(s0[0], s0[1]); w.y = cvt_pk_bf16(s0[2], s0[3]); w.z = cvt_pk_bf16(s0[4], s0[5]); w.w = cvt_pk_bf16(s0[6], s0[7]); P[0] = __builtin_bit_cast(bf16x8, w);
          w.x = cvt_pk_bf16(s0[8], s0[9]); w.y = cvt_pk_bf16(s0[10], s0[11]); w.z = cvt_pk_bf16(s0[12], s0[13]); w.w = cvt_pk_bf16(s0[14], s0[15]); P[1] = __builtin_bit_cast(bf16x8, w);
          w.x = cvt_pk_bf16(s1[0], s1[1]); w.y = cvt_pk_bf16(s1[2], s1[3]); w.z = cvt_pk_bf16(s1[4], s1[5]); w.w = cvt_pk_bf16(s1[6], s1[7]); P[2] = __builtin_bit_cast(bf16x8, w);
          w.x = cvt_pk_bf16(s1[8], s1[9]); w.y = cvt_pk_bf16(s1[10], s1[11]); w.z = cvt_pk_bf16(s1[12], s1[13]); w.w = cvt_pk_bf16(s1[14], s1[15]); P[3] = __builtin_bit_cast(bf16x8, w); }
        __builtin_amdgcn_sched_barrier(0);
        ATT_LDV(1, 1);
        __builtin_amdgcn_sched_barrier(0);
#pragma unroll
        for (int dblk = 0; dblk < 4; ++dblk) O[dblk] = __builtin_amdgcn_mfma_f32_32x32x16_bf16(__builtin_bit_cast(bf16x8, vf[0][dblk]), P[0], O[dblk], 0, 0, 0);
        __builtin_amdgcn_sched_barrier(0);
        ATT_LDV(0, 2);
        __builtin_amdgcn_sched_barrier(0);
#pragma unroll
        for (int dblk = 0; dblk < 4; ++dblk) O[dblk] = __builtin_amdgcn_mfma_f32_32x32x16_bf16(__builtin_bit_cast(bf16x8, vf[1][dblk]), P[1], O[dblk], 0, 0, 0);
        __builtin_amdgcn_sched_barrier(0);
        ATT_LDV(1, 3);
        __builtin_amdgcn_sched_barrier(0);
#pragma unroll
        for (int dblk = 0; dblk < 4; ++dblk) O[dblk] = __builtin_amdgcn_mfma_f32_32x32x16_bf16(__builtin_bit_cast(bf16x8, vf[0][dblk]), P[2], O[dblk], 0, 0, 0);
        __builtin_amdgcn_sched_barrier(0);
#pragma unroll
        for (int dblk = 0; dblk < 4; ++dblk) O[dblk] = __builtin_amdgcn_mfma_f32_32x32x16_bf16(__builtin_bit_cast(bf16x8, vf[1][dblk]), P[3], O[dblk], 0, 0, 0);
#undef ATT_LDV
        if (t + 1 < nkt) ATT_STORE(tt ^ 1, tt ^ 1);
        asm volatile("s_waitcnt lgkmcnt(0)" ::: "memory"); __builtin_amdgcn_s_barrier(); asm volatile("" ::: "memory");
      }
    }
#undef ATT_LOAD
#undef ATT_STORE
    lrun += __shfl_xor(lrun, 32);
    const float inv = 1.f / lrun;
    LAS float* ex = (LAS float*)lds + qg * 4096;
    if (map == 1) {
#pragma unroll
        for (int i = 0; i < 4; ++i)
#pragma unroll
            for (int r = 0; r < 16; ++r) ex[(i * 16 + r) * 64 + lane] = O[i][r] * inv;
    }
    __syncthreads();
    if (map == 0) {
        float ss = 0.f;
#pragma unroll
        for (int i = 0; i < 4; ++i)
#pragma unroll
            for (int r = 0; r < 16; ++r) { const float o = O[i][r] * inv - A.lam * ex[(i * 16 + r) * 64 + lane]; O[i][r] = o; ss += o * o; }
        ss += __shfl_xor(ss, 32);
        const float rstd = __builtin_amdgcn_rsqf(ss * (1.f / 128.f) + EPSV) * A.omli;
        bf16_t* dst = A.MIXA + (size_t)(qrow0 + qg * 32 + r32) * DM + h * 128 + 4 * hi;
#pragma unroll
        for (int i = 0; i < 4; ++i)
#pragma unroll
            for (int rq = 0; rq < 4; ++rq) {
                const int d0 = 32 * i + 8 * rq;
                const f32x4 gg = *(const f32x4*)(A.subln + d0 + 4 * hi);
                f32x4 v = {O[i][4 * rq] * rstd * gg[0], O[i][4 * rq + 1] * rstd * gg[1], O[i][4 * rq + 2] * rstd * gg[2], O[i][4 * rq + 3] * rstd * gg[3]};
                *(u32x2*)(dst + d0) = pack4(v);
            }
    }
    __syncthreads();
}
}

__device__ __forceinline__ void conv_item(const Params& p, LAS unsigned char* lds, int l, int item, const bf16_t* UC, bf16_t* MIXA) {
    const int tid = fresh_tid(), lane = tid & 63, wid = tid >> 6, g = wid & 3, th = wid >> 2;
    const int ch = g * 64 + lane;
    int rowbase, t0, L;
    if (item < 256) { rowbase = (item >> 5) * SEQ; t0 = (item & 31) * 64; L = SEQ; }
    else { const int j = item - 256; rowbase = NLAT + (j >> 2) * CTXL; t0 = (j & 3) * 64; L = CTXL; }
    LAS float* zl = (LAS float*)lds;
    {
        u32x4 av[6], gv[6];
#pragma unroll
        for (int it = 0; it < 6; ++it) {
            int idx = tid + it * 512; idx = idx < 94 * 32 ? idx : 94 * 32 - 1;
            const int pr = idx >> 5, c8 = idx & 31; int pp = t0 - 15 + pr; pp = pp < 0 ? 0 : (pp >= L ? L - 1 : pp);
            const bf16_t* up = UC + (size_t)(rowbase + pp) * 512 + c8 * 8;
            av[it] = *(const u32x4*)up; gv[it] = *(const u32x4*)(up + 256);
        }
#pragma unroll
        for (int it = 0; it < 6; ++it) {
            const int idx = tid + it * 512;
            const int pr = idx >> 5, c8 = idx & 31, pp = t0 - 15 + pr;
            const float msk = (pp >= 0 && pp < L) ? 1.f : 0.f;
            f32x4 z0, z1;
#pragma unroll
            for (int q = 0; q < 4; ++q) {
                const float a_lo = __uint_as_float(av[it][q] << 16), a_hi = __uint_as_float(av[it][q] & 0xffff0000u);
                const float g_lo = __uint_as_float(gv[it][q] << 16), g_hi = __uint_as_float(gv[it][q] & 0xffff0000u);
                const float zlo = a_lo * sigmoidf_(g_lo) * msk, zhi = a_hi * sigmoidf_(g_hi) * msk;
                if (q < 2) { z0[2 * q] = zlo; z0[2 * q + 1] = zhi; } else { z1[2 * (q - 2)] = zlo; z1[2 * (q - 2) + 1] = zhi; }
            }
            if (idx < 94 * 32) { *(LAS f32x4*)(zl + pr * 256 + c8 * 8) = z0; *(LAS f32x4*)(zl + pr * 256 + c8 * 8 + 4) = z1; }
        }
    }
    __syncthreads();
    const int ts = t0 + th * 32;
    float w[31];
#pragma unroll
    for (int k = 0; k < 31; ++k) w[k] = p.conv_w[(size_t)l * 31 * 256 + k * 256 + ch];
    float o[32];
    const float bias = p.conv_b[l * 256 + ch];
    const LAS float* zp = zl + (th * 32) * 256 + ch;
    float z[62];
#pragma unroll
    for (int jj = 0; jj < 62; ++jj) z[jj] = zp[jj * 256];
#pragma unroll
    for (int i = 0; i < 32; ++i) {
        float acc = bias;
#pragma unroll
        for (int k = 0; k < 31; ++k) acc += w[k] * z[i + k];
        o[i] = acc;
    }
    const float lg = p.conv_ln_g[l * 256 + ch], lb = p.conv_ln_b[l * 256 + ch];
#pragma unroll
    for (int i = 0; i < 32; ++i) {
        const float mu = wave_sum(o[i]) * (1.f / 64.f);
        const float d = o[i] - mu;
        const float var = wave_sum(d * d) * (1.f / 64.f);
        const float zn = d * __builtin_amdgcn_rsqf(var + EPSV) * lg + lb;
        MIXA[(size_t)(rowbase + ts + i) * DM + 768 + ch] = f2bf(zn * sigmoidf_(zn));
    }
    __syncthreads();
}

__device__ __forceinline__ int drow_map(int mode, int n) {
    if (mode == 0) return n;
    if (mode == 1) return n < 1792 ? n : n + 256;
    const int r = 256 * (n >> 7) + 128 * ((n >> 2) & 1) + 32 * ((n >> 5) & 3) + 4 * ((n >> 3) & 3) + (n & 3);
    return mode == 2 ? r : r + 16;
}
__device__ __forceinline__ void transpose_item(const float* W, int ldw, int K, bf16_t* WT, int mode, LAS float* scr, int kb, int nb, int lane) {
    const int k0 = 64 * kb, n0 = 32 * nb;
#pragma unroll 8
    for (int i = 0; i < 32; ++i) { const int kk = 2 * i + (lane >> 5); scr[kk * 33 + (lane & 31)] = W[(size_t)(k0 + kk) * ldw + n0 + (lane & 31)]; }
    asm volatile("s_waitcnt lgkmcnt(0)" ::: "memory");
    const int c = lane & 7;
#pragma unroll
    for (int j = 0; j < 4; ++j) { const int n = (lane >> 3) + 8 * j; const LAS float* s = scr + (8 * c) * 33 + n;
        u32x4 o; o.x = cvt_pk_bf16(s[0 * 33], s[1 * 33]); o.y = cvt_pk_bf16(s[2 * 33], s[3 * 33]); o.z = cvt_pk_bf16(s[4 * 33], s[5 * 33]); o.w = cvt_pk_bf16(s[6 * 33], s[7 * 33]);
        *(u32x4*)(WT + (size_t)drow_map(mode, n0 + n) * K + k0 + 8 * c) = o; }
    asm volatile("s_waitcnt lgkmcnt(0)" ::: "memory");
}

__device__ __forceinline__ void prep_phase(const Params& p, LAS unsigned char* lds) {
    const int tid = fresh_tid(), lane = tid & 63, wave = tid >> 6, G = gridDim.x;
    const int gw = blockIdx.x * 8 + wave, NGW = G * 8;
    const int gt = blockIdx.x * 512 + tid, NGT = G * 512;
    unsigned char* ws = p.ws;
    LAS float* tab = (LAS float*)(lds + 73728);
    LAS float* t64c = tab + 2048; LAS float* t64s = t64c + 64;
    for (int m = tid; m < 2048; m += 512) tab[m] = cospif((float)m * (1.f / 1024.f));
    if (tid < 64) { t64c[tid] = cospif((float)tid * (1.f / 32.f)); t64s[tid] = sinpif((float)tid * (1.f / 32.f)); }
    __syncthreads();
    if (gt < 1024) { const int pos = gt >> 4, f = gt & 15; const float inv = powf(10000.f, -(float)f / 16.f); const float ang = (float)pos * inv;
        float* rope = (float*)(ws + WS_ROPE); rope[gt] = cosf(ang); rope[1024 + gt] = sinf(ang); }
    {
        LAS float* scr = (LAS float*)(lds + wave * 8448);
        constexpr int I_IN = 16 * 72, I_OUT = 16 * 32, I_F1 = 16 * 88, I_F2 = 44 * 32, I_L = I_IN + I_OUT + 2 * I_F1 + I_F2;
        for (int it = gw; it < 2 * I_L; it += NGW) {
            const int l = it / I_L; int r = it % I_L;
            if (r < I_IN) { const int kb = r / 72, nb = r % 72; if (nb >= 48 && nb < 56) continue;
                transpose_item(p.w_in + (size_t)l * DM * INW_SRC, INW_SRC, DM, (bf16_t*)(ws + WS_WIN) + (size_t)l * INW * DM, 1, scr, kb, nb, lane); continue; }
            r -= I_IN;
            if (r < I_OUT) { transpose_item(p.w_out + (size_t)l * DM * DM, DM, DM, (bf16_t*)(ws + WS_WOUT) + (size_t)l * DM * DM, 0, scr, r / 32, r % 32, lane); continue; }
            r -= I_OUT;
            if (r < I_F1) { transpose_item(p.w_ffn1 + (size_t)l * DM * DFF, DFF, DM, (bf16_t*)(ws + WS_W13) + (size_t)l * N13 * DM, 2, scr, r / 88, r % 88, lane); continue; }
            r -= I_F1;
            if (r < I_F1) { transpose_item(p.w_ffn3 + (size_t)l * DM * DFF, DFF, DM, (bf16_t*)(ws + WS_W13) + (size_t)l * N13 * DM, 3, scr, r / 88, r % 88, lane); continue; }
            r -= I_F1;
            transpose_item(p.w_ffn2 + (size_t)l * DFF * DM, DM, DFF, (bf16_t*)(ws + WS_W2) + (size_t)l * DM * DFF, 0, scr, r / 32, r % 32, lane);
        }
    }
    {
        const float tcl = cospif((float)lane * (1.f / 32.f)), tsl = sinpif((float)lane * (1.f / 32.f));
        for (int it = gw; it < 2 * 4 * 16 * 16; it += NGW) {
            const int l = it >> 10, g = (it >> 8) & 3, kbk = (it >> 4) & 15, lqg = it & 15;
            const int k = kbk * 64 + lane;
            const float* wr_ = p.w_in + (size_t)l * DM * INW_SRC + (size_t)k * INW_SRC + 1536 + g * 64;
            float wv[64];
#pragma unroll
            for (int c4 = 0; c4 < 16; ++c4) { const f32x4 v = *(const f32x4*)(wr_ + 4 * c4); wv[4 * c4] = v[0]; wv[4 * c4 + 1] = v[1]; wv[4 * c4 + 2] = v[2]; wv[4 * c4 + 3] = v[3]; }
            bf16_t* wt = (bf16_t*)(ws + WS_WIN) + (size_t)l * INW * DM;
#pragma unroll 1
            for (int li = 0; li < 4; ++li) {
                const int lq = __builtin_amdgcn_readfirstlane(lqg * 4 + li);
                float ac = 0.f, as = 0.f;
#pragma unroll
                for (int c = 0; c < 64; ++c) {
                    const int m = (lq * c) & 63;
                    const float ct = __int_as_float(__builtin_amdgcn_readlane(__float_as_int(tcl), m)), st = __int_as_float(__builtin_amdgcn_readlane(__float_as_int(tsl), m));
                    ac += wv[c] * ct; as += wv[c] * st;
                }
                wt[(size_t)(1536 + g * 64 + lq) * DM + k] = f2bf(ac);
                wt[(size_t)(1536 + 256 + g * 64 + lq) * DM + k] = f2bf(as);
            }
        }
    }
    for (int e = gt; e < 2 * WSM_L; e += NGT) {
        const int l = e / WSM_L, r = e % WSM_L; float v;
        if (r < 256 * 512) { const int n = r >> 9, k = r & 255; const int g = n >> 6, d = n & 63, g2 = k >> 6, c = k & 63; v = (g == g2) ? p.w_fourier[(((size_t)l * 4 + g) * 64 + c) * 64 + d] : 0.f; }
        else { const int r2 = r - 256 * 512, n = r2 >> 8, k = r2 & 255; v = p.w_conv_out[((size_t)l * 256 + k) * 256 + n]; }
        ((bf16_t*)(ws + WS_WSM))[e] = f2bf(v);
    }
    {
        const float nl = 1.f / sqrtf(2048.f * 64.f), nc = 1.f / 128.f;
        for (int e = gt; e < 2048 * 4096 / 8; e += NGT) {
            const int k = e >> 9, col0 = (e & 511) * 8, s = col0 >> 11; float v[8];
#pragma unroll
            for (int j = 0; j < 8; ++j) { const int n = (col0 + j) & 2047, m = (k * n) & 2047; v[j] = s ? -tab[(m - 512) & 2047] * nl : tab[m] * nl; }
            u32x4 o; o.x = cvt_pk_bf16(v[0], v[1]); o.y = cvt_pk_bf16(v[2], v[3]); o.z = cvt_pk_bf16(v[4], v[5]); o.w = cvt_pk_bf16(v[6], v[7]);
            *(u32x4*)((bf16_t*)(ws + WS_DFTL) + (size_t)e * 8) = o;
        }
        for (int e = gt; e < 256 * 512 / 8; e += NGT) {
            const int k = e >> 6, col0 = (e & 63) * 8, s = col0 >> 8; float v[8];
#pragma unroll
            for (int j = 0; j < 8; ++j) { const int n = (col0 + j) & 255, m = ((k * n) & 255) * 8; v[j] = s ? -tab[(m - 512) & 2047] * nc : tab[m] * nc; }
            u32x4 o; o.x = cvt_pk_bf16(v[0], v[1]); o.y = cvt_pk_bf16(v[2], v[3]); o.z = cvt_pk_bf16(v[4], v[5]); o.w = cvt_pk_bf16(v[6], v[7]);
            *(u32x4*)((bf16_t*)(ws + WS_DFTC) + (size_t)e * 8) = o;
        }
    }
    for (int it = gw; it < 2 * 96 * 8; it += NGW) {
        const int l = it / 768, r = it % 768, cgp = r >> 3, kc = r & 7;
        const int col = cgp * 64 + lane, k0 = kc * 128;
        float sv[9][2];
#pragma unroll
        for (int b = 0; b < 9; ++b)
#pragma unroll
            for (int hh = 0; hh < 2; ++hh) { const int k = k0 + hh * 64 + lane; const float cv = (b < 8) ? p.c[b * DM + k] : p.c_ctx[k]; sv[b][hh] = cv * sigmoidf_(cv); }
        float ac[9];
#pragma unroll
        for (int b = 0; b < 9; ++b) ac[b] = 0.f;
        const float* wp = p.w_ada + ((size_t)l * DM + k0) * 6144 + col;
#pragma unroll
        for (int hh = 0; hh < 2; ++hh) {
#pragma unroll 8
            for (int kk = 0; kk < 64; ++kk) {
                const float wv = wp[(size_t)(hh * 64 + kk) * 6144];
#pragma unroll
                for (int b = 0; b < 9; ++b) ac[b] += __int_as_float(__builtin_amdgcn_readlane(__float_as_int(sv[b][hh]), kk)) * wv;
            }
        }
        const float bias = (kc == 0) ? p.b_ada[l * 6144 + col] : 0.f;
        float* mod = (float*)(ws + WS_MOD) + (size_t)l * 9 * 6144;
#pragma unroll
        for (int b = 0; b < 9; ++b) atomicAdd(mod + b * 6144 + col, ac[b] + bias);
    }
}

__device__ __forceinline__ void norm_phase(const float* xlat, const float* xctx, const float* gvec, const float* mod, int sh_off, int sc_off, bf16_t* H, int nrows,
                                           const float* part, const float* pgate, float* xctx_out) {
    const int tid = fresh_tid(), lane = tid & 63, gw = blockIdx.x * 8 + (tid >> 6), NGW = gridDim.x * 8;
    f32x4 vn[4];
#define NORM_LOADX(dst, r_) do { const int r__ = (r_); const float* xr_ = r__ < NLAT ? xlat + (size_t)r__ * DM : xctx + (size_t)(r__ - NLAT) * DM; \
        _Pragma("unroll") for (int j = 0; j < 4; ++j) dst[j] = *(const f32x4*)(xr_ + 4 * lane + 256 * j); } while (0)
    if (gw < nrows) NORM_LOADX(vn, gw);
    for (int row = gw; row < nrows; row += NGW) {
        const int bb = row < NLAT ? row >> 11 : 8;
        f32x4 v[4]; float ss = 0.f;
#pragma unroll
        for (int j = 0; j < 4; ++j) v[j] = vn[j];
        if (row + NGW < nrows) NORM_LOADX(vn, row + NGW);
        const float* mp = mod + bb * 6144;
        f32x4 gg[4], sc[4], sh[4];
#pragma unroll
        for (int j = 0; j < 4; ++j) { const int col = 4 * lane + 256 * j; gg[j] = *(const f32x4*)(gvec + col); sc[j] = *(const f32x4*)(mp + sc_off + col); sh[j] = *(const f32x4*)(mp + sh_off + col); }
        if (part != nullptr && row >= NLAT) {
#pragma unroll
            for (int j = 0; j < 4; ++j) {
                const size_t o = (size_t)(row - NLAT) * DM + 4 * lane + 256 * j;
                const f32x4 ps = (*(const f32x4*)(part + o) + *(const f32x4*)(part + (size_t)NCTX * DM + o)) + (*(const f32x4*)(part + (size_t)2 * NCTX * DM + o) + *(const f32x4*)(part + (size_t)3 * NCTX * DM + o));
                v[j] = v[j] + *(const f32x4*)(pgate + 4 * lane + 256 * j) * ps;
                *(f32x4*)(xctx_out + o) = v[j];
            }
        }
#pragma unroll
        for (int j = 0; j < 4; ++j) ss += (v[j][0] * v[j][0] + v[j][1] * v[j][1]) + (v[j][2] * v[j][2] + v[j][3] * v[j][3]);
        const float rstd = __builtin_amdgcn_rsqf(wave_sum(ss) * (1.f / DM) + EPSV);
#pragma unroll
        for (int j = 0; j < 4; ++j) {
            const int col = 4 * lane + 256 * j;
            const f32x4 y = (v[j] * rstd) * gg[j];
            const f32x4 hv = y * (sc[j] + 1.f) + sh[j];
            *(u32x2*)(H + (size_t)row * DM + col) = pack4(hv);
        }
    }
#undef NORM_LOADX
}

__global__ void __launch_bounds__(512, 2) fwd_kernel(Params p) {
    extern __shared__ __attribute__((aligned(16))) unsigned char lds_raw[];
    LAS unsigned char* lds = (LAS unsigned char*)lds_raw;
    cg::grid_group grid = cg::this_grid();
    const int G = gridDim.x, cu = blockIdx.x;
    unsigned char* ws = p.ws;
    bf16_t* H = (bf16_t*)(ws + WS_H);
    bf16_t* Q1 = (bf16_t*)(ws + WS_Q1); bf16_t* Q2 = (bf16_t*)(ws + WS_Q2); bf16_t* K1c = (bf16_t*)(ws + WS_K1); bf16_t* K2c = (bf16_t*)(ws + WS_K2);
    bf16_t* VT = (bf16_t*)(ws + WS_VT); bf16_t* TTl = (bf16_t*)(ws + WS_TTL); bf16_t* TTc = (bf16_t*)(ws + WS_TTC); bf16_t* UC = (bf16_t*)(ws + WS_UC);
    bf16_t* MIXA = (bf16_t*)(ws + WS_MIX); bf16_t* ACT = (bf16_t*)(ws + WS_ACT);
    float* PB1 = (float*)(ws + WS_R); float* PB2 = (float*)(ws + WS_R + 99 * MiB);
    bf16_t* FP = (bf16_t*)(ws + WS_H);
    float* XL = p.out; float* XC = (float*)(ws + WS_XCTX);
    const float* rope = (const float*)(ws + WS_ROPE);

    volatile LAS unsigned* bst = (volatile LAS unsigned*)(lds + LDS_BYTES - 64);
    if (threadIdx.x < 2) bst[threadIdx.x] = 0u;
    __syncthreads();
    const XcdBarrier xbar = xcd_barrier_post((unsigned*)(ws + WS_BAR), bst);
#define GSYNC() xcd_barrier(xbar)

    prep_phase(p, lds);
    grid.sync();

#pragma unroll 1
    for (int l = 0; l < 2; ++l) {
        const float* mod = (const float*)(ws + WS_MOD) + (size_t)l * 9 * 6144;
        const float* xin_l = l == 0 ? p.x : XL; const float* xin_c = l == 0 ? p.ctx : XC;
        const int mrows = l == 0 ? MTOT : NLAT;
        if (PROBE == 3) { for (int rep = 0; rep < 8; ++rep) GSYNC(); }
        norm_phase(xin_l, xin_c, p.norm1_g + l * DM, mod, 0, 1024, H, MTOT, l == 1 ? PB2 : nullptr, (const float*)(ws + WS_MOD) + 8 * 6144 + 5120, XC);
        GSYNC();
        for (int rep = 0; rep < (PROBE == 4 ? 2 : 1); ++rep) {
            if (rep) GSYNC();
            pg8::Gemm g{H, (const bf16_t*)(ws + WS_WIN) + (size_t)l * INW * DM, MTOT, INW, DM, DM, DM, 0};
            pg8::StaticOrder S; S.init(MTOT, INW, G, cu);
            EpiInProj E{Q1, Q2, K1c, K2c, VT, TTl, TTc, UC, rope};
            pg8::gemm_phase<EpiInProj, pg8::StaticOrder, true>(lds, g, S, E);
        }
        GSYNC();
        for (int rep = 0; rep < (PROBE == 1 ? 2 : 1); ++rep) {
            if (rep) GSYNC();
            const float li = 0.8f - 0.6f * __expf(-0.3f * (float)l);
            float lam;
            { const int lane = fresh_tid() & 63;
              const float s1 = wave_sum(p.lam_q1[l * 64 + lane] * p.lam_k1[l * 64 + lane]), s2 = wave_sum(p.lam_q2[l * 64 + lane] * p.lam_k2[l * 64 + lane]);
              lam = expf(s1) - expf(s2) + li; }
            att::Args A{Q1, Q2, K1c, K2c, VT, MIXA, p.subln_g + l * 128, lam, 1.f - li};
            const int n_att = 512 + (l == 0 ? 64 : 0);
            for (int u = cu; u < n_att; u += G) {
                if (u < 512) att::attn_unit(lds, A, u >> 6, (u >> 4) & 3, (u >> 6) * SEQ + (u & 15) * 128, 36);
                else { const int v = u - 512; att::attn_unit(lds, A, v >> 3, (v >> 1) & 3, NLAT + (v >> 3) * CTXL + (v & 1) * 128, 4); }
            }
#pragma unroll 1
            for (int hf = 0; hf < 2; ++hf) {
                pg8::Gemm g{(const bf16_t*)(ws + WS_DFTL) + hf * 2048, TTl + hf * 2048, 2048, 2048, 2048, 4096, 4096, 0};
                pg8::OffsetOrder S; S.init(2048, 2048, G, cu, 64 + 64 * hf);
                EpiMix E{FP, 512, hf * 256, 0, SEQ, 0};
                pg8::gemm_phase<EpiMix, pg8::OffsetOrder, true>(lds, g, S, E);
            }
            if (l == 0) {
#pragma unroll 1
                for (int hf = 0; hf < 2; ++hf) {
                    pg8::Gemm g{(const bf16_t*)(ws + WS_DFTC) + hf * 256, TTc + hf * 256, 256, 2048, 256, 512, 512, 0};
                    pg8::OffsetOrder S; S.init(256, 2048, G, cu, 192 + 8 * hf);
                    EpiMix E{FP, 512, hf * 256, NLAT, CTXL, 0};
                    pg8::gemm_phase<EpiMix, pg8::OffsetOrder, true>(lds, g, S, E);
                }
            }
            const int n_conv = l == 0 ? 288 : 256;
            if (G == 256) {
                const int sidx = cu < 64 ? cu : (cu >= 192 ? cu - 128 : -1);
                if (sidx >= 0) for (int it = sidx; it < n_conv; it += 128) conv_item(p, lds, l, it, UC, MIXA);
            } else for (int it = cu; it < n_conv; it += G) conv_item(p, lds, l, it, UC, MIXA);
        }
        GSYNC();
        {
            const bf16_t* wsm = (const bf16_t*)(ws + WS_WSM) + (size_t)l * WSM_L;
            {
                pg8::Gemm g{FP, wsm, mrows, 256, 512, 512, 512, 0};
                pg8::OffsetOrder S; S.init(mrows, 256, G, cu, 0);
                EpiMix E{MIXA, DM, 512, 0, 0, 0};
                pg8::gemm_phase<EpiMix, pg8::OffsetOrder, true>(lds, g, S, E);
            }
            {
                pg8::Gemm g{MIXA + 768, wsm + 256 * 512, mrows, 256, 256, DM, 256, 0};
                pg8::OffsetOrder S; S.init(mrows, 256, G, cu, 72);
                EpiMix E{MIXA, DM, 768, 0, 0, 0};
                pg8::gemm_phase<EpiMix, pg8::OffsetOrder, true>(lds, g, S, E);
            }
        }
        GSYNC();
        {
            pg8::Gemm g{MIXA, (const bf16_t*)(ws + WS_WOUT) + (size_t)l * DM * DM, mrows, DM, DM, DM, DM, 0};
            EpiRes E{xin_l, xin_c, XL, XC, mod, 2048, PB1};
            if (l == 0) { pg8::CtxSplitOrder S; S.init(DM, DM, G, cu); pg8::gemm_phase<EpiRes, pg8::CtxSplitOrder, true>(lds, g, S, E); }
            else { pg8::StaticOrder S; S.init(mrows, DM, G, cu); pg8::gemm_phase<EpiRes, pg8::StaticOrder, true>(lds, g, S, E); }
        }
        GSYNC();
        norm_phase(XL, l == 0 ? p.ctx : XC, p.norm2_g + l * DM, mod, 3072, 4096, H, mrows, l == 0 ? PB1 : nullptr, mod + 8 * 6144 + 2048, XC);
        GSYNC();
        for (int rep = 0; rep < (PROBE == 2 ? 2 : 1); ++rep) {
            if (rep) GSYNC();
            pg8::Gemm g{H, (const bf16_t*)(ws + WS_W13) + (size_t)l * N13 * DM, mrows, N13, DM, DM, DM, 0};
            pg8::StaticOrder S; S.init(mrows, N13, G, cu);
            EpiFfn13 E{ACT};
            pg8::gemm_phase<EpiFfn13, pg8::StaticOrder, true>(lds, g, S, E);
        }
        GSYNC();
        {
            pg8::Gemm g{ACT, (const bf16_t*)(ws + WS_W2) + (size_t)l * DM * DFF, mrows, DM, DFF, DFF, DFF, 0};
            EpiRes E{XL, XC, XL, XC, mod, 5120, PB2};
            if (l == 0) { pg8::CtxSplitOrder S; S.init(DM, DFF, G, cu); pg8::gemm_phase<EpiRes, pg8::CtxSplitOrder, true>(lds, g, S, E); }
            else { pg8::StaticOrder S; S.init(mrows, DM, G, cu); pg8::gemm_phase<EpiRes, pg8::StaticOrder, true>(lds, g, S, E); }
        }
        GSYNC();
    }
    {
        const int tid = fresh_tid(), lane = tid & 63, gw = blockIdx.x * 8 + (tid >> 6), NGW = gridDim.x * 8;
        f32x4 gg[4], vn[4];
#pragma unroll
        for (int j = 0; j < 4; ++j) { gg[j] = *(const f32x4*)(p.final_g + 4 * lane + 256 * j); vn[j] = *(const f32x4*)(XL + (size_t)gw * DM + 4 * lane + 256 * j); }
        for (int row = gw; row < NLAT; row += NGW) {
            float* xr = XL + (size_t)row * DM;
            f32x4 v[4]; float ss = 0.f;
#pragma unroll
            for (int j = 0; j < 4; ++j) { v[j] = vn[j]; ss += (v[j][0] * v[j][0] + v[j][1] * v[j][1]) + (v[j][2] * v[j][2] + v[j][3] * v[j][3]); }
            if (row + NGW < NLAT) {
#pragma unroll
                for (int j = 0; j < 4; ++j) vn[j] = *(const f32x4*)(xr + (size_t)NGW * DM + 4 * lane + 256 * j);
            }
            const float rstd = __builtin_amdgcn_rsqf(wave_sum(ss) * (1.f / DM) + EPSV);
#pragma unroll
            for (int j = 0; j < 4; ++j) { const int col = 4 * lane + 256 * j; *(f32x4*)(xr + col) = (v[j] * rstd) * gg[j]; }
        }
    }
}

extern "C" void kernel_launch(void* const* d_in, const int* in_sizes, int n_in, void* d_out, int out_size, void* d_ws, size_t ws_size, hipStream_t stream) {
    static int grid_blocks = 0;
    if (grid_blocks == 0) {
        if (n_in != 25 || ws_size < WS_END) { fprintf(stderr, "kernel_launch: unexpected n_in %d / ws %zu\n", n_in, ws_size); grid_blocks = -1; return; }
        int dev = 0, cus = 0, per_cu = 0;
        (void)hipGetDevice(&dev);
        (void)hipDeviceGetAttribute(&cus, hipDeviceAttributeMultiprocessorCount, dev);
        if (hipFuncSetAttribute((const void*)fwd_kernel, hipFuncAttributeMaxDynamicSharedMemorySize, LDS_BYTES) != hipSuccess) fprintf(stderr, "kernel_launch: hipFuncSetAttribute failed\n");
        if (hipOccupancyMaxActiveBlocksPerMultiprocessor(&per_cu, (const void*)fwd_kernel, 512, LDS_BYTES) != hipSuccess || per_cu < 1) { fprintf(stderr, "kernel_launch: occupancy query gave %d\n", per_cu); per_cu = 1; }
        (void)hipGetLastError();
        grid_blocks = cus * per_cu;
    }
    if (grid_blocks < 0) return;
    Params p{};
    const float** pp = (const float**)&p;
    for (int i = 0; i < 25; ++i) pp[i] = (const float*)d_in[i];
    p.out = (float*)d_out; p.ws = (unsigned char*)d_ws;
    (void)hipMemsetAsync((unsigned char*)d_ws + WS_MOD, 0, ZERO_BYTES, stream);
    void* args[] = {&p};
    hipError_t e = hipLaunchCooperativeKernel((const void*)fwd_kernel, dim3(grid_blocks), dim3(512), args, LDS_BYTES, stream);
    if (e != hipSuccess) fprintf(stderr, "cooperative launch failed: %s (grid %d)\n", hipGetErrorString(e), grid_blocks);
}
```

```cpp
#include <hip/hip_runtime.h>
#include <hip/hip_cooperative_groups.h>
#include <cstdint>
#include <cstdio>
namespace cg = cooperative_groups;
#ifndef PROBE
#define PROBE 0
#endif

#define LAS __attribute__((address_space(3)))
typedef unsigned short bf16_t;
typedef short bf16x8 __attribute__((ext_vector_type(8)));
typedef float f32x4 __attribute__((ext_vector_type(4)));
typedef float f32x16 __attribute__((ext_vector_type(16)));
typedef unsigned u32x4 __attribute__((ext_vector_type(4)));
typedef unsigned u32x2 __attribute__((ext_vector_type(2)));

constexpr int NB = 8, SEQ = 2048, DM = 1024, CTXL = 256, NLAT = NB * SEQ, NCTX = NB * CTXL, MTOT = NLAT + NCTX;
constexpr int INW = 2560, INW_SRC = 2304, DFF = 2816, N13 = 2 * DFF, KCAT = CTXL + SEQ;
constexpr float EPSV = 1e-6f;
constexpr float QSCALE = 0.125f * 1.4426950408889634f;
constexpr int LDS_BYTES = 147456;
constexpr int XCD_BAR_WORDS_C = 3456;

constexpr size_t MiB = 1u << 20;
constexpr size_t WS_WIN = 0, WS_WOUT = 10 * MiB, WS_W13 = 14 * MiB, WS_W2 = 36 * MiB, WS_WSM = 47 * MiB, WS_DFTL = 48 * MiB, WS_DFTC = 64 * MiB;
constexpr size_t WS_MOD = 64 * MiB + 256 * 1024, WS_ROPE = 64 * MiB + 768 * 1024, WS_XCTX = 65 * MiB, WS_H = 73 * MiB, WS_R = 109 * MiB;
constexpr size_t WS_Q1 = WS_R, WS_Q2 = WS_R + 9 * MiB, WS_K1 = WS_R + 18 * MiB, WS_K2 = WS_R + 27 * MiB, WS_VT = WS_R + 36 * MiB, WS_TTL = WS_R + 54 * MiB,
                 WS_TTC = WS_R + 70 * MiB, WS_UC = WS_R + 72 * MiB, WS_MIX = WS_R + 90 * MiB, WS_ACT = WS_R, WS_END = WS_R + 131 * MiB;
constexpr size_t MOD_BYTES = 2 * 9 * 6144 * 4;
constexpr int WSM_L = 256 * 512 + 256 * 256;
constexpr size_t WS_BAR = 64 * MiB + 704 * 1024, ZERO_BYTES = WS_BAR + XCD_BAR_WORDS_C * 4 - WS_MOD;

struct Params {
    const float *x, *c, *ctx, *c_ctx, *w_ada, *b_ada, *norm1_g, *norm2_g, *w_in, *lam_q1, *lam_k1, *lam_q2, *lam_k2, *subln_g, *w_fourier, *conv_w, *conv_b,
        *conv_ln_g, *conv_ln_b, *w_conv_out, *w_out, *w_ffn1, *w_ffn3, *w_ffn2, *final_g;
    float* out; unsigned char* ws;
};

__device__ __forceinline__ unsigned cvt_pk_bf16(float lo, float hi) { unsigned r; asm("v_cvt_pk_bf16_f32 %0, %1, %2" : "=v"(r) : "v"(lo), "v"(hi)); return r; }
__device__ __forceinline__ u32x2 pack4(f32x4 v) { u32x2 w; w.x = cvt_pk_bf16(v[0], v[1]); w.y = cvt_pk_bf16(v[2], v[3]); return w; }
__device__ __forceinline__ bf16_t f2bf(float v) { return (bf16_t)(cvt_pk_bf16(v, 0.f) & 0xffffu); }
__device__ __forceinline__ float wave_sum(float v) {
#pragma unroll
    for (int o = 1; o < 64; o <<= 1) v += __shfl_xor(v, o);
    return v;
}
__device__ __forceinline__ int fresh_tid() { int t = threadIdx.x; asm volatile("" : "+v"(t)); return t; }
__device__ __forceinline__ float max3f(float a, float b, float c) { float r; asm("v_max3_f32 %0, %1, %2, %3" : "=v"(r) : "v"(a), "v"(b), "v"(c)); return r; }
__device__ __forceinline__ float sigmoidf_(float v) { return __builtin_amdgcn_rcpf(1.f + __expf(-v)); }


#define XB_TMO      128
#define XB_XCNT(j)  (256  + 64 * (j))
#define XB_XSUB(j)  (1280 + 64 * (j))
#define XB_XGEN(j)  (2304 + 64 * (j))
#define XB_TOP      3328
#define XB_TOPGEN   3392
#define XCD_BAR_WORDS 3456
#define XB_SPIN_CAP (1u << 18)
__device__ __forceinline__ unsigned xb_ld(unsigned* p)              { return __hip_atomic_load(p, __ATOMIC_RELAXED, __HIP_MEMORY_SCOPE_AGENT); }
__device__ __forceinline__ unsigned xb_add(unsigned* p, unsigned v) { return __hip_atomic_fetch_add(p, v, __ATOMIC_RELAXED, __HIP_MEMORY_SCOPE_AGENT); }
__device__ __forceinline__ unsigned xb_xcc_id() { return (unsigned)__builtin_amdgcn_s_getreg((3 << 11) | 20) & 0xFu; }
#define XB_SPIN(cond, bar) do { unsigned _sp = 0; while (cond) { __builtin_amdgcn_s_sleep(1); \
    if ((++_sp & 255u) == 0u) { if (xb_ld(&(bar)[XB_TMO])) break; if (_sp > XB_SPIN_CAP) { atomicAdd(&(bar)[XB_TMO], 1u); break; } } } } while (0)
struct XcdBarrier { unsigned* bar; unsigned x; volatile LAS unsigned* st; };
__device__ __forceinline__ XcdBarrier xcd_barrier_post(unsigned* bar, volatile LAS unsigned* st) {
    XcdBarrier b; b.bar = bar; b.x = xb_xcc_id(); b.st = st;
    if (threadIdx.x == 0) (void)xb_add(&bar[XB_XCNT(b.x)], 1u);
    return b;
}
__device__ __forceinline__ void xcd_barrier_complete(unsigned* bar, unsigned x, unsigned& nloc, unsigned& nx) {
    const unsigned G = gridDim.x * gridDim.y * gridDim.z;
    unsigned sum, cnt, mine, sp = 0u;
    for (;;) {
        sum = 0u; cnt = 0u; mine = 0u;
#pragma unroll
        for (unsigned j = 0; j < 16; ++j) { const unsigned c = xb_ld(&bar[XB_XCNT(j)]); sum += c; cnt += (c > 0u) ? 1u : 0u; mine = (j == x) ? c : mine; }
        if (sum == G) break;
        __builtin_amdgcn_s_sleep(1);
        if ((++sp & 255u) == 0u) { if (xb_ld(&bar[XB_TMO])) break; if (sp > XB_SPIN_CAP) { atomicAdd(&bar[XB_TMO], 1u); break; } }
    }
    nloc = mine > 0u ? mine : 1u; nx = cnt > 0u ? cnt : 1u;
}
__device__ __forceinline__ void xcd_barrier(const XcdBarrier& b) {
    asm volatile("s_waitcnt vmcnt(0)" ::: "memory");
    __syncthreads();
    if (threadIdx.x == 0) {
        unsigned* bar = b.bar;
        __builtin_amdgcn_s_waitcnt(0);
        unsigned nloc = b.st[0], nx = b.st[1];
        if (nloc == 0u) { xcd_barrier_complete(bar, b.x, nloc, nx); b.st[0] = nloc; b.st[1] = nx; }
        const unsigned old = xb_add(&bar[XB_XSUB(b.x)], 1u);
        const unsigned gen = old / nloc;
        if (old + 1u == (gen + 1u) * nloc) {
            __builtin_amdgcn_fence(__ATOMIC_RELEASE, "agent");
            asm volatile("s_waitcnt vmcnt(0)" ::: "memory");
            const unsigned og = xb_add(&bar[XB_TOP], 1u);
            const unsigned tg = og / nx;
            if (og + 1u == (tg + 1u) * nx) xb_add(&bar[XB_TOPGEN], 1u);
            else XB_SPIN(xb_ld(&bar[XB_TOPGEN]) == tg, bar);
            __builtin_amdgcn_fence(__ATOMIC_ACQUIRE, "agent");
            xb_add(&bar[XB_XGEN(b.x)], 1u);
            asm volatile("s_waitcnt vmcnt(0)" ::: "memory");
        } else {
            XB_SPIN(xb_ld(&bar[XB_XGEN(b.x)]) == gen, bar);
            __builtin_amdgcn_fence(__ATOMIC_ACQUIRE, "agent");
            asm volatile("s_waitcnt vmcnt(0)" ::: "memory");
        }
    }
    __syncthreads();
}

namespace pg8 {
constexpr int BM = 256, BK = 64, HALF = 128, HTB = HALF * BK * 2, STAGE_BYTES = 8 * HTB, NXCD = 8, WGM = 8;
__host__ __device__ __forceinline__ int lds_byte(int r, int c) { const int st = (r >> 4) * 2 + (c >> 5), rr = r & 15, cc = c & 31, ob = rr * 64 + cc * 2; return st * 1024 + (ob ^ (((ob >> 9) & 1) << 5)); }
__host__ __device__ __forceinline__ void stage_rc(int b, int& R, int& C) { const int st = b / 1024, sb = b % 1024, swz = sb ^ (((sb >> 9) & 1) << 5); R = (st >> 1) * 16 + swz / 64; C = (st & 1) * 32 + (swz % 64) / 2; }

struct Unit { int pm, pn, k0, nt, flags; };
struct Gemm { const bf16_t* A; const bf16_t* Bt; int M, N, K, lda, ldb, a_pn_off; };

struct StaticOrder {
    int nM, nN, nwg, G, c;
    __host__ __device__ void init(int M, int N, int G_, int c_) { nM = M / BM; nN = N / BM; nwg = nM * nN; G = G_; c = c_; }
    __host__ __device__ __forceinline__ bool next(int i, Unit& u) const {
        const long L = (long)i * G + c; if (L >= nwg) return false;
        int wgid = (int)L; { const int q = nwg / NXCD, r = nwg % NXCD, xcd = wgid % NXCD, off = wgid / NXCD; wgid = (xcd < r ? xcd * (q + 1) : r * (q + 1) + (xcd - r) * q) + off; }
        const int nig = WGM * nN, gid = wgid / nig, fm = gid * WGM, gsz = (nM - fm) < WGM ? (nM - fm) : WGM;
        u.pm = fm + ((wgid % nig) % gsz); u.pn = (wgid % nig) / gsz; u.k0 = 0; u.nt = -1; u.flags = 0; return true;
    }
};
struct OffsetOrder {
    int nN, nwg, G, cc;
    __host__ __device__ void init(int M, int N, int G_, int c_, int off) { nN = N / BM; nwg = (M / BM) * nN; G = G_; cc = ((c_ - off) % G_ + G_) % G_; }
    __host__ __device__ __forceinline__ bool next(int i, Unit& u) const { const long L = (long)i * G + cc; if (L >= nwg) return false; u.pm = (int)L / nN; u.pn = (int)L % nN; u.k0 = 0; u.nt = -1; u.flags = 0; return true; }
};

struct CtxSplitOrder {
    StaticOrder lat; int nN, ntf;
    __host__ __device__ void init(int N, int K, int G_, int c_) { lat.init(NLAT, N, G_, c_); nN = N / BM; ntf = K / BK; }
    __host__ __device__ __forceinline__ bool next(int i, Unit& u) const {
        const long L = (long)i * lat.G + lat.c;
        int pm, pn, k0 = 0, ntq = -1, fl = 0;
        if (L < lat.nwg) {
            int wgid = (int)L; { const int q = lat.nwg / NXCD, r = lat.nwg % NXCD, xcd = wgid % NXCD, off = wgid / NXCD; wgid = (xcd < r ? xcd * (q + 1) : r * (q + 1) + (xcd - r) * q) + off; }
            const int nig = WGM * lat.nN, gid = wgid / nig, fm = gid * WGM, gsz = (lat.nM - fm) < WGM ? (lat.nM - fm) : WGM;
            pm = fm + ((wgid % nig) % gsz); pn = (wgid % nig) / gsz;
        } else {
            const int s = (int)(L - lat.nwg); if (s >= (NCTX / BM) * nN * 4) return false;
            const int cu_ = s >> 2, q = s & 3, base = (ntf / 8) * 2, extra = (ntf - 4 * base) / 2;
            pm = NLAT / BM + cu_ / nN; pn = cu_ % nN; ntq = base + (q < extra ? 2 : 0); k0 = (q * base + 2 * (q < extra ? q : extra)) * BK; fl = 1 | (q << 1);
        }
        u.pm = pm; u.pn = pn; u.k0 = k0; u.nt = ntq; u.flags = fl; return true;
    }
};

template <class Epi, class Sched, bool ALIGN_EPI>
__device__ __forceinline__ void gemm_phase(LAS unsigned char* lds, const Gemm g, const Sched& S, const Epi& E) {
    const int tid = fresh_tid(), wid = __builtin_amdgcn_readfirstlane(tid >> 6), lane = tid & 63, wr = wid >> 2, wc = wid & 3, fr = lane & 15, fq = lane >> 4;
    const int K = g.K, nt = K / BK;
    unsigned voffA[2], voffB[2];
#pragma unroll
    for (int i = 0; i < 2; ++i) { int R, C; stage_rc(tid * 16 + i * 8192, R, C);
        voffA[i] = (unsigned)(R * g.lda + C) * 2u; voffB[i] = (unsigned)(R * g.ldb + C) * 2u; }
    const size_t kstep = (size_t)(BK * 2);
    const size_t hstepA = (size_t)HALF * g.lda * 2, hstepB = (size_t)HALF * g.ldb * 2;
    const size_t tstepA = 2 * hstepA, tstepB = 2 * hstepB;
    const unsigned ldsw = (unsigned)wid * 1024u;
    const int aoff = lds_byte(wr * 64 + fr, fq * 8), boff = lds_byte(wc * 32 + fr, fq * 8);
#define PG8_SA(b, h) (((b) * 2 + (h)) * HTB)
#define PG8_SB(b, h) ((4 + (b) * 2 + (h)) * HTB)
#define PG8_STAGE(bufoff, gbase, voff) do { _Pragma("unroll") for (int _i = 0; _i < 2; ++_i) \
        __builtin_amdgcn_global_load_lds((const unsigned*)((const char*)(gbase) + (voff)[_i]), (LAS unsigned*)(lds + (bufoff) + ldsw + _i * 8192), 16, 0, 0); } while (0)
#define PG8_LDA(dst, b, h) do { _Pragma("unroll") for (int m = 0; m < 4; ++m) _Pragma("unroll") for (int k = 0; k < 2; ++k) dst[m][k] = *(const LAS bf16x8*)(lds + PG8_SA(b, h) + aoff + m * 2048 + k * 1024); } while (0)
#define PG8_LDB(dst, b, h) do { _Pragma("unroll") for (int n = 0; n < 2; ++n) _Pragma("unroll") for (int k = 0; k < 2; ++k) dst[n][k] = *(const LAS bf16x8*)(lds + PG8_SB(b, h) + boff + n * 2048 + k * 1024); } while (0)
#define PG8_MMA(ai, bj, At, Bt) do { __builtin_amdgcn_s_setprio(1); _Pragma("unroll") for (int m = 0; m < 4; ++m) _Pragma("unroll") for (int n = 0; n < 2; ++n) _Pragma("unroll") for (int k = 0; k < 2; ++k) \
        acc[ai][bj][m][n] = __builtin_amdgcn_mfma_f32_16x16x32_bf16(Bt[n][k], At[m][k], acc[ai][bj][m][n], 0, 0, 0); __builtin_amdgcn_s_setprio(0); } while (0)
#define PG8_WAIT_V(n) asm volatile("s_waitcnt vmcnt(" #n ")" ::: "memory")
#define PG8_WAIT_L(n) asm volatile("s_waitcnt lgkmcnt(" #n ")" ::: "memory")
#define PG8_BAR __builtin_amdgcn_s_barrier()
#define PG8_SCHED __builtin_amdgcn_sched_barrier(0)
    Unit cur, nxt; int ui = 0;
    if (!S.next(0, cur)) return;
    f32x4 acc[2][2][4][2];
#pragma unroll
    for (int a = 0; a < 2; ++a)
#pragma unroll
        for (int b = 0; b < 2; ++b)
#pragma unroll
            for (int m = 0; m < 4; ++m)
#pragma unroll
                for (int n = 0; n < 2; ++n) acc[a][b][m][n] = (f32x4){0.f, 0.f, 0.f, 0.f};
    bf16x8 At[4][2], B0[2][2], B1[2][2];
    const char* cA = (const char*)g.A + (size_t)cur.pm * tstepA + (size_t)cur.pn * g.a_pn_off * 2 + (size_t)cur.k0 * 2; const char* cB = (const char*)g.Bt + (size_t)cur.pn * tstepB + (size_t)cur.k0 * 2;
    PG8_STAGE(PG8_SB(0, 0), cB, voffB); PG8_STAGE(PG8_SB(0, 1), cB + hstepB, voffB); PG8_STAGE(PG8_SA(0, 0), cA, voffA); PG8_STAGE(PG8_SA(0, 1), cA + hstepA, voffA);
    if (wr == 1) PG8_BAR;
    PG8_WAIT_V(2); PG8_BAR;
    PG8_STAGE(PG8_SB(1, 0), cB + kstep, voffB); PG8_STAGE(PG8_SA(1, 0), cA + kstep, voffA); PG8_STAGE(PG8_SB(1, 1), cB + hstepB + kstep, voffB);
    PG8_WAIT_V(6); PG8_BAR;
    for (;;) {
        const bool has_next = S.next(ui + 1, nxt);
        const char* nA = has_next ? (const char*)g.A + (size_t)nxt.pm * tstepA + (size_t)nxt.pn * g.a_pn_off * 2 + (size_t)nxt.k0 * 2 : cA; const char* nB = has_next ? (const char*)g.Bt + (size_t)nxt.pn * tstepB + (size_t)nxt.k0 * 2 : cB;
        const int ntc = cur.nt < 0 ? nt : cur.nt;
        for (int t = 0; t < ntc; t += 2) {
            const bool last = (t == ntc - 2);
            const char* a1 = cA + (size_t)(t + 1) * kstep;
            const char* a2 = last ? nA : cA + (size_t)(t + 2) * kstep; const char* b2 = last ? nB : cB + (size_t)(t + 2) * kstep;
            const char* a3 = a2 + kstep; const char* b3 = b2 + kstep;
            PG8_LDB(B0, 0, 0); PG8_LDB(B1, 0, 1); PG8_SCHED; PG8_LDA(At, 0, 0); PG8_STAGE(PG8_SA(1, 1), a1 + hstepA, voffA);
            PG8_WAIT_V(8); PG8_WAIT_L(0); PG8_BAR; PG8_MMA(0, 0, At, B0); PG8_MMA(0, 1, At, B1); PG8_BAR; PG8_SCHED;
            PG8_LDA(At, 0, 1); PG8_STAGE(PG8_SB(0, 0), b2, voffB); PG8_STAGE(PG8_SB(0, 1), b2 + hstepB, voffB); PG8_STAGE(PG8_SA(0, 0), a2, voffA);
            PG8_WAIT_V(8); PG8_WAIT_L(0); PG8_BAR; PG8_MMA(1, 0, At, B0); PG8_MMA(1, 1, At, B1); PG8_BAR; PG8_SCHED;
            PG8_LDB(B0, 1, 0); PG8_LDB(B1, 1, 1); PG8_SCHED; PG8_LDA(At, 1, 0); PG8_STAGE(PG8_SA(0, 1), a2 + hstepA, voffA);
            PG8_WAIT_V(8); PG8_WAIT_L(0); PG8_BAR; PG8_MMA(0, 0, At, B0); PG8_MMA(0, 1, At, B1); PG8_BAR; PG8_SCHED;
            PG8_LDA(At, 1, 1); PG8_STAGE(PG8_SB(1, 0), b3, voffB); PG8_STAGE(PG8_SB(1, 1), b3 + hstepB, voffB); PG8_STAGE(PG8_SA(1, 0), a3, voffA);
            PG8_WAIT_V(8); PG8_WAIT_L(0); PG8_BAR; PG8_MMA(1, 0, At, B0); PG8_MMA(1, 1, At, B1); PG8_BAR; PG8_SCHED;
        }
        if constexpr (ALIGN_EPI) { if (wr == 0) PG8_BAR; }
        E(acc, cur, wr, wc, fr, fq);
        if (!has_next) break;
#pragma unroll
        for (int a = 0; a < 2; ++a)
#pragma unroll
            for (int b = 0; b < 2; ++b)
#pragma unroll
                for (int m = 0; m < 4; ++m)
#pragma unroll
                    for (int n = 0; n < 2; ++n) acc[a][b][m][n] = (f32x4){0.f, 0.f, 0.f, 0.f};
        cur = nxt; cA = nA; cB = nB; ++ui;
        if constexpr (ALIGN_EPI) { if (wr == 1) PG8_BAR; }
    }
    PG8_WAIT_V(0);
    if constexpr (!ALIGN_EPI) { if (wr == 0) PG8_BAR; }
    PG8_BAR;
#undef PG8_SA
#undef PG8_SB
#undef PG8_STAGE
#undef PG8_LDA
#undef PG8_LDB
#undef PG8_MMA
#undef PG8_WAIT_V
#undef PG8_WAIT_L
#undef PG8_BAR
#undef PG8_SCHED
}
}

typedef f32x4 Acc[2][2][4][2];

struct EpiInProj {
    bf16_t *Q1, *Q2, *K1c, *K2c, *VT, *TTl, *TTc, *UC; const float* rope;
    __device__ __forceinline__ void operator()(const Acc& acc, const pg8::Unit& u, int wr, int wc, int fr, int fq) const {
        const int pn = u.pn; const bool lat = u.pm < 64;
#pragma unroll
        for (int ai = 0; ai < 2; ++ai)
#pragma unroll
            for (int m = 0; m < 4; ++m) {
                const int row = u.pm * 256 + ai * 128 + wr * 64 + m * 16 + fr;
                int b, t; if (lat) { b = row >> 11; t = row & 2047; } else { const int rc = row - NLAT; b = rc >> 8; t = rc & 255; }
                const int pos = lat ? CTXL + t : t;
                if (pn < 4) {
                    bf16_t* dst;
                    if (pn == 0) dst = Q1 + (size_t)row * 256; else if (pn == 1) dst = Q2 + (size_t)row * 256;
                    else if (pn == 2) dst = K1c + ((size_t)b * KCAT + pos) * 256; else dst = K2c + ((size_t)b * KCAT + pos) * 256;
                    const float scale = pn < 2 ? QSCALE : 1.f;
                    const int ax = fq >> 1, fh = fq & 1;
                    u32x4 w1, w2;
#pragma unroll
                    for (int bj = 0; bj < 2; ++bj) {
                        f32x4 cs = {1.f, 1.f, 1.f, 1.f}, sn = {0.f, 0.f, 0.f, 0.f};
                        if (lat) { const int pidx = ax ? (t & 63) : (t >> 6); cs = *(const f32x4*)(rope + pidx * 16 + 8 * fh + 4 * bj); sn = *(const f32x4*)(rope + 1024 + pidx * 16 + 8 * fh + 4 * bj); }
                        const f32x4 x1 = acc[ai][bj][m][0], x2 = acc[ai][bj][m][1];
                        const u32x2 p1 = pack4((x1 * cs - x2 * sn) * scale), p2 = pack4((x2 * cs + x1 * sn) * scale);
                        if (bj == 0) { w1.x = p1.x; w1.y = p1.y; w2.x = p2.x; w2.y = p2.y; } else { w1.z = p1.x; w1.w = p1.y; w2.z = p2.x; w2.w = p2.y; }
                    }
                    bf16_t* dq = dst + wc * 64 + ax * 32 + 8 * fh;
                    *(u32x4*)dq = w1; *(u32x4*)(dq + 16) = w2;
                } else if (pn < 6) {
#pragma unroll
                    for (int bj = 0; bj < 2; ++bj)
#pragma unroll
                        for (int n = 0; n < 2; ++n) {
                            bf16_t* dst = VT + ((size_t)(b * 4 + (pn - 4) * 2 + bj) * 128 + wc * 32 + n * 16 + 4 * fq) * KCAT + pos;
                            const f32x4 v = acc[ai][bj][m][n];
                            dst[0] = f2bf(v[0]); dst[KCAT] = f2bf(v[1]); dst[2 * KCAT] = f2bf(v[2]); dst[3 * KCAT] = f2bf(v[3]);
                        }
                } else if (pn < 8) {
                    const int s = pn - 6;
#pragma unroll
                    for (int bj = 0; bj < 2; ++bj)
#pragma unroll
                        for (int n = 0; n < 2; ++n) {
                            const int jf = bj * 128 + wc * 32 + n * 16 + 4 * fq;
                            const f32x4 v = acc[ai][bj][m][n];
                            if (lat) { bf16_t* dst = TTl + (((size_t)b * 256 + jf) * 2 + s) * SEQ + t; dst[0] = f2bf(v[0]); dst[2 * SEQ] = f2bf(v[1]); dst[4 * SEQ] = f2bf(v[2]); dst[6 * SEQ] = f2bf(v[3]); }
                            else { bf16_t* dst = TTc + (((size_t)b * 256 + jf) * 2 + s) * CTXL + t; dst[0] = f2bf(v[0]); dst[2 * CTXL] = f2bf(v[1]); dst[4 * CTXL] = f2bf(v[2]); dst[6 * CTXL] = f2bf(v[3]); }
                        }
                } else {
                    bf16_t* dst = UC + (size_t)row * 512 + (pn - 8) * 256 + wc * 32 + 8 * fq;
#pragma unroll
                    for (int n = 0; n < 2; ++n) { const u32x2 p0 = pack4(acc[ai][0][m][n]), p1 = pack4(acc[ai][1][m][n]); *(u32x4*)(dst + 128 * n) = (u32x4){p0.x, p0.y, p1.x, p1.y}; }
                }
            }
    }
};

struct EpiRes {
    const float* xin_lat; const float* xin_ctx; float* xout_lat; float* xout_ctx; const float* mod; int goff; float* pb;
    __device__ __forceinline__ void operator()(const Acc& acc, const pg8::Unit& u, int wr, int wc, int fr, int fq) const {
        const int tile0 = u.pm * 256, colb = u.pn * 256 + wc * 32 + 4 * fq, rloc = wr * 64 + fr;
        if (u.flags & 1) {
            float* pq = pb + ((size_t)(u.flags >> 1) * NCTX + (tile0 - NLAT) + rloc) * DM + colb;
#pragma unroll
            for (int ai = 0; ai < 2; ++ai)
#pragma unroll
                for (int m = 0; m < 4; ++m)
#pragma unroll
                    for (int bj = 0; bj < 2; ++bj)
#pragma unroll
                        for (int n = 0; n < 2; ++n) *(f32x4*)(pq + (size_t)(ai * 128 + m * 16) * DM + bj * 128 + n * 16) = acc[ai][bj][m][n];
            return;
        }
        const bool lat = tile0 < NLAT;
        const float* xi = (lat ? xin_lat + (size_t)tile0 * DM : xin_ctx + (size_t)(tile0 - NLAT) * DM) + (size_t)rloc * DM + colb;
        float* xo = (lat ? xout_lat + (size_t)tile0 * DM : xout_ctx + (size_t)(tile0 - NLAT) * DM) + (size_t)rloc * DM + colb;
        const float* gp = mod + (lat ? (tile0 >> 11) : 8) * 6144 + goff + colb;
        f32x4 gt[2][2];
#pragma unroll
        for (int bj = 0; bj < 2; ++bj)
#pragma unroll
            for (int n = 0; n < 2; ++n) gt[bj][n] = *(const f32x4*)(gp + bj * 128 + n * 16);
        f32x4 xv[2][2][2];
#define ER_LOAD(buf, g_) do { const float* xp_ = xi + (size_t)(((g_) >> 2) * 128 + ((g_) & 3) * 16) * DM; \
            _Pragma("unroll") for (int bj = 0; bj < 2; ++bj) _Pragma("unroll") for (int n = 0; n < 2; ++n) xv[buf][bj][n] = *(const f32x4*)(xp_ + bj * 128 + n * 16); } while (0)
        ER_LOAD(0, 0);
#pragma unroll
        for (int g_ = 0; g_ < 8; ++g_) {
            if (g_ + 1 < 8) ER_LOAD((g_ + 1) & 1, g_ + 1);
            float* xq = xo + (size_t)((g_ >> 2) * 128 + (g_ & 3) * 16) * DM;
#pragma unroll
            for (int bj = 0; bj < 2; ++bj)
#pragma unroll
                for (int n = 0; n < 2; ++n) *(f32x4*)(xq + bj * 128 + n * 16) = xv[g_ & 1][bj][n] + gt[bj][n] * acc[g_ >> 2][bj][g_ & 3][n];
        }
#undef ER_LOAD
    }
};

struct EpiFfn13 {
    bf16_t* ACT;
    __device__ __forceinline__ void operator()(const Acc& acc, const pg8::Unit& u, int wr, int wc, int fr, int fq) const {
#pragma unroll
        for (int ai = 0; ai < 2; ++ai)
#pragma unroll
            for (int m = 0; m < 4; ++m) {
                const int row = u.pm * 256 + ai * 128 + wr * 64 + m * 16 + fr;
                u32x4 w;
#pragma unroll
                for (int bj = 0; bj < 2; ++bj) {
                    const f32x4 a = acc[ai][bj][m][0], b = acc[ai][bj][m][1]; f32x4 o;
#pragma unroll
                    for (int j = 0; j < 4; ++j) o[j] = a[j] * sigmoidf_(a[j]) * b[j];
                    const u32x2 pk = pack4(o);
                    if (bj == 0) { w.x = pk.x; w.y = pk.y; } else { w.z = pk.x; w.w = pk.y; }
                }
                *(u32x4*)(ACT + (size_t)row * DFF + 128 * u.pn + 32 * wc + 8 * fq) = w;
            }
    }
};

struct EpiMix {
    bf16_t* out; int pitch, col0, tok_base, tok_pn_step, col_pn_step;
    __device__ __forceinline__ void operator()(const Acc& acc, const pg8::Unit& u, int wr, int wc, int fr, int fq) const {
#pragma unroll
        for (int ai = 0; ai < 2; ++ai)
#pragma unroll
            for (int m = 0; m < 4; ++m) {
                const int row = u.pm * 256 + ai * 128 + wr * 64 + m * 16 + fr;
                bf16_t* dst = out + (size_t)(tok_base + u.pn * tok_pn_step + row) * pitch + col0 + u.pn * col_pn_step + wc * 32 + 4 * fq;
#pragma unroll
                for (int bj = 0; bj < 2; ++bj)
#pragma unroll
                    for (int n = 0; n < 2; ++n) *(u32x2*)(dst + bj * 128 + n * 16) = pack4(acc[ai][bj][m][n]);
            }
    }
};

namespace att {
constexpr int VP = 144, OFF_K1 = 0, OFF_K2 = 8192, OFF_VT = 16384, BUFSZ = 16384 + 128 * VP;
struct Args { const bf16_t *Q1, *Q2, *K1c, *K2c, *VT; bf16_t* MIXA; const float* subln; float lam, omli; };

__device__ __forceinline__ void attn_unit(LAS unsigned char* lds, const Args& A, int b, int h, int qrow0, int nkt) {
    const int tid = fresh_tid(), lane = tid & 63, r32 = lane & 31, hi = lane >> 5;
    const int wid = __builtin_amdgcn_readfirstlane(tid >> 6), map = wid >> 2, qg = wid & 3;
    const bf16_t* Qm = map ? A.Q2 : A.Q1;
    bf16x8 qf[4];
    { const bf16_t* qp = Qm + (size_t)(qrow0 + qg * 32 + r32) * 256 + h * 64 + hi * 8;
#pragma unroll
      for (int d0 = 0; d0 < 4; ++d0) qf[d0] = *(const bf16x8*)(qp + d0 * 16); }
    const int key_s = tid >> 3, ch_s = tid & 7;
    const bf16_t* k1src = A.K1c + ((size_t)b * KCAT + key_s) * 256 + h * 64 + ch_s * 8;
    const bf16_t* k2src = A.K2c + ((size_t)b * KCAT + key_s) * 256 + h * 64 + ch_s * 8;
    const bf16_t* vsrc = A.VT + ((size_t)(b * 4 + h) * 128 + key_s) * KCAT + ch_s * 8;
    const int kdst = key_s * 128 + ((ch_s ^ ((key_s >> 1) & 7)) << 4), vdst = key_s * VP + 32 * (ch_s >> 1) + 8 * (ch_s & 1);
    u32x4 rk1[2], rk2[2], rv0[2], rv1[2];
#define ATT_LOAD(set, t) do { rk1[set] = *(const u32x4*)(k1src + (size_t)(t) * 64 * 256); rk2[set] = *(const u32x4*)(k2src + (size_t)(t) * 64 * 256); \
        rv0[set] = *(const u32x4*)(vsrc + (t) * 64); rv1[set] = *(const u32x4*)(vsrc + (size_t)64 * KCAT + (t) * 64); } while (0)
#define ATT_STORE(set, buf) do { LAS unsigned char* bb_ = lds + (buf) * BUFSZ; *(LAS u32x4*)(bb_ + OFF_K1 + kdst) = rk1[set]; *(LAS u32x4*)(bb_ + OFF_K2 + kdst) = rk2[set]; \
        *(LAS u32x2*)(bb_ + OFF_VT + vdst) = (u32x2){rv0[set].x, rv0[set].y}; *(LAS u32x2*)(bb_ + OFF_VT + vdst + 16) = (u32x2){rv0[set].z, rv0[set].w}; \
        *(LAS u32x2*)(bb_ + OFF_VT + 64 * VP + vdst) = (u32x2){rv1[set].x, rv1[set].y}; *(LAS u32x2*)(bb_ + OFF_VT + 64 * VP + vdst + 16) = (u32x2){rv1[set].z, rv1[set].w}; } while (0)
    constexpr float THR = 6.f;
    float mrun = 0.f, lrun = 0.f;
    f32x16 O[4];
#pragma unroll
    for (int i = 0; i < 4; ++i)
#pragma unroll
        for (int r = 0; r < 16; ++r) O[i][r] = 0.f;
    ATT_LOAD(0, 0); ATT_STORE(0, 0); __syncthreads();
    ATT_LOAD(1, 1);
    for (int t0 = 0; t0 < nkt; t0 += 2) {
#pragma unroll
      for (int tt = 0; tt < 2; ++tt) {
        const int t = t0 + tt, cur = tt;
        if (t + 2 < nkt) ATT_LOAD(tt, t + 2);
        LAS unsigned char* base = lds + cur * BUFSZ;
        LAS unsigned char* kb = base + (map ? OFF_K2 : OFF_K1) + r32 * 128;
        f32x16 s0, s1;
#pragma unroll
        for (int r = 0; r < 16; ++r) { s0[r] = -mrun; s1[r] = -mrun; }
#pragma unroll
        for (int d0 = 0; d0 < 4; ++d0) {
            const int chunk = ((2 * d0 + hi) ^ ((r32 >> 1) & 7)) << 4;
            const bf16x8 a0 = *(const LAS bf16x8*)(kb + chunk), a1 = *(const LAS bf16x8*)(kb + 32 * 128 + chunk);
            s0 = __builtin_amdgcn_mfma_f32_32x32x16_bf16(a0, qf[d0], s0, 0, 0, 0);
            s1 = __builtin_amdgcn_mfma_f32_32x32x16_bf16(a1, qf[d0], s1, 0, 0, 0);
        }
        asm volatile("s_nop 15\n\ts_nop 4" : "+v"(s0), "+v"(s1));
        LAS unsigned char* vb = base + OFF_VT + r32 * VP + 16 * hi;
        u32x4 vf[2][4];
#define ATT_LDV(slot, c) do { _Pragma("unroll") for (int dblk = 0; dblk < 4; ++dblk) { \
            vf[slot][dblk] = *(const LAS u32x4*)(vb + dblk * 32 * VP + 32 * (c)); } } while (0)
        ATT_LDV(0, 0);
        __builtin_amdgcn_sched_barrier(0);
        float rm = max3f(s0[0], s0[1], s1[0]), rm2 = max3f(s0[2], s0[3], s1[1]);
        rm = max3f(rm, s1[2], s1[3]);
#pragma unroll
        for (int r = 4; r < 16; r += 4) { rm = max3f(rm, s0[r], s0[r + 1]); rm2 = max3f(rm2, s0[r + 2], s0[r + 3]); rm = max3f(rm, s1[r], s1[r + 1]); rm2 = max3f(rm2, s1[r + 2], s1[r + 3]); }
        rm = fmaxf(rm, rm2);
        rm = fmaxf(rm, __shfl_xor(rm, 32));
        const bool need = (t == 0) || (rm > THR);
        if (__any(need)) {
            const float dlt = need ? rm : 0.f, alpha = (t == 0) ? 1.f : __builtin_amdgcn_exp2f(-dlt);
            mrun += dlt; lrun *= alpha;
            s0 = s0 - dlt; s1 = s1 - dlt;
#pragma unroll
            for (int i = 0; i < 4; ++i)
#pragma unroll
                for (int r = 0; r < 16; ++r) O[i][r] *= alpha;
        }
#pragma unroll
        for (int r = 0; r < 16; ++r) { s0[r] = __builtin_amdgcn_exp2f(s0[r]); s1[r] = __builtin_amdgcn_exp2f(s1[r]); }
        { const f32x16 t16 = s0 + s1;
          typedef float f32x8 __attribute__((ext_vector_type(8)));
          const f32x8 t8 = t16.lo + t16.hi; const f32x4 t4 = t8.lo + t8.hi;
          lrun += (t4[0] + t4[1]) + (t4[2] + t4[3]); }
        bf16x8 P[4];
        { u32x4 w;
          w.x = cvt_pk_bf16(s0[0], s0[1]); w.y = cvt_pk_bf16(s0[2], s0[3]); w.z = cvt_pk_bf16(s0[4], s0[5]); w.w = cvt_pk_bf16(s0[6], s0[7]); P[0] = __builtin_bit_cast(bf16x8, w);
          w.x = cvt_pk_bf16(s0[8], s0[9]); w.y = cvt_pk_bf16(s0[10], s0[11]); w.z = cvt_pk_bf16(s0[12], s0[13]); w.w = cvt_pk_bf16(s0[14], s0[15]); P[1] = __builtin_bit_cast(bf16x8, w);
          w.x = cvt_pk_bf16(s1[0], s1[1]); w.y = cvt_pk_bf16(s1[2], s1[3]); w.z = cvt_pk_bf16(s1[4], s1[5]); w.w = cvt_pk_bf16(s1[6], s1[7]); P[2] = __builtin_bit_cast(bf16x8, w);
          w.x = cvt_pk_bf16(s1[8], s1[9]); w.y = cvt_pk_bf16(s1[10], s1[11]); w.z = cvt_pk_bf16(s1[12], s1[13]); w.w = cvt_pk_bf16(s1[14], s1[15]); P[3] = __builtin_bit_cast(bf16x8, w); }
        __builtin_amdgcn_sched_barrier(0);
        ATT_LDV(1, 1);
        __builtin_amdgcn_sched_barrier(0);
#pragma unroll
        for (int dblk = 0; dblk < 4; ++dblk) O[dblk] = __builtin_amdgcn_mfma_f32_32x32x16_bf16(__builtin_bit_cast(bf16x8, vf[0][dblk]), P[0], O[dblk], 0, 0, 0);
        __builtin_amdgcn_sched_barrier(0);
        ATT_LDV(0, 2);
        __builtin_amdgcn_sched_barrier(0);
#pragma unroll
        for (int dblk = 0; dblk < 4; ++dblk) O[dblk] = __builtin_amdgcn_mfma_f32_32x32x16_bf16(__builtin_bit_cast(bf16x8, vf[1][dblk]), P[1], O[dblk], 0, 0, 0);
        __builtin_amdgcn_sched_barrier(0);
        ATT_LDV(1, 3);
        __builtin_amdgcn_sched_barrier(0);
#pragma unroll
        for (int dblk = 0; dblk < 4; ++dblk) O[dblk] = __builtin_amdgcn_mfma_f32_32x32x16_bf16(__builtin_bit_cast(bf16x8, vf[0][dblk]), P[2], O[dblk], 0, 0, 0);
        __builtin_amdgcn_sched_barrier(0);
#pragma unroll
        for (int dblk = 0; dblk < 4; ++dblk) O[dblk] = __builtin_amdgcn_mfma_f32_32x32x16_bf16(__builtin_bit_cast(bf16x8, vf[1][dblk]), P[3], O[dblk], 0, 0, 0);
#undef ATT_LDV
        if (t + 1 < nkt) ATT_STORE(tt ^ 1, tt ^ 1);
        asm volatile("s_waitcnt lgkmcnt(0)" ::: "memory"); __builtin_amdgcn_s_barrier(); asm volatile("" ::: "memory");
      }
    }
#undef ATT_LOAD
#undef ATT_STORE
    lrun += __shfl_xor(lrun, 32);
    const float inv = 1.f / lrun;
    LAS float* ex = (LAS float*)lds + qg * 4096;
    if (map == 1) {
#pragma unroll
        for (int i = 0; i < 4; ++i)
#pragma unroll
            for (int r = 0; r < 16; ++r) ex[(i * 16 + r) * 64 + lane] = O[i][r] * inv;
    }
    __syncthreads();
    if (map == 0) {
        float ss = 0.f;
#pragma unroll
        for (int i = 0; i < 4; ++i)
#pragma unroll
            for (int r = 0; r < 16; ++r) { const float o = O[i][r] * inv - A.lam * ex[(i * 16 + r) * 64 + lane]; O[i][r] = o; ss += o * o; }
        ss += __shfl_xor(ss, 32);
        const float rstd = __builtin_amdgcn_rsqf(ss * (1.f / 128.f) + EPSV) * A.omli;
        bf16_t* dst = A.MIXA + (size_t)(qrow0 + qg * 32 + r32) * DM + h * 128 + 4 * hi;
#pragma unroll
        for (int i = 0; i < 4; ++i)
#pragma unroll
            for (int rq = 0; rq < 4; ++rq) {
                const int d0 = 32 * i + 8 * rq;
                const f32x4 gg = *(const f32x4*)(A.subln + d0 + 4 * hi);
                f32x4 v = {O[i][4 * rq] * rstd * gg[0], O[i][4 * rq + 1] * rstd * gg[1], O[i][4 * rq + 2] * rstd * gg[2], O[i][4 * rq + 3] * rstd * gg[3]};
                *(u32x2*)(dst + d0) = pack4(v);
            }
    }
    __syncthreads();
}
}

__device__ __forceinline__ void conv_item(const Params& p, LAS unsigned char* lds, int l, int item, const bf16_t* UC, bf16_t* MIXA) {
    const int tid = fresh_tid(), lane = tid & 63, wid = tid >> 6, g = wid & 3, th = wid >> 2;
    const int ch = g * 64 + lane;
    int rowbase, t0, L;
    if (item < 256) { rowbase = (item >> 5) * SEQ; t0 = (item & 31) * 64; L = SEQ; }
    else { const int j = item - 256; rowbase = NLAT + (j >> 2) * CTXL; t0 = (j & 3) * 64; L = CTXL; }
    LAS float* zl = (LAS float*)lds;
    {
        u32x4 av[6], gv[6];
#pragma unroll
        for (int it = 0; it < 6; ++it) {
            int idx = tid + it * 512; idx = idx < 94 * 32 ? idx : 94 * 32 - 1;
            const int pr = idx >> 5, c8 = idx & 31; int pp = t0 - 15 + pr; pp = pp < 0 ? 0 : (pp >= L ? L - 1 : pp);
            const bf16_t* up = UC + (size_t)(rowbase + pp) * 512 + c8 * 8;
            av[it] = *(const u32x4*)up; gv[it] = *(const u32x4*)(up + 256);
        }
#pragma unroll
        for (int it = 0; it < 6; ++it) {
            const int idx = tid + it * 512;
            const int pr = idx >> 5, c8 = idx & 31, pp = t0 - 15 + pr;
            const float msk = (pp >= 0 && pp < L) ? 1.f : 0.f;
            f32x4 z0, z1;
#pragma unroll
            for (int q = 0; q < 4; ++q) {
                const float a_lo = __uint_as_float(av[it][q] << 16), a_hi = __uint_as_float(av[it][q] & 0xffff0000u);
                const float g_lo = __uint_as_float(gv[it][q] << 16), g_hi = __uint_as_float(gv[it][q] & 0xffff0000u);
                const float zlo = a_lo * sigmoidf_(g_lo) * msk, zhi = a_hi * sigmoidf_(g_hi) * msk;
                if (q < 2) { z0[2 * q] = zlo; z0[2 * q + 1] = zhi; } else { z1[2 * (q - 2)] = zlo; z1[2 * (q - 2) + 1] = zhi; }
            }
            if (idx < 94 * 32) { *(LAS f32x4*)(zl + pr * 256 + c8 * 8) = z0; *(LAS f32x4*)(zl + pr * 256 + c8 * 8 + 4) = z1; }
        }
    }
    __syncthreads();
    const int ts = t0 + th * 32;
    float w[31];
#pragma unroll
    for (int k = 0; k < 31; ++k) w[k] = p.conv_w[(size_t)l * 31 * 256 + k * 256 + ch];
    float o[32];
    const float bias = p.conv_b[l * 256 + ch];
    const LAS float* zp = zl + (th * 32) * 256 + ch;
    float z[62];
#pragma unroll
    for (int jj = 0; jj < 62; ++jj) z[jj] = zp[jj * 256];
#pragma unroll
    for (int i = 0; i < 32; ++i) {
        float acc = bias;
#pragma unroll
        for (int k = 0; k < 31; ++k) acc += w[k] * z[i + k];
        o[i] = acc;
    }
    const float lg = p.conv_ln_g[l * 256 + ch], lb = p.conv_ln_b[l * 256 + ch];
#pragma unroll
    for (int i = 0; i < 32; ++i) {
        const float mu = wave_sum(o[i]) * (1.f / 64.f);
        const float d = o[i] - mu;
        const float var = wave_sum(d * d) * (1.f / 64.f);
        const float zn = d * __builtin_amdgcn_rsqf(var + EPSV) * lg + lb;
        MIXA[(size_t)(rowbase + ts + i) * DM + 768 + ch] = f2bf(zn * sigmoidf_(zn));
    }
    __syncthreads();
}

__device__ __forceinline__ int drow_map(int mode, int n) {
    if (mode == 0) return n;
    if (mode == 1) {
        if (n < 1024) { const int cs = n & 255, head = cs >> 6, d = cs & 63, a = d >> 5, pp = (d >> 4) & 1, f = d & 15;
            return (n & ~255) + 128 * ((f >> 2) & 1) + 32 * head + 16 * pp + 4 * (2 * a + (f >> 3)) + (f & 3); }
        if (n < 1792) return n;
        { const int mm = n - 1792, cs = mm & 255;
          return 2048 + (mm & ~255) + 128 * ((cs >> 2) & 1) + 32 * ((cs >> 5) & 3) + 16 * (cs >> 7) + 4 * ((cs >> 3) & 3) + (cs & 3); }
    }
    const int r = 256 * (n >> 7) + 128 * ((n >> 2) & 1) + 32 * ((n >> 5) & 3) + 4 * ((n >> 3) & 3) + (n & 3);
    return mode == 2 ? r : r + 16;
}
__device__ __forceinline__ void transpose_item(const float* W, int ldw, int K, bf16_t* WT, int mode, LAS float* scr, int kb, int nb, int lane) {
    const int k0 = 64 * kb, n0 = 32 * nb;
#pragma unroll 8
    for (int i = 0; i < 32; ++i) { const int kk = 2 * i + (lane >> 5); scr[kk * 33 + (lane & 31)] = W[(size_t)(k0 + kk) * ldw + n0 + (lane & 31)]; }
    asm volatile("s_waitcnt lgkmcnt(0)" ::: "memory");
    const int c = lane & 7;
#pragma unroll
    for (int j = 0; j < 4; ++j) { const int n = (lane >> 3) + 8 * j; const LAS float* s = scr + (8 * c) * 33 + n;
        u32x4 o; o.x = cvt_pk_bf16(s[0 * 33], s[1 * 33]); o.y = cvt_pk_bf16(s[2 * 33], s[3 * 33]); o.z = cvt_pk_bf16(s[4 * 33], s[5 * 33]); o.w = cvt_pk_bf16(s[6 * 33], s[7 * 33]);
        *(u32x4*)(WT + (size_t)drow_map(mode, n0 + n) * K + k0 + 8 * c) = o; }
    asm volatile("s_waitcnt lgkmcnt(0)" ::: "memory");
}

__device__ __forceinline__ void prep_phase(const Params& p, LAS unsigned char* lds) {
    const int tid = fresh_tid(), lane = tid & 63, wave = tid >> 6, G = gridDim.x;
    const int gw = blockIdx.x * 8 + wave, NGW = G * 8;
    const int gt = blockIdx.x * 512 + tid, NGT = G * 512;
    unsigned char* ws = p.ws;
    LAS float* tab = (LAS float*)(lds + 73728);
    LAS float* t64c = tab + 2048; LAS float* t64s = t64c + 64;
    for (int m = tid; m < 2048; m += 512) tab[m] = cospif((float)m * (1.f / 1024.f));
    if (tid < 64) { t64c[tid] = cospif((float)tid * (1.f / 32.f)); t64s[tid] = sinpif((float)tid * (1.f / 32.f)); }
    __syncthreads();
    if (gt < 1024) { const int pos = gt >> 4, f = gt & 15; const float inv = powf(10000.f, -(float)f / 16.f); const float ang = (float)pos * inv;
        float* rope = (float*)(ws + WS_ROPE); rope[gt] = cosf(ang); rope[1024 + gt] = sinf(ang); }
    {
        LAS float* scr = (LAS float*)(lds + wave * 8448);
        constexpr int I_IN = 16 * 72, I_OUT = 16 * 32, I_F1 = 16 * 88, I_F2 = 44 * 32, I_L = I_IN + I_OUT + 2 * I_F1 + I_F2;
        for (int it = gw; it < 2 * I_L; it += NGW) {
            const int l = it / I_L; int r = it % I_L;
            if (r < I_IN) { const int kb = r / 72, nb = r % 72; if (nb >= 48 && nb < 56) continue;
                transpose_item(p.w_in + (size_t)l * DM * INW_SRC, INW_SRC, DM, (bf16_t*)(ws + WS_WIN) + (size_t)l * INW * DM, 1, scr, kb, nb, lane); continue; }
            r -= I_IN;
            if (r < I_OUT) { transpose_item(p.w_out + (size_t)l * DM * DM, DM, DM, (bf16_t*)(ws + WS_WOUT) + (size_t)l * DM * DM, 0, scr, r / 32, r % 32, lane); continue; }
            r -= I_OUT;
            if (r < I_F1) { transpose_item(p.w_ffn1 + (size_t)l * DM * DFF, DFF, DM, (bf16_t*)(ws + WS_W13) + (size_t)l * N13 * DM, 2, scr, r / 88, r % 88, lane); continue; }
            r -= I_F1;
            if (r < I_F1) { transpose_item(p.w_ffn3 + (size_t)l * DM * DFF, DFF, DM, (bf16_t*)(ws + WS_W13) + (size_t)l * N13 * DM, 3, scr, r / 88, r % 88, lane); continue; }
            r -= I_F1;
            transpose_item(p.w_ffn2 + (size_t)l * DFF * DM, DM, DFF, (bf16_t*)(ws + WS_W2) + (size_t)l * DM * DFF, 0, scr, r / 32, r % 32, lane);
        }
    }
    {
        const float tcl = cospif((float)lane * (1.f / 32.f)), tsl = sinpif((float)lane * (1.f / 32.f));
        for (int it = gw; it < 2 * 4 * 16 * 16; it += NGW) {
            const int l = it >> 10, g = (it >> 8) & 3, kbk = (it >> 4) & 15, lqg = it & 15;
            const int k = kbk * 64 + lane;
            const float* wr_ = p.w_in + (size_t)l * DM * INW_SRC + (size_t)k * INW_SRC + 1536 + g * 64;
            float wv[64];
#pragma unroll
            for (int c4 = 0; c4 < 16; ++c4) { const f32x4 v = *(const f32x4*)(wr_ + 4 * c4); wv[4 * c4] = v[0]; wv[4 * c4 + 1] = v[1]; wv[4 * c4 + 2] = v[2]; wv[4 * c4 + 3] = v[3]; }
            bf16_t* wt = (bf16_t*)(ws + WS_WIN) + (size_t)l * INW * DM;
#pragma unroll 1
            for (int li = 0; li < 4; ++li) {
                const int lq = __builtin_amdgcn_readfirstlane(lqg * 4 + li);
                float ac = 0.f, as = 0.f;
#pragma unroll
                for (int c = 0; c < 64; ++c) {
                    const int m = (lq * c) & 63;
                    const float ct = __int_as_float(__builtin_amdgcn_readlane(__float_as_int(tcl), m)), st = __int_as_float(__builtin_amdgcn_readlane(__float_as_int(tsl), m));
                    ac += wv[c] * ct; as += wv[c] * st;
                }
                wt[(size_t)(1536 + g * 64 + lq) * DM + k] = f2bf(ac);
                wt[(size_t)(1536 + 256 + g * 64 + lq) * DM + k] = f2bf(as);
            }
        }
    }
    for (int e = gt; e < 2 * WSM_L; e += NGT) {
        const int l = e / WSM_L, r = e % WSM_L; float v;
        if (r < 256 * 512) { const int n = r >> 9, k = r & 255; const int g = n >> 6, d = n & 63, g2 = k >> 6, c = k & 63; v = (g == g2) ? p.w_fourier[(((size_t)l * 4 + g) * 64 + c) * 64 + d] : 0.f; }
        else { const int r2 = r - 256 * 512, n = r2 >> 8, k = r2 & 255; v = p.w_conv_out[((size_t)l * 256 + k) * 256 + n]; }
        ((bf16_t*)(ws + WS_WSM))[e] = f2bf(v);
    }
    {
        const float nl = 1.f / sqrtf(2048.f * 64.f), nc = 1.f / 128.f;
        for (int e = gt; e < 2048 * 4096 / 8; e += NGT) {
            const int k = e >> 9, col0 = (e & 511) * 8, s = col0 >> 11; float v[8];
#pragma unroll
            for (int j = 0; j < 8; ++j) { const int n = (col0 + j) & 2047, m = (k * n) & 2047; v[j] = s ? -tab[(m - 512) & 2047] * nl : tab[m] * nl; }
            u32x4 o; o.x = cvt_pk_bf16(v[0], v[1]); o.y = cvt_pk_bf16(v[2], v[3]); o.z = cvt_pk_bf16(v[4], v[5]); o.w = cvt_pk_bf16(v[6], v[7]);
            *(u32x4*)((bf16_t*)(ws + WS_DFTL) + (size_t)e * 8) = o;
        }
        for (int e = gt; e < 256 * 512 / 8; e += NGT) {
            const int k = e >> 6, col0 = (e & 63) * 8, s = col0 >> 8; float v[8];
#pragma unroll
            for (int j = 0; j < 8; ++j) { const int n = (col0 + j) & 255, m = ((k * n) & 255) * 8; v[j] = s ? -tab[(m - 512) & 2047] * nc : tab[m] * nc; }
            u32x4 o; o.x = cvt_pk_bf16(v[0], v[1]); o.y = cvt_pk_bf16(v[2], v[3]); o.z = cvt_pk_bf16(v[4], v[5]); o.w = cvt_pk_bf16(v[6], v[7]);
            *(u32x4*)((bf16_t*)(ws + WS_DFTC) + (size_t)e * 8) = o;
        }
    }
    for (int it = gw; it < 2 * 96 * 8; it += NGW) {
        const int l = it / 768, r = it % 768, cgp = r >> 3, kc = r & 7;
        const int col = cgp * 64 + lane, k0 = kc * 128;
        float sv[9][2];
#pragma unroll
        for (int b = 0; b < 9; ++b)
#pragma unroll
            for (int hh = 0; hh < 2; ++hh) { const int k = k0 + hh * 64 + lane; const float cv = (b < 8) ? p.c[b * DM + k] : p.c_ctx[k]; sv[b][hh] = cv * sigmoidf_(cv); }
        float ac[9];
#pragma unroll
        for (int b = 0; b < 9; ++b) ac[b] = 0.f;
        const float* wp = p.w_ada + ((size_t)l * DM + k0) * 6144 + col;
#pragma unroll
        for (int hh = 0; hh < 2; ++hh) {
#pragma unroll 8
            for (int kk = 0; kk < 64; ++kk) {
                const float wv = wp[(size_t)(hh * 64 + kk) * 6144];
#pragma unroll
                for (int b = 0; b < 9; ++b) ac[b] += __int_as_float(__builtin_amdgcn_readlane(__float_as_int(sv[b][hh]), kk)) * wv;
            }
        }
        const float bias = (kc == 0) ? p.b_ada[l * 6144 + col] : 0.f;
        float* mod = (float*)(ws + WS_MOD) + (size_t)l * 9 * 6144;
#pragma unroll
        for (int b = 0; b < 9; ++b) atomicAdd(mod + b * 6144 + col, ac[b] + bias);
    }
}

__device__ __forceinline__ void norm_phase(const float* xlat, const float* xctx, const float* gvec, const float* mod, int sh_off, int sc_off, bf16_t* H, int nrows,
                                           const float* part, const float* pgate, float* xctx_out) {
    const int tid = fresh_tid(), lane = tid & 63, gw = blockIdx.x * 8 + (tid >> 6), NGW = gridDim.x * 8;
    f32x4 vn[4];
#define NORM_LOADX(dst, r_) do { const int r__ = (r_); const float* xr_ = r__ < NLAT ? xlat + (size_t)r__ * DM : xctx + (size_t)(r__ - NLAT) * DM; \
        _Pragma("unroll") for (int j = 0; j < 4; ++j) dst[j] = *(const f32x4*)(xr_ + 4 * lane + 256 * j); } while (0)
    if (gw < nrows) NORM_LOADX(vn, gw);
    for (int row = gw; row < nrows; row += NGW) {
        const int bb = row < NLAT ? row >> 11 : 8;
        f32x4 v[4]; float ss = 0.f;
#pragma unroll
        for (int j = 0; j < 4; ++j) v[j] = vn[j];
        if (row + NGW < nrows) NORM_LOADX(vn, row + NGW);
        const float* mp = mod + bb * 6144;
        f32x4 gg[4], sc[4], sh[4];
#pragma unroll
        for (int j = 0; j < 4; ++j) { const int col = 4 * lane + 256 * j; gg[j] = *(const f32x4*)(gvec + col); sc[j] = *(const f32x4*)(mp + sc_off + col); sh[j] = *(const f32x4*)(mp + sh_off + col); }
        if (part != nullptr && row >= NLAT) {
#pragma unroll
            for (int j = 0; j < 4; ++j) {
                const size_t o = (size_t)(row - NLAT) * DM + 4 * lane + 256 * j;
                const f32x4 ps = (*(const f32x4*)(part + o) + *(const f32x4*)(part + (size_t)NCTX * DM + o)) + (*(const f32x4*)(part + (size_t)2 * NCTX * DM + o) + *(const f32x4*)(part + (size_t)3 * NCTX * DM + o));
                v[j] = v[j] + *(const f32x4*)(pgate + 4 * lane + 256 * j) * ps;
                *(f32x4*)(xctx_out + o) = v[j];
            }
        }
#pragma unroll
        for (int j = 0; j < 4; ++j) ss += (v[j][0] * v[j][0] + v[j][1] * v[j][1]) + (v[j][2] * v[j][2] + v[j][3] * v[j][3]);
        const float rstd = __builtin_amdgcn_rsqf(wave_sum(ss) * (1.f / DM) + EPSV);
#pragma unroll
        for (int j = 0; j < 4; ++j) {
            const int col = 4 * lane + 256 * j;
            const f32x4 y = (v[j] * rstd) * gg[j];
            const f32x4 hv = y * (sc[j] + 1.f) + sh[j];
            *(u32x2*)(H + (size_t)row * DM + col) = pack4(hv);
        }
    }
#undef NORM_LOADX
}

__global__ void __launch_bounds__(512, 2) fwd_kernel(Params p) {
    extern __shared__ __attribute__((aligned(16))) unsigned char lds_raw[];
    LAS unsigned char* lds = (LAS unsigned char*)lds_raw;
    cg::grid_group grid = cg::this_grid();
    const int G = gridDim.x, cu = blockIdx.x;
    unsigned char* ws = p.ws;
    bf16_t* H = (bf16_t*)(ws + WS_H);
    bf16_t* Q1 = (bf16_t*)(ws + WS_Q1); bf16_t* Q2 = (bf16_t*)(ws + WS_Q2); bf16_t* K1c = (bf16_t*)(ws + WS_K1); bf16_t* K2c = (bf16_t*)(ws + WS_K2);
    bf16_t* VT = (bf16_t*)(ws + WS_VT); bf16_t* TTl = (bf16_t*)(ws + WS_TTL); bf16_t* TTc = (bf16_t*)(ws + WS_TTC); bf16_t* UC = (bf16_t*)(ws + WS_UC);
    bf16_t* MIXA = (bf16_t*)(ws + WS_MIX); bf16_t* ACT = (bf16_t*)(ws + WS_ACT);
    float* PB1 = (float*)(ws + WS_R); float* PB2 = (float*)(ws + WS_R + 99 * MiB);
    bf16_t* FP = (bf16_t*)(ws + WS_H);
    float* XL = p.out; float* XC = (float*)(ws + WS_XCTX);
    const float* rope = (const float*)(ws + WS_ROPE);

    volatile LAS unsigned* bst = (volatile LAS unsigned*)(lds + LDS_BYTES - 64);
    if (threadIdx.x < 2) bst[threadIdx.x] = 0u;
    __syncthreads();
    const XcdBarrier xbar = xcd_barrier_post((unsigned*)(ws + WS_BAR), bst);
#define GSYNC() xcd_barrier(xbar)

    prep_phase(p, lds);
    grid.sync();

#pragma unroll 1
    for (int l = 0; l < 2; ++l) {
        const float* mod = (const float*)(ws + WS_MOD) + (size_t)l * 9 * 6144;
        const float* xin_l = l == 0 ? p.x : XL; const float* xin_c = l == 0 ? p.ctx : XC;
        const int mrows = l == 0 ? MTOT : NLAT;
        if (PROBE == 3) { for (int rep = 0; rep < 8; ++rep) GSYNC(); }
        norm_phase(xin_l, xin_c, p.norm1_g + l * DM, mod, 0, 1024, H, MTOT, l == 1 ? PB2 : nullptr, (const float*)(ws + WS_MOD) + 8 * 6144 + 5120, XC);
        GSYNC();
        for (int rep = 0; rep < (PROBE == 4 ? 2 : 1); ++rep) {
            if (rep) GSYNC();
            pg8::Gemm g{H, (const bf16_t*)(ws + WS_WIN) + (size_t)l * INW * DM, MTOT, INW, DM, DM, DM, 0};
            pg8::StaticOrder S; S.init(MTOT, INW, G, cu);
            EpiInProj E{Q1, Q2, K1c, K2c, VT, TTl, TTc, UC, rope};
            pg8::gemm_phase<EpiInProj, pg8::StaticOrder, true>(lds, g, S, E);
        }
        GSYNC();
        for (int rep = 0; rep < (PROBE == 1 ? 2 : 1); ++rep) {
            if (rep) GSYNC();
            const float li = 0.8f - 0.6f * __expf(-0.3f * (float)l);
            float lam;
            { const int lane = fresh_tid() & 63;
              const float s1 = wave_sum(p.lam_q1[l * 64 + lane] * p.lam_k1[l * 64 + lane]), s2 = wave_sum(p.lam_q2[l * 64 + lane] * p.lam_k2[l * 64 + lane]);
              lam = expf(s1) - expf(s2) + li; }
            att::Args A{Q1, Q2, K1c, K2c, VT, MIXA, p.subln_g + l * 128, lam, 1.f - li};
            const int n_att = 512 + (l == 0 ? 64 : 0);
            for (int u = cu; u < n_att; u += G) {
                if (u < 512) att::attn_unit(lds, A, u >> 6, (u >> 4) & 3, (u >> 6) * SEQ + (u & 15) * 128, 36);
                else { const int v = u - 512; att::attn_unit(lds, A, v >> 3, (v >> 1) & 3, NLAT + (v >> 3) * CTXL + (v & 1) * 128, 4); }
            }
#pragma unroll 1
            for (int hf = 0; hf < 2; ++hf) {
                pg8::Gemm g{(const bf16_t*)(ws + WS_DFTL) + hf * 2048, TTl + hf * 2048, 2048, 2048, 2048, 4096, 4096, 0};
                pg8::OffsetOrder S; S.init(2048, 2048, G, cu, 64 + 64 * hf);
                EpiMix E{FP, 512, hf * 256, 0, SEQ, 0};
                pg8::gemm_phase<EpiMix, pg8::OffsetOrder, true>(lds, g, S, E);
            }
            if (l == 0) {
#pragma unroll 1
                for (int hf = 0; hf < 2; ++hf) {
                    pg8::Gemm g{(const bf16_t*)(ws + WS_DFTC) + hf * 256, TTc + hf * 256, 256, 2048, 256, 512, 512, 0};
                    pg8::OffsetOrder S; S.init(256, 2048, G, cu, 192 + 8 * hf);
                    EpiMix E{FP, 512, hf * 256, NLAT, CTXL, 0};
                    pg8::gemm_phase<EpiMix, pg8::OffsetOrder, true>(lds, g, S, E);
                }
            }
            const int n_conv = l == 0 ? 288 : 256;
            if (G == 256) {
                const int sidx = cu < 64 ? cu : (cu >= 192 ? cu - 128 : -1);
                if (sidx >= 0) for (int it = sidx; it < n_conv; it += 128) conv_item(p, lds, l, it, UC, MIXA);
            } else for (int it = cu; it < n_conv; it += G) conv_item(p, lds, l, it, UC, MIXA);
        }
        GSYNC();
        {
            const bf16_t* wsm = (const bf16_t*)(ws + WS_WSM) + (size_t)l * WSM_L;
            {
                pg8::Gemm g{FP, wsm, mrows, 256, 512, 512, 512, 0};
                pg8::OffsetOrder S; S.init(mrows, 256, G, cu, 0);
                EpiMix E{MIXA, DM, 512, 0, 0, 0};
                pg8::gemm_phase<EpiMix, pg8::OffsetOrder, true>(lds, g, S, E);
            }
            {
                pg8::Gemm g{MIXA + 768, wsm + 256 * 512, mrows, 256, 256, DM, 256, 0};
                pg8::OffsetOrder S; S.init(mrows, 256, G, cu, 72);
                EpiMix E{MIXA, DM, 768, 0, 0, 0};
                pg8::gemm_phase<EpiMix, pg8::OffsetOrder, true>(lds, g, S, E);
            }
        }
        GSYNC();
        {
            pg8::Gemm g{MIXA, (const bf16_t*)(ws + WS_WOUT) + (size_t)l * DM * DM, mrows, DM, DM, DM, DM, 0};
            EpiRes E{xin_l, xin_c, XL, XC, mod, 2048, PB1};
            if (l == 0) { pg8::CtxSplitOrder S; S.init(DM, DM, G, cu); pg8::gemm_phase<EpiRes, pg8::CtxSplitOrder, true>(lds, g, S, E); }
            else { pg8::StaticOrder S; S.init(mrows, DM, G, cu); pg8::gemm_phase<EpiRes, pg8::StaticOrder, true>(lds, g, S, E); }
        }
        GSYNC();
        norm_phase(XL, l == 0 ? p.ctx : XC, p.norm2_g + l * DM, mod, 3072, 4096, H, mrows, l == 0 ? PB1 : nullptr, mod + 8 * 6144 + 2048, XC);
        GSYNC();
        for (int rep = 0; rep < (PROBE == 2 ? 2 : 1); ++rep) {
            if (rep) GSYNC();
            pg8::Gemm g{H, (const bf16_t*)(ws + WS_W13) + (size_t)l * N13 * DM, mrows, N13, DM, DM, DM, 0};
            pg8::StaticOrder S; S.init(mrows, N13, G, cu);
            EpiFfn13 E{ACT};
            pg8::gemm_phase<EpiFfn13, pg8::StaticOrder, true>(lds, g, S, E);
        }
        GSYNC();
        {
            pg8::Gemm g{ACT, (const bf16_t*)(ws + WS_W2) + (size_t)l * DM * DFF, mrows, DM, DFF, DFF, DFF, 0};
            EpiRes E{XL, XC, XL, XC, mod, 5120, PB2};
            if (l == 0) { pg8::CtxSplitOrder S; S.init(DM, DFF, G, cu); pg8::gemm_phase<EpiRes, pg8::CtxSplitOrder, true>(lds, g, S, E); }
            else { pg8::StaticOrder S; S.init(mrows, DM, G, cu); pg8::gemm_phase<EpiRes, pg8::StaticOrder, true>(lds, g, S, E); }
        }
        GSYNC();
    }
    {
        const int tid = fresh_tid(), lane = tid & 63, gw = blockIdx.x * 8 + (tid >> 6), NGW = gridDim.x * 8;
        f32x4 gg[4], vn[4];
#pragma unroll
        for (int j = 0; j < 4; ++j) { gg[j] = *(const f32x4*)(p.final_g + 4 * lane + 256 * j); vn[j] = *(const f32x4*)(XL + (size_t)gw * DM + 4 * lane + 256 * j); }
        for (int row = gw; row < NLAT; row += NGW) {
            float* xr = XL + (size_t)row * DM;
            f32x4 v[4]; float ss = 0.f;
#pragma unroll
            for (int j = 0; j < 4; ++j) { v[j] = vn[j]; ss += (v[j][0] * v[j][0] + v[j][1] * v[j][1]) + (v[j][2] * v[j][2] + v[j][3] * v[j][3]); }
            if (row + NGW < NLAT) {
#pragma unroll
                for (int j = 0; j < 4; ++j) vn[j] = *(const f32x4*)(xr + (size_t)NGW * DM + 4 * lane + 256 * j);
            }
            const float rstd = __builtin_amdgcn_rsqf(wave_sum(ss) * (1.f / DM) + EPSV);
#pragma unroll
            for (int j = 0; j < 4; ++j) { const int col = 4 * lane + 256 * j; *(f32x4*)(xr + col) = (v[j] * rstd) * gg[j]; }
        }
    }
}

extern "C" void kernel_launch(void* const* d_in, const int* in_sizes, int n_in, void* d_out, int out_size, void* d_ws, size_t ws_size, hipStream_t stream) {
    static int grid_blocks = 0;
    if (grid_blocks == 0) {
        if (n_in != 25 || ws_size < WS_END) { fprintf(stderr, "kernel_launch: unexpected n_in %d / ws %zu\n", n_in, ws_size); grid_blocks = -1; return; }
        int dev = 0, cus = 0, per_cu = 0;
        (void)hipGetDevice(&dev);
        (void)hipDeviceGetAttribute(&cus, hipDeviceAttributeMultiprocessorCount, dev);
        if (hipFuncSetAttribute((const void*)fwd_kernel, hipFuncAttributeMaxDynamicSharedMemorySize, LDS_BYTES) != hipSuccess) fprintf(stderr, "kernel_launch: hipFuncSetAttribute failed\n");
        if (hipOccupancyMaxActiveBlocksPerMultiprocessor(&per_cu, (const void*)fwd_kernel, 512, LDS_BYTES) != hipSuccess || per_cu < 1) { fprintf(stderr, "kernel_launch: occupancy query gave %d\n", per_cu); per_cu = 1; }
        (void)hipGetLastError();
        grid_blocks = cus * per_cu;
    }
    if (grid_blocks < 0) return;
    Params p{};
    const float** pp = (const float**)&p;
    for (int i = 0; i < 25; ++i) pp[i] = (const float*)d_in[i];
    p.out = (float*)d_out; p.ws = (unsigned char*)d_ws;
    (void)hipMemsetAsync((unsigned char*)d_ws + WS_MOD, 0, ZERO_BYTES, stream);
    void* args[] = {&p};
    hipError_t e = hipLaunchCooperativeKernel((const void*)fwd_kernel, dim3(grid_blocks), dim3(512), args, LDS_BYTES, stream);
    if (e != hipSuccess) fprintf(stderr, "cooperative launch failed: %s (grid %d)\n", hipGetErrorString(e), grid_blocks);
}
```

```cpp
#include <hip/hip_runtime.h>
#include <hip/hip_cooperative_groups.h>
#include <cstdint>
#include <cstdio>
namespace cg = cooperative_groups;
#ifndef PROBE
#define PROBE 0
#endif

#define LAS __attribute__((address_space(3)))
typedef unsigned short bf16_t;
typedef short bf16x8 __attribute__((ext_vector_type(8)));
typedef float f32x4 __attribute__((ext_vector_type(4)));
typedef float f32x16 __attribute__((ext_vector_type(16)));
typedef unsigned u32x4 __attribute__((ext_vector_type(4)));
typedef unsigned u32x2 __attribute__((ext_vector_type(2)));

constexpr int NB = 8, SEQ = 2048, DM = 1024, CTXL = 256, NLAT = NB * SEQ, NCTX = NB * CTXL, MTOT = NLAT + NCTX;
constexpr int INW = 2560, INW_SRC = 2304, DFF = 2816, N13 = 2 * DFF, KCAT = CTXL + SEQ;
constexpr float EPSV = 1e-6f;
constexpr float QSCALE = 0.125f * 1.4426950408889634f;
constexpr int LDS_BYTES = 147456;
constexpr int XCD_BAR_WORDS_C = 3456;

constexpr size_t MiB = 1u << 20;
constexpr size_t WS_WIN = 0, WS_WOUT = 10 * MiB, WS_W13 = 14 * MiB, WS_W2 = 36 * MiB, WS_WSM = 47 * MiB, WS_DFTL = 48 * MiB, WS_DFTC = 64 * MiB;
constexpr size_t WS_MOD = 64 * MiB + 256 * 1024, WS_ROPE = 64 * MiB + 768 * 1024, WS_XCTX = 65 * MiB, WS_H = 73 * MiB, WS_R = 109 * MiB;
constexpr size_t WS_Q1 = WS_R, WS_Q2 = WS_R + 9 * MiB, WS_K1 = WS_R + 18 * MiB, WS_K2 = WS_R + 27 * MiB, WS_VT = WS_R + 36 * MiB, WS_TTL = WS_R + 54 * MiB,
                 WS_TTC = WS_R + 70 * MiB, WS_UC = WS_R + 72 * MiB, WS_MIX = WS_R + 90 * MiB, WS_ACT = WS_R, WS_END = WS_R + 131 * MiB;
constexpr size_t MOD_BYTES = 2 * 9 * 6144 * 4;
constexpr int WSM_L = 256 * 512 + 256 * 256;
constexpr size_t WS_BAR = 64 * MiB + 704 * 1024, ZERO_BYTES = WS_BAR + XCD_BAR_WORDS_C * 4 - WS_MOD;

struct Params {
    const float *x, *c, *ctx, *c_ctx, *w_ada, *b_ada, *norm1_g, *norm2_g, *w_in, *lam_q1, *lam_k1, *lam_q2, *lam_k2, *subln_g, *w_fourier, *conv_w, *conv_b,
        *conv_ln_g, *conv_ln_b, *w_conv_out, *w_out, *w_ffn1, *w_ffn3, *w_ffn2, *final_g;
    float* out; unsigned char* ws;
};

__device__ __forceinline__ unsigned cvt_pk_bf16(float lo, float hi) { unsigned r; asm("v_cvt_pk_bf16_f32 %0, %1, %2" : "=v"(r) : "v"(lo), "v"(hi)); return r; }
__device__ __forceinline__ u32x2 pack4(f32x4 v) { u32x2 w; w.x = cvt_pk_bf16(v[0], v[1]); w.y = cvt_pk_bf16(v[2], v[3]); return w; }
__device__ __forceinline__ bf16_t f2bf(float v) { return (bf16_t)(cvt_pk_bf16(v, 0.f) & 0xffffu); }
__device__ __forceinline__ float wave_sum(float v) {
#pragma unroll
    for (int o = 1; o < 64; o <<= 1) v += __shfl_xor(v, o);
    return v;
}
__device__ __forceinline__ int fresh_tid() { int t = threadIdx.x; asm volatile("" : "+v"(t)); return t; }
__device__ __forceinline__ float max3f(float a, float b, float c) { float r; asm("v_max3_f32 %0, %1, %2, %3" : "=v"(r) : "v"(a), "v"(b), "v"(c)); return r; }
__device__ __forceinline__ float sigmoidf_(float v) { return __builtin_amdgcn_rcpf(1.f + __expf(-v)); }


#define XB_TMO      128
#define XB_XCNT(j)  (256  + 64 * (j))
#define XB_XSUB(j)  (1280 + 64 * (j))
#define XB_XGEN(j)  (2304 + 64 * (j))
#define XB_TOP      3328
#define XB_TOPGEN   3392
#define XCD_BAR_WORDS 3456
#define XB_SPIN_CAP (1u << 18)
__device__ __forceinline__ unsigned xb_ld(unsigned* p)              { return __hip_atomic_load(p, __ATOMIC_RELAXED, __HIP_MEMORY_SCOPE_AGENT); }
__device__ __forceinline__ unsigned xb_add(unsigned* p, unsigned v) { return __hip_atomic_fetch_add(p, v, __ATOMIC_RELAXED, __HIP_MEMORY_SCOPE_AGENT); }
__device__ __forceinline__ unsigned xb_xcc_id() { return (unsigned)__builtin_amdgcn_s_getreg((3 << 11) | 20) & 0xFu; }
#define XB_SPIN(cond, bar) do { unsigned _sp = 0; while (cond) { __builtin_amdgcn_s_sleep(1); \
    if ((++_sp & 255u) == 0u) { if (xb_ld(&(bar)[XB_TMO])) break; if (_sp > XB_SPIN_CAP) { atomicAdd(&(bar)[XB_TMO], 1u); break; } } } } while (0)
struct XcdBarrier { unsigned* bar; unsigned x; volatile LAS unsigned* st; };
__device__ __forceinline__ XcdBarrier xcd_barrier_post(unsigned* bar, volatile LAS unsigned* st) {
    XcdBarrier b; b.bar = bar; b.x = xb_xcc_id(); b.st = st;
    if (threadIdx.x == 0) (void)xb_add(&bar[XB_XCNT(b.x)], 1u);
    return b;
}
__device__ __forceinline__ void xcd_barrier_complete(unsigned* bar, unsigned x, unsigned& nloc, unsigned& nx) {
    const unsigned G = gridDim.x * gridDim.y * gridDim.z;
    unsigned sum, cnt, mine, sp = 0u;
    for (;;) {
        sum = 0u; cnt = 0u; mine = 0u;
#pragma unroll
        for (unsigned j = 0; j < 16; ++j) { const unsigned c = xb_ld(&bar[XB_XCNT(j)]); sum += c; cnt += (c > 0u) ? 1u : 0u; mine = (j == x) ? c : mine; }
        if (sum == G) break;
        __builtin_amdgcn_s_sleep(1);
        if ((++sp & 255u) == 0u) { if (xb_ld(&bar[XB_TMO])) break; if (sp > XB_SPIN_CAP) { atomicAdd(&bar[XB_TMO], 1u); break; } }
    }
    nloc = mine > 0u ? mine : 1u; nx = cnt > 0u ? cnt : 1u;
}
__device__ __forceinline__ void xcd_barrier(const XcdBarrier& b) {
    asm volatile("s_waitcnt vmcnt(0)" ::: "memory");
    __syncthreads();
    if (threadIdx.x == 0) {
        unsigned* bar = b.bar;
        __builtin_amdgcn_s_waitcnt(0);
        unsigned nloc = b.st[0], nx = b.st[1];
        if (nloc == 0u) { xcd_barrier_complete(bar, b.x, nloc, nx); b.st[0] = nloc; b.st[1] = nx; }
        const unsigned old = xb_add(&bar[XB_XSUB(b.x)], 1u);
        const unsigned gen = old / nloc;
        if (old + 1u == (gen + 1u) * nloc) {
            __builtin_amdgcn_fence(__ATOMIC_RELEASE, "agent");
            asm volatile("s_waitcnt vmcnt(0)" ::: "memory");
            const unsigned og = xb_add(&bar[XB_TOP], 1u);
            const unsigned tg = og / nx;
            if (og + 1u == (tg + 1u) * nx) xb_add(&bar[XB_TOPGEN], 1u);
            else XB_SPIN(xb_ld(&bar[XB_TOPGEN]) == tg, bar);
            __builtin_amdgcn_fence(__ATOMIC_ACQUIRE, "agent");
            xb_add(&bar[XB_XGEN(b.x)], 1u);
            asm volatile("s_waitcnt vmcnt(0)" ::: "memory");
        } else {
            XB_SPIN(xb_ld(&bar[XB_XGEN(b.x)]) == gen, bar);
            __builtin_amdgcn_fence(__ATOMIC_ACQUIRE, "agent");
            asm volatile("s_waitcnt vmcnt(0)" ::: "memory");
        }
    }
    __syncthreads();
}

namespace pg8 {
constexpr int BM = 256, BK = 64, HALF = 128, HTB = HALF * BK * 2, STAGE_BYTES = 8 * HTB, NXCD = 8, WGM = 8;
__host__ __device__ __forceinline__ int lds_byte(int r, int c) { const int st = (r >> 4) * 2 + (c >> 5), rr = r & 15, cc = c & 31, ob = rr * 64 + cc * 2; return st * 1024 + (ob ^ (((ob >> 9) & 1) << 5)); }
__host__ __device__ __forceinline__ void stage_rc(int b, int& R, int& C) { const int st = b / 1024, sb = b % 1024, swz = sb ^ (((sb >> 9) & 1) << 5); R = (st >> 1) * 16 + swz / 64; C = (st & 1) * 32 + (swz % 64) / 2; }

__host__ __device__ __forceinline__ int perm32(int rho) { const int n = rho >> 4, i = rho & 15; return 8 * (i >> 2) + 4 * n + (i & 3); }
struct Unit { int pm, pn, k0, nt, flags; };
struct Gemm { const bf16_t* A; const bf16_t* Bt; int M, N, K, lda, ldb, a_pn_off; };

struct StaticOrder {
    int nM, nN, nwg, G, c;
    __host__ __device__ void init(int M, int N, int G_, int c_) { nM = M / BM; nN = N / BM; nwg = nM * nN; G = G_; c = c_; }
    __host__ __device__ __forceinline__ bool next(int i, Unit& u) const {
        const long L = (long)i * G + c; if (L >= nwg) return false;
        int wgid = (int)L; { const int q = nwg / NXCD, r = nwg % NXCD, xcd = wgid % NXCD, off = wgid / NXCD; wgid = (xcd < r ? xcd * (q + 1) : r * (q + 1) + (xcd - r) * q) + off; }
        const int nig = WGM * nN, gid = wgid / nig, fm = gid * WGM, gsz = (nM - fm) < WGM ? (nM - fm) : WGM;
        u.pm = fm + ((wgid % nig) % gsz); u.pn = (wgid % nig) / gsz; u.k0 = 0; u.nt = -1; u.flags = 0; return true;
    }
};
struct OffsetOrder {
    int nN, nwg, G, cc;
    __host__ __device__ void init(int M, int N, int G_, int c_, int off) { nN = N / BM; nwg = (M / BM) * nN; G = G_; cc = ((c_ - off) % G_ + G_) % G_; }
    __host__ __device__ __forceinline__ bool next(int i, Unit& u) const { const long L = (long)i * G + cc; if (L >= nwg) return false; u.pm = (int)L / nN; u.pn = (int)L % nN; u.k0 = 0; u.nt = -1; u.flags = 0; return true; }
};

struct CtxSplitOrder {
    StaticOrder lat; int nN, ntf;
    __host__ __device__ void init(int N, int K, int G_, int c_) { lat.init(NLAT, N, G_, c_); nN = N / BM; ntf = K / BK; }
    __host__ __device__ __forceinline__ bool next(int i, Unit& u) const {
        const long L = (long)i * lat.G + lat.c;
        int pm, pn, k0 = 0, ntq = -1, fl = 0;
        if (L < lat.nwg) {
            int wgid = (int)L; { const int q = lat.nwg / NXCD, r = lat.nwg % NXCD, xcd = wgid % NXCD, off = wgid / NXCD; wgid = (xcd < r ? xcd * (q + 1) : r * (q + 1) + (xcd - r) * q) + off; }
            const int nig = WGM * lat.nN, gid = wgid / nig, fm = gid * WGM, gsz = (lat.nM - fm) < WGM ? (lat.nM - fm) : WGM;
            pm = fm + ((wgid % nig) % gsz); pn = (wgid % nig) / gsz;
        } else {
            const int s = (int)(L - lat.nwg); if (s >= (NCTX / BM) * nN * 4) return false;
            const int cu_ = s >> 2, q = s & 3, base = (ntf / 8) * 2, extra = (ntf - 4 * base) / 2;
            pm = NLAT / BM + cu_ / nN; pn = cu_ % nN; ntq = base + (q < extra ? 2 : 0); k0 = (q * base + 2 * (q < extra ? q : extra)) * BK; fl = 1 | (q << 1);
        }
        u.pm = pm; u.pn = pn; u.k0 = k0; u.nt = ntq; u.flags = fl; return true;
    }
};

template <class Epi, class Sched, bool ALIGN_EPI>
__device__ __forceinline__ void gemm_phase(LAS unsigned char* lds, const Gemm g, const Sched& S, const Epi& E) {
    const int tid = fresh_tid(), wid = __builtin_amdgcn_readfirstlane(tid >> 6), lane = tid & 63, wr = wid >> 2, wc = wid & 3, fr = lane & 15, fq = lane >> 4;
    const int K = g.K, nt = K / BK;
    unsigned voffA[2], voffB[2];
#pragma unroll
    for (int i = 0; i < 2; ++i) { int R, C; stage_rc(tid * 16 + i * 8192, R, C);
        const int Rb = Epi::PERM ? ((R & ~31) + perm32(R & 31)) : R;
        voffA[i] = (unsigned)(R * g.lda + C) * 2u; voffB[i] = (unsigned)(Rb * g.ldb + C) * 2u; }
    const size_t kstep = (size_t)(BK * 2);
    const size_t hstepA = (size_t)HALF * g.lda * 2, hstepB = (size_t)HALF * g.ldb * 2;
    const size_t tstepA = 2 * hstepA, tstepB = 2 * hstepB;
    const unsigned ldsw = (unsigned)wid * 1024u;
    const int aoff = lds_byte(wr * 64 + fr, fq * 8), boff = lds_byte(wc * 32 + fr, fq * 8);
#define PG8_SA(b, h) (((b) * 2 + (h)) * HTB)
#define PG8_SB(b, h) ((4 + (b) * 2 + (h)) * HTB)
#define PG8_STAGE(bufoff, gbase, voff) do { _Pragma("unroll") for (int _i = 0; _i < 2; ++_i) \
        __builtin_amdgcn_global_load_lds((const unsigned*)((const char*)(gbase) + (voff)[_i]), (LAS unsigned*)(lds + (bufoff) + ldsw + _i * 8192), 16, 0, 0); } while (0)
#define PG8_LDA(dst, b, h) do { _Pragma("unroll") for (int m = 0; m < 4; ++m) _Pragma("unroll") for (int k = 0; k < 2; ++k) dst[m][k] = *(const LAS bf16x8*)(lds + PG8_SA(b, h) + aoff + m * 2048 + k * 1024); } while (0)
#define PG8_LDB(dst, b, h) do { _Pragma("unroll") for (int n = 0; n < 2; ++n) _Pragma("unroll") for (int k = 0; k < 2; ++k) dst[n][k] = *(const LAS bf16x8*)(lds + PG8_SB(b, h) + boff + n * 2048 + k * 1024); } while (0)
#define PG8_MMA(ai, bj, At, Bt) do { __builtin_amdgcn_s_setprio(1); _Pragma("unroll") for (int m = 0; m < 4; ++m) _Pragma("unroll") for (int n = 0; n < 2; ++n) _Pragma("unroll") for (int k = 0; k < 2; ++k) \
        acc[ai][bj][m][n] = __builtin_amdgcn_mfma_f32_16x16x32_bf16(Bt[n][k], At[m][k], acc[ai][bj][m][n], 0, 0, 0); __builtin_amdgcn_s_setprio(0); } while (0)
#define PG8_WAIT_V(n) asm volatile("s_waitcnt vmcnt(" #n ")" ::: "memory")
#define PG8_WAIT_L(n) asm volatile("s_waitcnt lgkmcnt(" #n ")" ::: "memory")
#define PG8_BAR __builtin_amdgcn_s_barrier()
#define PG8_SCHED __builtin_amdgcn_sched_barrier(0)
    Unit cur, nxt; int ui = 0;
    if (!S.next(0, cur)) return;
    f32x4 acc[2][2][4][2];
#pragma unroll
    for (int a = 0; a < 2; ++a)
#pragma unroll
        for (int b = 0; b < 2; ++b)
#pragma unroll
            for (int m = 0; m < 4; ++m)
#pragma unroll
                for (int n = 0; n < 2; ++n) acc[a][b][m][n] = (f32x4){0.f, 0.f, 0.f, 0.f};
    bf16x8 At[4][2], B0[2][2], B1[2][2];
    const char* cA = (const char*)g.A + (size_t)cur.pm * tstepA + (size_t)cur.pn * g.a_pn_off * 2 + (size_t)cur.k0 * 2; const char* cB = (const char*)g.Bt + (size_t)cur.pn * tstepB + (size_t)cur.k0 * 2;
    PG8_STAGE(PG8_SB(0, 0), cB, voffB); PG8_STAGE(PG8_SB(0, 1), cB + hstepB, voffB); PG8_STAGE(PG8_SA(0, 0), cA, voffA); PG8_STAGE(PG8_SA(0, 1), cA + hstepA, voffA);
    if (wr == 1) PG8_BAR;
    PG8_WAIT_V(2); PG8_BAR;
    PG8_STAGE(PG8_SB(1, 0), cB + kstep, voffB); PG8_STAGE(PG8_SA(1, 0), cA + kstep, voffA); PG8_STAGE(PG8_SB(1, 1), cB + hstepB + kstep, voffB);
    PG8_WAIT_V(6); PG8_BAR;
    for (;;) {
        const bool has_next = S.next(ui + 1, nxt);
        const char* nA = has_next ? (const char*)g.A + (size_t)nxt.pm * tstepA + (size_t)nxt.pn * g.a_pn_off * 2 + (size_t)nxt.k0 * 2 : cA; const char* nB = has_next ? (const char*)g.Bt + (size_t)nxt.pn * tstepB + (size_t)nxt.k0 * 2 : cB;
        const int ntc = cur.nt < 0 ? nt : cur.nt;
        for (int t = 0; t < ntc; t += 2) {
            const bool last = (t == ntc - 2);
            const char* a1 = cA + (size_t)(t + 1) * kstep;
            const char* a2 = last ? nA : cA + (size_t)(t + 2) * kstep; const char* b2 = last ? nB : cB + (size_t)(t + 2) * kstep;
            const char* a3 = a2 + kstep; const char* b3 = b2 + kstep;
            PG8_LDB(B0, 0, 0); PG8_LDB(B1, 0, 1); PG8_SCHED; PG8_LDA(At, 0, 0); PG8_STAGE(PG8_SA(1, 1), a1 + hstepA, voffA);
            PG8_WAIT_V(8); PG8_WAIT_L(0); PG8_BAR; PG8_MMA(0, 0, At, B0); PG8_MMA(0, 1, At, B1); PG8_BAR; PG8_SCHED;
            PG8_LDA(At, 0, 1); PG8_STAGE(PG8_SB(0, 0), b2, voffB); PG8_STAGE(PG8_SB(0, 1), b2 + hstepB, voffB); PG8_STAGE(PG8_SA(0, 0), a2, voffA);
            PG8_WAIT_V(8); PG8_WAIT_L(0); PG8_BAR; PG8_MMA(1, 0, At, B0); PG8_MMA(1, 1, At, B1); PG8_BAR; PG8_SCHED;
            PG8_LDB(B0, 1, 0); PG8_LDB(B1, 1, 1); PG8_SCHED; PG8_LDA(At, 1, 0); PG8_STAGE(PG8_SA(0, 1), a2 + hstepA, voffA);
            PG8_WAIT_V(8); PG8_WAIT_L(0); PG8_BAR; PG8_MMA(0, 0, At, B0); PG8_MMA(0, 1, At, B1); PG8_BAR; PG8_SCHED;
            PG8_LDA(At, 1, 1); PG8_STAGE(PG8_SB(1, 0), b3, voffB); PG8_STAGE(PG8_SB(1, 1), b3 + hstepB, voffB); PG8_STAGE(PG8_SA(1, 0), a3, voffA);
            PG8_WAIT_V(8); PG8_WAIT_L(0); PG8_BAR; PG8_MMA(1, 0, At, B0); PG8_MMA(1, 1, At, B1); PG8_BAR; PG8_SCHED;
        }
        if constexpr (ALIGN_EPI) { if (wr == 0) PG8_BAR; }
        E(acc, cur, wr, wc, fr, fq);
        if (!has_next) break;
#pragma unroll
        for (int a = 0; a < 2; ++a)
#pragma unroll
            for (int b = 0; b < 2; ++b)
#pragma unroll
                for (int m = 0; m < 4; ++m)
#pragma unroll
                    for (int n = 0; n < 2; ++n) acc[a][b][m][n] = (f32x4){0.f, 0.f, 0.f, 0.f};
        cur = nxt; cA = nA; cB = nB; ++ui;
        if constexpr (ALIGN_EPI) { if (wr == 1) PG8_BAR; }
    }
    PG8_WAIT_V(0);
    if constexpr (!ALIGN_EPI) { if (wr == 0) PG8_BAR; }
    PG8_BAR;
#undef PG8_SA
#undef PG8_SB
#undef PG8_STAGE
#undef PG8_LDA
#undef PG8_LDB
#undef PG8_MMA
#undef PG8_WAIT_V
#undef PG8_WAIT_L
#undef PG8_BAR
#undef PG8_SCHED
}
}

typedef f32x4 Acc[2][2][4][2];

struct EpiInProj {
    static constexpr bool PERM = false;
    bf16_t *Q1, *Q2, *K1c, *K2c, *VT, *TTl, *TTc, *UC; const float* rope;
    __device__ __forceinline__ void operator()(const Acc& acc, const pg8::Unit& u, int wr, int wc, int fr, int fq) const {
        const int pn = u.pn; const bool lat = u.pm < 64;
#pragma unroll
        for (int ai = 0; ai < 2; ++ai)
#pragma unroll
            for (int m = 0; m < 4; ++m) {
                const int row = u.pm * 256 + ai * 128 + wr * 64 + m * 16 + fr;
                int b, t; if (lat) { b = row >> 11; t = row & 2047; } else { const int rc = row - NLAT; b = rc >> 8; t = rc & 255; }
                const int pos = lat ? CTXL + t : t;
                if (pn < 4) {
                    bf16_t* dst;
                    if (pn == 0) dst = Q1 + (size_t)row * 256; else if (pn == 1) dst = Q2 + (size_t)row * 256;
                    else if (pn == 2) dst = K1c + ((size_t)b * KCAT + pos) * 256; else dst = K2c + ((size_t)b * KCAT + pos) * 256;
                    const float scale = pn < 2 ? QSCALE : 1.f;
                    const int ax = fq >> 1, fh = fq & 1;
                    u32x4 w1, w2;
#pragma unroll
                    for (int bj = 0; bj < 2; ++bj) {
                        f32x4 cs = {1.f, 1.f, 1.f, 1.f}, sn = {0.f, 0.f, 0.f, 0.f};
                        if (lat) { const int pidx = ax ? (t & 63) : (t >> 6); cs = *(const f32x4*)(rope + pidx * 16 + 8 * fh + 4 * bj); sn = *(const f32x4*)(rope + 1024 + pidx * 16 + 8 * fh + 4 * bj); }
                        const f32x4 x1 = acc[ai][bj][m][0], x2 = acc[ai][bj][m][1];
                        const u32x2 p1 = pack4((x1 * cs - x2 * sn) * scale), p2 = pack4((x2 * cs + x1 * sn) * scale);
                        if (bj == 0) { w1.x = p1.x; w1.y = p1.y; w2.x = p2.x; w2.y = p2.y; } else { w1.z = p1.x; w1.w = p1.y; w2.z = p2.x; w2.w = p2.y; }
                    }
                    bf16_t* dq = dst + wc * 64 + ax * 32 + 8 * fh;
                    *(u32x4*)dq = w1; *(u32x4*)(dq + 16) = w2;
                } else if (pn < 6) {
#pragma unroll
                    for (int bj = 0; bj < 2; ++bj)
#pragma unroll
                        for (int n = 0; n < 2; ++n) {
                            bf16_t* dst = VT + ((size_t)(b * 4 + (pn - 4) * 2 + bj) * 128 + wc * 32 + n * 16 + 4 * fq) * KCAT + pos;
                            const f32x4 v = acc[ai][bj][m][n];
                            dst[0] = f2bf(v[0]); dst[KCAT] = f2bf(v[1]); dst[2 * KCAT] = f2bf(v[2]); dst[3 * KCAT] = f2bf(v[3]);
                        }
                } else if (pn < 8) {
                    const int s = pn - 6;
#pragma unroll
                    for (int bj = 0; bj < 2; ++bj)
#pragma unroll
                        for (int n = 0; n < 2; ++n) {
                            const int jf = bj * 128 + wc * 32 + n * 16 + 4 * fq;
                            const f32x4 v = acc[ai][bj][m][n];
                            if (lat) { bf16_t* dst = TTl + (((size_t)b * 256 + jf) * 2 + s) * SEQ + t; dst[0] = f2bf(v[0]); dst[2 * SEQ] = f2bf(v[1]); dst[4 * SEQ] = f2bf(v[2]); dst[6 * SEQ] = f2bf(v[3]); }
                            else { bf16_t* dst = TTc + (((size_t)b * 256 + jf) * 2 + s) * CTXL + t; dst[0] = f2bf(v[0]); dst[2 * CTXL] = f2bf(v[1]); dst[4 * CTXL] = f2bf(v[2]); dst[6 * CTXL] = f2bf(v[3]); }
                        }
                } else {
                    bf16_t* dst = UC + (size_t)row * 512 + (pn - 8) * 256 + wc * 32 + 8 * fq;
#pragma unroll
                    for (int n = 0; n < 2; ++n) { const u32x2 p0 = pack4(acc[ai][0][m][n]), p1 = pack4(acc[ai][1][m][n]); *(u32x4*)(dst + 128 * n) = (u32x4){p0.x, p0.y, p1.x, p1.y}; }
                }
            }
    }
};

struct EpiRes {
    static constexpr bool PERM = false;
    const float* xin_lat; const float* xin_ctx; float* xout_lat; float* xout_ctx; const float* mod; int goff; float* pb;
    __device__ __forceinline__ void operator()(const Acc& acc, const pg8::Unit& u, int wr, int wc, int fr, int fq) const {
        const int tile0 = u.pm * 256, colb = u.pn * 256 + wc * 32 + 4 * fq, rloc = wr * 64 + fr;
        if (u.flags & 1) {
            float* pq = pb + ((size_t)(u.flags >> 1) * NCTX + (tile0 - NLAT) + rloc) * DM + colb;
#pragma unroll
            for (int ai = 0; ai < 2; ++ai)
#pragma unroll
                for (int m = 0; m < 4; ++m)
#pragma unroll
                    for (int bj = 0; bj < 2; ++bj)
#pragma unroll
                        for (int n = 0; n < 2; ++n) *(f32x4*)(pq + (size_t)(ai * 128 + m * 16) * DM + bj * 128 + n * 16) = acc[ai][bj][m][n];
            return;
        }
        const bool lat = tile0 < NLAT;
        const float* xi = (lat ? xin_lat + (size_t)tile0 * DM : xin_ctx + (size_t)(tile0 - NLAT) * DM) + (size_t)rloc * DM + colb;
        float* xo = (lat ? xout_lat + (size_t)tile0 * DM : xout_ctx + (size_t)(tile0 - NLAT) * DM) + (size_t)rloc * DM + colb;
        const float* gp = mod + (lat ? (tile0 >> 11) : 8) * 6144 + goff + colb;
        f32x4 gt[2][2];
#pragma unroll
        for (int bj = 0; bj < 2; ++bj)
#pragma unroll
            for (int n = 0; n < 2; ++n) gt[bj][n] = *(const f32x4*)(gp + bj * 128 + n * 16);
        f32x4 xv[2][2][2];
#define ER_LOAD(buf, g_) do { const float* xp_ = xi + (size_t)(((g_) >> 2) * 128 + ((g_) & 3) * 16) * DM; \
            _Pragma("unroll") for (int bj = 0; bj < 2; ++bj) _Pragma("unroll") for (int n = 0; n < 2; ++n) xv[buf][bj][n] = *(const f32x4*)(xp_ + bj * 128 + n * 16); } while (0)
        ER_LOAD(0, 0);
#pragma unroll
        for (int g_ = 0; g_ < 8; ++g_) {
            if (g_ + 1 < 8) ER_LOAD((g_ + 1) & 1, g_ + 1);
            float* xq = xo + (size_t)((g_ >> 2) * 128 + (g_ & 3) * 16) * DM;
#pragma unroll
            for (int bj = 0; bj < 2; ++bj)
#pragma unroll
                for (int n = 0; n < 2; ++n) *(f32x4*)(xq + bj * 128 + n * 16) = xv[g_ & 1][bj][n] + gt[bj][n] * acc[g_ >> 2][bj][g_ & 3][n];
        }
#undef ER_LOAD
    }
};

struct EpiFfn13 {
    static constexpr bool PERM = false;
    bf16_t* ACT;
    __device__ __forceinline__ void operator()(const Acc& acc, const pg8::Unit& u, int wr, int wc, int fr, int fq) const {
#pragma unroll
        for (int ai = 0; ai < 2; ++ai)
#pragma unroll
            for (int m = 0; m < 4; ++m) {
                const int row = u.pm * 256 + ai * 128 + wr * 64 + m * 16 + fr;
                u32x4 w;
#pragma unroll
                for (int bj = 0; bj < 2; ++bj) {
                    const f32x4 a = acc[ai][bj][m][0], b = acc[ai][bj][m][1]; f32x4 o;
#pragma unroll
                    for (int j = 0; j < 4; ++j) o[j] = a[j] * sigmoidf_(a[j]) * b[j];
                    const u32x2 pk = pack4(o);
                    if (bj == 0) { w.x = pk.x; w.y = pk.y; } else { w.z = pk.x; w.w = pk.y; }
                }
                *(u32x4*)(ACT + (size_t)row * DFF + 128 * u.pn + 32 * wc + 8 * fq) = w;
            }
    }
};

struct EpiMix {
    static constexpr bool PERM = true;
    bf16_t* out; int pitch, col0, tok_base, tok_pn_step, col_pn_step;
    __device__ __forceinline__ void operator()(const Acc& acc, const pg8::Unit& u, int wr, int wc, int fr, int fq) const {
#pragma unroll
        for (int ai = 0; ai < 2; ++ai)
#pragma unroll
            for (int m = 0; m < 4; ++m) {
                const int row = u.pm * 256 + ai * 128 + wr * 64 + m * 16 + fr;
                bf16_t* dst = out + (size_t)(tok_base + u.pn * tok_pn_step + row) * pitch + col0 + u.pn * col_pn_step + wc * 32 + 8 * fq;
#pragma unroll
                for (int bj = 0; bj < 2; ++bj) { const u32x2 p0 = pack4(acc[ai][bj][m][0]), p1 = pack4(acc[ai][bj][m][1]); *(u32x4*)(dst + bj * 128) = (u32x4){p0.x, p0.y, p1.x, p1.y}; }
            }
    }
};

namespace att {
constexpr int VP = 144, OFF_K1 = 0, OFF_K2 = 8192, OFF_VT = 16384, BUFSZ = 16384 + 128 * VP;
struct Args { const bf16_t *Q1, *Q2, *K1c, *K2c, *VT; bf16_t* MIXA; const float* subln; float lam, omli; };

__device__ __forceinline__ void attn_unit(LAS unsigned char* lds, const Args& A, int b, int h, int qrow0, int nkt) {
    const int tid = fresh_tid(), lane = tid & 63, r32 = lane & 31, hi = lane >> 5;
    const int wid = __builtin_amdgcn_readfirstlane(tid >> 6), map = wid >> 2, qg = wid & 3;
    const bf16_t* Qm = map ? A.Q2 : A.Q1;
    bf16x8 qf[4];
    { const bf16_t* qp = Qm + (size_t)(qrow0 + qg * 32 + r32) * 256 + h * 64 + hi * 8;
#pragma unroll
      for (int d0 = 0; d0 < 4; ++d0) qf[d0] = *(const bf16x8*)(qp + d0 * 16); }
    const int key_s = tid >> 3, ch_s = tid & 7;
    const bf16_t* k1src = A.K1c + ((size_t)b * KCAT + key_s) * 256 + h * 64 + ch_s * 8;
    const bf16_t* k2src = A.K2c + ((size_t)b * KCAT + key_s) * 256 + h * 64 + ch_s * 8;
    const bf16_t* vsrc = A.VT + ((size_t)(b * 4 + h) * 128 + key_s) * KCAT + ch_s * 8;
    const int kdst = key_s * 128 + ((ch_s ^ ((key_s >> 1) & 7)) << 4), vdst = key_s * VP + 32 * (ch_s >> 1) + 8 * (ch_s & 1);
    u32x4 rk1[2], rk2[2], rv0[2], rv1[2];
#define ATT_LOAD(set, t) do { rk1[set] = *(const u32x4*)(k1src + (size_t)(t) * 64 * 256); rk2[set] = *(const u32x4*)(k2src + (size_t)(t) * 64 * 256); \
        rv0[set] = *(const u32x4*)(vsrc + (t) * 64); rv1[set] = *(const u32x4*)(vsrc + (size_t)64 * KCAT + (t) * 64); } while (0)
#define ATT_STORE(set, buf) do { LAS unsigned char* bb_ = lds + (buf) * BUFSZ; *(LAS u32x4*)(bb_ + OFF_K1 + kdst) = rk1[set]; *(LAS u32x4*)(bb_ + OFF_K2 + kdst) = rk2[set]; \
        *(LAS u32x2*)(bb_ + OFF_VT + vdst) = (u32x2){rv0[set].x, rv0[set].y}; *(LAS u32x2*)(bb_ + OFF_VT + vdst + 16) = (u32x2){rv0[set].z, rv0[set].w}; \
        *(LAS u32x2*)(bb_ + OFF_VT + 64 * VP + vdst) = (u32x2){rv1[set].x, rv1[set].y}; *(LAS u32x2*)(bb_ + OFF_VT + 64 * VP + vdst + 16) = (u32x2){rv1[set].z, rv1[set].w}; } while (0)
    constexpr float THR = 6.f;
    float mrun = 0.f, lrun = 0.f;
    f32x16 O[4];
#pragma unroll
    for (int i = 0; i < 4; ++i)
#pragma unroll
        for (int r = 0; r < 16; ++r) O[i][r] = 0.f;
    ATT_LOAD(0, 0); ATT_STORE(0, 0); __syncthreads();
    ATT_LOAD(1, 1);
    for (int t0 = 0; t0 < nkt; t0 += 2) {
#pragma unroll
      for (int tt = 0; tt < 2; ++tt) {
        const int t = t0 + tt, cur = tt;
        if (t + 2 < nkt) ATT_LOAD(tt, t + 2);
        LAS unsigned char* base = lds + cur * BUFSZ;
        LAS unsigned char* kb = base + (map ? OFF_K2 : OFF_K1) + r32 * 128;
        f32x16 s0, s1;
#pragma unroll
        for (int r = 0; r < 16; ++r) { s0[r] = -mrun; s1[r] = -mrun; }
#pragma unroll
        for (int d0 = 0; d0 < 4; ++d0) {
            const int chunk = ((2 * d0 + hi) ^ ((r32 >> 1) & 7)) << 4;
            const bf16x8 a0 = *(const LAS bf16x8*)(kb + chunk), a1 = *(const LAS bf16x8*)(kb + 32 * 128 + chunk);
            s0 = __builtin_amdgcn_mfma_f32_32x32x16_bf16(a0, qf[d0], s0, 0, 0, 0);
            s1 = __builtin_amdgcn_mfma_f32_32x32x16_bf16(a1, qf[d0], s1, 0, 0, 0);
        }
        asm volatile("s_nop 15\n\ts_nop 4" : "+v"(s0), "+v"(s1));
        LAS unsigned char* vb = base + OFF_VT + r32 * VP + 16 * hi;
        u32x4 vf[2][4];
#define ATT_LDV(slot, c) do { _Pragma("unroll") for (int dblk = 0; dblk < 4; ++dblk) { \
            vf[slot][dblk] = *(const LAS u32x4*)(vb + dblk * 32 * VP + 32 * (c)); } } while (0)
        ATT_LDV(0, 0);
        __builtin_amdgcn_sched_barrier(0);
        float rm = max3f(s0[0], s0[1], s1[0]), rm2 = max3f(s0[2], s0[3], s1[1]);
        rm = max3f(rm, s1[2], s1[3]);
#pragma unroll
        for (int r = 4; r < 16; r += 4) { rm = max3f(rm, s0[r], s0[r + 1]); rm2 = max3f(rm2, s0[r + 2], s0[r + 3]); rm = max3f(rm, s1[r], s1[r + 1]); rm2 = max3f(rm2, s1[r + 2], s1[r + 3]); }
        rm = fmaxf(rm, rm2);
        rm = fmaxf(rm, __shfl_xor(rm, 32));
        const bool need = (t == 0) || (rm > THR);
        if (__any(need)) {
            const float dlt = need ? rm : 0.f, alpha = (t == 0) ? 1.f : __builtin_amdgcn_exp2f(-dlt);
            mrun += dlt; lrun *= alpha;
            s0 = s0 - dlt; s1 = s1 - dlt;
#pragma unroll
            for (int i = 0; i < 4; ++i)
#pragma unroll
                for (int r = 0; r < 16; ++r) O[i][r] *= alpha;
        }
#pragma unroll
        for (int r = 0; r < 16; ++r) { s0[r] = __builtin_amdgcn_exp2f(s0[r]); s1[r] = __builtin_amdgcn_exp2f(s1[r]); }
        { const f32x16 t16 = s0 + s1;
          typedef float f32x8 __attribute__((ext_vector_type(8)));
          const f32x8 t8 = t16.lo + t16.hi; const f32x4 t4 = t8.lo + t8.hi;
          lrun += (t4[0] + t4[1]) + (t4[2] + t4[3]); }
        bf16x8 P[4];
        { u32x4 w;
          w.x = cvt_pk_bf16(s0[0], s0[1]); w.y = cvt_pk_bf16(s0[2], s0[3]); w.z = cvt_pk_bf16(s0[4], s0[5]); w.w = cvt_pk_bf16(s0[6], s0[7]); P[0] = __builtin_bit_cast(bf16x8, w);
          w.x = cvt_pk_bf16(s0[8], s0[9]); w.y = cvt_pk_bf16(s0[10], s0[11]); w.z = cvt_pk_bf16(s0[12], s0[13]); w.w = cvt_pk_bf16(s0[14], s0[15]); P[1] = __builtin_bit_cast(bf16x8, w);
          w.x = cvt_pk_bf16(s1[0], s1[1]); w.y = cvt_pk_bf16(s1[2], s1[3]); w.z = cvt_pk_bf16(s1[4], s1[5]); w.w = cvt_pk_bf16(s1[6], s1[7]); P[2] = __builtin_bit_cast(bf16x8, w);
          w.x = cvt_pk_bf16(s1[8], s1[9]); w.y = cvt_pk_bf16(s1[10], s1[11]); w.z = cvt_pk_bf16(s1[12], s1[13]); w.w = cvt_pk_bf16(s1[14], s1[15]); P[3] = __builtin_bit_cast(bf16x8, w); }
        __builtin_amdgcn_sched_barrier(0);
        ATT_LDV(1, 1);
        __builtin_amdgcn_sched_barrier(0);
#pragma unroll
        for (int dblk = 0; dblk < 4; ++dblk) O[dblk] = __builtin_amdgcn_mfma_f32_32x32x16_bf16(__builtin_bit_cast(bf16x8, vf[0][dblk]), P[0], O[dblk], 0, 0, 0);
        __builtin_amdgcn_sched_barrier(0);
        ATT_LDV(0, 2);
        __builtin_amdgcn_sched_barrier(0);
#pragma unroll
        for (int dblk = 0; dblk < 4; ++dblk) O[dblk] = __builtin_amdgcn_mfma_f32_32x32x16_bf16(__builtin_bit_cast(bf16x8, vf[1][dblk]), P[1], O[dblk], 0, 0, 0);
        __builtin_amdgcn_sched_barrier(0);
        ATT_LDV(1, 3);
        __builtin_amdgcn_sched_barrier(0);
#pragma unroll
        for (int dblk = 0; dblk < 4; ++dblk) O[dblk] = __builtin_amdgcn_mfma_f32_32x32x16_bf16(__builtin_bit_cast(bf16x8, vf[0][dblk]), P[2], O[dblk], 0, 0, 0);
        __builtin_amdgcn_sched_barrier(0);
#pragma unroll
        for (int dblk = 0; dblk < 4; ++dblk) O[dblk] = __builtin_amdgcn_mfma_f32_32x32x16_bf16(__builtin_bit_cast(bf16x8, vf[1][dblk]), P[3], O[dblk], 0, 0, 0);
#undef ATT_LDV
        if (t + 1 < nkt) ATT_STORE(tt ^ 1, tt ^ 1);
        asm volatile("s_waitcnt lgkmcnt(0)" ::: "memory"); __builtin_amdgcn_s_barrier(); asm volatile("" ::: "memory");
      }
    }
#undef ATT_LOAD
#undef ATT_STORE
    lrun += __shfl_xor(lrun, 32);
    const float inv = 1.f / lrun;
    LAS float* ex = (LAS float*)lds + qg * 4096;
    if (map == 1) {
#pragma unroll
        for (int i = 0; i < 4; ++i)
#pragma unroll
            for (int r = 0; r < 16; ++r) ex[(i * 16 + r) * 64 + lane] = O[i][r] * inv;
    }
    __syncthreads();
    if (map == 0) {
        float ss = 0.f;
#pragma unroll
        for (int i = 0; i < 4; ++i)
#pragma unroll
            for (int r = 0; r < 16; ++r) { const float o = O[i][r] * inv - A.lam * ex[(i * 16 + r) * 64 + lane]; O[i][r] = o; ss += o * o; }
        ss += __shfl_xor(ss, 32);
        const float rstd = __builtin_amdgcn_rsqf(ss * (1.f / 128.f) + EPSV) * A.omli;
        bf16_t* dst = A.MIXA + (size_t)(qrow0 + qg * 32 + r32) * DM + h * 128 + 4 * hi;
#pragma unroll
        for (int i = 0; i < 4; ++i)
#pragma unroll
            for (int rq = 0; rq < 4; ++rq) {
                const int d0 = 32 * i + 8 * rq;
                const f32x4 gg = *(const f32x4*)(A.subln + d0 + 4 * hi);
                f32x4 v = {O[i][4 * rq] * rstd * gg[0], O[i][4 * rq + 1] * rstd * gg[1], O[i][4 * rq + 2] * rstd * gg[2], O[i][4 * rq + 3] * rstd * gg[3]};
                *(u32x2*)(dst + d0) = pack4(v);
            }
    }
    __syncthreads();
}
}

__device__ __forceinline__ void conv_item(const Params& p, LAS unsigned char* lds, int l, int item, const bf16_t* UC, bf16_t* MIXA) {
    const int tid = fresh_tid(), lane = tid & 63, wid = tid >> 6, g = wid & 3, th = wid >> 2;
    const int ch = g * 64 + lane;
    int rowbase, t0, L;
    if (item < 256) { rowbase = (item >> 5) * SEQ; t0 = (item & 31) * 64; L = SEQ; }
    else { const int j = item - 256; rowbase = NLAT + (j >> 2) * CTXL; t0 = (j & 3) * 64; L = CTXL; }
    LAS float* zl = (LAS float*)lds;
    {
        u32x4 av[6], gv[6];
#pragma unroll
        for (int it = 0; it < 6; ++it) {
            int idx = tid + it * 512; idx = idx < 94 * 32 ? idx : 94 * 32 - 1;
            const int pr = idx >> 5, c8 = idx & 31; int pp = t0 - 15 + pr; pp = pp < 0 ? 0 : (pp >= L ? L - 1 : pp);
            const bf16_t* up = UC + (size_t)(rowbase + pp) * 512 + c8 * 8;
            av[it] = *(const u32x4*)up; gv[it] = *(const u32x4*)(up + 256);
        }
#pragma unroll
        for (int it = 0; it < 6; ++it) {
            const int idx = tid + it * 512;
            const int pr = idx >> 5, c8 = idx & 31, pp = t0 - 15 + pr;
            const float msk = (pp >= 0 && pp < L) ? 1.f : 0.f;
            f32x4 z0, z1;
#pragma unroll
            for (int q = 0; q < 4; ++q) {
                const float a_lo = __uint_as_float(av[it][q] << 16), a_hi = __uint_as_float(av[it][q] & 0xffff0000u);
                const float g_lo = __uint_as_float(gv[it][q] << 16), g_hi = __uint_as_float(gv[it][q] & 0xffff0000u);
                const float zlo = a_lo * sigmoidf_(g_lo) * msk, zhi = a_hi * sigmoidf_(g_hi) * msk;
                if (q < 2) { z0[2 * q] = zlo; z0[2 * q + 1] = zhi; } else { z1[2 * (q - 2)] = zlo; z1[2 * (q - 2) + 1] = zhi; }
            }
            if (idx < 94 * 32) { *(LAS f32x4*)(zl + pr * 256 + c8 * 8) = z0; *(LAS f32x4*)(zl + pr * 256 + c8 * 8 + 4) = z1; }
        }
    }
    __syncthreads();
    const int ts = t0 + th * 32;
    float w[31];
#pragma unroll
    for (int k = 0; k < 31; ++k) w[k] = p.conv_w[(size_t)l * 31 * 256 + k * 256 + ch];
    float o[32];
    const float bias = p.conv_b[l * 256 + ch];
    const LAS float* zp = zl + (th * 32) * 256 + ch;
    float z[62];
#pragma unroll
    for (int jj = 0; jj < 62; ++jj) z[jj] = zp[jj * 256];
#pragma unroll
    for (int i = 0; i < 32; ++i) {
        float acc = bias;
#pragma unroll
        for (int k = 0; k < 31; ++k) acc += w[k] * z[i + k];
        o[i] = acc;
    }
    const float lg = p.conv_ln_g[l * 256 + ch], lb = p.conv_ln_b[l * 256 + ch];
#pragma unroll
    for (int i = 0; i < 32; ++i) {
        const float mu = wave_sum(o[i]) * (1.f / 64.f);
        const float d = o[i] - mu;
        const float var = wave_sum(d * d) * (1.f / 64.f);
        const float zn = d * __builtin_amdgcn_rsqf(var + EPSV) * lg + lb;
        MIXA[(size_t)(rowbase + ts + i) * DM + 768 + ch] = f2bf(zn * sigmoidf_(zn));
    }
    __syncthreads();
}

__device__ __forceinline__ int drow_map(int mode, int n) {
    if (mode == 0) return n;
    if (mode == 1) {
        if (n < 1024) { const int cs = n & 255, head = cs >> 6, d = cs & 63, a = d >> 5, pp = (d >> 4) & 1, f = d & 15;
            return (n & ~255) + 128 * ((f >> 2) & 1) + 32 * head + 16 * pp + 4 * (2 * a + (f >> 3)) + (f & 3); }
        if (n < 1792) return n;
        { const int mm = n - 1792, cs = mm & 255;
          return 2048 + (mm & ~255) + 128 * ((cs >> 2) & 1) + 32 * ((cs >> 5) & 3) + 16 * (cs >> 7) + 4 * ((cs >> 3) & 3) + (cs & 3); }
    }
    const int r = 256 * (n >> 7) + 128 * ((n >> 2) & 1) + 32 * ((n >> 5) & 3) + 4 * ((n >> 3) & 3) + (n & 3);
    return mode == 2 ? r : r + 16;
}
__device__ __forceinline__ void transpose_item(const float* W, int ldw, int K, bf16_t* WT, int mode, LAS float* scr, int kb, int nb, int lane) {
    const int k0 = 64 * kb, n0 = 32 * nb;
#pragma unroll 8
    for (int i = 0; i < 32; ++i) { const int kk = 2 * i + (lane >> 5); scr[kk * 33 + (lane & 31)] = W[(size_t)(k0 + kk) * ldw + n0 + (lane & 31)]; }
    asm volatile("s_waitcnt lgkmcnt(0)" ::: "memory");
    const int c = lane & 7;
#pragma unroll
    for (int j = 0; j < 4; ++j) { const int n = (lane >> 3) + 8 * j; const LAS float* s = scr + (8 * c) * 33 + n;
        u32x4 o; o.x = cvt_pk_bf16(s[0 * 33], s[1 * 33]); o.y = cvt_pk_bf16(s[2 * 33], s[3 * 33]); o.z = cvt_pk_bf16(s[4 * 33], s[5 * 33]); o.w = cvt_pk_bf16(s[6 * 33], s[7 * 33]);
        *(u32x4*)(WT + (size_t)drow_map(mode, n0 + n) * K + k0 + 8 * c) = o; }
    asm volatile("s_waitcnt lgkmcnt(0)" ::: "memory");
}

__device__ __forceinline__ void prep_phase(const Params& p, LAS unsigned char* lds) {
    const int tid = fresh_tid(), lane = tid & 63, wave = tid >> 6, G = gridDim.x;
    const int gw = blockIdx.x * 8 + wave, NGW = G * 8;
    const int gt = blockIdx.x * 512 + tid, NGT = G * 512;
    unsigned char* ws = p.ws;
    LAS float* tab = (LAS float*)(lds + 73728);
    LAS float* t64c = tab + 2048; LAS float* t64s = t64c + 64;
    for (int m = tid; m < 2048; m += 512) tab[m] = cospif((float)m * (1.f / 1024.f));
    if (tid < 64) { t64c[tid] = cospif((float)tid * (1.f / 32.f)); t64s[tid] = sinpif((float)tid * (1.f / 32.f)); }
    __syncthreads();
    if (gt < 1024) { const int pos = gt >> 4, f = gt & 15; const float inv = powf(10000.f, -(float)f / 16.f); const float ang = (float)pos * inv;
        float* rope = (float*)(ws + WS_ROPE); rope[gt] = cosf(ang); rope[1024 + gt] = sinf(ang); }
    {
        LAS float* scr = (LAS float*)(lds + wave * 8448);
        constexpr int I_IN = 16 * 72, I_OUT = 16 * 32, I_F1 = 16 * 88, I_F2 = 44 * 32, I_L = I_IN + I_OUT + 2 * I_F1 + I_F2;
        for (int it = gw; it < 2 * I_L; it += NGW) {
            const int l = it / I_L; int r = it % I_L;
            if (r < I_IN) { const int kb = r / 72, nb = r % 72; if (nb >= 48 && nb < 56) continue;
                transpose_item(p.w_in + (size_t)l * DM * INW_SRC, INW_SRC, DM, (bf16_t*)(ws + WS_WIN) + (size_t)l * INW * DM, 1, scr, kb, nb, lane); continue; }
            r -= I_IN;
            if (r < I_OUT) { transpose_item(p.w_out + (size_t)l * DM * DM, DM, DM, (bf16_t*)(ws + WS_WOUT) + (size_t)l * DM * DM, 0, scr, r / 32, r % 32, lane); continue; }
            r -= I_OUT;
            if (r < I_F1) { transpose_item(p.w_ffn1 + (size_t)l * DM * DFF, DFF, DM, (bf16_t*)(ws + WS_W13) + (size_t)l * N13 * DM, 2, scr, r / 88, r % 88, lane); continue; }
            r -= I_F1;
            if (r < I_F1) { transpose_item(p.w_ffn3 + (size_t)l * DM * DFF, DFF, DM, (bf16_t*)(ws + WS_W13) + (size_t)l * N13 * DM, 3, scr, r / 88, r % 88, lane); continue; }
            r -= I_F1;
            transpose_item(p.w_ffn2 + (size_t)l * DFF * DM, DM, DFF, (bf16_t*)(ws + WS_W2) + (size_t)l * DM * DFF, 0, scr, r / 32, r % 32, lane);
        }
    }
    {
        const float tcl = cospif((float)lane * (1.f / 32.f)), tsl = sinpif((float)lane * (1.f / 32.f));
        for (int it = gw; it < 2 * 4 * 16 * 16; it += NGW) {
            const int l = it >> 10, g = (it >> 8) & 3, kbk = (it >> 4) & 15, lqg = it & 15;
            const int k = kbk * 64 + lane;
            const float* wr_ = p.w_in + (size_t)l * DM * INW_SRC + (size_t)k * INW_SRC + 1536 + g * 64;
            float wv[64];
#pragma unroll
            for (int c4 = 0; c4 < 16; ++c4) { const f32x4 v = *(const f32x4*)(wr_ + 4 * c4); wv[4 * c4] = v[0]; wv[4 * c4 + 1] = v[1]; wv[4 * c4 + 2] = v[2]; wv[4 * c4 + 3] = v[3]; }
            bf16_t* wt = (bf16_t*)(ws + WS_WIN) + (size_t)l * INW * DM;
#pragma unroll 1
            for (int li = 0; li < 4; ++li) {
                const int lq = __builtin_amdgcn_readfirstlane(lqg * 4 + li);
                float ac = 0.f, as = 0.f;
#pragma unroll
                for (int c = 0; c < 64; ++c) {
                    const int m = (lq * c) & 63;
                    const float ct = __int_as_float(__builtin_amdgcn_readlane(__float_as_int(tcl), m)), st = __int_as_float(__builtin_amdgcn_readlane(__float_as_int(tsl), m));
                    ac += wv[c] * ct; as += wv[c] * st;
                }
                wt[(size_t)(1536 + g * 64 + lq) * DM + k] = f2bf(ac);
                wt[(size_t)(1536 + 256 + g * 64 + lq) * DM + k] = f2bf(as);
            }
        }
    }
    for (int e = gt; e < 2 * WSM_L; e += NGT) {
        const int l = e / WSM_L, r = e % WSM_L; float v;
        if (r < 256 * 512) { const int n = r >> 9, k = r & 255; const int g = n >> 6, d = n & 63, g2 = k >> 6, c = k & 63; v = (g == g2) ? p.w_fourier[(((size_t)l * 4 + g) * 64 + c) * 64 + d] : 0.f; }
        else { const int r2 = r - 256 * 512, n = r2 >> 8, k = r2 & 255; v = p.w_conv_out[((size_t)l * 256 + k) * 256 + n]; }
        ((bf16_t*)(ws + WS_WSM))[e] = f2bf(v);
    }
    {
        const float nl = 1.f / sqrtf(2048.f * 64.f), nc = 1.f / 128.f;
        for (int e = gt; e < 2048 * 4096 / 8; e += NGT) {
            const int k = e >> 9, col0 = (e & 511) * 8, s = col0 >> 11; float v[8];
#pragma unroll
            for (int j = 0; j < 8; ++j) { const int n = (col0 + j) & 2047, m = (k * n) & 2047; v[j] = s ? -tab[(m - 512) & 2047] * nl : tab[m] * nl; }
            u32x4 o; o.x = cvt_pk_bf16(v[0], v[1]); o.y = cvt_pk_bf16(v[2], v[3]); o.z = cvt_pk_bf16(v[4], v[5]); o.w = cvt_pk_bf16(v[6], v[7]);
            *(u32x4*)((bf16_t*)(ws + WS_DFTL) + (size_t)e * 8) = o;
        }
        for (int e = gt; e < 256 * 512 / 8; e += NGT) {
            const int k = e >> 6, col0 = (e & 63) * 8, s = col0 >> 8; float v[8];
#pragma unroll
            for (int j = 0; j < 8; ++j) { const int n = (col0 + j) & 255, m = ((k * n) & 255) * 8; v[j] = s ? -tab[(m - 512) & 2047] * nc : tab[m] * nc; }
            u32x4 o; o.x = cvt_pk_bf16(v[0], v[1]); o.y = cvt_pk_bf16(v[2], v[3]); o.z = cvt_pk_bf16(v[4], v[5]); o.w = cvt_pk_bf16(v[6], v[7]);
            *(u32x4*)((bf16_t*)(ws + WS_DFTC) + (size_t)e * 8) = o;
        }
    }
    for (int it = gw; it < 2 * 96 * 8; it += NGW) {
        const int l = it / 768, r = it % 768, cgp = r >> 3, kc = r & 7;
        const int col = cgp * 64 + lane, k0 = kc * 128;
        float sv[9][2];
#pragma unroll
        for (int b = 0; b < 9; ++b)
#pragma unroll
            for (int hh = 0; hh < 2; ++hh) { const int k = k0 + hh * 64 + lane; const float cv = (b < 8) ? p.c[b * DM + k] : p.c_ctx[k]; sv[b][hh] = cv * sigmoidf_(cv); }
        float ac[9];
#pragma unroll
        for (int b = 0; b < 9; ++b) ac[b] = 0.f;
        const float* wp = p.w_ada + ((size_t)l * DM + k0) * 6144 + col;
#pragma unroll
        for (int hh = 0; hh < 2; ++hh) {
#pragma unroll 8
            for (int kk = 0; kk < 64; ++kk) {
                const float wv = wp[(size_t)(hh * 64 + kk) * 6144];
#pragma unroll
                for (int b = 0; b < 9; ++b) ac[b] += __int_as_float(__builtin_amdgcn_readlane(__float_as_int(sv[b][hh]), kk)) * wv;
            }
        }
        const float bias = (kc == 0) ? p.b_ada[l * 6144 + col] : 0.f;
        float* mod = (float*)(ws + WS_MOD) + (size_t)l * 9 * 6144;
#pragma unroll
        for (int b = 0; b < 9; ++b) atomicAdd(mod + b * 6144 + col, ac[b] + bias);
    }
}

__device__ __forceinline__ void norm_phase(const float* xlat, const float* xctx, const float* gvec, const float* mod, int sh_off, int sc_off, bf16_t* H, int nrows,
                                           const float* part, const float* pgate, float* xctx_out) {
    const int tid = fresh_tid(), lane = tid & 63, gw = blockIdx.x * 8 + (tid >> 6), NGW = gridDim.x * 8;
    f32x4 vn[4];
#define NORM_LOADX(dst, r_) do { const int r__ = (r_); const float* xr_ = r__ < NLAT ? xlat + (size_t)r__ * DM : xctx + (size_t)(r__ - NLAT) * DM; \
        _Pragma("unroll") for (int j = 0; j < 4; ++j) dst[j] = *(const f32x4*)(xr_ + 4 * lane + 256 * j); } while (0)
    if (gw < nrows) NORM_LOADX(vn, gw);
    for (int row = gw; row < nrows; row += NGW) {
        const int bb = row < NLAT ? row >> 11 : 8;
        f32x4 v[4]; float ss = 0.f;
#pragma unroll
        for (int j = 0; j < 4; ++j) v[j] = vn[j];
        if (row + NGW < nrows) NORM_LOADX(vn, row + NGW);
        const float* mp = mod + bb * 6144;
        f32x4 gg[4], sc[4], sh[4];
#pragma unroll
        for (int j = 0; j < 4; ++j) { const int col = 4 * lane + 256 * j; gg[j] = *(const f32x4*)(gvec + col); sc[j] = *(const f32x4*)(mp + sc_off + col); sh[j] = *(const f32x4*)(mp + sh_off + col); }
        if (part != nullptr && row >= NLAT) {
#pragma unroll
            for (int j = 0; j < 4; ++j) {
                const size_t o = (size_t)(row - NLAT) * DM + 4 * lane + 256 * j;
                const f32x4 ps = (*(const f32x4*)(part + o) + *(const f32x4*)(part + (size_t)NCTX * DM + o)) + (*(const f32x4*)(part + (size_t)2 * NCTX * DM + o) + *(const f32x4*)(part + (size_t)3 * NCTX * DM + o));
                v[j] = v[j] + *(const f32x4*)(pgate + 4 * lane + 256 * j) * ps;
                *(f32x4*)(xctx_out + o) = v[j];
            }
        }
#pragma unroll
        for (int j = 0; j < 4; ++j) ss += (v[j][0] * v[j][0] + v[j][1] * v[j][1]) + (v[j][2] * v[j][2] + v[j][3] * v[j][3]);
        const float rstd = __builtin_amdgcn_rsqf(wave_sum(ss) * (1.f / DM) + EPSV);
#pragma unroll
        for (int j = 0; j < 4; ++j) {
            const int col = 4 * lane + 256 * j;
            const f32x4 y = (v[j] * rstd) * gg[j];
            const f32x4 hv = y * (sc[j] + 1.f) + sh[j];
            *(u32x2*)(H + (size_t)row * DM + col) = pack4(hv);
        }
    }
#undef NORM_LOADX
}

__global__ void __launch_bounds__(512, 2) fwd_kernel(Params p) {
    extern __shared__ __attribute__((aligned(16))) unsigned char lds_raw[];
    LAS unsigned char* lds = (LAS unsigned char*)lds_raw;
    cg::grid_group grid = cg::this_grid();
    const int G = gridDim.x, cu = blockIdx.x;
    unsigned char* ws = p.ws;
    bf16_t* H = (bf16_t*)(ws + WS_H);
    bf16_t* Q1 = (bf16_t*)(ws + WS_Q1); bf16_t* Q2 = (bf16_t*)(ws + WS_Q2); bf16_t* K1c = (bf16_t*)(ws + WS_K1); bf16_t* K2c = (bf16_t*)(ws + WS_K2);
    bf16_t* VT = (bf16_t*)(ws + WS_VT); bf16_t* TTl = (bf16_t*)(ws + WS_TTL); bf16_t* TTc = (bf16_t*)(ws + WS_TTC); bf16_t* UC = (bf16_t*)(ws + WS_UC);
    bf16_t* MIXA = (bf16_t*)(ws + WS_MIX); bf16_t* ACT = (bf16_t*)(ws + WS_ACT);
    float* PB1 = (float*)(ws + WS_R); float* PB2 = (float*)(ws + WS_R + 99 * MiB);
    bf16_t* FP = (bf16_t*)(ws + WS_H);
    float* XL = p.out; float* XC = (float*)(ws + WS_XCTX);
    const float* rope = (const float*)(ws + WS_ROPE);

    volatile LAS unsigned* bst = (volatile LAS unsigned*)(lds + LDS_BYTES - 64);
    if (threadIdx.x < 2) bst[threadIdx.x] = 0u;
    __syncthreads();
    const XcdBarrier xbar = xcd_barrier_post((unsigned*)(ws + WS_BAR), bst);
#define GSYNC() xcd_barrier(xbar)

    prep_phase(p, lds);
    grid.sync();

#pragma unroll 1
    for (int l = 0; l < 2; ++l) {
        const float* mod = (const float*)(ws + WS_MOD) + (size_t)l * 9 * 6144;
        const float* xin_l = l == 0 ? p.x : XL; const float* xin_c = l == 0 ? p.ctx : XC;
        const int mrows = l == 0 ? MTOT : NLAT;
        if (PROBE == 3) { for (int rep = 0; rep < 8; ++rep) GSYNC(); }
        norm_phase(xin_l, xin_c, p.norm1_g + l * DM, mod, 0, 1024, H, MTOT, l == 1 ? PB2 : nullptr, (const float*)(ws + WS_MOD) + 8 * 6144 + 5120, XC);
        GSYNC();
        for (int rep = 0; rep < (PROBE == 4 ? 2 : 1); ++rep) {
            if (rep) GSYNC();
            pg8::Gemm g{H, (const bf16_t*)(ws + WS_WIN) + (size_t)l * INW * DM, MTOT, INW, DM, DM, DM, 0};
            pg8::StaticOrder S; S.init(MTOT, INW, G, cu);
            EpiInProj E{Q1, Q2, K1c, K2c, VT, TTl, TTc, UC, rope};
            pg8::gemm_phase<EpiInProj, pg8::StaticOrder, true>(lds, g, S, E);
        }
        GSYNC();
        for (int rep = 0; rep < (PROBE == 1 ? 2 : 1); ++rep) {
            if (rep) GSYNC();
            const float li = 0.8f - 0.6f * __expf(-0.3f * (float)l);
            float lam;
            { const int lane = fresh_tid() & 63;
              const float s1 = wave_sum(p.lam_q1[l * 64 + lane] * p.lam_k1[l * 64 + lane]), s2 = wave_sum(p.lam_q2[l * 64 + lane] * p.lam_k2[l * 64 + lane]);
              lam = expf(s1) - expf(s2) + li; }
            att::Args A{Q1, Q2, K1c, K2c, VT, MIXA, p.subln_g + l * 128, lam, 1.f - li};
            const int n_att = 512 + (l == 0 ? 64 : 0);
            for (int u = cu; u < n_att; u += G) {
                if (u < 512) att::attn_unit(lds, A, u >> 6, (u >> 4) & 3, (u >> 6) * SEQ + (u & 15) * 128, 36);
                else { const int v = u - 512; att::attn_unit(lds, A, v >> 3, (v >> 1) & 3, NLAT + (v >> 3) * CTXL + (v & 1) * 128, 4); }
            }
#pragma unroll 1
            for (int hf = 0; hf < 2; ++hf) {
                pg8::Gemm g{(const bf16_t*)(ws + WS_DFTL) + hf * 2048, TTl + hf * 2048, 2048, 2048, 2048, 4096, 4096, 0};
                pg8::OffsetOrder S; S.init(2048, 2048, G, cu, 64 + 64 * hf);
                EpiMix E{FP, 512, hf * 256, 0, SEQ, 0};
                pg8::gemm_phase<EpiMix, pg8::OffsetOrder, true>(lds, g, S, E);
            }
            if (l == 0) {
#pragma unroll 1
                for (int hf = 0; hf < 2; ++hf) {
                    pg8::Gemm g{(const bf16_t*)(ws + WS_DFTC) + hf * 256, TTc + hf * 256, 256, 2048, 256, 512, 512, 0};
                    pg8::OffsetOrder S; S.init(256, 2048, G, cu, 192 + 8 * hf);
                    EpiMix E{FP, 512, hf * 256, NLAT, CTXL, 0};
                    pg8::gemm_phase<EpiMix, pg8::OffsetOrder, true>(lds, g, S, E);
                }
            }
            const int n_conv = l == 0 ? 288 : 256;
            if (G == 256) {
                const int sidx = cu < 64 ? cu : (cu >= 192 ? cu - 128 : -1);
                if (sidx >= 0) for (int it = sidx; it < n_conv; it += 128) conv_item(p, lds, l, it, UC, MIXA);
            } else for (int it = cu; it < n_conv; it += G) conv_item(p, lds, l, it, UC, MIXA);
        }
        GSYNC();
        {
            const bf16_t* wsm = (const bf16_t*)(ws + WS_WSM) + (size_t)l * WSM_L;
            {
                pg8::Gemm g{FP, wsm, mrows, 256, 512, 512, 512, 0};
                pg8::OffsetOrder S; S.init(mrows, 256, G, cu, 0);
                EpiMix E{MIXA, DM, 512, 0, 0, 0};
                pg8::gemm_phase<EpiMix, pg8::OffsetOrder, true>(lds, g, S, E);
            }
            {
                pg8::Gemm g{MIXA + 768, wsm + 256 * 512, mrows, 256, 256, DM, 256, 0};
                pg8::OffsetOrder S; S.init(mrows, 256, G, cu, 72);
                EpiMix E{MIXA, DM, 768, 0, 0, 0};
                pg8::gemm_phase<EpiMix, pg8::OffsetOrder, true>(lds, g, S, E);
            }
        }
        GSYNC();
        {
            pg8::Gemm g{MIXA, (const bf16_t*)(ws + WS_WOUT) + (size_t)l * DM * DM, mrows, DM, DM, DM, DM, 0};
            EpiRes E{xin_l, xin_c, XL, XC, mod, 2048, PB1};
            if (l == 0) { pg8::CtxSplitOrder S; S.init(DM, DM, G, cu); pg8::gemm_phase<EpiRes, pg8::CtxSplitOrder, true>(lds, g, S, E); }
            else { pg8::StaticOrder S; S.init(mrows, DM, G, cu); pg8::gemm_phase<EpiRes, pg8::StaticOrder, true>(lds, g, S, E); }
        }
        GSYNC();
        norm_phase(XL, l == 0 ? p.ctx : XC, p.norm2_g + l * DM, mod, 3072, 4096, H, mrows, l == 0 ? PB1 : nullptr, mod + 8 * 6144 + 2048, XC);
        GSYNC();
        for (int rep = 0; rep < (PROBE == 2 ? 2 : 1); ++rep) {
            if (rep) GSYNC();
            pg8::Gemm g{H, (const bf16_t*)(ws + WS_W13) + (size_t)l * N13 * DM, mrows, N13, DM, DM, DM, 0};
            pg8::StaticOrder S; S.init(mrows, N13, G, cu);
            EpiFfn13 E{ACT};
            pg8::gemm_phase<EpiFfn13, pg8::StaticOrder, true>(lds, g, S, E);
        }
        GSYNC();
        {
            pg8::Gemm g{ACT, (const bf16_t*)(ws + WS_W2) + (size_t)l * DM * DFF, mrows, DM, DFF, DFF, DFF, 0};
            EpiRes E{XL, XC, XL, XC, mod, 5120, PB2};
            if (l == 0) { pg8::CtxSplitOrder S; S.init(DM, DFF, G, cu); pg8::gemm_phase<EpiRes, pg8::CtxSplitOrder, true>(lds, g, S, E); }
            else { pg8::StaticOrder S; S.init(mrows, DM, G, cu); pg8::gemm_phase<EpiRes, pg8::StaticOrder, true>(lds, g, S, E); }
        }
        GSYNC();
    }
    {
        const int tid = fresh_tid(), lane = tid & 63, gw = blockIdx.x * 8 + (tid >> 6), NGW = gridDim.x * 8;
        f32x4 gg[4], vn[4];
#pragma unroll
        for (int j = 0; j < 4; ++j) { gg[j] = *(const f32x4*)(p.final_g + 4 * lane + 256 * j); vn[j] = *(const f32x4*)(XL + (size_t)gw * DM + 4 * lane + 256 * j); }
        for (int row = gw; row < NLAT; row += NGW) {
            float* xr = XL + (size_t)row * DM;
            f32x4 v[4]; float ss = 0.f;
#pragma unroll
            for (int j = 0; j < 4; ++j) { v[j] = vn[j]; ss += (v[j][0] * v[j][0] + v[j][1] * v[j][1]) + (v[j][2] * v[j][2] + v[j][3] * v[j][3]); }
            if (row + NGW < NLAT) {
#pragma unroll
                for (int j = 0; j < 4; ++j) vn[j] = *(const f32x4*)(xr + (size_t)NGW * DM + 4 * lane + 256 * j);
            }
            const float rstd = __builtin_amdgcn_rsqf(wave_sum(ss) * (1.f / DM) + EPSV);
#pragma unroll
            for (int j = 0; j < 4; ++j) { const int col = 4 * lane + 256 * j; *(f32x4*)(xr + col) = (v[j] * rstd) * gg[j]; }
        }
    }
}

extern "C" void kernel_launch(void* const* d_in, const int* in_sizes, int n_in, void* d_out, int out_size, void* d_ws, size_t ws_size, hipStream_t stream) {
    static int grid_blocks = 0;
    if (grid_blocks == 0) {
        if (n_in != 25 || ws_size < WS_END) { fprintf(stderr, "kernel_launch: unexpected n_in %d / ws %zu\n", n_in, ws_size); grid_blocks = -1; return; }
        int dev = 0, cus = 0, per_cu = 0;
        (void)hipGetDevice(&dev);
        (void)hipDeviceGetAttribute(&cus, hipDeviceAttributeMultiprocessorCount, dev);
        if (hipFuncSetAttribute((const void*)fwd_kernel, hipFuncAttributeMaxDynamicSharedMemorySize, LDS_BYTES) != hipSuccess) fprintf(stderr, "kernel_launch: hipFuncSetAttribute failed\n");
        if (hipOccupancyMaxActiveBlocksPerMultiprocessor(&per_cu, (const void*)fwd_kernel, 512, LDS_BYTES) != hipSuccess || per_cu < 1) { fprintf(stderr, "kernel_launch: occupancy query gave %d\n", per_cu); per_cu = 1; }
        (void)hipGetLastError();
        grid_blocks = cus * per_cu;
    }
    if (grid_blocks < 0) return;
    Params p{};
    const float** pp = (const float**)&p;
    for (int i = 0; i < 25; ++i) pp[i] = (const float*)d_in[i];
    p.out = (float*)d_out; p.ws = (unsigned char*)d_ws;
    (void)hipMemsetAsync((unsigned char*)d_ws + WS_MOD, 0, ZERO_BYTES, stream);
    void* args[] = {&p};
    hipError_t e = hipLaunchCooperativeKernel((const void*)fwd_kernel, dim3(grid_blocks), dim3(512), args, LDS_BYTES, stream);
    if (e != hipSuccess) fprintf(stderr, "cooperative launch failed: %s (grid %d)\n", hipGetErrorString(e), grid_blocks);
}
```

```cpp
#include <hip/hip_runtime.h>
#include <hip/hip_cooperative_groups.h>
#include <cstdint>
#include <cstdio>
namespace cg = cooperative_groups;
#ifndef PROBE
#define PROBE 0
#endif

#define LAS __attribute__((address_space(3)))
typedef unsigned short bf16_t;
typedef short bf16x8 __attribute__((ext_vector_type(8)));
typedef float f32x4 __attribute__((ext_vector_type(4)));
typedef float f32x16 __attribute__((ext_vector_type(16)));
typedef unsigned u32x4 __attribute__((ext_vector_type(4)));
typedef unsigned u32x2 __attribute__((ext_vector_type(2)));

constexpr int NB = 8, SEQ = 2048, DM = 1024, CTXL = 256, NLAT = NB * SEQ, NCTX = NB * CTXL, MTOT = NLAT + NCTX;
constexpr int INW = 2560, INW_SRC = 2304, DFF = 2816, N13 = 2 * DFF, KCAT = CTXL + SEQ;
constexpr float EPSV = 1e-6f;
constexpr float QSCALE = 0.125f * 1.4426950408889634f;
constexpr int LDS_BYTES = 147456;
constexpr int XCD_BAR_WORDS_C = 3456;

constexpr size_t MiB = 1u << 20;
constexpr size_t WS_WIN = 0, WS_WOUT = 10 * MiB, WS_W13 = 14 * MiB, WS_W2 = 36 * MiB, WS_WSM = 47 * MiB, WS_DFTL = 48 * MiB, WS_DFTC = 64 * MiB;
constexpr size_t WS_MOD = 64 * MiB + 256 * 1024, WS_ROPE = 64 * MiB + 768 * 1024, WS_XCTX = 65 * MiB, WS_H = 73 * MiB, WS_R = 109 * MiB;
constexpr size_t WS_Q1 = WS_R, WS_Q2 = WS_R + 9 * MiB, WS_K1 = WS_R + 18 * MiB, WS_K2 = WS_R + 27 * MiB, WS_VT = WS_R + 36 * MiB, WS_TTL = WS_R + 54 * MiB,
                 WS_TTC = WS_R + 70 * MiB, WS_UC = WS_R + 72 * MiB, WS_MIX = WS_R + 90 * MiB, WS_ACT = WS_R, WS_END = WS_R + 131 * MiB;
constexpr size_t MOD_BYTES = 2 * 9 * 6144 * 4;
constexpr int WSM_L = 256 * 512 + 256 * 256;
constexpr size_t WS_BAR = 64 * MiB + 704 * 1024, WS_PCNT = WS_BAR + 14336, ZERO_BYTES = WS_PCNT + 64 * 256 - WS_MOD;

struct Params {
    const float *x, *c, *ctx, *c_ctx, *w_ada, *b_ada, *norm1_g, *norm2_g, *w_in, *lam_q1, *lam_k1, *lam_q2, *lam_k2, *subln_g, *w_fourier, *conv_w, *conv_b,
        *conv_ln_g, *conv_ln_b, *w_conv_out, *w_out, *w_ffn1, *w_ffn3, *w_ffn2, *final_g;
    float* out; unsigned char* ws;
};

__device__ __forceinline__ unsigned cvt_pk_bf16(float lo, float hi) { unsigned r; asm("v_cvt_pk_bf16_f32 %0, %1, %2" : "=v"(r) : "v"(lo), "v"(hi)); return r; }
__device__ __forceinline__ u32x2 pack4(f32x4 v) { u32x2 w; w.x = cvt_pk_bf16(v[0], v[1]); w.y = cvt_pk_bf16(v[2], v[3]); return w; }
__device__ __forceinline__ bf16_t f2bf(float v) { return (bf16_t)(cvt_pk_bf16(v, 0.f) & 0xffffu); }
__device__ __forceinline__ float wave_sum(float v) {
#pragma unroll
    for (int o = 1; o < 64; o <<= 1) v += __shfl_xor(v, o);
    return v;
}
__device__ __forceinline__ int fresh_tid() { int t = threadIdx.x; asm volatile("" : "+v"(t)); return t; }
__device__ __forceinline__ float max3f(float a, float b, float c) { float r; asm("v_max3_f32 %0, %1, %2, %3" : "=v"(r) : "v"(a), "v"(b), "v"(c)); return r; }
__device__ __forceinline__ float sigmoidf_(float v) { return __builtin_amdgcn_rcpf(1.f + __expf(-v)); }


#define XB_TMO      128
#define XB_XCNT(j)  (256  + 64 * (j))
#define XB_XSUB(j)  (1280 + 64 * (j))
#define XB_XGEN(j)  (2304 + 64 * (j))
#define XB_TOP      3328
#define XB_TOPGEN   3392
#define XCD_BAR_WORDS 3456
#define XB_SPIN_CAP (1u << 18)
__device__ __forceinline__ unsigned xb_ld(unsigned* p)              { return __hip_atomic_load(p, __ATOMIC_RELAXED, __HIP_MEMORY_SCOPE_AGENT); }
__device__ __forceinline__ unsigned xb_add(unsigned* p, unsigned v) { return __hip_atomic_fetch_add(p, v, __ATOMIC_RELAXED, __HIP_MEMORY_SCOPE_AGENT); }
__device__ __forceinline__ unsigned xb_xcc_id() { return (unsigned)__builtin_amdgcn_s_getreg((3 << 11) | 20) & 0xFu; }
#define XB_SPIN(cond, bar) do { unsigned _sp = 0; while (cond) { __builtin_amdgcn_s_sleep(1); \
    if ((++_sp & 255u) == 0u) { if (xb_ld(&(bar)[XB_TMO])) break; if (_sp > XB_SPIN_CAP) { atomicAdd(&(bar)[XB_TMO], 1u); break; } } } } while (0)
struct XcdBarrier { unsigned* bar; unsigned x; volatile LAS unsigned* st; };
__device__ __forceinline__ XcdBarrier xcd_barrier_post(unsigned* bar, volatile LAS unsigned* st) {
    XcdBarrier b; b.bar = bar; b.x = xb_xcc_id(); b.st = st;
    if (threadIdx.x == 0) (void)xb_add(&bar[XB_XCNT(b.x)], 1u);
    return b;
}
__device__ __forceinline__ void xcd_barrier_complete(unsigned* bar, unsigned x, unsigned& nloc, unsigned& nx) {
    const unsigned G = gridDim.x * gridDim.y * gridDim.z;
    unsigned sum, cnt, mine, sp = 0u;
    for (;;) {
        sum = 0u; cnt = 0u; mine = 0u;
#pragma unroll
        for (unsigned j = 0; j < 16; ++j) { const unsigned c = xb_ld(&bar[XB_XCNT(j)]); sum += c; cnt += (c > 0u) ? 1u : 0u; mine = (j == x) ? c : mine; }
        if (sum == G) break;
        __builtin_amdgcn_s_sleep(1);
        if ((++sp & 255u) == 0u) { if (xb_ld(&bar[XB_TMO])) break; if (sp > XB_SPIN_CAP) { atomicAdd(&bar[XB_TMO], 1u); break; } }
    }
    nloc = mine > 0u ? mine : 1u; nx = cnt > 0u ? cnt : 1u;
}
__device__ __forceinline__ void xcd_barrier(const XcdBarrier& b) {
    asm volatile("s_waitcnt vmcnt(0)" ::: "memory");
    __syncthreads();
    if (threadIdx.x == 0) {
        unsigned* bar = b.bar;
        __builtin_amdgcn_s_waitcnt(0);
        unsigned nloc = b.st[0], nx = b.st[1];
        if (nloc == 0u) { xcd_barrier_complete(bar, b.x, nloc, nx); b.st[0] = nloc; b.st[1] = nx; }
        const unsigned old = xb_add(&bar[XB_XSUB(b.x)], 1u);
        const unsigned gen = old / nloc;
        if (old + 1u == (gen + 1u) * nloc) {
            __builtin_amdgcn_fence(__ATOMIC_RELEASE, "agent");
            asm volatile("s_waitcnt vmcnt(0)" ::: "memory");
            const unsigned og = xb_add(&bar[XB_TOP], 1u);
            const unsigned tg = og / nx;
            if (og + 1u == (tg + 1u) * nx) xb_add(&bar[XB_TOPGEN], 1u);
            else XB_SPIN(xb_ld(&bar[XB_TOPGEN]) == tg, bar);
            __builtin_amdgcn_fence(__ATOMIC_ACQUIRE, "agent");
            xb_add(&bar[XB_XGEN(b.x)], 1u);
            asm volatile("s_waitcnt vmcnt(0)" ::: "memory");
        } else {
            XB_SPIN(xb_ld(&bar[XB_XGEN(b.x)]) == gen, bar);
            __builtin_amdgcn_fence(__ATOMIC_ACQUIRE, "agent");
            asm volatile("s_waitcnt vmcnt(0)" ::: "memory");
        }
    }
    __syncthreads();
}

namespace pg8 {
constexpr int BM = 256, BK = 64, HALF = 128, HTB = HALF * BK * 2, STAGE_BYTES = 8 * HTB, NXCD = 8, WGM = 8;
__host__ __device__ __forceinline__ int lds_byte(int r, int c) { const int st = (r >> 4) * 2 + (c >> 5), rr = r & 15, cc = c & 31, ob = rr * 64 + cc * 2; return st * 1024 + (ob ^ (((ob >> 9) & 1) << 5)); }
__host__ __device__ __forceinline__ void stage_rc(int b, int& R, int& C) { const int st = b / 1024, sb = b % 1024, swz = sb ^ (((sb >> 9) & 1) << 5); R = (st >> 1) * 16 + swz / 64; C = (st & 1) * 32 + (swz % 64) / 2; }

__host__ __device__ __forceinline__ int perm32(int rho) { const int n = rho >> 4, i = rho & 15; return 8 * (i >> 2) + 4 * n + (i & 3); }
struct Unit { int pm, pn, k0, nt, flags; };
struct Gemm { const bf16_t* A; const bf16_t* Bt; int M, N, K, lda, ldb, a_pn_off; };

struct StaticOrder {
    int nM, nN, nwg, G, c;
    __host__ __device__ void init(int M, int N, int G_, int c_) { nM = M / BM; nN = N / BM; nwg = nM * nN; G = G_; c = c_; }
    __host__ __device__ __forceinline__ bool next(int i, Unit& u) const {
        const long L = (long)i * G + c; if (L >= nwg) return false;
        int wgid = (int)L; { const int q = nwg / NXCD, r = nwg % NXCD, xcd = wgid % NXCD, off = wgid / NXCD; wgid = (xcd < r ? xcd * (q + 1) : r * (q + 1) + (xcd - r) * q) + off; }
        const int nig = WGM * nN, gid = wgid / nig, fm = gid * WGM, gsz = (nM - fm) < WGM ? (nM - fm) : WGM;
        u.pm = fm + ((wgid % nig) % gsz); u.pn = (wgid % nig) / gsz; u.k0 = 0; u.nt = -1; u.flags = 0; return true;
    }
};
struct OffsetOrder {
    int nN, nwg, G, cc;
    __host__ __device__ void init(int M, int N, int G_, int c_, int off) { nN = N / BM; nwg = (M / BM) * nN; G = G_; cc = ((c_ - off) % G_ + G_) % G_; }
    __host__ __device__ __forceinline__ bool next(int i, Unit& u) const { const long L = (long)i * G + cc; if (L >= nwg) return false; u.pm = (int)L / nN; u.pn = (int)L % nN; u.k0 = 0; u.nt = -1; u.flags = 0; return true; }
};

struct CtxSplitOrder {
    StaticOrder lat; int nN, ntf;
    __host__ __device__ void init(int N, int K, int G_, int c_) { lat.init(NLAT, N, G_, c_); nN = N / BM; ntf = K / BK; }
    __host__ __device__ __forceinline__ bool next(int i, Unit& u) const {
        const long L = (long)i * lat.G + lat.c;
        int pm, pn, k0 = 0, ntq = -1, fl = 0;
        if (L < lat.nwg) {
            int wgid = (int)L; { const int q = lat.nwg / NXCD, r = lat.nwg % NXCD, xcd = wgid % NXCD, off = wgid / NXCD; wgid = (xcd < r ? xcd * (q + 1) : r * (q + 1) + (xcd - r) * q) + off; }
            const int nig = WGM * lat.nN, gid = wgid / nig, fm = gid * WGM, gsz = (lat.nM - fm) < WGM ? (lat.nM - fm) : WGM;
            pm = fm + ((wgid % nig) % gsz); pn = (wgid % nig) / gsz;
        } else {
            const int s = (int)(L - lat.nwg); if (s >= (NCTX / BM) * nN * 4) return false;
            const int cu_ = s >> 2, q = s & 3, base = (ntf / 8) * 2, extra = (ntf - 4 * base) / 2;
            pm = NLAT / BM + cu_ / nN; pn = cu_ % nN; ntq = base + (q < extra ? 2 : 0); k0 = (q * base + 2 * (q < extra ? q : extra)) * BK; fl = 1 | (q << 1);
        }
        u.pm = pm; u.pn = pn; u.k0 = k0; u.nt = ntq; u.flags = fl; return true;
    }
};

template <class Epi, class Sched, bool ALIGN_EPI>
__device__ __forceinline__ void gemm_phase(LAS unsigned char* lds, const Gemm g, const Sched& S, const Epi& E) {
    const int tid = fresh_tid(), wid = __builtin_amdgcn_readfirstlane(tid >> 6), lane = tid & 63, wr = wid >> 2, wc = wid & 3, fr = lane & 15, fq = lane >> 4;
    const int K = g.K, nt = K / BK;
    unsigned voffA[2], voffB[2];
#pragma unroll
    for (int i = 0; i < 2; ++i) { int R, C; stage_rc(tid * 16 + i * 8192, R, C);
        const int Rb = Epi::PERM ? ((R & ~31) + perm32(R & 31)) : R;
        voffA[i] = (unsigned)(R * g.lda + C) * 2u; voffB[i] = (unsigned)(Rb * g.ldb + C) * 2u; }
    const size_t kstep = (size_t)(BK * 2);
    const size_t hstepA = (size_t)HALF * g.lda * 2, hstepB = (size_t)HALF * g.ldb * 2;
    const size_t tstepA = 2 * hstepA, tstepB = 2 * hstepB;
    const unsigned ldsw = (unsigned)wid * 1024u;
    const int aoff = lds_byte(wr * 64 + fr, fq * 8), boff = lds_byte(wc * 32 + fr, fq * 8);
#define PG8_SA(b, h) (((b) * 2 + (h)) * HTB)
#define PG8_SB(b, h) ((4 + (b) * 2 + (h)) * HTB)
#define PG8_STAGE(bufoff, gbase, voff) do { _Pragma("unroll") for (int _i = 0; _i < 2; ++_i) \
        __builtin_amdgcn_global_load_lds((const unsigned*)((const char*)(gbase) + (voff)[_i]), (LAS unsigned*)(lds + (bufoff) + ldsw + _i * 8192), 16, 0, 0); } while (0)
#define PG8_LDA(dst, b, h) do { _Pragma("unroll") for (int m = 0; m < 4; ++m) _Pragma("unroll") for (int k = 0; k < 2; ++k) dst[m][k] = *(const LAS bf16x8*)(lds + PG8_SA(b, h) + aoff + m * 2048 + k * 1024); } while (0)
#define PG8_LDB(dst, b, h) do { _Pragma("unroll") for (int n = 0; n < 2; ++n) _Pragma("unroll") for (int k = 0; k < 2; ++k) dst[n][k] = *(const LAS bf16x8*)(lds + PG8_SB(b, h) + boff + n * 2048 + k * 1024); } while (0)
#define PG8_MMA(ai, bj, At, Bt) do { __builtin_amdgcn_s_setprio(1); _Pragma("unroll") for (int m = 0; m < 4; ++m) _Pragma("unroll") for (int n = 0; n < 2; ++n) _Pragma("unroll") for (int k = 0; k < 2; ++k) \
        acc[ai][bj][m][n] = __builtin_amdgcn_mfma_f32_16x16x32_bf16(Bt[n][k], At[m][k], acc[ai][bj][m][n], 0, 0, 0); __builtin_amdgcn_s_setprio(0); } while (0)
#define PG8_WAIT_V(n) asm volatile("s_waitcnt vmcnt(" #n ")" ::: "memory")
#define PG8_WAIT_L(n) asm volatile("s_waitcnt lgkmcnt(" #n ")" ::: "memory")
#define PG8_BAR __builtin_amdgcn_s_barrier()
#define PG8_SCHED __builtin_amdgcn_sched_barrier(0)
    Unit cur, nxt; int ui = 0;
    if (!S.next(0, cur)) return;
    f32x4 acc[2][2][4][2];
#pragma unroll
    for (int a = 0; a < 2; ++a)
#pragma unroll
        for (int b = 0; b < 2; ++b)
#pragma unroll
            for (int m = 0; m < 4; ++m)
#pragma unroll
                for (int n = 0; n < 2; ++n) acc[a][b][m][n] = (f32x4){0.f, 0.f, 0.f, 0.f};
    bf16x8 At[4][2], B0[2][2], B1[2][2];
    const char* cA = (const char*)g.A + (size_t)cur.pm * tstepA + (size_t)cur.pn * g.a_pn_off * 2 + (size_t)cur.k0 * 2; const char* cB = (const char*)g.Bt + (size_t)cur.pn * tstepB + (size_t)cur.k0 * 2;
    PG8_STAGE(PG8_SB(0, 0), cB, voffB); PG8_STAGE(PG8_SB(0, 1), cB + hstepB, voffB); PG8_STAGE(PG8_SA(0, 0), cA, voffA); PG8_STAGE(PG8_SA(0, 1), cA + hstepA, voffA);
    if (wr == 1) PG8_BAR;
    PG8_WAIT_V(2); PG8_BAR;
    PG8_STAGE(PG8_SB(1, 0), cB + kstep, voffB); PG8_STAGE(PG8_SA(1, 0), cA + kstep, voffA); PG8_STAGE(PG8_SB(1, 1), cB + hstepB + kstep, voffB);
    PG8_WAIT_V(6); PG8_BAR;
    for (;;) {
        const bool has_next = S.next(ui + 1, nxt);
        const char* nA = has_next ? (const char*)g.A + (size_t)nxt.pm * tstepA + (size_t)nxt.pn * g.a_pn_off * 2 + (size_t)nxt.k0 * 2 : cA; const char* nB = has_next ? (const char*)g.Bt + (size_t)nxt.pn * tstepB + (size_t)nxt.k0 * 2 : cB;
        const int ntc = cur.nt < 0 ? nt : cur.nt;
        for (int t = 0; t < ntc; t += 2) {
            const bool last = (t == ntc - 2);
            const char* a1 = cA + (size_t)(t + 1) * kstep;
            const char* a2 = last ? nA : cA + (size_t)(t + 2) * kstep; const char* b2 = last ? nB : cB + (size_t)(t + 2) * kstep;
            const char* a3 = a2 + kstep; const char* b3 = b2 + kstep;
            PG8_LDB(B0, 0, 0); PG8_LDB(B1, 0, 1); PG8_SCHED; PG8_LDA(At, 0, 0); PG8_STAGE(PG8_SA(1, 1), a1 + hstepA, voffA);
            PG8_WAIT_V(8); PG8_WAIT_L(0); PG8_BAR; PG8_MMA(0, 0, At, B0); PG8_MMA(0, 1, At, B1); PG8_BAR; PG8_SCHED;
            PG8_LDA(At, 0, 1); PG8_STAGE(PG8_SB(0, 0), b2, voffB); PG8_STAGE(PG8_SB(0, 1), b2 + hstepB, voffB); PG8_STAGE(PG8_SA(0, 0), a2, voffA);
            PG8_WAIT_V(8); PG8_WAIT_L(0); PG8_BAR; PG8_MMA(1, 0, At, B0); PG8_MMA(1, 1, At, B1); PG8_BAR; PG8_SCHED;
            PG8_LDB(B0, 1, 0); PG8_LDB(B1, 1, 1); PG8_SCHED; PG8_LDA(At, 1, 0); PG8_STAGE(PG8_SA(0, 1), a2 + hstepA, voffA);
            PG8_WAIT_V(8); PG8_WAIT_L(0); PG8_BAR; PG8_MMA(0, 0, At, B0); PG8_MMA(0, 1, At, B1); PG8_BAR; PG8_SCHED;
            PG8_LDA(At, 1, 1); PG8_STAGE(PG8_SB(1, 0), b3, voffB); PG8_STAGE(PG8_SB(1, 1), b3 + hstepB, voffB); PG8_STAGE(PG8_SA(1, 0), a3, voffA);
            PG8_WAIT_V(8); PG8_WAIT_L(0); PG8_BAR; PG8_MMA(1, 0, At, B0); PG8_MMA(1, 1, At, B1); PG8_BAR; PG8_SCHED;
        }
        if constexpr (ALIGN_EPI) { if (wr == 0) PG8_BAR; }
        if constexpr (!Epi::AFTER_DRAIN) E(acc, cur, wr, wc, fr, fq);
        if (!has_next) break;
#pragma unroll
        for (int a = 0; a < 2; ++a)
#pragma unroll
            for (int b = 0; b < 2; ++b)
#pragma unroll
                for (int m = 0; m < 4; ++m)
#pragma unroll
                    for (int n = 0; n < 2; ++n) acc[a][b][m][n] = (f32x4){0.f, 0.f, 0.f, 0.f};
        cur = nxt; cA = nA; cB = nB; ++ui;
        if constexpr (ALIGN_EPI) { if (wr == 1) PG8_BAR; }
    }
    PG8_WAIT_V(0);
    if constexpr (!ALIGN_EPI) { if (wr == 0) PG8_BAR; }
    PG8_BAR;
    if constexpr (Epi::AFTER_DRAIN) E.fused(acc, cur, wr, wc, fr, fq, lds, wid, lane);
#undef PG8_SA
#undef PG8_SB
#undef PG8_STAGE
#undef PG8_LDA
#undef PG8_LDB
#undef PG8_MMA
#undef PG8_WAIT_V
#undef PG8_WAIT_L
#undef PG8_BAR
#undef PG8_SCHED
}
}

typedef f32x4 Acc[2][2][4][2];

struct EpiInProj {
    static constexpr bool PERM = false;
    static constexpr bool AFTER_DRAIN = false;
    bf16_t *Q1, *Q2, *K1c, *K2c, *VT, *TTl, *TTc, *UC; const float* rope;
    __device__ __forceinline__ void operator()(const Acc& acc, const pg8::Unit& u, int wr, int wc, int fr, int fq) const {
        const int pn = u.pn; const bool lat = u.pm < 64;
#pragma unroll
        for (int ai = 0; ai < 2; ++ai)
#pragma unroll
            for (int m = 0; m < 4; ++m) {
                const int row = u.pm * 256 + ai * 128 + wr * 64 + m * 16 + fr;
                int b, t; if (lat) { b = row >> 11; t = row & 2047; } else { const int rc = row - NLAT; b = rc >> 8; t = rc & 255; }
                const int pos = lat ? CTXL + t : t;
                if (pn < 4) {
                    bf16_t* dst;
                    if (pn == 0) dst = Q1 + (size_t)row * 256; else if (pn == 1) dst = Q2 + (size_t)row * 256;
                    else if (pn == 2) dst = K1c + ((size_t)b * KCAT + pos) * 256; else dst = K2c + ((size_t)b * KCAT + pos) * 256;
                    const float scale = pn < 2 ? QSCALE : 1.f;
                    const int ax = fq >> 1, fh = fq & 1;
                    u32x4 w1, w2;
#pragma unroll
                    for (int bj = 0; bj < 2; ++bj) {
                        f32x4 cs = {1.f, 1.f, 1.f, 1.f}, sn = {0.f, 0.f, 0.f, 0.f};
                        if (lat) { const int pidx = ax ? (t & 63) : (t >> 6); cs = *(const f32x4*)(rope + pidx * 16 + 8 * fh + 4 * bj); sn = *(const f32x4*)(rope + 1024 + pidx * 16 + 8 * fh + 4 * bj); }
                        const f32x4 x1 = acc[ai][bj][m][0], x2 = acc[ai][bj][m][1];
                        const u32x2 p1 = pack4((x1 * cs - x2 * sn) * scale), p2 = pack4((x2 * cs + x1 * sn) * scale);
                        if (bj == 0) { w1.x = p1.x; w1.y = p1.y; w2.x = p2.x; w2.y = p2.y; } else { w1.z = p1.x; w1.w = p1.y; w2.z = p2.x; w2.w = p2.y; }
                    }
                    bf16_t* dq = dst + wc * 64 + ax * 32 + 8 * fh;
                    *(u32x4*)dq = w1; *(u32x4*)(dq + 16) = w2;
                } else if (pn < 6) {
#pragma unroll
                    for (int bj = 0; bj < 2; ++bj)
#pragma unroll
                        for (int n = 0; n < 2; ++n) {
                            bf16_t* dst = VT + ((size_t)(b * 4 + (pn - 4) * 2 + bj) * 128 + wc * 32 + n * 16 + 4 * fq) * KCAT + pos;
                            const f32x4 v = acc[ai][bj][m][n];
                            dst[0] = f2bf(v[0]); dst[KCAT] = f2bf(v[1]); dst[2 * KCAT] = f2bf(v[2]); dst[3 * KCAT] = f2bf(v[3]);
                        }
                } else if (pn < 8) {
                    const int s = pn - 6;
#pragma unroll
                    for (int bj = 0; bj < 2; ++bj)
#pragma unroll
                        for (int n = 0; n < 2; ++n) {
                            const int jf = bj * 128 + wc * 32 + n * 16 + 4 * fq;
                            const f32x4 v = acc[ai][bj][m][n];
                            if (lat) { bf16_t* dst = TTl + (((size_t)b * 256 + jf) * 2 + s) * SEQ + t; dst[0] = f2bf(v[0]); dst[2 * SEQ] = f2bf(v[1]); dst[4 * SEQ] = f2bf(v[2]); dst[6 * SEQ] = f2bf(v[3]); }
                            else { bf16_t* dst = TTc + (((size_t)b * 256 + jf) * 2 + s) * CTXL + t; dst[0] = f2bf(v[0]); dst[2 * CTXL] = f2bf(v[1]); dst[4 * CTXL] = f2bf(v[2]); dst[6 * CTXL] = f2bf(v[3]); }
                        }
                } else {
                    bf16_t* dst = UC + (size_t)row * 512 + (pn - 8) * 256 + wc * 32 + 8 * fq;
#pragma unroll
                    for (int n = 0; n < 2; ++n) { const u32x2 p0 = pack4(acc[ai][0][m][n]), p1 = pack4(acc[ai][1][m][n]); *(u32x4*)(dst + 128 * n) = (u32x4){p0.x, p0.y, p1.x, p1.y}; }
                }
            }
    }
};

struct EpiRes {
    static constexpr bool PERM = false;
    static constexpr bool AFTER_DRAIN = false;
    const float* xin_lat; const float* xin_ctx; float* xout_lat; float* xout_ctx; const float* mod; int goff; float* pb;
    __device__ __forceinline__ void operator()(const Acc& acc, const pg8::Unit& u, int wr, int wc, int fr, int fq) const {
        const int tile0 = u.pm * 256, colb = u.pn * 256 + wc * 32 + 4 * fq, rloc = wr * 64 + fr;
        if (u.flags & 1) {
            float* pq = pb + ((size_t)(u.flags >> 1) * NCTX + (tile0 - NLAT) + rloc) * DM + colb;
#pragma unroll
            for (int ai = 0; ai < 2; ++ai)
#pragma unroll
                for (int m = 0; m < 4; ++m)
#pragma unroll
                    for (int bj = 0; bj < 2; ++bj)
#pragma unroll
                        for (int n = 0; n < 2; ++n) *(f32x4*)(pq + (size_t)(ai * 128 + m * 16) * DM + bj * 128 + n * 16) = acc[ai][bj][m][n];
            return;
        }
        const bool lat = tile0 < NLAT;
        const float* xi = (lat ? xin_lat + (size_t)tile0 * DM : xin_ctx + (size_t)(tile0 - NLAT) * DM) + (size_t)rloc * DM + colb;
        float* xo = (lat ? xout_lat + (size_t)tile0 * DM : xout_ctx + (size_t)(tile0 - NLAT) * DM) + (size_t)rloc * DM + colb;
        const float* gp = mod + (lat ? (tile0 >> 11) : 8) * 6144 + goff + colb;
        f32x4 gt[2][2];
#pragma unroll
        for (int bj = 0; bj < 2; ++bj)
#pragma unroll
            for (int n = 0; n < 2; ++n) gt[bj][n] = *(const f32x4*)(gp + bj * 128 + n * 16);
        f32x4 xv[2][2][2];
#define ER_LOAD(buf, g_) do { const float* xp_ = xi + (size_t)(((g_) >> 2) * 128 + ((g_) & 3) * 16) * DM; \
            _Pragma("unroll") for (int bj = 0; bj < 2; ++bj) _Pragma("unroll") for (int n = 0; n < 2; ++n) xv[buf][bj][n] = *(const f32x4*)(xp_ + bj * 128 + n * 16); } while (0)
        ER_LOAD(0, 0);
#pragma unroll
        for (int g_ = 0; g_ < 8; ++g_) {
            if (g_ + 1 < 8) ER_LOAD((g_ + 1) & 1, g_ + 1);
            float* xq = xo + (size_t)((g_ >> 2) * 128 + (g_ & 3) * 16) * DM;
#pragma unroll
            for (int bj = 0; bj < 2; ++bj)
#pragma unroll
                for (int n = 0; n < 2; ++n) *(f32x4*)(xq + bj * 128 + n * 16) = xv[g_ & 1][bj][n] + gt[bj][n] * acc[g_ >> 2][bj][g_ & 3][n];
        }
#undef ER_LOAD
    }
};

struct EpiFinal {
    static constexpr bool PERM = false;
    static constexpr bool AFTER_DRAIN = true;
    const float* xin; float* out; const float* mod; int goff; const float* final_g; unsigned* slots; unsigned* cnt;
    __device__ __forceinline__ void fused(Acc& acc, const pg8::Unit& u, int wr, int wc, int fr, int fq, LAS unsigned char* lds, int wid, int lane) const {
        const int tile0 = u.pm * 256, colb = u.pn * 256 + wc * 32 + 4 * fq, rloc = wr * 64 + fr;
        const float* xi = xin + (size_t)(tile0 + rloc) * DM + colb;
        float* xo = out + (size_t)(tile0 + rloc) * DM + colb;
        const float* gp = mod + (tile0 >> 11) * 6144 + goff + colb;
        f32x4 gt[2][2];
#pragma unroll
        for (int bj = 0; bj < 2; ++bj)
#pragma unroll
            for (int n = 0; n < 2; ++n) gt[bj][n] = *(const f32x4*)(gp + bj * 128 + n * 16);
        f32x4 xv[2][2][2];
#define EF_LOAD(buf, g_) do { const float* xp_ = xi + (size_t)(((g_) >> 2) * 128 + ((g_) & 3) * 16) * DM; \
            _Pragma("unroll") for (int bj = 0; bj < 2; ++bj) _Pragma("unroll") for (int n = 0; n < 2; ++n) xv[buf][bj][n] = *(const f32x4*)(xp_ + bj * 128 + n * 16); } while (0)
        LAS float* P = (LAS float*)lds;
        LAS float* S = (LAS float*)(lds + 4096);
        EF_LOAD(0, 0);
#pragma unroll
        for (int g_ = 0; g_ < 8; ++g_) {
            if (g_ + 1 < 8) EF_LOAD((g_ + 1) & 1, g_ + 1);
            float sq = 0.f;
#pragma unroll
            for (int bj = 0; bj < 2; ++bj)
#pragma unroll
                for (int n = 0; n < 2; ++n) { const f32x4 xn = xv[g_ & 1][bj][n] + gt[bj][n] * acc[g_ >> 2][bj][g_ & 3][n]; acc[g_ >> 2][bj][g_ & 3][n] = xn;
                    sq += (xn[0] * xn[0] + xn[1] * xn[1]) + (xn[2] * xn[2] + xn[3] * xn[3]); }
            sq += __shfl_xor(sq, 16); sq += __shfl_xor(sq, 32);
            if (fq == 0) P[((g_ >> 2) * 128 + wr * 64 + (g_ & 3) * 16 + fr) * 4 + wc] = sq;
        }
#undef EF_LOAD
        asm volatile("s_waitcnt lgkmcnt(0)" ::: "memory"); __builtin_amdgcn_s_barrier(); asm volatile("" ::: "memory");
        const int row = wid * 32 + (lane & 31);
        if (lane < 32) { const float tsum = (P[row * 4 + 0] + P[row * 4 + 1]) + (P[row * 4 + 2] + P[row * 4 + 3]);
            __hip_atomic_store(slots + (size_t)(tile0 + row) * 4 + u.pn, __float_as_uint(tsum), __ATOMIC_RELAXED, __HIP_MEMORY_SCOPE_AGENT); }
        asm volatile("s_waitcnt vmcnt(0)" ::: "memory");
        if (lane == 0) __hip_atomic_fetch_add(cnt + 64 * u.pm, 1u, __ATOMIC_RELAXED, __HIP_MEMORY_SCOPE_AGENT);
        if (wid == 0) {
            unsigned sp = 0;
            while ((unsigned)__builtin_amdgcn_readfirstlane(__hip_atomic_load(cnt + 64 * u.pm, __ATOMIC_RELAXED, __HIP_MEMORY_SCOPE_AGENT)) < 32u) { __builtin_amdgcn_s_sleep(2); if (++sp > (1u << 20)) break; }
            __builtin_amdgcn_fence(__ATOMIC_ACQUIRE, "agent");
        }
        asm volatile("s_waitcnt vmcnt(0) lgkmcnt(0)" ::: "memory"); __builtin_amdgcn_s_barrier(); asm volatile("" ::: "memory");
        if (lane < 32) { float tot = 0.f;
#pragma unroll
            for (int t4 = 0; t4 < 4; ++t4) tot += __uint_as_float(__hip_atomic_load(slots + (size_t)(tile0 + row) * 4 + t4, __ATOMIC_RELAXED, __HIP_MEMORY_SCOPE_AGENT));
            S[row] = __builtin_amdgcn_rsqf(tot * (1.f / DM) + EPSV); }
        asm volatile("s_waitcnt lgkmcnt(0)" ::: "memory"); __builtin_amdgcn_s_barrier(); asm volatile("" ::: "memory");
        f32x4 fg[2][2];
#pragma unroll
        for (int bj = 0; bj < 2; ++bj)
#pragma unroll
            for (int n = 0; n < 2; ++n) fg[bj][n] = *(const f32x4*)(final_g + colb + bj * 128 + n * 16);
#pragma unroll
        for (int g_ = 0; g_ < 8; ++g_) {
            const float rs = S[(g_ >> 2) * 128 + wr * 64 + (g_ & 3) * 16 + fr];
            float* xq = xo + (size_t)((g_ >> 2) * 128 + (g_ & 3) * 16) * DM;
#pragma unroll
            for (int bj = 0; bj < 2; ++bj)
#pragma unroll
                for (int n = 0; n < 2; ++n) *(f32x4*)(xq + bj * 128 + n * 16) = (acc[g_ >> 2][bj][g_ & 3][n] * rs) * fg[bj][n];
        }
    }
};

struct EpiFfn13 {
    static constexpr bool PERM = false;
    static constexpr bool AFTER_DRAIN = false;
    bf16_t* ACT;
    __device__ __forceinline__ void operator()(const Acc& acc, const pg8::Unit& u, int wr, int wc, int fr, int fq) const {
#pragma unroll
        for (int ai = 0; ai < 2; ++ai)
#pragma unroll
            for (int m = 0; m < 4; ++m) {
                const int row = u.pm * 256 + ai * 128 + wr * 64 + m * 16 + fr;
                u32x4 w;
#pragma unroll
                for (int bj = 0; bj < 2; ++bj) {
                    const f32x4 a = acc[ai][bj][m][0], b = acc[ai][bj][m][1]; f32x4 o;
#pragma unroll
                    for (int j = 0; j < 4; ++j) o[j] = a[j] * sigmoidf_(a[j]) * b[j];
                    const u32x2 pk = pack4(o);
                    if (bj == 0) { w.x = pk.x; w.y = pk.y; } else { w.z = pk.x; w.w = pk.y; }
                }
                *(u32x4*)(ACT + (size_t)row * DFF + 128 * u.pn + 32 * wc + 8 * fq) = w;
            }
    }
};

struct EpiMix {
    static constexpr bool PERM = true;
    static constexpr bool AFTER_DRAIN = false;
    bf16_t* out; int pitch, col0, tok_base, tok_pn_step, col_pn_step;
    __device__ __forceinline__ void operator()(const Acc& acc, const pg8::Unit& u, int wr, int wc, int fr, int fq) const {
#pragma unroll
        for (int ai = 0; ai < 2; ++ai)
#pragma unroll
            for (int m = 0; m < 4; ++m) {
                const int row = u.pm * 256 + ai * 128 + wr * 64 + m * 16 + fr;
                bf16_t* dst = out + (size_t)(tok_base + u.pn * tok_pn_step + row) * pitch + col0 + u.pn * col_pn_step + wc * 32 + 8 * fq;
#pragma unroll
                for (int bj = 0; bj < 2; ++bj) { const u32x2 p0 = pack4(acc[ai][bj][m][0]), p1 = pack4(acc[ai][bj][m][1]); *(u32x4*)(dst + bj * 128) = (u32x4){p0.x, p0.y, p1.x, p1.y}; }
            }
    }
};

namespace att {
constexpr int VP = 144, OFF_K1 = 0, OFF_K2 = 8192, OFF_VT = 16384, BUFSZ = 16384 + 128 * VP;
struct Args { const bf16_t *Q1, *Q2, *K1c, *K2c, *VT; bf16_t* MIXA; const float* subln; float lam, omli; };

__device__ __forceinline__ void attn_unit(LAS unsigned char* lds, const Args& A, int b, int h, int qrow0, int nkt) {
    const int tid = fresh_tid(), lane = tid & 63, r32 = lane & 31, hi = lane >> 5;
    const int wid = __builtin_amdgcn_readfirstlane(tid >> 6), map = wid >> 2, qg = wid & 3;
    const bf16_t* Qm = map ? A.Q2 : A.Q1;
    bf16x8 qf[4];
    { const bf16_t* qp = Qm + (size_t)(qrow0 + qg * 32 + r32) * 256 + h * 64 + hi * 8;
#pragma unroll
      for (int d0 = 0; d0 < 4; ++d0) qf[d0] = *(const bf16x8*)(qp + d0 * 16); }
    const int key_s = tid >> 3, ch_s = tid & 7;
    const bf16_t* k1src = A.K1c + ((size_t)b * KCAT + key_s) * 256 + h * 64 + ch_s * 8;
    const bf16_t* k2src = A.K2c + ((size_t)b * KCAT + key_s) * 256 + h * 64 + ch_s * 8;
    const bf16_t* vsrc = A.VT + ((size_t)(b * 4 + h) * 128 + key_s) * KCAT + ch_s * 8;
    const int kdst = key_s * 128 + ((ch_s ^ ((key_s >> 1) & 7)) << 4), vdst = key_s * VP + 32 * (ch_s >> 1) + 8 * (ch_s & 1);
    u32x4 rk1[2], rk2[2], rv0[2], rv1[2];
#define ATT_LOAD(set, t) do { rk1[set] = *(const u32x4*)(k1src + (size_t)(t) * 64 * 256); rk2[set] = *(const u32x4*)(k2src + (size_t)(t) * 64 * 256); \
        rv0[set] = *(const u32x4*)(vsrc + (t) * 64); rv1[set] = *(const u32x4*)(vsrc + (size_t)64 * KCAT + (t) * 64); } while (0)
#define ATT_STORE(set, buf) do { LAS unsigned char* bb_ = lds + (buf) * BUFSZ; *(LAS u32x4*)(bb_ + OFF_K1 + kdst) = rk1[set]; *(LAS u32x4*)(bb_ + OFF_K2 + kdst) = rk2[set]; \
        *(LAS u32x2*)(bb_ + OFF_VT + vdst) = (u32x2){rv0[set].x, rv0[set].y}; *(LAS u32x2*)(bb_ + OFF_VT + vdst + 16) = (u32x2){rv0[set].z, rv0[set].w}; \
        *(LAS u32x2*)(bb_ + OFF_VT + 64 * VP + vdst) = (u32x2){rv1[set].x, rv1[set].y}; *(LAS u32x2*)(bb_ + OFF_VT + 64 * VP + vdst + 16) = (u32x2){rv1[set].z, rv1[set].w}; } while (0)
    constexpr float THR = 6.f;
    float mrun = 0.f, lrun = 0.f;
    f32x16 O[4];
#pragma unroll
    for (int i = 0; i < 4; ++i)
#pragma unroll
        for (int r = 0; r < 16; ++r) O[i][r] = 0.f;
    ATT_LOAD(0, 0); ATT_STORE(0, 0); __syncthreads();
    ATT_LOAD(1, 1);
    for (int t0 = 0; t0 < nkt; t0 += 2) {
#pragma unroll
      for (int tt = 0; tt < 2; ++tt) {
        const int t = t0 + tt, cur = tt;
        if (t + 2 < nkt) ATT_LOAD(tt, t + 2);
        LAS unsigned char* base = lds + cur * BUFSZ;
        LAS unsigned char* kb = base + (map ? OFF_K2 : OFF_K1) + r32 * 128;
        f32x16 s0, s1;
#pragma unroll
        for (int r = 0; r < 16; ++r) { s0[r] = -mrun; s1[r] = -mrun; }
#pragma unroll
        for (int d0 = 0; d0 < 4; ++d0) {
            const int chunk = ((2 * d0 + hi) ^ ((r32 >> 1) & 7)) << 4;
            const bf16x8 a0 = *(const LAS bf16x8*)(kb + chunk), a1 = *(const LAS bf16x8*)(kb + 32 * 128 + chunk);
            s0 = __builtin_amdgcn_mfma_f32_32x32x16_bf16(a0, qf[d0], s0, 0, 0, 0);
            s1 = __builtin_amdgcn_mfma_f32_32x32x16_bf16(a1, qf[d0], s1, 0, 0, 0);
        }
        asm volatile("s_nop 15\n\ts_nop 4" : "+v"(s0), "+v"(s1));
        LAS unsigned char* vb = base + OFF_VT + r32 * VP + 16 * hi;
        u32x4 vf[2][4];
#define ATT_LDV(slot, c) do { _Pragma("unroll") for (int dblk = 0; dblk < 4; ++dblk) { \
            vf[slot][dblk] = *(const LAS u32x4*)(vb + dblk * 32 * VP + 32 * (c)); } } while (0)
        ATT_LDV(0, 0);
        __builtin_amdgcn_sched_barrier(0);
        float rm = max3f(s0[0], s0[1], s1[0]), rm2 = max3f(s0[2], s0[3], s1[1]);
        rm = max3f(rm, s1[2], s1[3]);
#pragma unroll
        for (int r = 4; r < 16; r += 4) { rm = max3f(rm, s0[r], s0[r + 1]); rm2 = max3f(rm2, s0[r + 2], s0[r + 3]); rm = max3f(rm, s1[r], s1[r + 1]); rm2 = max3f(rm2, s1[r + 2], s1[r + 3]); }
        rm = fmaxf(rm, rm2);
        rm = fmaxf(rm, __shfl_xor(rm, 32));
        const bool need = (t == 0) || (rm > THR);
        if (__any(need)) {
            const float dlt = need ? rm : 0.f, alpha = (t == 0) ? 1.f : __builtin_amdgcn_exp2f(-dlt);
            mrun += dlt; lrun *= alpha;
            s0 = s0 - dlt; s1 = s1 - dlt;
#pragma unroll
            for (int i = 0; i < 4; ++i)
#pragma unroll
                for (int r = 0; r < 16; ++r) O[i][r] *= alpha;
        }
#pragma unroll
        for (int r = 0; r < 16; ++r) { s0[r] = __builtin_amdgcn_exp2f(s0[r]); s1[r] = __builtin_amdgcn_exp2f(s1[r]); }
        { const f32x16 t16 = s0 + s1;
          typedef float f32x8 __attribute__((ext_vector_type(8)));
          const f32x8 t8 = t16.lo + t16.hi; const f32x4 t4 = t8.lo + t8.hi;
          lrun += (t4[0] + t4[1]) + (t4[2] + t4[3]); }
        bf16x8 P[4];
        { u32x4 w;
          w.x = cvt_pk_bf16(s0[0], s0[1]); w.y = cvt_pk_bf16(s0[2], s0[3]); w.z = cvt_pk_bf16(s0[4], s0[5]); w.w = cvt_pk_bf16(s0[6], s0[7]); P[0] = __builtin_bit_cast(bf16x8, w);
          w.x = cvt_pk_bf16(s0[8], s0[9]); w.y = cvt_pk_bf16(s0[10], s0[11]); w.z = cvt_pk_bf16(s0[12], s0[13]); w.w = cvt_pk_bf16(s0[14], s0[15]); P[1] = __builtin_bit_cast(bf16x8, w);
          w.x = cvt_pk_bf16(s1[0], s1[1]); w.y = cvt_pk_bf16(s1[2], s1[3]); w.z = cvt_pk_bf16(s1[4], s1[5]); w.w = cvt_pk_bf16(s1[6], s1[7]); P[2] = __builtin_bit_cast(bf16x8, w);
          w.x = cvt_pk_bf16(s1[8], s1[9]); w.y = cvt_pk_bf16(s1[10], s1[11]); w.z = cvt_pk_bf16(s1[12], s1[13]); w.w = cvt_pk_bf16(s1[14], s1[15]); P[3] = __builtin_bit_cast(bf16x8, w); }
        __builtin_amdgcn_sched_barrier(0);
        ATT_LDV(1, 1);
        __builtin_amdgcn_sched_barrier(0);
#pragma unroll
        for (int dblk = 0; dblk < 4; ++dblk) O[dblk] = __builtin_amdgcn_mfma_f32_32x32x16_bf16(__builtin_bit_cast(bf16x8, vf[0][dblk]), P[0], O[dblk], 0, 0, 0);
        __builtin_amdgcn_sched_barrier(0);
        ATT_LDV(0, 2);
        __builtin_amdgcn_sched_barrier(0);
#pragma unroll
        for (int dblk = 0; dblk < 4; ++dblk) O[dblk] = __builtin_amdgcn_mfma_f32_32x32x16_bf16(__builtin_bit_cast(bf16x8, vf[1][dblk]), P[1], O[dblk], 0, 0, 0);
        __builtin_amdgcn_sched_barrier(0);
        ATT_LDV(1, 3);
        __builtin_amdgcn_sched_barrier(0);
#pragma unroll
        for (int dblk = 0; dblk < 4; ++dblk) O[dblk] = __builtin_amdgcn_mfma_f32_32x32x16_bf16(__builtin_bit_cast(bf16x8, vf[0][dblk]), P[2], O[dblk], 0, 0, 0);
        __builtin_amdgcn_sched_barrier(0);
#pragma unroll
        for (int dblk = 0; dblk < 4; ++dblk) O[dblk] = __builtin_amdgcn_mfma_f32_32x32x16_bf16(__builtin_bit_cast(bf16x8, vf[1][dblk]), P[3], O[dblk], 0, 0, 0);
#undef ATT_LDV
        if (t + 1 < nkt) ATT_STORE(tt ^ 1, tt ^ 1);
        asm volatile("s_waitcnt lgkmcnt(0)" ::: "memory"); __builtin_amdgcn_s_barrier(); asm volatile("" ::: "memory");
      }
    }
#undef ATT_LOAD
#undef ATT_STORE
    lrun += __shfl_xor(lrun, 32);
    const float inv = 1.f / lrun;
    LAS float* ex = (LAS float*)lds + qg * 4096;
    if (map == 1) {
#pragma unroll
        for (int i = 0; i < 4; ++i)
#pragma unroll
            for (int r = 0; r < 16; ++r) ex[(i * 16 + r) * 64 + lane] = O[i][r] * inv;
    }
    __syncthreads();
    if (map == 0) {
        float ss = 0.f;
#pragma unroll
        for (int i = 0; i < 4; ++i)
#pragma unroll
            for (int r = 0; r < 16; ++r) { const float o = O[i][r] * inv - A.lam * ex[(i * 16 + r) * 64 + lane]; O[i][r] = o; ss += o * o; }
        ss += __shfl_xor(ss, 32);
        const float rstd = __builtin_amdgcn_rsqf(ss * (1.f / 128.f) + EPSV) * A.omli;
        bf16_t* dst = A.MIXA + (size_t)(qrow0 + qg * 32 + r32) * DM + h * 128 + 4 * hi;
#pragma unroll
        for (int i = 0; i < 4; ++i)
#pragma unroll
            for (int rq = 0; rq < 4; ++rq) {
                const int d0 = 32 * i + 8 * rq;
                const f32x4 gg = *(const f32x4*)(A.subln + d0 + 4 * hi);
                f32x4 v = {O[i][4 * rq] * rstd * gg[0], O[i][4 * rq + 1] * rstd * gg[1], O[i][4 * rq + 2] * rstd * gg[2], O[i][4 * rq + 3] * rstd * gg[3]};
                *(u32x2*)(dst + d0) = pack4(v);
            }
    }
    __syncthreads();
}
}

__device__ __forceinline__ void conv_item(const Params& p, LAS unsigned char* lds, int l, int item, const bf16_t* UC, bf16_t* MIXA) {
    const int tid = fresh_tid(), lane = tid & 63, wid = tid >> 6, g = wid & 3, th = wid >> 2;
    const int ch = g * 64 + lane;
    int rowbase, t0, L;
    if (item < 256) { rowbase = (item >> 5) * SEQ; t0 = (item & 31) * 64; L = SEQ; }
    else { const int j = item - 256; rowbase = NLAT + (j >> 2) * CTXL; t0 = (j & 3) * 64; L = CTXL; }
    LAS float* zl = (LAS float*)lds;
    {
        u32x4 av[6], gv[6];
#pragma unroll
        for (int it = 0; it < 6; ++it) {
            int idx = tid + it * 512; idx = idx < 94 * 32 ? idx : 94 * 32 - 1;
            const int pr = idx >> 5, c8 = idx & 31; int pp = t0 - 15 + pr; pp = pp < 0 ? 0 : (pp >= L ? L - 1 : pp);
            const bf16_t* up = UC + (size_t)(rowbase + pp) * 512 + c8 * 8;
            av[it] = *(const u32x4*)up; gv[it] = *(const u32x4*)(up + 256);
        }
#pragma unroll
        for (int it = 0; it < 6; ++it) {
            const int idx = tid + it * 512;
            const int pr = idx >> 5, c8 = idx & 31, pp = t0 - 15 + pr;
            const float msk = (pp >= 0 && pp < L) ? 1.f : 0.f;
            f32x4 z0, z1;
#pragma unroll
            for (int q = 0; q < 4; ++q) {
                const float a_lo = __uint_as_float(av[it][q] << 16), a_hi = __uint_as_float(av[it][q] & 0xffff0000u);
                const float g_lo = __uint_as_float(gv[it][q] << 16), g_hi = __uint_as_float(gv[it][q] & 0xffff0000u);
                const float zlo = a_lo * sigmoidf_(g_lo) * msk, zhi = a_hi * sigmoidf_(g_hi) * msk;
                if (q < 2) { z0[2 * q] = zlo; z0[2 * q + 1] = zhi; } else { z1[2 * (q - 2)] = zlo; z1[2 * (q - 2) + 1] = zhi; }
            }
            if (idx < 94 * 32) { *(LAS f32x4*)(zl + pr * 256 + c8 * 8) = z0; *(LAS f32x4*)(zl + pr * 256 + c8 * 8 + 4) = z1; }
        }
    }
    __syncthreads();
    const int ts = t0 + th * 32;
    float w[31];
#pragma unroll
    for (int k = 0; k < 31; ++k) w[k] = p.conv_w[(size_t)l * 31 * 256 + k * 256 + ch];
    float o[32];
    const float bias = p.conv_b[l * 256 + ch];
    const LAS float* zp = zl + (th * 32) * 256 + ch;
    float z[62];
#pragma unroll
    for (int jj = 0; jj < 62; ++jj) z[jj] = zp[jj * 256];
#pragma unroll
    for (int i = 0; i < 32; ++i) {
        float acc = bias;
#pragma unroll
        for (int k = 0; k < 31; ++k) acc += w[k] * z[i + k];
        o[i] = acc;
    }
    const float lg = p.conv_ln_g[l * 256 + ch], lb = p.conv_ln_b[l * 256 + ch];
#pragma unroll
    for (int i = 0; i < 32; ++i) {
        const float mu = wave_sum(o[i]) * (1.f / 64.f);
        const float d = o[i] - mu;
        const float var = wave_sum(d * d) * (1.f / 64.f);
        const float zn = d * __builtin_amdgcn_rsqf(var + EPSV) * lg + lb;
        MIXA[(size_t)(rowbase + ts + i) * DM + 768 + ch] = f2bf(zn * sigmoidf_(zn));
    }
    __syncthreads();
}

__device__ __forceinline__ int drow_map(int mode, int n) {
    if (mode == 0) return n;
    if (mode == 1) {
        if (n < 1024) { const int cs = n & 255, head = cs >> 6, d = cs & 63, a = d >> 5, pp = (d >> 4) & 1, f = d & 15;
            return (n & ~255) + 128 * ((f >> 2) & 1) + 32 * head + 16 * pp + 4 * (2 * a + (f >> 3)) + (f & 3); }
        if (n < 1792) return n;
        { const int mm = n - 1792, cs = mm & 255;
          return 2048 + (mm & ~255) + 128 * ((cs >> 2) & 1) + 32 * ((cs >> 5) & 3) + 16 * (cs >> 7) + 4 * ((cs >> 3) & 3) + (cs & 3); }
    }
    const int r = 256 * (n >> 7) + 128 * ((n >> 2) & 1) + 32 * ((n >> 5) & 3) + 4 * ((n >> 3) & 3) + (n & 3);
    return mode == 2 ? r : r + 16;
}
__device__ __forceinline__ void transpose_item(const float* W, int ldw, int K, bf16_t* WT, int mode, LAS float* scr, int kb, int nb, int lane) {
    const int k0 = 64 * kb, n0 = 32 * nb;
#pragma unroll 8
    for (int i = 0; i < 32; ++i) { const int kk = 2 * i + (lane >> 5); scr[kk * 33 + (lane & 31)] = W[(size_t)(k0 + kk) * ldw + n0 + (lane & 31)]; }
    asm volatile("s_waitcnt lgkmcnt(0)" ::: "memory");
    const int c = lane & 7;
#pragma unroll
    for (int j = 0; j < 4; ++j) { const int n = (lane >> 3) + 8 * j; const LAS float* s = scr + (8 * c) * 33 + n;
        u32x4 o; o.x = cvt_pk_bf16(s[0 * 33], s[1 * 33]); o.y = cvt_pk_bf16(s[2 * 33], s[3 * 33]); o.z = cvt_pk_bf16(s[4 * 33], s[5 * 33]); o.w = cvt_pk_bf16(s[6 * 33], s[7 * 33]);
        *(u32x4*)(WT + (size_t)drow_map(mode, n0 + n) * K + k0 + 8 * c) = o; }
    asm volatile("s_waitcnt lgkmcnt(0)" ::: "memory");
}

__device__ __forceinline__ void prep_phase(const Params& p, LAS unsigned char* lds) {
    const int tid = fresh_tid(), lane = tid & 63, wave = tid >> 6, G = gridDim.x;
    const int gw = blockIdx.x * 8 + wave, NGW = G * 8;
    const int gt = blockIdx.x * 512 + tid, NGT = G * 512;
    unsigned char* ws = p.ws;
    LAS float* tab = (LAS float*)(lds + 73728);
    LAS float* t64c = tab + 2048; LAS float* t64s = t64c + 64;
    for (int m = tid; m < 2048; m += 512) tab[m] = cospif((float)m * (1.f / 1024.f));
    if (tid < 64) { t64c[tid] = cospif((float)tid * (1.f / 32.f)); t64s[tid] = sinpif((float)tid * (1.f / 32.f)); }
    __syncthreads();
    if (gt < 1024) { const int pos = gt >> 4, f = gt & 15; const float inv = powf(10000.f, -(float)f / 16.f); const float ang = (float)pos * inv;
        float* rope = (float*)(ws + WS_ROPE); rope[gt] = cosf(ang); rope[1024 + gt] = sinf(ang); }
    {
        LAS float* scr = (LAS float*)(lds + wave * 8448);
        constexpr int I_IN = 16 * 72, I_OUT = 16 * 32, I_F1 = 16 * 88, I_F2 = 44 * 32, I_L = I_IN + I_OUT + 2 * I_F1 + I_F2;
        for (int it = gw; it < 2 * I_L; it += NGW) {
            const int l = it / I_L; int r = it % I_L;
            if (r < I_IN) { const int kb = r / 72, nb = r % 72; if (nb >= 48 && nb < 56) continue;
                transpose_item(p.w_in + (size_t)l * DM * INW_SRC, INW_SRC, DM, (bf16_t*)(ws + WS_WIN) + (size_t)l * INW * DM, 1, scr, kb, nb, lane); continue; }
            r -= I_IN;
            if (r < I_OUT) { transpose_item(p.w_out + (size_t)l * DM * DM, DM, DM, (bf16_t*)(ws + WS_WOUT) + (size_t)l * DM * DM, 0, scr, r / 32, r % 32, lane); continue; }
            r -= I_OUT;
            if (r < I_F1) { transpose_item(p.w_ffn1 + (size_t)l * DM * DFF, DFF, DM, (bf16_t*)(ws + WS_W13) + (size_t)l * N13 * DM, 2, scr, r / 88, r % 88, lane); continue; }
            r -= I_F1;
            if (r < I_F1) { transpose_item(p.w_ffn3 + (size_t)l * DM * DFF, DFF, DM, (bf16_t*)(ws + WS_W13) + (size_t)l * N13 * DM, 3, scr, r / 88, r % 88, lane); continue; }
            r -= I_F1;
            transpose_item(p.w_ffn2 + (size_t)l * DFF * DM, DM, DFF, (bf16_t*)(ws + WS_W2) + (size_t)l * DM * DFF, 0, scr, r / 32, r % 32, lane);
        }
    }
    {
        const float tcl = cospif((float)lane * (1.f / 32.f)), tsl = sinpif((float)lane * (1.f / 32.f));
        for (int it = gw; it < 2 * 4 * 16 * 16; it += NGW) {
            const int l = it >> 10, g = (it >> 8) & 3, kbk = (it >> 4) & 15, lqg = it & 15;
            const int k = kbk * 64 + lane;
            const float* wr_ = p.w_in + (size_t)l * DM * INW_SRC + (size_t)k * INW_SRC + 1536 + g * 64;
            float wv[64];
#pragma unroll
            for (int c4 = 0; c4 < 16; ++c4) { const f32x4 v = *(const f32x4*)(wr_ + 4 * c4); wv[4 * c4] = v[0]; wv[4 * c4 + 1] = v[1]; wv[4 * c4 + 2] = v[2]; wv[4 * c4 + 3] = v[3]; }
            bf16_t* wt = (bf16_t*)(ws + WS_WIN) + (size_t)l * INW * DM;
#pragma unroll 1
            for (int li = 0; li < 4; ++li) {
                const int lq = __builtin_amdgcn_readfirstlane(lqg * 4 + li);
                float ac = 0.f, as = 0.f;
#pragma unroll
                for (int c = 0; c < 64; ++c) {
                    const int m = (lq * c) & 63;
                    const float ct = __int_as_float(__builtin_amdgcn_readlane(__float_as_int(tcl), m)), st = __int_as_float(__builtin_amdgcn_readlane(__float_as_int(tsl), m));
                    ac += wv[c] * ct; as += wv[c] * st;
                }
                wt[(size_t)(1536 + g * 64 + lq) * DM + k] = f2bf(ac);
                wt[(size_t)(1536 + 256 + g * 64 + lq) * DM + k] = f2bf(as);
            }
        }
    }
    for (int e = gt; e < 2 * WSM_L; e += NGT) {
        const int l = e / WSM_L, r = e % WSM_L; float v;
        if (r < 256 * 512) { const int n = r >> 9, k = r & 255; const int g = n >> 6, d = n & 63, g2 = k >> 6, c = k & 63; v = (g == g2) ? p.w_fourier[(((size_t)l * 4 + g) * 64 + c) * 64 + d] : 0.f; }
        else { const int r2 = r - 256 * 512, n = r2 >> 8, k = r2 & 255; v = p.w_conv_out[((size_t)l * 256 + k) * 256 + n]; }
        ((bf16_t*)(ws + WS_WSM))[e] = f2bf(v);
    }
    {
        const float nl = 1.f / sqrtf(2048.f * 64.f), nc = 1.f / 128.f;
        for (int e = gt; e < 2048 * 4096 / 8; e += NGT) {
            const int k = e >> 9, col0 = (e & 511) * 8, s = col0 >> 11; float v[8];
#pragma unroll
            for (int j = 0; j < 8; ++j) { const int n = (col0 + j) & 2047, m = (k * n) & 2047; v[j] = s ? -tab[(m - 512) & 2047] * nl : tab[m] * nl; }
            u32x4 o; o.x = cvt_pk_bf16(v[0], v[1]); o.y = cvt_pk_bf16(v[2], v[3]); o.z = cvt_pk_bf16(v[4], v[5]); o.w = cvt_pk_bf16(v[6], v[7]);
            *(u32x4*)((bf16_t*)(ws + WS_DFTL) + (size_t)e * 8) = o;
        }
        for (int e = gt; e < 256 * 512 / 8; e += NGT) {
            const int k = e >> 6, col0 = (e & 63) * 8, s = col0 >> 8; float v[8];
#pragma unroll
            for (int j = 0; j < 8; ++j) { const int n = (col0 + j) & 255, m = ((k * n) & 255) * 8; v[j] = s ? -tab[(m - 512) & 2047] * nc : tab[m] * nc; }
            u32x4 o; o.x = cvt_pk_bf16(v[0], v[1]); o.y = cvt_pk_bf16(v[2], v[3]); o.z = cvt_pk_bf16(v[4], v[5]); o.w = cvt_pk_bf16(v[6], v[7]);
            *(u32x4*)((bf16_t*)(ws + WS_DFTC) + (size_t)e * 8) = o;
        }
    }
    for (int it = gw; it < 2 * 96 * 8; it += NGW) {
        const int l = it / 768, r = it % 768, cgp = r >> 3, kc = r & 7;
        const int col = cgp * 64 + lane, k0 = kc * 128;
        float sv[9][2];
#pragma unroll
        for (int b = 0; b < 9; ++b)
#pragma unroll
            for (int hh = 0; hh < 2; ++hh) { const int k = k0 + hh * 64 + lane; const float cv = (b < 8) ? p.c[b * DM + k] : p.c_ctx[k]; sv[b][hh] = cv * sigmoidf_(cv); }
        float ac[9];
#pragma unroll
        for (int b = 0; b < 9; ++b) ac[b] = 0.f;
        const float* wp = p.w_ada + ((size_t)l * DM + k0) * 6144 + col;
#pragma unroll
        for (int hh = 0; hh < 2; ++hh) {
#pragma unroll 8
            for (int kk = 0; kk < 64; ++kk) {
                const float wv = wp[(size_t)(hh * 64 + kk) * 6144];
#pragma unroll
                for (int b = 0; b < 9; ++b) ac[b] += __int_as_float(__builtin_amdgcn_readlane(__float_as_int(sv[b][hh]), kk)) * wv;
            }
        }
        const float bias = (kc == 0) ? p.b_ada[l * 6144 + col] : 0.f;
        float* mod = (float*)(ws + WS_MOD) + (size_t)l * 9 * 6144;
#pragma unroll
        for (int b = 0; b < 9; ++b) atomicAdd(mod + b * 6144 + col, ac[b] + bias);
    }
}

__device__ __forceinline__ void norm_phase(const float* xlat, const float* xctx, const float* gvec, const float* mod, int sh_off, int sc_off, bf16_t* H, int nrows,
                                           const float* part, const float* pgate, float* xctx_out) {
    const int tid = fresh_tid(), lane = tid & 63, gw = blockIdx.x * 8 + (tid >> 6), NGW = gridDim.x * 8;
    f32x4 vn[4];
#define NORM_LOADX(dst, r_) do { const int r__ = (r_); const float* xr_ = r__ < NLAT ? xlat + (size_t)r__ * DM : xctx + (size_t)(r__ - NLAT) * DM; \
        _Pragma("unroll") for (int j = 0; j < 4; ++j) dst[j] = *(const f32x4*)(xr_ + 4 * lane + 256 * j); } while (0)
    if (gw < nrows) NORM_LOADX(vn, gw);
    for (int row = gw; row < nrows; row += NGW) {
        const int bb = row < NLAT ? row >> 11 : 8;
        f32x4 v[4]; float ss = 0.f;
#pragma unroll
        for (int j = 0; j < 4; ++j) v[j] = vn[j];
        if (row + NGW < nrows) NORM_LOADX(vn, row + NGW);
        const float* mp = mod + bb * 6144;
        f32x4 gg[4], sc[4], sh[4];
#pragma unroll
        for (int j = 0; j < 4; ++j) { const int col = 4 * lane + 256 * j; gg[j] = *(const f32x4*)(gvec + col); sc[j] = *(const f32x4*)(mp + sc_off + col); sh[j] = *(const f32x4*)(mp + sh_off + col); }
        if (part != nullptr && row >= NLAT) {
#pragma unroll
            for (int j = 0; j < 4; ++j) {
                const size_t o = (size_t)(row - NLAT) * DM + 4 * lane + 256 * j;
                const f32x4 ps = (*(const f32x4*)(part + o) + *(const f32x4*)(part + (size_t)NCTX * DM + o)) + (*(const f32x4*)(part + (size_t)2 * NCTX * DM + o) + *(const f32x4*)(part + (size_t)3 * NCTX * DM + o));
                v[j] = v[j] + *(const f32x4*)(pgate + 4 * lane + 256 * j) * ps;
                *(f32x4*)(xctx_out + o) = v[j];
            }
        }
#pragma unroll
        for (int j = 0; j < 4; ++j) ss += (v[j][0] * v[j][0] + v[j][1] * v[j][1]) + (v[j][2] * v[j][2] + v[j][3] * v[j][3]);
        const float rstd = __builtin_amdgcn_rsqf(wave_sum(ss) * (1.f / DM) + EPSV);
#pragma unroll
        for (int j = 0; j < 4; ++j) {
            const int col = 4 * lane + 256 * j;
            const f32x4 y = (v[j] * rstd) * gg[j];
            const f32x4 hv = y * (sc[j] + 1.f) + sh[j];
            *(u32x2*)(H + (size_t)row * DM + col) = pack4(hv);
        }
    }
#undef NORM_LOADX
}

__global__ void __launch_bounds__(512, 2) fwd_kernel(Params p) {
    extern __shared__ __attribute__((aligned(16))) unsigned char lds_raw[];
    LAS unsigned char* lds = (LAS unsigned char*)lds_raw;
    cg::grid_group grid = cg::this_grid();
    const int G = gridDim.x, cu = blockIdx.x;
    unsigned char* ws = p.ws;
    bf16_t* H = (bf16_t*)(ws + WS_H);
    bf16_t* Q1 = (bf16_t*)(ws + WS_Q1); bf16_t* Q2 = (bf16_t*)(ws + WS_Q2); bf16_t* K1c = (bf16_t*)(ws + WS_K1); bf16_t* K2c = (bf16_t*)(ws + WS_K2);
    bf16_t* VT = (bf16_t*)(ws + WS_VT); bf16_t* TTl = (bf16_t*)(ws + WS_TTL); bf16_t* TTc = (bf16_t*)(ws + WS_TTC); bf16_t* UC = (bf16_t*)(ws + WS_UC);
    bf16_t* MIXA = (bf16_t*)(ws + WS_MIX); bf16_t* ACT = (bf16_t*)(ws + WS_ACT);
    float* PB1 = (float*)(ws + WS_R); float* PB2 = (float*)(ws + WS_R + 99 * MiB);
    bf16_t* FP = (bf16_t*)(ws + WS_H);
    float* XL = p.out; float* XC = (float*)(ws + WS_XCTX);
    const float* rope = (const float*)(ws + WS_ROPE);

    volatile LAS unsigned* bst = (volatile LAS unsigned*)(lds + LDS_BYTES - 64);
    if (threadIdx.x < 2) bst[threadIdx.x] = 0u;
    __syncthreads();
    const XcdBarrier xbar = xcd_barrier_post((unsigned*)(ws + WS_BAR), bst);
#define GSYNC() xcd_barrier(xbar)

    prep_phase(p, lds);
    grid.sync();

#pragma unroll 1
    for (int l = 0; l < 2; ++l) {
        const float* mod = (const float*)(ws + WS_MOD) + (size_t)l * 9 * 6144;
        const float* xin_l = l == 0 ? p.x : XL; const float* xin_c = l == 0 ? p.ctx : XC;
        const int mrows = l == 0 ? MTOT : NLAT;
        if (PROBE == 3) { for (int rep = 0; rep < 8; ++rep) GSYNC(); }
        norm_phase(xin_l, xin_c, p.norm1_g + l * DM, mod, 0, 1024, H, MTOT, l == 1 ? PB2 : nullptr, (const float*)(ws + WS_MOD) + 8 * 6144 + 5120, XC);
        GSYNC();
        for (int rep = 0; rep < (PROBE == 4 ? 2 : 1); ++rep) {
            if (rep) GSYNC();
            pg8::Gemm g{H, (const bf16_t*)(ws + WS_WIN) + (size_t)l * INW * DM, MTOT, INW, DM, DM, DM, 0};
            pg8::StaticOrder S; S.init(MTOT, INW, G, cu);
            EpiInProj E{Q1, Q2, K1c, K2c, VT, TTl, TTc, UC, rope};
            pg8::gemm_phase<EpiInProj, pg8::StaticOrder, true>(lds, g, S, E);
        }
        GSYNC();
        for (int rep = 0; rep < (PROBE == 1 ? 2 : 1); ++rep) {
            if (rep) GSYNC();
            const float li = 0.8f - 0.6f * __expf(-0.3f * (float)l);
            float lam;
            { const int lane = fresh_tid() & 63;
              const float s1 = wave_sum(p.lam_q1[l * 64 + lane] * p.lam_k1[l * 64 + lane]), s2 = wave_sum(p.lam_q2[l * 64 + lane] * p.lam_k2[l * 64 + lane]);
              lam = expf(s1) - expf(s2) + li; }
            att::Args A{Q1, Q2, K1c, K2c, VT, MIXA, p.subln_g + l * 128, lam, 1.f - li};
            const int n_att = 512 + (l == 0 ? 64 : 0);
            for (int u = cu; u < n_att; u += G) {
                if (u < 512) att::attn_unit(lds, A, u >> 6, (u >> 4) & 3, (u >> 6) * SEQ + (u & 15) * 128, 36);
                else { const int v = u - 512; att::attn_unit(lds, A, v >> 3, (v >> 1) & 3, NLAT + (v >> 3) * CTXL + (v & 1) * 128, 4); }
            }
#pragma unroll 1
            for (int hf = 0; hf < 2; ++hf) {
                pg8::Gemm g{(const bf16_t*)(ws + WS_DFTL) + hf * 2048, TTl + hf * 2048, 2048, 2048, 2048, 4096, 4096, 0};
                pg8::OffsetOrder S; S.init(2048, 2048, G, cu, 64 + 64 * hf);
                EpiMix E{FP, 512, hf * 256, 0, SEQ, 0};
                pg8::gemm_phase<EpiMix, pg8::OffsetOrder, true>(lds, g, S, E);
            }
            if (l == 0) {
#pragma unroll 1
                for (int hf = 0; hf < 2; ++hf) {
                    pg8::Gemm g{(const bf16_t*)(ws + WS_DFTC) + hf * 256, TTc + hf * 256, 256, 2048, 256, 512, 512, 0};
                    pg8::OffsetOrder S; S.init(256, 2048, G, cu, 192 + 8 * hf);
                    EpiMix E{FP, 512, hf * 256, NLAT, CTXL, 0};
                    pg8::gemm_phase<EpiMix, pg8::OffsetOrder, true>(lds, g, S, E);
                }
            }
            const int n_conv = l == 0 ? 288 : 256;
            if (G == 256) {
                const int sidx = cu < 64 ? cu : (cu >= 192 ? cu - 128 : -1);
                if (sidx >= 0) for (int it = sidx; it < n_conv; it += 128) conv_item(p, lds, l, it, UC, MIXA);
            } else for (int it = cu; it < n_conv; it += G) conv_item(p, lds, l, it, UC, MIXA);
        }
        GSYNC();
        {
            const bf16_t* wsm = (const bf16_t*)(ws + WS_WSM) + (size_t)l * WSM_L;
            {
                pg8::Gemm g{FP, wsm, mrows, 256, 512, 512, 512, 0};
                pg8::OffsetOrder S; S.init(mrows, 256, G, cu, 0);
                EpiMix E{MIXA, DM, 512, 0, 0, 0};
                pg8::gemm_phase<EpiMix, pg8::OffsetOrder, true>(lds, g, S, E);
            }
            {
                pg8::Gemm g{MIXA + 768, wsm + 256 * 512, mrows, 256, 256, DM, 256, 0};
                pg8::OffsetOrder S; S.init(mrows, 256, G, cu, 72);
                EpiMix E{MIXA, DM, 768, 0, 0, 0};
                pg8::gemm_phase<EpiMix, pg8::OffsetOrder, true>(lds, g, S, E);
            }
        }
        GSYNC();
        {
            pg8::Gemm g{MIXA, (const bf16_t*)(ws + WS_WOUT) + (size_t)l * DM * DM, mrows, DM, DM, DM, DM, 0};
            EpiRes E{xin_l, xin_c, XL, XC, mod, 2048, PB1};
            if (l == 0) { pg8::CtxSplitOrder S; S.init(DM, DM, G, cu); pg8::gemm_phase<EpiRes, pg8::CtxSplitOrder, true>(lds, g, S, E); }
            else { pg8::StaticOrder S; S.init(mrows, DM, G, cu); pg8::gemm_phase<EpiRes, pg8::StaticOrder, true>(lds, g, S, E); }
        }
        GSYNC();
        norm_phase(XL, l == 0 ? p.ctx : XC, p.norm2_g + l * DM, mod, 3072, 4096, H, mrows, l == 0 ? PB1 : nullptr, mod + 8 * 6144 + 2048, XC);
        GSYNC();
        for (int rep = 0; rep < (PROBE == 2 ? 2 : 1); ++rep) {
            if (rep) GSYNC();
            pg8::Gemm g{H, (const bf16_t*)(ws + WS_W13) + (size_t)l * N13 * DM, mrows, N13, DM, DM, DM, 0};
            pg8::StaticOrder S; S.init(mrows, N13, G, cu);
            EpiFfn13 E{ACT};
            pg8::gemm_phase<EpiFfn13, pg8::StaticOrder, true>(lds, g, S, E);
        }
        GSYNC();
        {
            pg8::Gemm g{ACT, (const bf16_t*)(ws + WS_W2) + (size_t)l * DM * DFF, mrows, DM, DFF, DFF, DFF, 0};
            EpiRes E{XL, XC, XL, XC, mod, 5120, PB2};
            if (l == 0) { pg8::CtxSplitOrder S; S.init(DM, DFF, G, cu); pg8::gemm_phase<EpiRes, pg8::CtxSplitOrder, true>(lds, g, S, E); }
            else if (G == 256) {
                pg8::StaticOrder S; S.init(mrows, DM, G, cu);
                EpiFinal EF{XL, XL, mod, 5120, p.final_g, (unsigned*)(ws + WS_H), (unsigned*)(ws + WS_PCNT)};
                pg8::gemm_phase<EpiFinal, pg8::StaticOrder, true>(lds, g, S, EF);
            }
            else { pg8::StaticOrder S; S.init(mrows, DM, G, cu); pg8::gemm_phase<EpiRes, pg8::StaticOrder, true>(lds, g, S, E); }
        }
        if (!(l == 1 && G == 256)) GSYNC();
    }
    if (G != 256) {
        const int tid = fresh_tid(), lane = tid & 63, gw = blockIdx.x * 8 + (tid >> 6), NGW = gridDim.x * 8;
        f32x4 gg[4], vn[4];
#pragma unroll
        for (int j = 0; j < 4; ++j) { gg[j] = *(const f32x4*)(p.final_g + 4 * lane + 256 * j); vn[j] = *(const f32x4*)(XL + (size_t)gw * DM + 4 * lane + 256 * j); }
        for (int row = gw; row < NLAT; row += NGW) {
            float* xr = XL + (size_t)row * DM;
            f32x4 v[4]; float ss = 0.f;
#pragma unroll
            for (int j = 0; j < 4; ++j) { v[j] = vn[j]; ss += (v[j][0] * v[j][0] + v[j][1] * v[j][1]) + (v[j][2] * v[j][2] + v[j][3] * v[j][3]); }
            if (row + NGW < NLAT) {
#pragma unroll
                for (int j = 0; j < 4; ++j) vn[j] = *(const f32x4*)(xr + (size_t)NGW * DM + 4 * lane + 256 * j);
            }
            const float rstd = __builtin_amdgcn_rsqf(wave_sum(ss) * (1.f / DM) + EPSV);
#pragma unroll
            for (int j = 0; j < 4; ++j) { const int col = 4 * lane + 256 * j; *(f32x4*)(xr + col) = (v[j] * rstd) * gg[j]; }
        }
    }
}

extern "C" void kernel_launch(void* const* d_in, const int* in_sizes, int n_in, void* d_out, int out_size, void* d_ws, size_t ws_size, hipStream_t stream) {
    static int grid_blocks = 0;
    if (grid_blocks == 0) {
        if (n_in != 25 || ws_size < WS_END) { fprintf(stderr, "kernel_launch: unexpected n_in %d / ws %zu\n", n_in, ws_size); grid_blocks = -1; return; }
        int dev = 0, cus = 0, per_cu = 0;
        (void)hipGetDevice(&dev);
        (void)hipDeviceGetAttribute(&cus, hipDeviceAttributeMultiprocessorCount, dev);
        if (hipFuncSetAttribute((const void*)fwd_kernel, hipFuncAttributeMaxDynamicSharedMemorySize, LDS_BYTES) != hipSuccess) fprintf(stderr, "kernel_launch: hipFuncSetAttribute failed\n");
        if (hipOccupancyMaxActiveBlocksPerMultiprocessor(&per_cu, (const void*)fwd_kernel, 512, LDS_BYTES) != hipSuccess || per_cu < 1) { fprintf(stderr, "kernel_launch: occupancy query gave %d\n", per_cu); per_cu = 1; }
        (void)hipGetLastError();
        grid_blocks = cus * per_cu;
    }
    if (grid_blocks < 0) return;
    Params p{};
    const float** pp = (const float**)&p;
    for (int i = 0; i < 25; ++i) pp[i] = (const float*)d_in[i];
    p.out = (float*)d_out; p.ws = (unsigned char*)d_ws;
    (void)hipMemsetAsync((unsigned char*)d_ws + WS_MOD, 0, ZERO_BYTES, stream);
    void* args[] = {&p};
    hipError_t e = hipLaunchCooperativeKernel((const void*)fwd_kernel, dim3(grid_blocks), dim3(512), args, LDS_BYTES, stream);
    if (e != hipSuccess) fprintf(stderr, "cooperative launch failed: %s (grid %d)\n", hipGetErrorString(e), grid_blocks);
}
```

```cpp
#include <hip/hip_runtime.h>
#include <hip/hip_cooperative_groups.h>
#include <cstdint>
#include <cstdio>
namespace cg = cooperative_groups;
#ifndef PROBE
#define PROBE 0
#endif

#define LAS __attribute__((address_space(3)))
typedef unsigned short bf16_t;
typedef short bf16x8 __attribute__((ext_vector_type(8)));
typedef float f32x4 __attribute__((ext_vector_type(4)));
typedef float f32x16 __attribute__((ext_vector_type(16)));
typedef unsigned u32x4 __attribute__((ext_vector_type(4)));
typedef unsigned u32x2 __attribute__((ext_vector_type(2)));

constexpr int NB = 8, SEQ = 2048, DM = 1024, CTXL = 256, NLAT = NB * SEQ, NCTX = NB * CTXL, MTOT = NLAT + NCTX;
constexpr int INW = 2560, INW_SRC = 2304, DFF = 2816, N13 = 2 * DFF, KCAT = CTXL + SEQ;
constexpr float EPSV = 1e-6f;
constexpr float QSCALE = 0.125f * 1.4426950408889634f;
constexpr int LDS_BYTES = 147456;
constexpr int XCD_BAR_WORDS_C = 3456;

constexpr size_t MiB = 1u << 20;
constexpr size_t WS_WIN = 0, WS_WOUT = 10 * MiB, WS_W13 = 14 * MiB, WS_W2 = 36 * MiB, WS_WSM = 47 * MiB, WS_DFTL = 48 * MiB, WS_DFTC = 64 * MiB;
constexpr size_t WS_MOD = 64 * MiB + 256 * 1024, WS_ROPE = 64 * MiB + 768 * 1024, WS_XCTX = 65 * MiB, WS_H = 73 * MiB, WS_R = 109 * MiB;
constexpr size_t WS_Q1 = WS_R, WS_Q2 = WS_R + 9 * MiB, WS_K1 = WS_R + 18 * MiB, WS_K2 = WS_R + 27 * MiB, WS_VT = WS_R + 36 * MiB, WS_TTL = WS_R + 54 * MiB,
                 WS_TTC = WS_R + 70 * MiB, WS_UC = WS_R + 72 * MiB, WS_MIX = WS_R + 90 * MiB, WS_ACT = WS_R, WS_END = WS_R + 131 * MiB;
constexpr size_t MOD_BYTES = 2 * 9 * 6144 * 4;
constexpr int WSM_L = 256 * 512 + 256 * 256;
constexpr size_t WS_BAR = 64 * MiB + 704 * 1024, WS_PCNT = WS_BAR + 14336, ZERO_BYTES = WS_PCNT + 2 * 64 * 256 - WS_MOD;

struct Params {
    const float *x, *c, *ctx, *c_ctx, *w_ada, *b_ada, *norm1_g, *norm2_g, *w_in, *lam_q1, *lam_k1, *lam_q2, *lam_k2, *subln_g, *w_fourier, *conv_w, *conv_b,
        *conv_ln_g, *conv_ln_b, *w_conv_out, *w_out, *w_ffn1, *w_ffn3, *w_ffn2, *final_g;
    float* out; unsigned char* ws;
};

__device__ __forceinline__ unsigned cvt_pk_bf16(float lo, float hi) { unsigned r; asm("v_cvt_pk_bf16_f32 %0, %1, %2" : "=v"(r) : "v"(lo), "v"(hi)); return r; }
__device__ __forceinline__ u32x2 pack4(f32x4 v) { u32x2 w; w.x = cvt_pk_bf16(v[0], v[1]); w.y = cvt_pk_bf16(v[2], v[3]); return w; }
__device__ __forceinline__ bf16_t f2bf(float v) { return (bf16_t)(cvt_pk_bf16(v, 0.f) & 0xffffu); }
__device__ __forceinline__ float wave_sum(float v) {
#pragma unroll
    for (int o = 1; o < 64; o <<= 1) v += __shfl_xor(v, o);
    return v;
}
__device__ __forceinline__ int fresh_tid() { int t = threadIdx.x; asm volatile("" : "+v"(t)); return t; }
__device__ __forceinline__ float max3f(float a, float b, float c) { float r; asm("v_max3_f32 %0, %1, %2, %3" : "=v"(r) : "v"(a), "v"(b), "v"(c)); return r; }
__device__ __forceinline__ float sigmoidf_(float v) { return __builtin_amdgcn_rcpf(1.f + __expf(-v)); }


#define XB_TMO      128
#define XB_XCNT(j)  (256  + 64 * (j))
#define XB_XSUB(j)  (1280 + 64 * (j))
#define XB_XGEN(j)  (2304 + 64 * (j))
#define XB_TOP      3328
#define XB_TOPGEN   3392
#define XCD_BAR_WORDS 3456
#define XB_SPIN_CAP (1u << 18)
__device__ __forceinline__ unsigned xb_ld(unsigned* p)              { return __hip_atomic_load(p, __ATOMIC_RELAXED, __HIP_MEMORY_SCOPE_AGENT); }
__device__ __forceinline__ unsigned xb_add(unsigned* p, unsigned v) { return __hip_atomic_fetch_add(p, v, __ATOMIC_RELAXED, __HIP_MEMORY_SCOPE_AGENT); }
__device__ __forceinline__ unsigned xb_xcc_id() { return (unsigned)__builtin_amdgcn_s_getreg((3 << 11) | 20) & 0xFu; }
#define XB_SPIN(cond, bar) do { unsigned _sp = 0; while (cond) { __builtin_amdgcn_s_sleep(1); \
    if ((++_sp & 255u) == 0u) { if (xb_ld(&(bar)[XB_TMO])) break; if (_sp > XB_SPIN_CAP) { atomicAdd(&(bar)[XB_TMO], 1u); break; } } } } while (0)
struct XcdBarrier { unsigned* bar; unsigned x; volatile LAS unsigned* st; };
__device__ __forceinline__ XcdBarrier xcd_barrier_post(unsigned* bar, volatile LAS unsigned* st) {
    XcdBarrier b; b.bar = bar; b.x = xb_xcc_id(); b.st = st;
    if (threadIdx.x == 0) (void)xb_add(&bar[XB_XCNT(b.x)], 1u);
    return b;
}
__device__ __forceinline__ void xcd_barrier_complete(unsigned* bar, unsigned x, unsigned& nloc, unsigned& nx) {
    const unsigned G = gridDim.x * gridDim.y * gridDim.z;
    unsigned sum, cnt, mine, sp = 0u;
    for (;;) {
        sum = 0u; cnt = 0u; mine = 0u;
#pragma unroll
        for (unsigned j = 0; j < 16; ++j) { const unsigned c = xb_ld(&bar[XB_XCNT(j)]); sum += c; cnt += (c > 0u) ? 1u : 0u; mine = (j == x) ? c : mine; }
        if (sum == G) break;
        __builtin_amdgcn_s_sleep(1);
        if ((++sp & 255u) == 0u) { if (xb_ld(&bar[XB_TMO])) break; if (sp > XB_SPIN_CAP) { atomicAdd(&bar[XB_TMO], 1u); break; } }
    }
    nloc = mine > 0u ? mine : 1u; nx = cnt > 0u ? cnt : 1u;
}
__device__ __forceinline__ void xcd_barrier(const XcdBarrier& b) {
    asm volatile("s_waitcnt vmcnt(0)" ::: "memory");
    __syncthreads();
    if (threadIdx.x == 0) {
        unsigned* bar = b.bar;
        __builtin_amdgcn_s_waitcnt(0);
        unsigned nloc = b.st[0], nx = b.st[1];
        if (nloc == 0u) { xcd_barrier_complete(bar, b.x, nloc, nx); b.st[0] = nloc; b.st[1] = nx; }
        const unsigned old = xb_add(&bar[XB_XSUB(b.x)], 1u);
        const unsigned gen = old / nloc;
        if (old + 1u == (gen + 1u) * nloc) {
            __builtin_amdgcn_fence(__ATOMIC_RELEASE, "agent");
            asm volatile("s_waitcnt vmcnt(0)" ::: "memory");
            const unsigned og = xb_add(&bar[XB_TOP], 1u);
            const unsigned tg = og / nx;
            if (og + 1u == (tg + 1u) * nx) xb_add(&bar[XB_TOPGEN], 1u);
            else XB_SPIN(xb_ld(&bar[XB_TOPGEN]) == tg, bar);
            __builtin_amdgcn_fence(__ATOMIC_ACQUIRE, "agent");
            xb_add(&bar[XB_XGEN(b.x)], 1u);
            asm volatile("s_waitcnt vmcnt(0)" ::: "memory");
        } else {
            XB_SPIN(xb_ld(&bar[XB_XGEN(b.x)]) == gen, bar);
            __builtin_amdgcn_fence(__ATOMIC_ACQUIRE, "agent");
            asm volatile("s_waitcnt vmcnt(0)" ::: "memory");
        }
    }
    __syncthreads();
}

namespace pg8 {
constexpr int BM = 256, BK = 64, HALF = 128, HTB = HALF * BK * 2, STAGE_BYTES = 8 * HTB, NXCD = 8, WGM = 8;
__host__ __device__ __forceinline__ int lds_byte(int r, int c) { const int st = (r >> 4) * 2 + (c >> 5), rr = r & 15, cc = c & 31, ob = rr * 64 + cc * 2; return st * 1024 + (ob ^ (((ob >> 9) & 1) << 5)); }
__host__ __device__ __forceinline__ void stage_rc(int b, int& R, int& C) { const int st = b / 1024, sb = b % 1024, swz = sb ^ (((sb >> 9) & 1) << 5); R = (st >> 1) * 16 + swz / 64; C = (st & 1) * 32 + (swz % 64) / 2; }

__host__ __device__ __forceinline__ int perm32(int rho) { const int n = rho >> 4, i = rho & 15; return 8 * (i >> 2) + 4 * n + (i & 3); }
struct Unit { int pm, pn, k0, nt, flags; };
struct Gemm { const bf16_t* A; const bf16_t* Bt; int M, N, K, lda, ldb, a_pn_off; };

struct StaticOrder {
    int nM, nN, nwg, G, c;
    __host__ __device__ void init(int M, int N, int G_, int c_) { nM = M / BM; nN = N / BM; nwg = nM * nN; G = G_; c = c_; }
    __host__ __device__ __forceinline__ bool next(int i, Unit& u) const {
        const long L = (long)i * G + c; if (L >= nwg) return false;
        int wgid = (int)L; { const int q = nwg / NXCD, r = nwg % NXCD, xcd = wgid % NXCD, off = wgid / NXCD; wgid = (xcd < r ? xcd * (q + 1) : r * (q + 1) + (xcd - r) * q) + off; }
        const int nig = WGM * nN, gid = wgid / nig, fm = gid * WGM, gsz = (nM - fm) < WGM ? (nM - fm) : WGM;
        u.pm = fm + ((wgid % nig) % gsz); u.pn = (wgid % nig) / gsz; u.k0 = 0; u.nt = -1; u.flags = 0; return true;
    }
};
struct OffsetOrder {
    int nN, nwg, G, cc;
    __host__ __device__ void init(int M, int N, int G_, int c_, int off) { nN = N / BM; nwg = (M / BM) * nN; G = G_; cc = ((c_ - off) % G_ + G_) % G_; }
    __host__ __device__ __forceinline__ bool next(int i, Unit& u) const { const long L = (long)i * G + cc; if (L >= nwg) return false; u.pm = (int)L / nN; u.pn = (int)L % nN; u.k0 = 0; u.nt = -1; u.flags = 0; return true; }
};

struct CtxSplitOrder {
    StaticOrder lat; int nN, ntf;
    __host__ __device__ void init(int N, int K, int G_, int c_) { lat.init(NLAT, N, G_, c_); nN = N / BM; ntf = K / BK; }
    __host__ __device__ __forceinline__ bool next(int i, Unit& u) const {
        const long L = (long)i * lat.G + lat.c;
        int pm, pn, k0 = 0, ntq = -1, fl = 0;
        if (L < lat.nwg) {
            int wgid = (int)L; { const int q = lat.nwg / NXCD, r = lat.nwg % NXCD, xcd = wgid % NXCD, off = wgid / NXCD; wgid = (xcd < r ? xcd * (q + 1) : r * (q + 1) + (xcd - r) * q) + off; }
            const int nig = WGM * lat.nN, gid = wgid / nig, fm = gid * WGM, gsz = (lat.nM - fm) < WGM ? (lat.nM - fm) : WGM;
            pm = fm + ((wgid % nig) % gsz); pn = (wgid % nig) / gsz;
        } else {
            const int s = (int)(L - lat.nwg); if (s >= (NCTX / BM) * nN * 4) return false;
            const int cu_ = s >> 2, q = s & 3, base = (ntf / 8) * 2, extra = (ntf - 4 * base) / 2;
            pm = NLAT / BM + cu_ / nN; pn = cu_ % nN; ntq = base + (q < extra ? 2 : 0); k0 = (q * base + 2 * (q < extra ? q : extra)) * BK; fl = 1 | (q << 1);
        }
        u.pm = pm; u.pn = pn; u.k0 = k0; u.nt = ntq; u.flags = fl; return true;
    }
};

template <class Epi, class Sched, bool ALIGN_EPI>
__device__ __forceinline__ void gemm_phase(LAS unsigned char* lds, const Gemm g, const Sched& S, const Epi& E) {
    const int tid = fresh_tid(), wid = __builtin_amdgcn_readfirstlane(tid >> 6), lane = tid & 63, wr = wid >> 2, wc = wid & 3, fr = lane & 15, fq = lane >> 4;
    const int K = g.K, nt = K / BK;
    unsigned voffA[2], voffB[2];
#pragma unroll
    for (int i = 0; i < 2; ++i) { int R, C; stage_rc(tid * 16 + i * 8192, R, C);
        const int Rb = Epi::PERM ? ((R & ~31) + perm32(R & 31)) : R;
        voffA[i] = (unsigned)(R * g.lda + C) * 2u; voffB[i] = (unsigned)(Rb * g.ldb + C) * 2u; }
    const size_t kstep = (size_t)(BK * 2);
    const size_t hstepA = (size_t)HALF * g.lda * 2, hstepB = (size_t)HALF * g.ldb * 2;
    const size_t tstepA = 2 * hstepA, tstepB = 2 * hstepB;
    const unsigned ldsw = (unsigned)wid * 1024u;
    const int aoff = lds_byte(wr * 64 + fr, fq * 8), boff = lds_byte(wc * 32 + fr, fq * 8);
#define PG8_SA(b, h) (((b) * 2 + (h)) * HTB)
#define PG8_SB(b, h) ((4 + (b) * 2 + (h)) * HTB)
#define PG8_STAGE(bufoff, gbase, voff) do { _Pragma("unroll") for (int _i = 0; _i < 2; ++_i) \
        __builtin_amdgcn_global_load_lds((const unsigned*)((const char*)(gbase) + (voff)[_i]), (LAS unsigned*)(lds + (bufoff) + ldsw + _i * 8192), 16, 0, 0); } while (0)
#define PG8_LDA(dst, b, h) do { _Pragma("unroll") for (int m = 0; m < 4; ++m) _Pragma("unroll") for (int k = 0; k < 2; ++k) dst[m][k] = *(const LAS bf16x8*)(lds + PG8_SA(b, h) + aoff + m * 2048 + k * 1024); } while (0)
#define PG8_LDB(dst, b, h) do { _Pragma("unroll") for (int n = 0; n < 2; ++n) _Pragma("unroll") for (int k = 0; k < 2; ++k) dst[n][k] = *(const LAS bf16x8*)(lds + PG8_SB(b, h) + boff + n * 2048 + k * 1024); } while (0)
#define PG8_MMA(ai, bj, At, Bt) do { __builtin_amdgcn_s_setprio(1); _Pragma("unroll") for (int m = 0; m < 4; ++m) _Pragma("unroll") for (int n = 0; n < 2; ++n) _Pragma("unroll") for (int k = 0; k < 2; ++k) \
        acc[ai][bj][m][n] = __builtin_amdgcn_mfma_f32_16x16x32_bf16(Bt[n][k], At[m][k], acc[ai][bj][m][n], 0, 0, 0); __builtin_amdgcn_s_setprio(0); } while (0)
#define PG8_WAIT_V(n) asm volatile("s_waitcnt vmcnt(" #n ")" ::: "memory")
#define PG8_WAIT_L(n) asm volatile("s_waitcnt lgkmcnt(" #n ")" ::: "memory")
#define PG8_BAR __builtin_amdgcn_s_barrier()
#define PG8_SCHED __builtin_amdgcn_sched_barrier(0)
    Unit cur, nxt; int ui = 0;
    if (!S.next(0, cur)) return;
    f32x4 acc[2][2][4][2];
#pragma unroll
    for (int a = 0; a < 2; ++a)
#pragma unroll
        for (int b = 0; b < 2; ++b)
#pragma unroll
            for (int m = 0; m < 4; ++m)
#pragma unroll
                for (int n = 0; n < 2; ++n) acc[a][b][m][n] = (f32x4){0.f, 0.f, 0.f, 0.f};
    bf16x8 At[4][2], B0[2][2], B1[2][2];
    const char* cA = (const char*)g.A + (size_t)cur.pm * tstepA + (size_t)cur.pn * g.a_pn_off * 2 + (size_t)cur.k0 * 2; const char* cB = (const char*)g.Bt + (size_t)cur.pn * tstepB + (size_t)cur.k0 * 2;
    PG8_STAGE(PG8_SB(0, 0), cB, voffB); PG8_STAGE(PG8_SB(0, 1), cB + hstepB, voffB); PG8_STAGE(PG8_SA(0, 0), cA, voffA); PG8_STAGE(PG8_SA(0, 1), cA + hstepA, voffA);
    if (wr == 1) PG8_BAR;
    PG8_WAIT_V(2); PG8_BAR;
    PG8_STAGE(PG8_SB(1, 0), cB + kstep, voffB); PG8_STAGE(PG8_SA(1, 0), cA + kstep, voffA); PG8_STAGE(PG8_SB(1, 1), cB + hstepB + kstep, voffB);
    PG8_WAIT_V(6); PG8_BAR;
    for (;;) {
        const bool has_next = S.next(ui + 1, nxt);
        const char* nA = has_next ? (const char*)g.A + (size_t)nxt.pm * tstepA + (size_t)nxt.pn * g.a_pn_off * 2 + (size_t)nxt.k0 * 2 : cA; const char* nB = has_next ? (const char*)g.Bt + (size_t)nxt.pn * tstepB + (size_t)nxt.k0 * 2 : cB;
        const int ntc = cur.nt < 0 ? nt : cur.nt;
        for (int t = 0; t < ntc; t += 2) {
            const bool last = (t == ntc - 2);
            const char* a1 = cA + (size_t)(t + 1) * kstep;
            const char* a2 = last ? nA : cA + (size_t)(t + 2) * kstep; const char* b2 = last ? nB : cB + (size_t)(t + 2) * kstep;
            const char* a3 = a2 + kstep; const char* b3 = b2 + kstep;
            PG8_LDB(B0, 0, 0); PG8_LDB(B1, 0, 1); PG8_SCHED; PG8_LDA(At, 0, 0); PG8_STAGE(PG8_SA(1, 1), a1 + hstepA, voffA);
            PG8_WAIT_V(8); PG8_WAIT_L(0); PG8_BAR; PG8_MMA(0, 0, At, B0); PG8_MMA(0, 1, At, B1); PG8_BAR; PG8_SCHED;
            PG8_LDA(At, 0, 1); PG8_STAGE(PG8_SB(0, 0), b2, voffB); PG8_STAGE(PG8_SB(0, 1), b2 + hstepB, voffB); PG8_STAGE(PG8_SA(0, 0), a2, voffA);
            PG8_WAIT_V(8); PG8_WAIT_L(0); PG8_BAR; PG8_MMA(1, 0, At, B0); PG8_MMA(1, 1, At, B1); PG8_BAR; PG8_SCHED;
            PG8_LDB(B0, 1, 0); PG8_LDB(B1, 1, 1); PG8_SCHED; PG8_LDA(At, 1, 0); PG8_STAGE(PG8_SA(0, 1), a2 + hstepA, voffA);
            PG8_WAIT_V(8); PG8_WAIT_L(0); PG8_BAR; PG8_MMA(0, 0, At, B0); PG8_MMA(0, 1, At, B1); PG8_BAR; PG8_SCHED;
            PG8_LDA(At, 1, 1); PG8_STAGE(PG8_SB(1, 0), b3, voffB); PG8_STAGE(PG8_SB(1, 1), b3 + hstepB, voffB); PG8_STAGE(PG8_SA(1, 0), a3, voffA);
            PG8_WAIT_V(8); PG8_WAIT_L(0); PG8_BAR; PG8_MMA(1, 0, At, B0); PG8_MMA(1, 1, At, B1); PG8_BAR; PG8_SCHED;
        }
        if constexpr (ALIGN_EPI) { if (wr == 0) PG8_BAR; }
        if constexpr (!Epi::AFTER_DRAIN) E(acc, cur, wr, wc, fr, fq);
        if (!has_next) break;
#pragma unroll
        for (int a = 0; a < 2; ++a)
#pragma unroll
            for (int b = 0; b < 2; ++b)
#pragma unroll
                for (int m = 0; m < 4; ++m)
#pragma unroll
                    for (int n = 0; n < 2; ++n) acc[a][b][m][n] = (f32x4){0.f, 0.f, 0.f, 0.f};
        cur = nxt; cA = nA; cB = nB; ++ui;
        if constexpr (ALIGN_EPI) { if (wr == 1) PG8_BAR; }
    }
    PG8_WAIT_V(0);
    if constexpr (!ALIGN_EPI) { if (wr == 0) PG8_BAR; }
    PG8_BAR;
    if constexpr (Epi::AFTER_DRAIN) E.fused(acc, cur, wr, wc, fr, fq, lds, wid, lane);
#undef PG8_SA
#undef PG8_SB
#undef PG8_STAGE
#undef PG8_LDA
#undef PG8_LDB
#undef PG8_MMA
#undef PG8_WAIT_V
#undef PG8_WAIT_L
#undef PG8_BAR
#undef PG8_SCHED
}
}

typedef f32x4 Acc[2][2][4][2];

struct EpiInProj {
    static constexpr bool PERM = false;
    static constexpr bool AFTER_DRAIN = false;
    bf16_t *Q1, *Q2, *K1c, *K2c, *VT, *TTl, *TTc, *UC; const float* rope;
    __device__ __forceinline__ void operator()(const Acc& acc, const pg8::Unit& u, int wr, int wc, int fr, int fq) const {
        const int pn = u.pn; const bool lat = u.pm < 64;
#pragma unroll
        for (int ai = 0; ai < 2; ++ai)
#pragma unroll
            for (int m = 0; m < 4; ++m) {
                const int row = u.pm * 256 + ai * 128 + wr * 64 + m * 16 + fr;
                int b, t; if (lat) { b = row >> 11; t = row & 2047; } else { const int rc = row - NLAT; b = rc >> 8; t = rc & 255; }
                const int pos = lat ? CTXL + t : t;
                if (pn < 4) {
                    bf16_t* dst;
                    if (pn == 0) dst = Q1 + (size_t)row * 256; else if (pn == 1) dst = Q2 + (size_t)row * 256;
                    else if (pn == 2) dst = K1c + ((size_t)b * KCAT + pos) * 256; else dst = K2c + ((size_t)b * KCAT + pos) * 256;
                    const float scale = pn < 2 ? QSCALE : 1.f;
                    const int ax = fq >> 1, fh = fq & 1;
                    u32x4 w1, w2;
#pragma unroll
                    for (int bj = 0; bj < 2; ++bj) {
                        f32x4 cs = {1.f, 1.f, 1.f, 1.f}, sn = {0.f, 0.f, 0.f, 0.f};
                        if (lat) { const int pidx = ax ? (t & 63) : (t >> 6); cs = *(const f32x4*)(rope + pidx * 16 + 8 * fh + 4 * bj); sn = *(const f32x4*)(rope + 1024 + pidx * 16 + 8 * fh + 4 * bj); }
                        const f32x4 x1 = acc[ai][bj][m][0], x2 = acc[ai][bj][m][1];
                        const u32x2 p1 = pack4((x1 * cs - x2 * sn) * scale), p2 = pack4((x2 * cs + x1 * sn) * scale);
                        if (bj == 0) { w1.x = p1.x; w1.y = p1.y; w2.x = p2.x; w2.y = p2.y; } else { w1.z = p1.x; w1.w = p1.y; w2.z = p2.x; w2.w = p2.y; }
                    }
                    bf16_t* dq = dst + wc * 64 + ax * 32 + 8 * fh;
                    *(u32x4*)dq = w1; *(u32x4*)(dq + 16) = w2;
                } else if (pn < 6) {
#pragma unroll
                    for (int bj = 0; bj < 2; ++bj)
#pragma unroll
                        for (int n = 0; n < 2; ++n) {
                            bf16_t* dst = VT + ((size_t)(b * 4 + (pn - 4) * 2 + bj) * 128 + wc * 32 + n * 16 + 4 * fq) * KCAT + pos;
                            const f32x4 v = acc[ai][bj][m][n];
                            dst[0] = f2bf(v[0]); dst[KCAT] = f2bf(v[1]); dst[2 * KCAT] = f2bf(v[2]); dst[3 * KCAT] = f2bf(v[3]);
                        }
                } else if (pn < 8) {
                    const int s = pn - 6;
#pragma unroll
                    for (int bj = 0; bj < 2; ++bj)
#pragma unroll
                        for (int n = 0; n < 2; ++n) {
                            const int jf = bj * 128 + wc * 32 + n * 16 + 4 * fq;
                            const f32x4 v = acc[ai][bj][m][n];
                            if (lat) { bf16_t* dst = TTl + (((size_t)b * 256 + jf) * 2 + s) * SEQ + t; dst[0] = f2bf(v[0]); dst[2 * SEQ] = f2bf(v[1]); dst[4 * SEQ] = f2bf(v[2]); dst[6 * SEQ] = f2bf(v[3]); }
                            else { bf16_t* dst = TTc + (((size_t)b * 256 + jf) * 2 + s) * CTXL + t; dst[0] = f2bf(v[0]); dst[2 * CTXL] = f2bf(v[1]); dst[4 * CTXL] = f2bf(v[2]); dst[6 * CTXL] = f2bf(v[3]); }
                        }
                } else {
                    bf16_t* dst = UC + (size_t)row * 512 + (pn - 8) * 256 + wc * 32 + 8 * fq;
#pragma unroll
                    for (int n = 0; n < 2; ++n) { const u32x2 p0 = pack4(acc[ai][0][m][n]), p1 = pack4(acc[ai][1][m][n]); *(u32x4*)(dst + 128 * n) = (u32x4){p0.x, p0.y, p1.x, p1.y}; }
                }
            }
    }
};

struct EpiRes {
    static constexpr bool PERM = false;
    static constexpr bool AFTER_DRAIN = false;
    const float* xin_lat; const float* xin_ctx; float* xout_lat; float* xout_ctx; const float* mod; int goff; float* pb;
    __device__ __forceinline__ void operator()(const Acc& acc, const pg8::Unit& u, int wr, int wc, int fr, int fq) const {
        const int tile0 = u.pm * 256, colb = u.pn * 256 + wc * 32 + 4 * fq, rloc = wr * 64 + fr;
        if (u.flags & 1) {
            float* pq = pb + ((size_t)(u.flags >> 1) * NCTX + (tile0 - NLAT) + rloc) * DM + colb;
#pragma unroll
            for (int ai = 0; ai < 2; ++ai)
#pragma unroll
                for (int m = 0; m < 4; ++m)
#pragma unroll
                    for (int bj = 0; bj < 2; ++bj)
#pragma unroll
                        for (int n = 0; n < 2; ++n) *(f32x4*)(pq + (size_t)(ai * 128 + m * 16) * DM + bj * 128 + n * 16) = acc[ai][bj][m][n];
            return;
        }
        const bool lat = tile0 < NLAT;
        const float* xi = (lat ? xin_lat + (size_t)tile0 * DM : xin_ctx + (size_t)(tile0 - NLAT) * DM) + (size_t)rloc * DM + colb;
        float* xo = (lat ? xout_lat + (size_t)tile0 * DM : xout_ctx + (size_t)(tile0 - NLAT) * DM) + (size_t)rloc * DM + colb;
        const float* gp = mod + (lat ? (tile0 >> 11) : 8) * 6144 + goff + colb;
        f32x4 gt[2][2];
#pragma unroll
        for (int bj = 0; bj < 2; ++bj)
#pragma unroll
            for (int n = 0; n < 2; ++n) gt[bj][n] = *(const f32x4*)(gp + bj * 128 + n * 16);
        f32x4 xv[2][2][2];
#define ER_LOAD(buf, g_) do { const float* xp_ = xi + (size_t)(((g_) >> 2) * 128 + ((g_) & 3) * 16) * DM; \
            _Pragma("unroll") for (int bj = 0; bj < 2; ++bj) _Pragma("unroll") for (int n = 0; n < 2; ++n) xv[buf][bj][n] = *(const f32x4*)(xp_ + bj * 128 + n * 16); } while (0)
        ER_LOAD(0, 0);
#pragma unroll
        for (int g_ = 0; g_ < 8; ++g_) {
            if (g_ + 1 < 8) ER_LOAD((g_ + 1) & 1, g_ + 1);
            float* xq = xo + (size_t)((g_ >> 2) * 128 + (g_ & 3) * 16) * DM;
#pragma unroll
            for (int bj = 0; bj < 2; ++bj)
#pragma unroll
                for (int n = 0; n < 2; ++n) *(f32x4*)(xq + bj * 128 + n * 16) = xv[g_ & 1][bj][n] + gt[bj][n] * acc[g_ >> 2][bj][g_ & 3][n];
        }
#undef ER_LOAD
    }
};

template <int MODE>
struct EpiPanelNorm {
    static constexpr bool PERM = false;
    static constexpr bool AFTER_DRAIN = true;
    const float* xin; float* out; const float* mod; int goff; const float* final_g; unsigned* slots; unsigned* cnt; bf16_t* Hout; int sh_off, sc_off;
    __device__ __forceinline__ void fused(Acc& acc, const pg8::Unit& u, int wr, int wc, int fr, int fq, LAS unsigned char* lds, int wid, int lane) const {
        const int tile0 = u.pm * 256, colb = u.pn * 256 + wc * 32 + 4 * fq, rloc = wr * 64 + fr;
        const float* xi = xin + (size_t)(tile0 + rloc) * DM + colb;
        float* xo = out + (size_t)(tile0 + rloc) * DM + colb;
        const float* gp = mod + (tile0 >> 11) * 6144 + goff + colb;
        f32x4 gt[2][2];
#pragma unroll
        for (int bj = 0; bj < 2; ++bj)
#pragma unroll
            for (int n = 0; n < 2; ++n) gt[bj][n] = *(const f32x4*)(gp + bj * 128 + n * 16);
        f32x4 xv[2][2][2];
#define EF_LOAD(buf, g_) do { const float* xp_ = xi + (size_t)(((g_) >> 2) * 128 + ((g_) & 3) * 16) * DM; \
            _Pragma("unroll") for (int bj = 0; bj < 2; ++bj) _Pragma("unroll") for (int n = 0; n < 2; ++n) xv[buf][bj][n] = *(const f32x4*)(xp_ + bj * 128 + n * 16); } while (0)
        LAS float* P = (LAS float*)lds;
        LAS float* S = (LAS float*)(lds + 4096);
        EF_LOAD(0, 0);
#pragma unroll
        for (int g_ = 0; g_ < 8; ++g_) {
            if (g_ + 1 < 8) EF_LOAD((g_ + 1) & 1, g_ + 1);
            float sq = 0.f;
#pragma unroll
            for (int bj = 0; bj < 2; ++bj)
#pragma unroll
                for (int n = 0; n < 2; ++n) { const f32x4 xn = xv[g_ & 1][bj][n] + gt[bj][n] * acc[g_ >> 2][bj][g_ & 3][n]; acc[g_ >> 2][bj][g_ & 3][n] = xn;
                    if (MODE == 1) *(f32x4*)(xo + (size_t)((g_ >> 2) * 128 + (g_ & 3) * 16) * DM + bj * 128 + n * 16) = xn;
                    sq += (xn[0] * xn[0] + xn[1] * xn[1]) + (xn[2] * xn[2] + xn[3] * xn[3]); }
            sq += __shfl_xor(sq, 16); sq += __shfl_xor(sq, 32);
            if (fq == 0) P[((g_ >> 2) * 128 + wr * 64 + (g_ & 3) * 16 + fr) * 4 + wc] = sq;
        }
#undef EF_LOAD
        asm volatile("s_waitcnt lgkmcnt(0)" ::: "memory"); __builtin_amdgcn_s_barrier(); asm volatile("" ::: "memory");
        const int row = wid * 32 + (lane & 31);
        if (lane < 32) { const float tsum = (P[row * 4 + 0] + P[row * 4 + 1]) + (P[row * 4 + 2] + P[row * 4 + 3]);
            __hip_atomic_store(slots + (size_t)(tile0 + row) * 4 + u.pn, __float_as_uint(tsum), __ATOMIC_RELAXED, __HIP_MEMORY_SCOPE_AGENT); }
        asm volatile("s_waitcnt vmcnt(0)" ::: "memory");
        if (lane == 0) __hip_atomic_fetch_add(cnt + 64 * u.pm, 1u, __ATOMIC_RELAXED, __HIP_MEMORY_SCOPE_AGENT);
        if (wid == 0) {
            unsigned sp = 0;
            while ((unsigned)__builtin_amdgcn_readfirstlane(__hip_atomic_load(cnt + 64 * u.pm, __ATOMIC_RELAXED, __HIP_MEMORY_SCOPE_AGENT)) < 32u) { __builtin_amdgcn_s_sleep(2); if (++sp > (1u << 20)) break; }
            __builtin_amdgcn_fence(__ATOMIC_ACQUIRE, "agent");
        }
        asm volatile("s_waitcnt vmcnt(0) lgkmcnt(0)" ::: "memory"); __builtin_amdgcn_s_barrier(); asm volatile("" ::: "memory");
        if (lane < 32) { float tot = 0.f;
#pragma unroll
            for (int t4 = 0; t4 < 4; ++t4) tot += __uint_as_float(__hip_atomic_load(slots + (size_t)(tile0 + row) * 4 + t4, __ATOMIC_RELAXED, __HIP_MEMORY_SCOPE_AGENT));
            S[row] = __builtin_amdgcn_rsqf(tot * (1.f / DM) + EPSV); }
        asm volatile("s_waitcnt lgkmcnt(0)" ::: "memory"); __builtin_amdgcn_s_barrier(); asm volatile("" ::: "memory");
        f32x4 fg[2][2], sc[2][2], sh[2][2];
#pragma unroll
        for (int bj = 0; bj < 2; ++bj)
#pragma unroll
            for (int n = 0; n < 2; ++n) { fg[bj][n] = *(const f32x4*)(final_g + colb + bj * 128 + n * 16);
                if (MODE == 1) { const float* mp = mod + (tile0 >> 11) * 6144 + colb + bj * 128 + n * 16; sc[bj][n] = *(const f32x4*)(mp + sc_off) + 1.f; sh[bj][n] = *(const f32x4*)(mp + sh_off); } }
#pragma unroll
        for (int g_ = 0; g_ < 8; ++g_) {
            const float rs = S[(g_ >> 2) * 128 + wr * 64 + (g_ & 3) * 16 + fr];
            const size_t ro = (size_t)((g_ >> 2) * 128 + (g_ & 3) * 16) * DM;
#pragma unroll
            for (int bj = 0; bj < 2; ++bj)
#pragma unroll
                for (int n = 0; n < 2; ++n) {
                    const f32x4 y = (acc[g_ >> 2][bj][g_ & 3][n] * rs) * fg[bj][n];
                    if (MODE == 0) *(f32x4*)(xo + ro + bj * 128 + n * 16) = y;
                    else *(u32x2*)(Hout + (size_t)(tile0 + rloc) * DM + colb + ro + bj * 128 + n * 16) = pack4(y * sc[bj][n] + sh[bj][n]);
                }
        }
    }
};

struct EpiFfn13 {
    static constexpr bool PERM = false;
    static constexpr bool AFTER_DRAIN = false;
    bf16_t* ACT;
    __device__ __forceinline__ void operator()(const Acc& acc, const pg8::Unit& u, int wr, int wc, int fr, int fq) const {
#pragma unroll
        for (int ai = 0; ai < 2; ++ai)
#pragma unroll
            for (int m = 0; m < 4; ++m) {
                const int row = u.pm * 256 + ai * 128 + wr * 64 + m * 16 + fr;
                u32x4 w;
#pragma unroll
                for (int bj = 0; bj < 2; ++bj) {
                    const f32x4 a = acc[ai][bj][m][0], b = acc[ai][bj][m][1]; f32x4 o;
#pragma unroll
                    for (int j = 0; j < 4; ++j) o[j] = a[j] * sigmoidf_(a[j]) * b[j];
                    const u32x2 pk = pack4(o);
                    if (bj == 0) { w.x = pk.x; w.y = pk.y; } else { w.z = pk.x; w.w = pk.y; }
                }
                *(u32x4*)(ACT + (size_t)row * DFF + 128 * u.pn + 32 * wc + 8 * fq) = w;
            }
    }
};

struct EpiMix {
    static constexpr bool PERM = true;
    static constexpr bool AFTER_DRAIN = false;
    bf16_t* out; int pitch, col0, tok_base, tok_pn_step, col_pn_step;
    __device__ __forceinline__ void operator()(const Acc& acc, const pg8::Unit& u, int wr, int wc, int fr, int fq) const {
#pragma unroll
        for (int ai = 0; ai < 2; ++ai)
#pragma unroll
            for (int m = 0; m < 4; ++m) {
                const int row = u.pm * 256 + ai * 128 + wr * 64 + m * 16 + fr;
                bf16_t* dst = out + (size_t)(tok_base + u.pn * tok_pn_step + row) * pitch + col0 + u.pn * col_pn_step + wc * 32 + 8 * fq;
#pragma unroll
                for (int bj = 0; bj < 2; ++bj) { const u32x2 p0 = pack4(acc[ai][bj][m][0]), p1 = pack4(acc[ai][bj][m][1]); *(u32x4*)(dst + bj * 128) = (u32x4){p0.x, p0.y, p1.x, p1.y}; }
            }
    }
};

namespace att {
constexpr int VP = 144, OFF_K1 = 0, OFF_K2 = 8192, OFF_VT = 16384, BUFSZ = 16384 + 128 * VP;
struct Args { const bf16_t *Q1, *Q2, *K1c, *K2c, *VT; bf16_t* MIXA; const float* subln; float lam, omli; };

__device__ __forceinline__ void attn_unit(LAS unsigned char* lds, const Args& A, int b, int h, int qrow0, int nkt) {
    const int tid = fresh_tid(), lane = tid & 63, r32 = lane & 31, hi = lane >> 5;
    const int wid = __builtin_amdgcn_readfirstlane(tid >> 6), map = wid >> 2, qg = wid & 3;
    const bf16_t* Qm = map ? A.Q2 : A.Q1;
    bf16x8 qf[4];
    { const bf16_t* qp = Qm + (size_t)(qrow0 + qg * 32 + r32) * 256 + h * 64 + hi * 8;
#pragma unroll
      for (int d0 = 0; d0 < 4; ++d0) qf[d0] = *(const bf16x8*)(qp + d0 * 16); }
    const int key_s = tid >> 3, ch_s = tid & 7;
    const bf16_t* k1src = A.K1c + ((size_t)b * KCAT + key_s) * 256 + h * 64 + ch_s * 8;
    const bf16_t* k2src = A.K2c + ((size_t)b * KCAT + key_s) * 256 + h * 64 + ch_s * 8;
    const bf16_t* vsrc = A.VT + ((size_t)(b * 4 + h) * 128 + key_s) * KCAT + ch_s * 8;
    const int kdst = key_s * 128 + ((ch_s ^ ((key_s >> 1) & 7)) << 4), vdst = key_s * VP + 32 * (ch_s >> 1) + 8 * (ch_s & 1);
    u32x4 rk1[2], rk2[2], rv0[2], rv1[2];
#define ATT_LOAD(set, t) do { rk1[set] = *(const u32x4*)(k1src + (size_t)(t) * 64 * 256); rk2[set] = *(const u32x4*)(k2src + (size_t)(t) * 64 * 256); \
        rv0[set] = *(const u32x4*)(vsrc + (t) * 64); rv1[set] = *(const u32x4*)(vsrc + (size_t)64 * KCAT + (t) * 64); } while (0)
#define ATT_STORE(set, buf) do { LAS unsigned char* bb_ = lds + (buf) * BUFSZ; *(LAS u32x4*)(bb_ + OFF_K1 + kdst) = rk1[set]; *(LAS u32x4*)(bb_ + OFF_K2 + kdst) = rk2[set]; \
        *(LAS u32x2*)(bb_ + OFF_VT + vdst) = (u32x2){rv0[set].x, rv0[set].y}; *(LAS u32x2*)(bb_ + OFF_VT + vdst + 16) = (u32x2){rv0[set].z, rv0[set].w}; \
        *(LAS u32x2*)(bb_ + OFF_VT + 64 * VP + vdst) = (u32x2){rv1[set].x, rv1[set].y}; *(LAS u32x2*)(bb_ + OFF_VT + 64 * VP + vdst + 16) = (u32x2){rv1[set].z, rv1[set].w}; } while (0)
    constexpr float THR = 6.f;
    float mrun = 0.f, lrun = 0.f;
    f32x16 O[4];
#pragma unroll
    for (int i = 0; i < 4; ++i)
#pragma unroll
        for (int r = 0; r < 16; ++r) O[i][r] = 0.f;
    ATT_LOAD(0, 0); ATT_STORE(0, 0); __syncthreads();
    ATT_LOAD(1, 1);
    for (int t0 = 0; t0 < nkt; t0 += 2) {
#pragma unroll
      for (int tt = 0; tt < 2; ++tt) {
        const int t = t0 + tt, cur = tt;
        if (t + 2 < nkt) ATT_LOAD(tt, t + 2);
        LAS unsigned char* base = lds + cur * BUFSZ;
        LAS unsigned char* kb = base + (map ? OFF_K2 : OFF_K1) + r32 * 128;
        f32x16 s0, s1;
#pragma unroll
        for (int r = 0; r < 16; ++r) { s0[r] = -mrun; s1[r] = -mrun; }
#pragma unroll
        for (int d0 = 0; d0 < 4; ++d0) {
            const int chunk = ((2 * d0 + hi) ^ ((r32 >> 1) & 7)) << 4;
            const bf16x8 a0 = *(const LAS bf16x8*)(kb + chunk), a1 = *(const LAS bf16x8*)(kb + 32 * 128 + chunk);
            s0 = __builtin_amdgcn_mfma_f32_32x32x16_bf16(a0, qf[d0], s0, 0, 0, 0);
            s1 = __builtin_amdgcn_mfma_f32_32x32x16_bf16(a1, qf[d0], s1, 0, 0, 0);
        }
        asm volatile("s_nop 15\n\ts_nop 4" : "+v"(s0), "+v"(s1));
        LAS unsigned char* vb = base + OFF_VT + r32 * VP + 16 * hi;
        u32x4 vf[2][4];
#define ATT_LDV(slot, c) do { _Pragma("unroll") for (int dblk = 0; dblk < 4; ++dblk) { \
            vf[slot][dblk] = *(const LAS u32x4*)(vb + dblk * 32 * VP + 32 * (c)); } } while (0)
        ATT_LDV(0, 0);
        __builtin_amdgcn_sched_barrier(0);
        float rm = max3f(s0[0], s0[1], s1[0]), rm2 = max3f(s0[2], s0[3], s1[1]);
        rm = max3f(rm, s1[2], s1[3]);
#pragma unroll
        for (int r = 4; r < 16; r += 4) { rm = max3f(rm, s0[r], s0[r + 1]); rm2 = max3f(rm2, s0[r + 2], s0[r + 3]); rm = max3f(rm, s1[r], s1[r + 1]); rm2 = max3f(rm2, s1[r + 2], s1[r + 3]); }
        rm = fmaxf(rm, rm2);
        rm = fmaxf(rm, __shfl_xor(rm, 32));
        const bool need = (t == 0) || (rm > THR);
        if (__any(need)) {
            const float dlt = need ? rm : 0.f, alpha = (t == 0) ? 1.f : __builtin_amdgcn_exp2f(-dlt);
            mrun += dlt; lrun *= alpha;
            s0 = s0 - dlt; s1 = s1 - dlt;
#pragma unroll
            for (int i = 0; i < 4; ++i)
#pragma unroll
                for (int r = 0; r < 16; ++r) O[i][r] *= alpha;
        }
#pragma unroll
        for (int r = 0; r < 16; ++r) { s0[r] = __builtin_amdgcn_exp2f(s0[r]); s1[r] = __builtin_amdgcn_exp2f(s1[r]); }
        { const f32x16 t16 = s0 + s1;
          typedef float f32x8 __attribute__((ext_vector_type(8)));
          const f32x8 t8 = t16.lo + t16.hi; const f32x4 t4 = t8.lo + t8.hi;
          lrun += (t4[0] + t4[1]) + (t4[2] + t4[3]); }
        bf16x8 P[4];
        { u32x4 w;
          w.x = cvt_pk_bf16(s0[0], s0[1]); w.y = cvt_pk_bf16(s0[2], s0[3]); w.z = cvt_pk_bf16(s0[4], s0[5]); w.w = cvt_pk_bf16(s0[6], s0[7]); P[0] = __builtin_bit_cast(bf16x8, w);
          w.x = cvt_pk_bf16(s0[8], s0[9]); w.y = cvt_pk_bf16(s0[10], s0[11]); w.z = cvt_pk_bf16(s0[12], s0[13]); w.w = cvt_pk_bf16(s0[14], s0[15]); P[1] = __builtin_bit_cast(bf16x8, w);
          w.x = cvt_pk_bf16(s1[0], s1[1]); w.y = cvt_pk_bf16(s1[2], s1[3]); w.z = cvt_pk_bf16(s1[4], s1[5]); w.w = cvt_pk_bf16(s1[6], s1[7]); P[2] = __builtin_bit_cast(bf16x8, w);
          w.x = cvt_pk_bf16(s1[8], s1[9]); w.y = cvt_pk_bf16(s1[10], s1[11]); w.z = cvt_pk_bf16(s1[12], s1[13]); w.w = cvt_pk_bf16(s1[14], s1[15]); P[3] = __builtin_bit_cast(bf16x8, w); }
        __builtin_amdgcn_sched_barrier(0);
        ATT_LDV(1, 1);
        __builtin_amdgcn_sched_barrier(0);
#pragma unroll
        for (int dblk = 0; dblk < 4; ++dblk) O[dblk] = __builtin_amdgcn_mfma_f32_32x32x16_bf16(__builtin_bit_cast(bf16x8, vf[0][dblk]), P[0], O[dblk], 0, 0, 0);
        __builtin_amdgcn_sched_barrier(0);
        ATT_LDV(0, 2);
        __builtin_amdgcn_sched_barrier(0);
#pragma unroll
        for (int dblk = 0; dblk < 4; ++dblk) O[dblk] = __builtin_amdgcn_mfma_f32_32x32x16_bf16(__builtin_bit_cast(bf16x8, vf[1][dblk]), P[1], O[dblk], 0, 0, 0);
        __builtin_amdgcn_sched_barrier(0);
        ATT_LDV(1, 3);
        __builtin_amdgcn_sched_barrier(0);
#pragma unroll
        for (int dblk = 0; dblk < 4; ++dblk) O[dblk] = __builtin_amdgcn_mfma_f32_32x32x16_bf16(__builtin_bit_cast(bf16x8, vf[0][dblk]), P[2], O[dblk], 0, 0, 0);
        __builtin_amdgcn_sched_barrier(0);
#pragma unroll
        for (int dblk = 0; dblk < 4; ++dblk) O[dblk] = __builtin_amdgcn_mfma_f32_32x32x16_bf16(__builtin_bit_cast(bf16x8, vf[1][dblk]), P[3], O[dblk], 0, 0, 0);
#undef ATT_LDV
        if (t + 1 < nkt) ATT_STORE(tt ^ 1, tt ^ 1);
        asm volatile("s_waitcnt lgkmcnt(0)" ::: "memory"); __builtin_amdgcn_s_barrier(); asm volatile("" ::: "memory");
      }
    }
#undef ATT_LOAD
#undef ATT_STORE
    lrun += __shfl_xor(lrun, 32);
    const float inv = 1.f / lrun;
    LAS float* ex = (LAS float*)lds + qg * 4096;
    if (map == 1) {
#pragma unroll
        for (int i = 0; i < 4; ++i)
#pragma unroll
            for (int r = 0; r < 16; ++r) ex[(i * 16 + r) * 64 + lane] = O[i][r] * inv;
    }
    __syncthreads();
    if (map == 0) {
        float ss = 0.f;
#pragma unroll
        for (int i = 0; i < 4; ++i)
#pragma unroll
            for (int r = 0; r < 16; ++r) { const float o = O[i][r] * inv - A.lam * ex[(i * 16 + r) * 64 + lane]; O[i][r] = o; ss += o * o; }
        ss += __shfl_xor(ss, 32);
        const float rstd = __builtin_amdgcn_rsqf(ss * (1.f / 128.f) + EPSV) * A.omli;
        bf16_t* dst = A.MIXA + (size_t)(qrow0 + qg * 32 + r32) * DM + h * 128 + 4 * hi;
#pragma unroll
        for (int i = 0; i < 4; ++i)
#pragma unroll
            for (int rq = 0; rq < 4; ++rq) {
                const int d0 = 32 * i + 8 * rq;
                const f32x4 gg = *(const f32x4*)(A.subln + d0 + 4 * hi);
                f32x4 v = {O[i][4 * rq] * rstd * gg[0], O[i][4 * rq + 1] * rstd * gg[1], O[i][4 * rq + 2] * rstd * gg[2], O[i][4 * rq + 3] * rstd * gg[3]};
                *(u32x2*)(dst + d0) = pack4(v);
            }
    }
    __syncthreads();
}
}

__device__ __forceinline__ void conv_item(const Params& p, LAS unsigned char* lds, int l, int item, const bf16_t* UC, bf16_t* MIXA) {
    const int tid = fresh_tid(), lane = tid & 63, wid = tid >> 6, g = wid & 3, th = wid >> 2;
    const int ch = g * 64 + lane;
    int rowbase, t0, L;
    if (item < 256) { rowbase = (item >> 5) * SEQ; t0 = (item & 31) * 64; L = SEQ; }
    else { const int j = item - 256; rowbase = NLAT + (j >> 2) * CTXL; t0 = (j & 3) * 64; L = CTXL; }
    LAS float* zl = (LAS float*)lds;
    {
        u32x4 av[6], gv[6];
#pragma unroll
        for (int it = 0; it < 6; ++it) {
            int idx = tid + it * 512; idx = idx < 94 * 32 ? idx : 94 * 32 - 1;
            const int pr = idx >> 5, c8 = idx & 31; int pp = t0 - 15 + pr; pp = pp < 0 ? 0 : (pp >= L ? L - 1 : pp);
            const bf16_t* up = UC + (size_t)(rowbase + pp) * 512 + c8 * 8;
            av[it] = *(const u32x4*)up; gv[it] = *(const u32x4*)(up + 256);
        }
#pragma unroll
        for (int it = 0; it < 6; ++it) {
            const int idx = tid + it * 512;
            const int pr = idx >> 5, c8 = idx & 31, pp = t0 - 15 + pr;
            const float msk = (pp >= 0 && pp < L) ? 1.f : 0.f;
            f32x4 z0, z1;
#pragma unroll
            for (int q = 0; q < 4; ++q) {
                const float a_lo = __uint_as_float(av[it][q] << 16), a_hi = __uint_as_float(av[it][q] & 0xffff0000u);
                const float g_lo = __uint_as_float(gv[it][q] << 16), g_hi = __uint_as_float(gv[it][q] & 0xffff0000u);
                const float zlo = a_lo * sigmoidf_(g_lo) * msk, zhi = a_hi * sigmoidf_(g_hi) * msk;
                if (q < 2) { z0[2 * q] = zlo; z0[2 * q + 1] = zhi; } else { z1[2 * (q - 2)] = zlo; z1[2 * (q - 2) + 1] = zhi; }
            }
            if (idx < 94 * 32) { *(LAS f32x4*)(zl + pr * 256 + c8 * 8) = z0; *(LAS f32x4*)(zl + pr * 256 + c8 * 8 + 4) = z1; }
        }
    }
    __syncthreads();
    const int ts = t0 + th * 32;
    float w[31];
#pragma unroll
    for (int k = 0; k < 31; ++k) w[k] = p.conv_w[(size_t)l * 31 * 256 + k * 256 + ch];
    float o[32];
    const float bias = p.conv_b[l * 256 + ch];
    const LAS float* zp = zl + (th * 32) * 256 + ch;
    float z[62];
#pragma unroll
    for (int jj = 0; jj < 62; ++jj) z[jj] = zp[jj * 256];
#pragma unroll
    for (int i = 0; i < 32; ++i) {
        float acc = bias;
#pragma unroll
        for (int k = 0; k < 31; ++k) acc += w[k] * z[i + k];
        o[i] = acc;
    }
    const float lg = p.conv_ln_g[l * 256 + ch], lb = p.conv_ln_b[l * 256 + ch];
#pragma unroll
    for (int i = 0; i < 32; ++i) {
        const float mu = wave_sum(o[i]) * (1.f / 64.f);
        const float d = o[i] - mu;
        const float var = wave_sum(d * d) * (1.f / 64.f);
        const float zn = d * __builtin_amdgcn_rsqf(var + EPSV) * lg + lb;
        MIXA[(size_t)(rowbase + ts + i) * DM + 768 + ch] = f2bf(zn * sigmoidf_(zn));
    }
    __syncthreads();
}

__device__ __forceinline__ int drow_map(int mode, int n) {
    if (mode == 0) return n;
    if (mode == 1) {
        if (n < 1024) { const int cs = n & 255, head = cs >> 6, d = cs & 63, a = d >> 5, pp = (d >> 4) & 1, f = d & 15;
            return (n & ~255) + 128 * ((f >> 2) & 1) + 32 * head + 16 * pp + 4 * (2 * a + (f >> 3)) + (f & 3); }
        if (n < 1792) return n;
        { const int mm = n - 1792, cs = mm & 255;
          return 2048 + (mm & ~255) + 128 * ((cs >> 2) & 1) + 32 * ((cs >> 5) & 3) + 16 * (cs >> 7) + 4 * ((cs >> 3) & 3) + (cs & 3); }
    }
    const int r = 256 * (n >> 7) + 128 * ((n >> 2) & 1) + 32 * ((n >> 5) & 3) + 4 * ((n >> 3) & 3) + (n & 3);
    return mode == 2 ? r : r + 16;
}
__device__ __forceinline__ void transpose_item(const float* W, int ldw, int K, bf16_t* WT, int mode, LAS float* scr, int kb, int nb, int lane) {
    const int k0 = 64 * kb, n0 = 32 * nb;
#pragma unroll 8
    for (int i = 0; i < 32; ++i) { const int kk = 2 * i + (lane >> 5); scr[kk * 33 + (lane & 31)] = W[(size_t)(k0 + kk) * ldw + n0 + (lane & 31)]; }
    asm volatile("s_waitcnt lgkmcnt(0)" ::: "memory");
    const int c = lane & 7;
#pragma unroll
    for (int j = 0; j < 4; ++j) { const int n = (lane >> 3) + 8 * j; const LAS float* s = scr + (8 * c) * 33 + n;
        u32x4 o; o.x = cvt_pk_bf16(s[0 * 33], s[1 * 33]); o.y = cvt_pk_bf16(s[2 * 33], s[3 * 33]); o.z = cvt_pk_bf16(s[4 * 33], s[5 * 33]); o.w = cvt_pk_bf16(s[6 * 33], s[7 * 33]);
        *(u32x4*)(WT + (size_t)drow_map(mode, n0 + n) * K + k0 + 8 * c) = o; }
    asm volatile("s_waitcnt lgkmcnt(0)" ::: "memory");
}

__device__ __forceinline__ void prep_phase(const Params& p, LAS unsigned char* lds) {
    const int tid = fresh_tid(), lane = tid & 63, wave = tid >> 6, G = gridDim.x;
    const int gw = blockIdx.x * 8 + wave, NGW = G * 8;
    const int gt = blockIdx.x * 512 + tid, NGT = G * 512;
    unsigned char* ws = p.ws;
    LAS float* tab = (LAS float*)(lds + 73728);
    LAS float* t64c = tab + 2048; LAS float* t64s = t64c + 64;
    for (int m = tid; m < 2048; m += 512) tab[m] = cospif((float)m * (1.f / 1024.f));
    if (tid < 64) { t64c[tid] = cospif((float)tid * (1.f / 32.f)); t64s[tid] = sinpif((float)tid * (1.f / 32.f)); }
    __syncthreads();
    if (gt < 1024) { const int pos = gt >> 4, f = gt & 15; const float inv = powf(10000.f, -(float)f / 16.f); const float ang = (float)pos * inv;
        float* rope = (float*)(ws + WS_ROPE); rope[gt] = cosf(ang); rope[1024 + gt] = sinf(ang); }
    {
        LAS float* scr = (LAS float*)(lds + wave * 8448);
        constexpr int I_IN = 16 * 72, I_OUT = 16 * 32, I_F1 = 16 * 88, I_F2 = 44 * 32, I_L = I_IN + I_OUT + 2 * I_F1 + I_F2;
        for (int it = gw; it < 2 * I_L; it += NGW) {
            const int l = it / I_L; int r = it % I_L;
            if (r < I_IN) { const int kb = r / 72, nb = r % 72; if (nb >= 48 && nb < 56) continue;
                transpose_item(p.w_in + (size_t)l * DM * INW_SRC, INW_SRC, DM, (bf16_t*)(ws + WS_WIN) + (size_t)l * INW * DM, 1, scr, kb, nb, lane); continue; }
            r -= I_IN;
            if (r < I_OUT) { transpose_item(p.w_out + (size_t)l * DM * DM, DM, DM, (bf16_t*)(ws + WS_WOUT) + (size_t)l * DM * DM, 0, scr, r / 32, r % 32, lane); continue; }
            r -= I_OUT;
            if (r < I_F1) { transpose_item(p.w_ffn1 + (size_t)l * DM * DFF, DFF, DM, (bf16_t*)(ws + WS_W13) + (size_t)l * N13 * DM, 2, scr, r / 88, r % 88, lane); continue; }
            r -= I_F1;
            if (r < I_F1) { transpose_item(p.w_ffn3 + (size_t)l * DM * DFF, DFF, DM, (bf16_t*)(ws + WS_W13) + (size_t)l * N13 * DM, 3, scr, r / 88, r % 88, lane); continue; }
            r -= I_F1;
            transpose_item(p.w_ffn2 + (size_t)l * DFF * DM, DM, DFF, (bf16_t*)(ws + WS_W2) + (size_t)l * DM * DFF, 0, scr, r / 32, r % 32, lane);
        }
    }
    {
        const float tcl = cospif((float)lane * (1.f / 32.f)), tsl = sinpif((float)lane * (1.f / 32.f));
        for (int it = gw; it < 2 * 4 * 16 * 16; it += NGW) {
            const int l = it >> 10, g = (it >> 8) & 3, kbk = (it >> 4) & 15, lqg = it & 15;
            const int k = kbk * 64 + lane;
            const float* wr_ = p.w_in + (size_t)l * DM * INW_SRC + (size_t)k * INW_SRC + 1536 + g * 64;
            float wv[64];
#pragma unroll
            for (int c4 = 0; c4 < 16; ++c4) { const f32x4 v = *(const f32x4*)(wr_ + 4 * c4); wv[4 * c4] = v[0]; wv[4 * c4 + 1] = v[1]; wv[4 * c4 + 2] = v[2]; wv[4 * c4 + 3] = v[3]; }
            bf16_t* wt = (bf16_t*)(ws + WS_WIN) + (size_t)l * INW * DM;
#pragma unroll 1
            for (int li = 0; li < 4; ++li) {
                const int lq = __builtin_amdgcn_readfirstlane(lqg * 4 + li);
                float ac = 0.f, as = 0.f;
#pragma unroll
                for (int c = 0; c < 64; ++c) {
                    const int m = (lq * c) & 63;
                    const float ct = __int_as_float(__builtin_amdgcn_readlane(__float_as_int(tcl), m)), st = __int_as_float(__builtin_amdgcn_readlane(__float_as_int(tsl), m));
                    ac += wv[c] * ct; as += wv[c] * st;
                }
                wt[(size_t)(1536 + g * 64 + lq) * DM + k] = f2bf(ac);
                wt[(size_t)(1536 + 256 + g * 64 + lq) * DM + k] = f2bf(as);
            }
        }
    }
    for (int e = gt; e < 2 * WSM_L; e += NGT) {
        const int l = e / WSM_L, r = e % WSM_L; float v;
        if (r < 256 * 512) { const int n = r >> 9, k = r & 255; const int g = n >> 6, d = n & 63, g2 = k >> 6, c = k & 63; v = (g == g2) ? p.w_fourier[(((size_t)l * 4 + g) * 64 + c) * 64 + d] : 0.f; }
        else { const int r2 = r - 256 * 512, n = r2 >> 8, k = r2 & 255; v = p.w_conv_out[((size_t)l * 256 + k) * 256 + n]; }
        ((bf16_t*)(ws + WS_WSM))[e] = f2bf(v);
    }
    {
        const float nl = 1.f / sqrtf(2048.f * 64.f), nc = 1.f / 128.f;
        for (int e = gt; e < 2048 * 4096 / 8; e += NGT) {
            const int k = e >> 9, col0 = (e & 511) * 8, s = col0 >> 11; float v[8];
#pragma unroll
            for (int j = 0; j < 8; ++j) { const int n = (col0 + j) & 2047, m = (k * n) & 2047; v[j] = s ? -tab[(m - 512) & 2047] * nl : tab[m] * nl; }
            u32x4 o; o.x = cvt_pk_bf16(v[0], v[1]); o.y = cvt_pk_bf16(v[2], v[3]); o.z = cvt_pk_bf16(v[4], v[5]); o.w = cvt_pk_bf16(v[6], v[7]);
            *(u32x4*)((bf16_t*)(ws + WS_DFTL) + (size_t)e * 8) = o;
        }
        for (int e = gt; e < 256 * 512 / 8; e += NGT) {
            const int k = e >> 6, col0 = (e & 63) * 8, s = col0 >> 8; float v[8];
#pragma unroll
            for (int j = 0; j < 8; ++j) { const int n = (col0 + j) & 255, m = ((k * n) & 255) * 8; v[j] = s ? -tab[(m - 512) & 2047] * nc : tab[m] * nc; }
            u32x4 o; o.x = cvt_pk_bf16(v[0], v[1]); o.y = cvt_pk_bf16(v[2], v[3]); o.z = cvt_pk_bf16(v[4], v[5]); o.w = cvt_pk_bf16(v[6], v[7]);
            *(u32x4*)((bf16_t*)(ws + WS_DFTC) + (size_t)e * 8) = o;
        }
    }
    for (int it = gw; it < 2 * 96 * 8; it += NGW) {
        const int l = it / 768, r = it % 768, cgp = r >> 3, kc = r & 7;
        const int col = cgp * 64 + lane, k0 = kc * 128;
        float sv[9][2];
#pragma unroll
        for (int b = 0; b < 9; ++b)
#pragma unroll
            for (int hh = 0; hh < 2; ++hh) { const int k = k0 + hh * 64 + lane; const float cv = (b < 8) ? p.c[b * DM + k] : p.c_ctx[k]; sv[b][hh] = cv * sigmoidf_(cv); }
        float ac[9];
#pragma unroll
        for (int b = 0; b < 9; ++b) ac[b] = 0.f;
        const float* wp = p.w_ada + ((size_t)l * DM + k0) * 6144 + col;
#pragma unroll
        for (int hh = 0; hh < 2; ++hh) {
#pragma unroll 8
            for (int kk = 0; kk < 64; ++kk) {
                const float wv = wp[(size_t)(hh * 64 + kk) * 6144];
#pragma unroll
                for (int b = 0; b < 9; ++b) ac[b] += __int_as_float(__builtin_amdgcn_readlane(__float_as_int(sv[b][hh]), kk)) * wv;
            }
        }
        const float bias = (kc == 0) ? p.b_ada[l * 6144 + col] : 0.f;
        float* mod = (float*)(ws + WS_MOD) + (size_t)l * 9 * 6144;
#pragma unroll
        for (int b = 0; b < 9; ++b) atomicAdd(mod + b * 6144 + col, ac[b] + bias);
    }
}

__device__ __forceinline__ void norm_phase(const float* xlat, const float* xctx, const float* gvec, const float* mod, int sh_off, int sc_off, bf16_t* H, int nrows,
                                           const float* part, const float* pgate, float* xctx_out) {
    const int tid = fresh_tid(), lane = tid & 63, gw = blockIdx.x * 8 + (tid >> 6), NGW = gridDim.x * 8;
    f32x4 vn[4];
#define NORM_LOADX(dst, r_) do { const int r__ = (r_); const float* xr_ = r__ < NLAT ? xlat + (size_t)r__ * DM : xctx + (size_t)(r__ - NLAT) * DM; \
        _Pragma("unroll") for (int j = 0; j < 4; ++j) dst[j] = *(const f32x4*)(xr_ + 4 * lane + 256 * j); } while (0)
    if (gw < nrows) NORM_LOADX(vn, gw);
    for (int row = gw; row < nrows; row += NGW) {
        const int bb = row < NLAT ? row >> 11 : 8;
        f32x4 v[4]; float ss = 0.f;
#pragma unroll
        for (int j = 0; j < 4; ++j) v[j] = vn[j];
        if (row + NGW < nrows) NORM_LOADX(vn, row + NGW);
        const float* mp = mod + bb * 6144;
        f32x4 gg[4], sc[4], sh[4];
#pragma unroll
        for (int j = 0; j < 4; ++j) { const int col = 4 * lane + 256 * j; gg[j] = *(const f32x4*)(gvec + col); sc[j] = *(const f32x4*)(mp + sc_off + col); sh[j] = *(const f32x4*)(mp + sh_off + col); }
        if (part != nullptr && row >= NLAT) {
#pragma unroll
            for (int j = 0; j < 4; ++j) {
                const size_t o = (size_t)(row - NLAT) * DM + 4 * lane + 256 * j;
                const f32x4 ps = (*(const f32x4*)(part + o) + *(const f32x4*)(part + (size_t)NCTX * DM + o)) + (*(const f32x4*)(part + (size_t)2 * NCTX * DM + o) + *(const f32x4*)(part + (size_t)3 * NCTX * DM + o));
                v[j] = v[j] + *(const f32x4*)(pgate + 4 * lane + 256 * j) * ps;
                *(f32x4*)(xctx_out + o) = v[j];
            }
        }
#pragma unroll
        for (int j = 0; j < 4; ++j) ss += (v[j][0] * v[j][0] + v[j][1] * v[j][1]) + (v[j][2] * v[j][2] + v[j][3] * v[j][3]);
        const float rstd = __builtin_amdgcn_rsqf(wave_sum(ss) * (1.f / DM) + EPSV);
#pragma unroll
        for (int j = 0; j < 4; ++j) {
            const int col = 4 * lane + 256 * j;
            const f32x4 y = (v[j] * rstd) * gg[j];
            const f32x4 hv = y * (sc[j] + 1.f) + sh[j];
            *(u32x2*)(H + (size_t)row * DM + col) = pack4(hv);
        }
    }
#undef NORM_LOADX
}

__global__ void __launch_bounds__(512, 2) fwd_kernel(Params p) {
    extern __shared__ __attribute__((aligned(16))) unsigned char lds_raw[];
    LAS unsigned char* lds = (LAS unsigned char*)lds_raw;
    cg::grid_group grid = cg::this_grid();
    const int G = gridDim.x, cu = blockIdx.x;
    unsigned char* ws = p.ws;
    bf16_t* H = (bf16_t*)(ws + WS_H);
    bf16_t* Q1 = (bf16_t*)(ws + WS_Q1); bf16_t* Q2 = (bf16_t*)(ws + WS_Q2); bf16_t* K1c = (bf16_t*)(ws + WS_K1); bf16_t* K2c = (bf16_t*)(ws + WS_K2);
    bf16_t* VT = (bf16_t*)(ws + WS_VT); bf16_t* TTl = (bf16_t*)(ws + WS_TTL); bf16_t* TTc = (bf16_t*)(ws + WS_TTC); bf16_t* UC = (bf16_t*)(ws + WS_UC);
    bf16_t* MIXA = (bf16_t*)(ws + WS_MIX); bf16_t* ACT = (bf16_t*)(ws + WS_ACT);
    float* PB1 = (float*)(ws + WS_R); float* PB2 = (float*)(ws + WS_R + 99 * MiB);
    bf16_t* FP = (bf16_t*)(ws + WS_H);
    float* XL = p.out; float* XC = (float*)(ws + WS_XCTX);
    const float* rope = (const float*)(ws + WS_ROPE);

    volatile LAS unsigned* bst = (volatile LAS unsigned*)(lds + LDS_BYTES - 64);
    if (threadIdx.x < 2) bst[threadIdx.x] = 0u;
    __syncthreads();
    const XcdBarrier xbar = xcd_barrier_post((unsigned*)(ws + WS_BAR), bst);
#define GSYNC() xcd_barrier(xbar)

    prep_phase(p, lds);
    grid.sync();

#pragma unroll 1
    for (int l = 0; l < 2; ++l) {
        const float* mod = (const float*)(ws + WS_MOD) + (size_t)l * 9 * 6144;
        const float* xin_l = l == 0 ? p.x : XL; const float* xin_c = l == 0 ? p.ctx : XC;
        const int mrows = l == 0 ? MTOT : NLAT;
        if (PROBE == 3) { for (int rep = 0; rep < 8; ++rep) GSYNC(); }
        norm_phase(xin_l, xin_c, p.norm1_g + l * DM, mod, 0, 1024, H, MTOT, l == 1 ? PB2 : nullptr, (const float*)(ws + WS_MOD) + 8 * 6144 + 5120, XC);
        GSYNC();
        for (int rep = 0; rep < (PROBE == 4 ? 2 : 1); ++rep) {
            if (rep) GSYNC();
            pg8::Gemm g{H, (const bf16_t*)(ws + WS_WIN) + (size_t)l * INW * DM, MTOT, INW, DM, DM, DM, 0};
            pg8::StaticOrder S; S.init(MTOT, INW, G, cu);
            EpiInProj E{Q1, Q2, K1c, K2c, VT, TTl, TTc, UC, rope};
            pg8::gemm_phase<EpiInProj, pg8::StaticOrder, true>(lds, g, S, E);
        }
        GSYNC();
        for (int rep = 0; rep < (PROBE == 1 ? 2 : 1); ++rep) {
            if (rep) GSYNC();
            const float li = 0.8f - 0.6f * __expf(-0.3f * (float)l);
            float lam;
            { const int lane = fresh_tid() & 63;
              const float s1 = wave_sum(p.lam_q1[l * 64 + lane] * p.lam_k1[l * 64 + lane]), s2 = wave_sum(p.lam_q2[l * 64 + lane] * p.lam_k2[l * 64 + lane]);
              lam = expf(s1) - expf(s2) + li; }
            att::Args A{Q1, Q2, K1c, K2c, VT, MIXA, p.subln_g + l * 128, lam, 1.f - li};
            const int n_att = 512 + (l == 0 ? 64 : 0);
            for (int u = cu; u < n_att; u += G) {
                if (u < 512) att::attn_unit(lds, A, u >> 6, (u >> 4) & 3, (u >> 6) * SEQ + (u & 15) * 128, 36);
                else { const int v = u - 512; att::attn_unit(lds, A, v >> 3, (v >> 1) & 3, NLAT + (v >> 3) * CTXL + (v & 1) * 128, 4); }
            }
#pragma unroll 1
            for (int hf = 0; hf < 2; ++hf) {
                pg8::Gemm g{(const bf16_t*)(ws + WS_DFTL) + hf * 2048, TTl + hf * 2048, 2048, 2048, 2048, 4096, 4096, 0};
                pg8::OffsetOrder S; S.init(2048, 2048, G, cu, 64 + 64 * hf);
                EpiMix E{FP, 512, hf * 256, 0, SEQ, 0};
                pg8::gemm_phase<EpiMix, pg8::OffsetOrder, true>(lds, g, S, E);
            }
            if (l == 0) {
#pragma unroll 1
                for (int hf = 0; hf < 2; ++hf) {
                    pg8::Gemm g{(const bf16_t*)(ws + WS_DFTC) + hf * 256, TTc + hf * 256, 256, 2048, 256, 512, 512, 0};
                    pg8::OffsetOrder S; S.init(256, 2048, G, cu, 192 + 8 * hf);
                    EpiMix E{FP, 512, hf * 256, NLAT, CTXL, 0};
                    pg8::gemm_phase<EpiMix, pg8::OffsetOrder, true>(lds, g, S, E);
                }
            }
            const int n_conv = l == 0 ? 288 : 256;
            if (G == 256) {
                const int sidx = cu < 64 ? cu : (cu >= 192 ? cu - 128 : -1);
                if (sidx >= 0) for (int it = sidx; it < n_conv; it += 128) conv_item(p, lds, l, it, UC, MIXA);
            } else for (int it = cu; it < n_conv; it += G) conv_item(p, lds, l, it, UC, MIXA);
        }
        GSYNC();
        {
            const bf16_t* wsm = (const bf16_t*)(ws + WS_WSM) + (size_t)l * WSM_L;
            {
                pg8::Gemm g{FP, wsm, mrows, 256, 512, 512, 512, 0};
                pg8::OffsetOrder S; S.init(mrows, 256, G, cu, 0);
                EpiMix E{MIXA, DM, 512, 0, 0, 0};
                pg8::gemm_phase<EpiMix, pg8::OffsetOrder, true>(lds, g, S, E);
            }
            {
                pg8::Gemm g{MIXA + 768, wsm + 256 * 512, mrows, 256, 256, DM, 256, 0};
                pg8::OffsetOrder S; S.init(mrows, 256, G, cu, 72);
                EpiMix E{MIXA, DM, 768, 0, 0, 0};
                pg8::gemm_phase<EpiMix, pg8::OffsetOrder, true>(lds, g, S, E);
            }
        }
        GSYNC();
        {
            pg8::Gemm g{MIXA, (const bf16_t*)(ws + WS_WOUT) + (size_t)l * DM * DM, mrows, DM, DM, DM, DM, 0};
            EpiRes E{xin_l, xin_c, XL, XC, mod, 2048, PB1};
            if (l == 0) { pg8::CtxSplitOrder S; S.init(DM, DM, G, cu); pg8::gemm_phase<EpiRes, pg8::CtxSplitOrder, true>(lds, g, S, E); }
            else if (G == 256) {
                pg8::StaticOrder S; S.init(mrows, DM, G, cu);
                EpiPanelNorm<1> EN{xin_l, XL, mod, 2048, p.norm2_g + l * DM, (unsigned*)(ws + WS_R), (unsigned*)(ws + WS_PCNT) + 64 * 64, H, 3072, 4096};
                pg8::gemm_phase<EpiPanelNorm<1>, pg8::StaticOrder, true>(lds, g, S, EN);
            }
            else { pg8::StaticOrder S; S.init(mrows, DM, G, cu); pg8::gemm_phase<EpiRes, pg8::StaticOrder, true>(lds, g, S, E); }
        }
        GSYNC();
        if (!(l == 1 && G == 256)) {
        norm_phase(XL, l == 0 ? p.ctx : XC, p.norm2_g + l * DM, mod, 3072, 4096, H, mrows, l == 0 ? PB1 : nullptr, mod + 8 * 6144 + 2048, XC);
        GSYNC();
        }
        for (int rep = 0; rep < (PROBE == 2 ? 2 : 1); ++rep) {
            if (rep) GSYNC();
            pg8::Gemm g{H, (const bf16_t*)(ws + WS_W13) + (size_t)l * N13 * DM, mrows, N13, DM, DM, DM, 0};
            pg8::StaticOrder S; S.init(mrows, N13, G, cu);
            EpiFfn13 E{ACT};
            pg8::gemm_phase<EpiFfn13, pg8::StaticOrder, true>(lds, g, S, E);
        }
        GSYNC();
        {
            pg8::Gemm g{ACT, (const bf16_t*)(ws + WS_W2) + (size_t)l * DM * DFF, mrows, DM, DFF, DFF, DFF, 0};
            EpiRes E{XL, XC, XL, XC, mod, 5120, PB2};
            if (l == 0) { pg8::CtxSplitOrder S; S.init(DM, DFF, G, cu); pg8::gemm_phase<EpiRes, pg8::CtxSplitOrder, true>(lds, g, S, E); }
            else if (G == 256) {
                pg8::StaticOrder S; S.init(mrows, DM, G, cu);
                EpiPanelNorm<0> EF{XL, XL, mod, 5120, p.final_g, (unsigned*)(ws + WS_H), (unsigned*)(ws + WS_PCNT), nullptr, 0, 0};
                pg8::gemm_phase<EpiPanelNorm<0>, pg8::StaticOrder, true>(lds, g, S, EF);
            }
            else { pg8::StaticOrder S; S.init(mrows, DM, G, cu); pg8::gemm_phase<EpiRes, pg8::StaticOrder, true>(lds, g, S, E); }
        }
        if (!(l == 1 && G == 256)) GSYNC();
    }
    if (G != 256) {
        const int tid = fresh_tid(), lane = tid & 63, gw = blockIdx.x * 8 + (tid >> 6), NGW = gridDim.x * 8;
        f32x4 gg[4], vn[4];
#pragma unroll
        for (int j = 0; j < 4; ++j) { gg[j] = *(const f32x4*)(p.final_g + 4 * lane + 256 * j); vn[j] = *(const f32x4*)(XL + (size_t)gw * DM + 4 * lane + 256 * j); }
        for (int row = gw; row < NLAT; row += NGW) {
            float* xr = XL + (size_t)row * DM;
            f32x4 v[4]; float ss = 0.f;
#pragma unroll
            for (int j = 0; j < 4; ++j) { v[j] = vn[j]; ss += (v[j][0] * v[j][0] + v[j][1] * v[j][1]) + (v[j][2] * v[j][2] + v[j][3] * v[j][3]); }
            if (row + NGW < NLAT) {
#pragma unroll
                for (int j = 0; j < 4; ++j) vn[j] = *(const f32x4*)(xr + (size_t)NGW * DM + 4 * lane + 256 * j);
            }
            const float rstd = __builtin_amdgcn_rsqf(wave_sum(ss) * (1.f / DM) + EPSV);
#pragma unroll
            for (int j = 0; j < 4; ++j) { const int col = 4 * lane + 256 * j; *(f32x4*)(xr + col) = (v[j] * rstd) * gg[j]; }
        }
    }
}

extern "C" void kernel_launch(void* const* d_in, const int* in_sizes, int n_in, void* d_out, int out_size, void* d_ws, size_t ws_size, hipStream_t stream) {
    static int grid_blocks = 0;
    if (grid_blocks == 0) {
        if (n_in != 25 || ws_size < WS_END) { fprintf(stderr, "kernel_launch: unexpected n_in %d / ws %zu\n", n_in, ws_size); grid_blocks = -1; return; }
        int dev = 0, cus = 0, per_cu = 0;
        (void)hipGetDevice(&dev);
        (void)hipDeviceGetAttribute(&cus, hipDeviceAttributeMultiprocessorCount, dev);
        if (hipFuncSetAttribute((const void*)fwd_kernel, hipFuncAttributeMaxDynamicSharedMemorySize, LDS_BYTES) != hipSuccess) fprintf(stderr, "kernel_launch: hipFuncSetAttribute failed\n");
        if (hipOccupancyMaxActiveBlocksPerMultiprocessor(&per_cu, (const void*)fwd_kernel, 512, LDS_BYTES) != hipSuccess || per_cu < 1) { fprintf(stderr, "kernel_launch: occupancy query gave %d\n", per_cu); per_cu = 1; }
        (void)hipGetLastError();
        grid_blocks = cus * per_cu;
    }
    if (grid_blocks < 0) return;
    Params p{};
    const float** pp = (const float**)&p;
    for (int i = 0; i < 25; ++i) pp[i] = (const float*)d_in[i];
    p.out = (float*)d_out; p.ws = (unsigned char*)d_ws;
    (void)hipMemsetAsync((unsigned char*)d_ws + WS_MOD, 0, ZERO_BYTES, stream);
    void* args[] = {&p};
    hipError_t e = hipLaunchCooperativeKernel((const void*)fwd_kernel, dim3(grid_blocks), dim3(512), args, LDS_BYTES, stream);
    if (e != hipSuccess) fprintf(stderr, "cooperative launch failed: %s (grid %d)\n", hipGetErrorString(e), grid_blocks);
}
```

```cpp
#include <hip/hip_runtime.h>
#include <hip/hip_cooperative_groups.h>
#include <cstdint>
#include <cstdio>
namespace cg = cooperative_groups;
#ifndef PROBE
#define PROBE 0
#endif

#define LAS __attribute__((address_space(3)))
typedef unsigned short bf16_t;
typedef short bf16x8 __attribute__((ext_vector_type(8)));
typedef float f32x4 __attribute__((ext_vector_type(4)));
typedef float f32x16 __attribute__((ext_vector_type(16)));
typedef unsigned u32x4 __attribute__((ext_vector_type(4)));
typedef unsigned u32x2 __attribute__((ext_vector_type(2)));

constexpr int NB = 8, SEQ = 2048, DM = 1024, CTXL = 256, NLAT = NB * SEQ, NCTX = NB * CTXL, MTOT = NLAT + NCTX;
constexpr int INW = 2560, INW_SRC = 2304, DFF = 2816, N13 = 2 * DFF, KCAT = CTXL + SEQ;
constexpr float EPSV = 1e-6f;
constexpr float QSCALE = 0.125f * 1.4426950408889634f;
constexpr int LDS_BYTES = 147456;
constexpr int XCD_BAR_WORDS_C = 3456;

constexpr size_t MiB = 1u << 20;
constexpr size_t WS_WIN = 0, WS_WOUT = 10 * MiB, WS_W13 = 14 * MiB, WS_W2 = 36 * MiB, WS_WSM = 47 * MiB, WS_DFTL = 48 * MiB, WS_DFTC = 64 * MiB;
constexpr size_t WS_MOD = 64 * MiB + 256 * 1024, WS_ROPE = 64 * MiB + 768 * 1024, WS_XCTX = 65 * MiB, WS_H = 73 * MiB, WS_R = 109 * MiB;
constexpr size_t WS_Q1 = WS_R, WS_Q2 = WS_R + 9 * MiB, WS_K1 = WS_R + 18 * MiB, WS_K2 = WS_R + 27 * MiB, WS_VT = WS_R + 36 * MiB, WS_TTL = WS_R + 54 * MiB,
                 WS_TTC = WS_R + 70 * MiB, WS_UC = WS_R + 72 * MiB, WS_MIX = WS_R + 90 * MiB, WS_ACT = WS_R, WS_END = WS_R + 131 * MiB;
constexpr size_t MOD_BYTES = 2 * 9 * 6144 * 4;
constexpr int WSM_L = 256 * 512 + 256 * 256;
constexpr size_t WS_BAR = 64 * MiB + 704 * 1024, WS_PCNT = 64 * MiB + 784 * 1024, ZERO_BYTES = WS_PCNT + 4 * 64 * 256 - WS_MOD;

struct Params {
    const float *x, *c, *ctx, *c_ctx, *w_ada, *b_ada, *norm1_g, *norm2_g, *w_in, *lam_q1, *lam_k1, *lam_q2, *lam_k2, *subln_g, *w_fourier, *conv_w, *conv_b,
        *conv_ln_g, *conv_ln_b, *w_conv_out, *w_out, *w_ffn1, *w_ffn3, *w_ffn2, *final_g;
    float* out; unsigned char* ws;
};

__device__ __forceinline__ unsigned cvt_pk_bf16(float lo, float hi) { unsigned r; asm("v_cvt_pk_bf16_f32 %0, %1, %2" : "=v"(r) : "v"(lo), "v"(hi)); return r; }
__device__ __forceinline__ u32x2 pack4(f32x4 v) { u32x2 w; w.x = cvt_pk_bf16(v[0], v[1]); w.y = cvt_pk_bf16(v[2], v[3]); return w; }
__device__ __forceinline__ bf16_t f2bf(float v) { return (bf16_t)(cvt_pk_bf16(v, 0.f) & 0xffffu); }
__device__ __forceinline__ float wave_sum(float v) {
#pragma unroll
    for (int o = 1; o < 64; o <<= 1) v += __shfl_xor(v, o);
    return v;
}
__device__ __forceinline__ int fresh_tid() { int t = threadIdx.x; asm volatile("" : "+v"(t)); return t; }
__device__ __forceinline__ float max3f(float a, float b, float c) { float r; asm("v_max3_f32 %0, %1, %2, %3" : "=v"(r) : "v"(a), "v"(b), "v"(c)); return r; }
__device__ __forceinline__ float sigmoidf_(float v) { return __builtin_amdgcn_rcpf(1.f + __expf(-v)); }


#define XB_TMO      128
#define XB_XCNT(j)  (256  + 64 * (j))
#define XB_XSUB(j)  (1280 + 64 * (j))
#define XB_XGEN(j)  (2304 + 64 * (j))
#define XB_TOP      3328
#define XB_TOPGEN   3392
#define XCD_BAR_WORDS 3456
#define XB_SPIN_CAP (1u << 18)
__device__ __forceinline__ unsigned xb_ld(unsigned* p)              { return __hip_atomic_load(p, __ATOMIC_RELAXED, __HIP_MEMORY_SCOPE_AGENT); }
__device__ __forceinline__ unsigned xb_add(unsigned* p, unsigned v) { return __hip_atomic_fetch_add(p, v, __ATOMIC_RELAXED, __HIP_MEMORY_SCOPE_AGENT); }
__device__ __forceinline__ unsigned xb_xcc_id() { return (unsigned)__builtin_amdgcn_s_getreg((3 << 11) | 20) & 0xFu; }
#define XB_SPIN(cond, bar) do { unsigned _sp = 0; while (cond) { __builtin_amdgcn_s_sleep(1); \
    if ((++_sp & 255u) == 0u) { if (xb_ld(&(bar)[XB_TMO])) break; if (_sp > XB_SPIN_CAP) { atomicAdd(&(bar)[XB_TMO], 1u); break; } } } } while (0)
struct XcdBarrier { unsigned* bar; unsigned x; volatile LAS unsigned* st; };
__device__ __forceinline__ XcdBarrier xcd_barrier_post(unsigned* bar, volatile LAS unsigned* st) {
    XcdBarrier b; b.bar = bar; b.x = xb_xcc_id(); b.st = st;
    if (threadIdx.x == 0) (void)xb_add(&bar[XB_XCNT(b.x)], 1u);
    return b;
}
__device__ __forceinline__ void xcd_barrier_complete(unsigned* bar, unsigned x, unsigned& nloc, unsigned& nx) {
    const unsigned G = gridDim.x * gridDim.y * gridDim.z;
    unsigned sum, cnt, mine, sp = 0u;
    for (;;) {
        sum = 0u; cnt = 0u; mine = 0u;
#pragma unroll
        for (unsigned j = 0; j < 16; ++j) { const unsigned c = xb_ld(&bar[XB_XCNT(j)]); sum += c; cnt += (c > 0u) ? 1u : 0u; mine = (j == x) ? c : mine; }
        if (sum == G) break;
        __builtin_amdgcn_s_sleep(1);
        if ((++sp & 255u) == 0u) { if (xb_ld(&bar[XB_TMO])) break; if (sp > XB_SPIN_CAP) { atomicAdd(&bar[XB_TMO], 1u); break; } }
    }
    nloc = mine > 0u ? mine : 1u; nx = cnt > 0u ? cnt : 1u;
}
__device__ __forceinline__ void xcd_barrier(const XcdBarrier& b) {
    asm volatile("s_waitcnt vmcnt(0)" ::: "memory");
    __syncthreads();
    if (threadIdx.x == 0) {
        unsigned* bar = b.bar;
        __builtin_amdgcn_s_waitcnt(0);
        unsigned nloc = b.st[0], nx = b.st[1];
        if (nloc == 0u) { xcd_barrier_complete(bar, b.x, nloc, nx); b.st[0] = nloc; b.st[1] = nx; }
        const unsigned old = xb_add(&bar[XB_XSUB(b.x)], 1u);
        const unsigned gen = old / nloc;
        if (old + 1u == (gen + 1u) * nloc) {
            __builtin_amdgcn_fence(__ATOMIC_RELEASE, "agent");
            asm volatile("s_waitcnt vmcnt(0)" ::: "memory");
            const unsigned og = xb_add(&bar[XB_TOP], 1u);
            const unsigned tg = og / nx;
            if (og + 1u == (tg + 1u) * nx) xb_add(&bar[XB_TOPGEN], 1u);
            else XB_SPIN(xb_ld(&bar[XB_TOPGEN]) == tg, bar);
            __builtin_amdgcn_fence(__ATOMIC_ACQUIRE, "agent");
            xb_add(&bar[XB_XGEN(b.x)], 1u);
            asm volatile("s_waitcnt vmcnt(0)" ::: "memory");
        } else {
            XB_SPIN(xb_ld(&bar[XB_XGEN(b.x)]) == gen, bar);
            __builtin_amdgcn_fence(__ATOMIC_ACQUIRE, "agent");
            asm volatile("s_waitcnt vmcnt(0)" ::: "memory");
        }
    }
    __syncthreads();
}

namespace pg8 {
constexpr int BM = 256, BK = 64, HALF = 128, HTB = HALF * BK * 2, STAGE_BYTES = 8 * HTB, NXCD = 8, WGM = 8;
__host__ __device__ __forceinline__ int lds_byte(int r, int c) { const int st = (r >> 4) * 2 + (c >> 5), rr = r & 15, cc = c & 31, ob = rr * 64 + cc * 2; return st * 1024 + (ob ^ (((ob >> 9) & 1) << 5)); }
__host__ __device__ __forceinline__ void stage_rc(int b, int& R, int& C) { const int st = b / 1024, sb = b % 1024, swz = sb ^ (((sb >> 9) & 1) << 5); R = (st >> 1) * 16 + swz / 64; C = (st & 1) * 32 + (swz % 64) / 2; }

__host__ __device__ __forceinline__ int perm32(int rho) { const int n = rho >> 4, i = rho & 15; return 8 * (i >> 2) + 4 * n + (i & 3); }
struct Unit { int pm, pn, k0, nt, flags; };
struct Gemm { const bf16_t* A; const bf16_t* Bt; int M, N, K, lda, ldb, a_pn_off; };

struct StaticOrder {
    int nM, nN, nwg, G, c;
    __host__ __device__ void init(int M, int N, int G_, int c_) { nM = M / BM; nN = N / BM; nwg = nM * nN; G = G_; c = c_; }
    __host__ __device__ __forceinline__ bool next(int i, Unit& u) const {
        const long L = (long)i * G + c; if (L >= nwg) return false;
        int wgid = (int)L; { const int q = nwg / NXCD, r = nwg % NXCD, xcd = wgid % NXCD, off = wgid / NXCD; wgid = (xcd < r ? xcd * (q + 1) : r * (q + 1) + (xcd - r) * q) + off; }
        const int nig = WGM * nN, gid = wgid / nig, fm = gid * WGM, gsz = (nM - fm) < WGM ? (nM - fm) : WGM;
        u.pm = fm + ((wgid % nig) % gsz); u.pn = (wgid % nig) / gsz; u.k0 = 0; u.nt = -1; u.flags = 0; return true;
    }
};
struct OffsetOrder {
    int nN, nwg, G, cc;
    __host__ __device__ void init(int M, int N, int G_, int c_, int off) { nN = N / BM; nwg = (M / BM) * nN; G = G_; cc = ((c_ - off) % G_ + G_) % G_; }
    __host__ __device__ __forceinline__ bool next(int i, Unit& u) const { const long L = (long)i * G + cc; if (L >= nwg) return false; u.pm = (int)L / nN; u.pn = (int)L % nN; u.k0 = 0; u.nt = -1; u.flags = 0; return true; }
};

struct CtxSplitOrder {
    StaticOrder lat; int nN, ntf;
    __host__ __device__ void init(int N, int K, int G_, int c_) { lat.init(NLAT, N, G_, c_); nN = N / BM; ntf = K / BK; }
    __host__ __device__ __forceinline__ bool next(int i, Unit& u) const {
        const long L = (long)i * lat.G + lat.c;
        int pm, pn, k0 = 0, ntq = -1, fl = 0;
        if (L < lat.nwg) {
            int wgid = (int)L; { const int q = lat.nwg / NXCD, r = lat.nwg % NXCD, xcd = wgid % NXCD, off = wgid / NXCD; wgid = (xcd < r ? xcd * (q + 1) : r * (q + 1) + (xcd - r) * q) + off; }
            const int nig = WGM * lat.nN, gid = wgid / nig, fm = gid * WGM, gsz = (lat.nM - fm) < WGM ? (lat.nM - fm) : WGM;
            pm = fm + ((wgid % nig) % gsz); pn = (wgid % nig) / gsz;
        } else {
            const int s = (int)(L - lat.nwg); if (s >= (NCTX / BM) * nN * 4) return false;
            const int cu_ = s >> 2, q = s & 3, base = (ntf / 8) * 2, extra = (ntf - 4 * base) / 2;
            pm = NLAT / BM + cu_ / nN; pn = cu_ % nN; ntq = base + (q < extra ? 2 : 0); k0 = (q * base + 2 * (q < extra ? q : extra)) * BK; fl = 1 | (q << 1);
        }
        u.pm = pm; u.pn = pn; u.k0 = k0; u.nt = ntq; u.flags = fl; return true;
    }
};

template <class Epi, class Sched, bool ALIGN_EPI>
__device__ __forceinline__ void gemm_phase(LAS unsigned char* lds, const Gemm g, const Sched& S, const Epi& E) {
    const int tid = fresh_tid(), wid = __builtin_amdgcn_readfirstlane(tid >> 6), lane = tid & 63, wr = wid >> 2, wc = wid & 3, fr = lane & 15, fq = lane >> 4;
    const int K = g.K, nt = K / BK;
    unsigned voffA[2], voffB[2];
#pragma unroll
    for (int i = 0; i < 2; ++i) { int R, C; stage_rc(tid * 16 + i * 8192, R, C);
        const int Rb = Epi::PERM ? ((R & ~31) + perm32(R & 31)) : R;
        voffA[i] = (unsigned)(R * g.lda + C) * 2u; voffB[i] = (unsigned)(Rb * g.ldb + C) * 2u; }
    const size_t kstep = (size_t)(BK * 2);
    const size_t hstepA = (size_t)HALF * g.lda * 2, hstepB = (size_t)HALF * g.ldb * 2;
    const size_t tstepA = 2 * hstepA, tstepB = 2 * hstepB;
    const unsigned ldsw = (unsigned)wid * 1024u;
    const int aoff = lds_byte(wr * 64 + fr, fq * 8), boff = lds_byte(wc * 32 + fr, fq * 8);
#define PG8_SA(b, h) (((b) * 2 + (h)) * HTB)
#define PG8_SB(b, h) ((4 + (b) * 2 + (h)) * HTB)
#define PG8_STAGE(bufoff, gbase, voff) do { _Pragma("unroll") for (int _i = 0; _i < 2; ++_i) \
        __builtin_amdgcn_global_load_lds((const unsigned*)((const char*)(gbase) + (voff)[_i]), (LAS unsigned*)(lds + (bufoff) + ldsw + _i * 8192), 16, 0, 0); } while (0)
#define PG8_LDA(dst, b, h) do { _Pragma("unroll") for (int m = 0; m < 4; ++m) _Pragma("unroll") for (int k = 0; k < 2; ++k) dst[m][k] = *(const LAS bf16x8*)(lds + PG8_SA(b, h) + aoff + m * 2048 + k * 1024); } while (0)
#define PG8_LDB(dst, b, h) do { _Pragma("unroll") for (int n = 0; n < 2; ++n) _Pragma("unroll") for (int k = 0; k < 2; ++k) dst[n][k] = *(const LAS bf16x8*)(lds + PG8_SB(b, h) + boff + n * 2048 + k * 1024); } while (0)
#define PG8_MMA(ai, bj, At, Bt) do { __builtin_amdgcn_s_setprio(1); _Pragma("unroll") for (int m = 0; m < 4; ++m) _Pragma("unroll") for (int n = 0; n < 2; ++n) _Pragma("unroll") for (int k = 0; k < 2; ++k) \
        acc[ai][bj][m][n] = __builtin_amdgcn_mfma_f32_16x16x32_bf16(Bt[n][k], At[m][k], acc[ai][bj][m][n], 0, 0, 0); __builtin_amdgcn_s_setprio(0); } while (0)
#define PG8_WAIT_V(n) asm volatile("s_waitcnt vmcnt(" #n ")" ::: "memory")
#define PG8_WAIT_L(n) asm volatile("s_waitcnt lgkmcnt(" #n ")" ::: "memory")
#define PG8_BAR __builtin_amdgcn_s_barrier()
#define PG8_SCHED __builtin_amdgcn_sched_barrier(0)
    Unit cur, nxt; int ui = 0;
    if (!S.next(0, cur)) return;
    f32x4 acc[2][2][4][2];
#pragma unroll
    for (int a = 0; a < 2; ++a)
#pragma unroll
        for (int b = 0; b < 2; ++b)
#pragma unroll
            for (int m = 0; m < 4; ++m)
#pragma unroll
                for (int n = 0; n < 2; ++n) acc[a][b][m][n] = (f32x4){0.f, 0.f, 0.f, 0.f};
    bf16x8 At[4][2], B0[2][2], B1[2][2];
    const char* cA = (const char*)g.A + (size_t)cur.pm * tstepA + (size_t)cur.pn * g.a_pn_off * 2 + (size_t)cur.k0 * 2; const char* cB = (const char*)g.Bt + (size_t)cur.pn * tstepB + (size_t)cur.k0 * 2;
    PG8_STAGE(PG8_SB(0, 0), cB, voffB); PG8_STAGE(PG8_SB(0, 1), cB + hstepB, voffB); PG8_STAGE(PG8_SA(0, 0), cA, voffA); PG8_STAGE(PG8_SA(0, 1), cA + hstepA, voffA);
    if (wr == 1) PG8_BAR;
    PG8_WAIT_V(2); PG8_BAR;
    PG8_STAGE(PG8_SB(1, 0), cB + kstep, voffB); PG8_STAGE(PG8_SA(1, 0), cA + kstep, voffA); PG8_STAGE(PG8_SB(1, 1), cB + hstepB + kstep, voffB);
    PG8_WAIT_V(6); PG8_BAR;
    for (;;) {
        const bool has_next = S.next(ui + 1, nxt);
        const char* nA = has_next ? (const char*)g.A + (size_t)nxt.pm * tstepA + (size_t)nxt.pn * g.a_pn_off * 2 + (size_t)nxt.k0 * 2 : cA; const char* nB = has_next ? (const char*)g.Bt + (size_t)nxt.pn * tstepB + (size_t)nxt.k0 * 2 : cB;
        const int ntc = cur.nt < 0 ? nt : cur.nt;
        for (int t = 0; t < ntc; t += 2) {
            const bool last = (t == ntc - 2);
            const char* a1 = cA + (size_t)(t + 1) * kstep;
            const char* a2 = last ? nA : cA + (size_t)(t + 2) * kstep; const char* b2 = last ? nB : cB + (size_t)(t + 2) * kstep;
            const char* a3 = a2 + kstep; const char* b3 = b2 + kstep;
            PG8_LDB(B0, 0, 0); PG8_LDB(B1, 0, 1); PG8_SCHED; PG8_LDA(At, 0, 0); PG8_STAGE(PG8_SA(1, 1), a1 + hstepA, voffA);
            PG8_WAIT_V(8); PG8_WAIT_L(0); PG8_BAR; PG8_MMA(0, 0, At, B0); PG8_MMA(0, 1, At, B1); PG8_BAR; PG8_SCHED;
            PG8_LDA(At, 0, 1); PG8_STAGE(PG8_SB(0, 0), b2, voffB); PG8_STAGE(PG8_SB(0, 1), b2 + hstepB, voffB); PG8_STAGE(PG8_SA(0, 0), a2, voffA);
            PG8_WAIT_V(8); PG8_WAIT_L(0); PG8_BAR; PG8_MMA(1, 0, At, B0); PG8_MMA(1, 1, At, B1); PG8_BAR; PG8_SCHED;
            PG8_LDB(B0, 1, 0); PG8_LDB(B1, 1, 1); PG8_SCHED; PG8_LDA(At, 1, 0); PG8_STAGE(PG8_SA(0, 1), a2 + hstepA, voffA);
            PG8_WAIT_V(8); PG8_WAIT_L(0); PG8_BAR; PG8_MMA(0, 0, At, B0); PG8_MMA(0, 1, At, B1); PG8_BAR; PG8_SCHED;
            PG8_LDA(At, 1, 1); PG8_STAGE(PG8_SB(1, 0), b3, voffB); PG8_STAGE(PG8_SB(1, 1), b3 + hstepB, voffB); PG8_STAGE(PG8_SA(1, 0), a3, voffA);
            PG8_WAIT_V(8); PG8_WAIT_L(0); PG8_BAR; PG8_MMA(1, 0, At, B0); PG8_MMA(1, 1, At, B1); PG8_BAR; PG8_SCHED;
        }
        if constexpr (ALIGN_EPI) { if (wr == 0) PG8_BAR; }
        if constexpr (!Epi::AFTER_DRAIN) { if constexpr (Epi::LOOP_LDS) E.loop(acc, cur, wr, wc, fr, fq, lds + 131072, wid, lane); else E(acc, cur, wr, wc, fr, fq); }
        if (!has_next) break;
#pragma unroll
        for (int a = 0; a < 2; ++a)
#pragma unroll
            for (int b = 0; b < 2; ++b)
#pragma unroll
                for (int m = 0; m < 4; ++m)
#pragma unroll
                    for (int n = 0; n < 2; ++n) acc[a][b][m][n] = (f32x4){0.f, 0.f, 0.f, 0.f};
        cur = nxt; cA = nA; cB = nB; ++ui;
        if constexpr (ALIGN_EPI) { if (wr == 1) PG8_BAR; }
    }
    PG8_WAIT_V(0);
    if constexpr (!ALIGN_EPI) { if (wr == 0) PG8_BAR; }
    PG8_BAR;
    if constexpr (Epi::AFTER_DRAIN) E.fused(acc, cur, wr, wc, fr, fq, lds, wid, lane);
#undef PG8_SA
#undef PG8_SB
#undef PG8_STAGE
#undef PG8_LDA
#undef PG8_LDB
#undef PG8_MMA
#undef PG8_WAIT_V
#undef PG8_WAIT_L
#undef PG8_BAR
#undef PG8_SCHED
}
}

typedef f32x4 Acc[2][2][4][2];

struct EpiInProj {
    static constexpr bool PERM = false;
    static constexpr bool AFTER_DRAIN = false;
    static constexpr bool LOOP_LDS = false;
    bf16_t *Q1, *Q2, *K1c, *K2c, *VT, *TTl, *TTc, *UC; const float* rope;
    __device__ __forceinline__ void operator()(const Acc& acc, const pg8::Unit& u, int wr, int wc, int fr, int fq) const {
        const int pn = u.pn; const bool lat = u.pm < 64;
#pragma unroll
        for (int ai = 0; ai < 2; ++ai)
#pragma unroll
            for (int m = 0; m < 4; ++m) {
                const int row = u.pm * 256 + ai * 128 + wr * 64 + m * 16 + fr;
                int b, t; if (lat) { b = row >> 11; t = row & 2047; } else { const int rc = row - NLAT; b = rc >> 8; t = rc & 255; }
                const int pos = lat ? CTXL + t : t;
                if (pn < 4) {
                    bf16_t* dst;
                    if (pn == 0) dst = Q1 + (size_t)row * 256; else if (pn == 1) dst = Q2 + (size_t)row * 256;
                    else if (pn == 2) dst = K1c + ((size_t)b * KCAT + pos) * 256; else dst = K2c + ((size_t)b * KCAT + pos) * 256;
                    const float scale = pn < 2 ? QSCALE : 1.f;
                    const int ax = fq >> 1, fh = fq & 1;
                    u32x4 w1, w2;
#pragma unroll
                    for (int bj = 0; bj < 2; ++bj) {
                        f32x4 cs = {1.f, 1.f, 1.f, 1.f}, sn = {0.f, 0.f, 0.f, 0.f};
                        if (lat) { const int pidx = ax ? (t & 63) : (t >> 6); cs = *(const f32x4*)(rope + pidx * 16 + 8 * fh + 4 * bj); sn = *(const f32x4*)(rope + 1024 + pidx * 16 + 8 * fh + 4 * bj); }
                        const f32x4 x1 = acc[ai][bj][m][0], x2 = acc[ai][bj][m][1];
                        const u32x2 p1 = pack4((x1 * cs - x2 * sn) * scale), p2 = pack4((x2 * cs + x1 * sn) * scale);
                        if (bj == 0) { w1.x = p1.x; w1.y = p1.y; w2.x = p2.x; w2.y = p2.y; } else { w1.z = p1.x; w1.w = p1.y; w2.z = p2.x; w2.w = p2.y; }
                    }
                    bf16_t* dq = dst + wc * 64 + ax * 32 + 8 * fh;
                    *(u32x4*)dq = w1; *(u32x4*)(dq + 16) = w2;
                } else if (pn < 6) {
#pragma unroll
                    for (int bj = 0; bj < 2; ++bj)
#pragma unroll
                        for (int n = 0; n < 2; ++n) {
                            bf16_t* dst = VT + ((size_t)(b * 4 + (pn - 4) * 2 + bj) * 128 + wc * 32 + n * 16 + 4 * fq) * KCAT + pos;
                            const f32x4 v = acc[ai][bj][m][n];
                            dst[0] = f2bf(v[0]); dst[KCAT] = f2bf(v[1]); dst[2 * KCAT] = f2bf(v[2]); dst[3 * KCAT] = f2bf(v[3]);
                        }
                } else if (pn < 8) {
                    const int s = pn - 6;
#pragma unroll
                    for (int bj = 0; bj < 2; ++bj)
#pragma unroll
                        for (int n = 0; n < 2; ++n) {
                            const int jf = bj * 128 + wc * 32 + n * 16 + 4 * fq;
                            const f32x4 v = acc[ai][bj][m][n];
                            if (lat) { bf16_t* dst = TTl + (((size_t)b * 256 + jf) * 2 + s) * SEQ + t; dst[0] = f2bf(v[0]); dst[2 * SEQ] = f2bf(v[1]); dst[4 * SEQ] = f2bf(v[2]); dst[6 * SEQ] = f2bf(v[3]); }
                            else { bf16_t* dst = TTc + (((size_t)b * 256 + jf) * 2 + s) * CTXL + t; dst[0] = f2bf(v[0]); dst[2 * CTXL] = f2bf(v[1]); dst[4 * CTXL] = f2bf(v[2]); dst[6 * CTXL] = f2bf(v[3]); }
                        }
                } else {
                    bf16_t* dst = UC + (size_t)row * 512 + (pn - 8) * 256 + wc * 32 + 8 * fq;
#pragma unroll
                    for (int n = 0; n < 2; ++n) { const u32x2 p0 = pack4(acc[ai][0][m][n]), p1 = pack4(acc[ai][1][m][n]); *(u32x4*)(dst + 128 * n) = (u32x4){p0.x, p0.y, p1.x, p1.y}; }
                }
            }
    }
};

struct EpiRes {
    static constexpr bool PERM = false;
    static constexpr bool AFTER_DRAIN = false;
    static constexpr bool LOOP_LDS = false;
    const float* xin_lat; const float* xin_ctx; float* xout_lat; float* xout_ctx; const float* mod; int goff; float* pb;
    __device__ __forceinline__ void operator()(const Acc& acc, const pg8::Unit& u, int wr, int wc, int fr, int fq) const {
        const int tile0 = u.pm * 256, colb = u.pn * 256 + wc * 32 + 4 * fq, rloc = wr * 64 + fr;
        if (u.flags & 1) {
            float* pq = pb + ((size_t)(u.flags >> 1) * NCTX + (tile0 - NLAT) + rloc) * DM + colb;
#pragma unroll
            for (int ai = 0; ai < 2; ++ai)
#pragma unroll
                for (int m = 0; m < 4; ++m)
#pragma unroll
                    for (int bj = 0; bj < 2; ++bj)
#pragma unroll
                        for (int n = 0; n < 2; ++n) *(f32x4*)(pq + (size_t)(ai * 128 + m * 16) * DM + bj * 128 + n * 16) = acc[ai][bj][m][n];
            return;
        }
        const bool lat = tile0 < NLAT;
        const float* xi = (lat ? xin_lat + (size_t)tile0 * DM : xin_ctx + (size_t)(tile0 - NLAT) * DM) + (size_t)rloc * DM + colb;
        float* xo = (lat ? xout_lat + (size_t)tile0 * DM : xout_ctx + (size_t)(tile0 - NLAT) * DM) + (size_t)rloc * DM + colb;
        const float* gp = mod + (lat ? (tile0 >> 11) : 8) * 6144 + goff + colb;
        f32x4 gt[2][2];
#pragma unroll
        for (int bj = 0; bj < 2; ++bj)
#pragma unroll
            for (int n = 0; n < 2; ++n) gt[bj][n] = *(const f32x4*)(gp + bj * 128 + n * 16);
        f32x4 xv[2][2][2];
#define ER_LOAD(buf, g_) do { const float* xp_ = xi + (size_t)(((g_) >> 2) * 128 + ((g_) & 3) * 16) * DM; \
            _Pragma("unroll") for (int bj = 0; bj < 2; ++bj) _Pragma("unroll") for (int n = 0; n < 2; ++n) xv[buf][bj][n] = *(const f32x4*)(xp_ + bj * 128 + n * 16); } while (0)
        ER_LOAD(0, 0);
#pragma unroll
        for (int g_ = 0; g_ < 8; ++g_) {
            if (g_ + 1 < 8) ER_LOAD((g_ + 1) & 1, g_ + 1);
            float* xq = xo + (size_t)((g_ >> 2) * 128 + (g_ & 3) * 16) * DM;
#pragma unroll
            for (int bj = 0; bj < 2; ++bj)
#pragma unroll
                for (int n = 0; n < 2; ++n) *(f32x4*)(xq + bj * 128 + n * 16) = xv[g_ & 1][bj][n] + gt[bj][n] * acc[g_ >> 2][bj][g_ & 3][n];
        }
#undef ER_LOAD
    }
};

template <int MODE>
struct EpiPanelNorm {
    static constexpr bool PERM = false;
    static constexpr bool AFTER_DRAIN = true;
    static constexpr bool LOOP_LDS = false;
    const float* xin; float* out; const float* mod; int goff; const float* final_g; unsigned* slots; unsigned* cnt; bf16_t* Hout; int sh_off, sc_off; const float* modn;
    __device__ __forceinline__ void fused(Acc& acc, const pg8::Unit& u, int wr, int wc, int fr, int fq, LAS unsigned char* lds, int wid, int lane) const {
        const int tile0 = u.pm * 256, colb = u.pn * 256 + wc * 32 + 4 * fq, rloc = wr * 64 + fr;
        const float* xi = xin + (size_t)(tile0 + rloc) * DM + colb;
        float* xo = out + (size_t)(tile0 + rloc) * DM + colb;
        const float* gp = mod + (tile0 >> 11) * 6144 + goff + colb;
        f32x4 gt[2][2];
#pragma unroll
        for (int bj = 0; bj < 2; ++bj)
#pragma unroll
            for (int n = 0; n < 2; ++n) gt[bj][n] = *(const f32x4*)(gp + bj * 128 + n * 16);
        f32x4 xv[1][2][2];
#define EF_LOAD(buf, g_) do { const float* xp_ = xi + (size_t)(((g_) >> 2) * 128 + ((g_) & 3) * 16) * DM; \
            _Pragma("unroll") for (int bj = 0; bj < 2; ++bj) _Pragma("unroll") for (int n = 0; n < 2; ++n) xv[buf][bj][n] = *(const f32x4*)(xp_ + bj * 128 + n * 16); } while (0)
        LAS float* P = (LAS float*)lds;
        LAS float* S = (LAS float*)(lds + 4096);
#pragma unroll
        for (int g_ = 0; g_ < 8; ++g_) {
            EF_LOAD(0, g_);
            float sq = 0.f;
#pragma unroll
            for (int bj = 0; bj < 2; ++bj)
#pragma unroll
                for (int n = 0; n < 2; ++n) { const f32x4 xn = xv[0][bj][n] + gt[bj][n] * acc[g_ >> 2][bj][g_ & 3][n]; acc[g_ >> 2][bj][g_ & 3][n] = xn;
                    if (MODE == 1) *(f32x4*)(xo + (size_t)((g_ >> 2) * 128 + (g_ & 3) * 16) * DM + bj * 128 + n * 16) = xn;
                    sq += (xn[0] * xn[0] + xn[1] * xn[1]) + (xn[2] * xn[2] + xn[3] * xn[3]); }
            sq += __shfl_xor(sq, 16); sq += __shfl_xor(sq, 32);
            if (fq == 0) P[((g_ >> 2) * 128 + wr * 64 + (g_ & 3) * 16 + fr) * 4 + wc] = sq;
        }
#undef EF_LOAD
        asm volatile("s_waitcnt lgkmcnt(0)" ::: "memory"); __builtin_amdgcn_s_barrier(); asm volatile("" ::: "memory");
        const int row = wid * 32 + (lane & 31);
        if (lane < 32) { const float tsum = (P[row * 4 + 0] + P[row * 4 + 1]) + (P[row * 4 + 2] + P[row * 4 + 3]);
            __hip_atomic_store(slots + (size_t)(tile0 + row) * 4 + u.pn, __float_as_uint(tsum), __ATOMIC_RELAXED, __HIP_MEMORY_SCOPE_AGENT); }
        asm volatile("s_waitcnt vmcnt(0)" ::: "memory");
        if (lane == 0) __hip_atomic_fetch_add(cnt + 64 * u.pm, 1u, __ATOMIC_RELAXED, __HIP_MEMORY_SCOPE_AGENT);
        if (wid == 0) {
            unsigned sp = 0;
            while ((unsigned)__builtin_amdgcn_readfirstlane(__hip_atomic_load(cnt + 64 * u.pm, __ATOMIC_RELAXED, __HIP_MEMORY_SCOPE_AGENT)) < 32u) { __builtin_amdgcn_s_sleep(2); if (++sp > (1u << 20)) break; }
            __builtin_amdgcn_fence(__ATOMIC_ACQUIRE, "agent");
        }
        asm volatile("s_waitcnt vmcnt(0) lgkmcnt(0)" ::: "memory"); __builtin_amdgcn_s_barrier(); asm volatile("" ::: "memory");
        if (lane < 32) { float tot = 0.f;
#pragma unroll
            for (int t4 = 0; t4 < 4; ++t4) tot += __uint_as_float(__hip_atomic_load(slots + (size_t)(tile0 + row) * 4 + t4, __ATOMIC_RELAXED, __HIP_MEMORY_SCOPE_AGENT));
            S[row] = __builtin_amdgcn_rsqf(tot * (1.f / DM) + EPSV); }
        asm volatile("s_waitcnt lgkmcnt(0)" ::: "memory"); __builtin_amdgcn_s_barrier(); asm volatile("" ::: "memory");
#pragma unroll
        for (int bj = 0; bj < 2; ++bj)
#pragma unroll
            for (int n = 0; n < 2; ++n) {
                const f32x4 fg = *(const f32x4*)(final_g + colb + bj * 128 + n * 16);
                f32x4 sc = {1.f, 1.f, 1.f, 1.f}, sh = {0.f, 0.f, 0.f, 0.f};
                if (MODE == 1) { const float* mp = modn + (tile0 >> 11) * 6144 + colb + bj * 128 + n * 16; sc = *(const f32x4*)(mp + sc_off) + 1.f; sh = *(const f32x4*)(mp + sh_off); }
#pragma unroll
                for (int g_ = 0; g_ < 8; ++g_) {
                    const float rs = S[(g_ >> 2) * 128 + wr * 64 + (g_ & 3) * 16 + fr];
                    const size_t ro = (size_t)((g_ >> 2) * 128 + (g_ & 3) * 16) * DM;
                    const f32x4 y = (acc[g_ >> 2][bj][g_ & 3][n] * rs) * fg;
                    if (MODE == 0) *(f32x4*)(xo + ro + bj * 128 + n * 16) = y;
                    else *(u32x2*)(Hout + (size_t)(tile0 + rloc) * DM + colb + ro + bj * 128 + n * 16) = pack4(y * sc + sh);
                }
            }
    }
};

struct EpiResNormL0 {
    static constexpr bool PERM = false;
    static constexpr bool AFTER_DRAIN = false;
    static constexpr bool LOOP_LDS = true;
    EpiPanelNorm<1> pn_; float* pb;
    __device__ __forceinline__ void loop(Acc& acc, const pg8::Unit& u, int wr, int wc, int fr, int fq, LAS unsigned char* lds, int wid, int lane) const {
        if (u.flags & 1) {
            const int tile0 = u.pm * 256, colb = u.pn * 256 + wc * 32 + 4 * fq, rloc = wr * 64 + fr;
            float* pq = pb + ((size_t)(u.flags >> 1) * NCTX + (tile0 - NLAT) + rloc) * DM + colb;
#pragma unroll
            for (int ai = 0; ai < 2; ++ai)
#pragma unroll
                for (int m = 0; m < 4; ++m)
#pragma unroll
                    for (int bj = 0; bj < 2; ++bj)
#pragma unroll
                        for (int n = 0; n < 2; ++n) *(f32x4*)(pq + (size_t)(ai * 128 + m * 16) * DM + bj * 128 + n * 16) = acc[ai][bj][m][n];
        } else pn_.fused(acc, u, wr, wc, fr, fq, lds, wid, lane);
    }
};

struct EpiFfn13 {
    static constexpr bool PERM = false;
    static constexpr bool AFTER_DRAIN = false;
    static constexpr bool LOOP_LDS = false;
    bf16_t* ACT;
    __device__ __forceinline__ void operator()(const Acc& acc, const pg8::Unit& u, int wr, int wc, int fr, int fq) const {
#pragma unroll
        for (int ai = 0; ai < 2; ++ai)
#pragma unroll
            for (int m = 0; m < 4; ++m) {
                const int row = u.pm * 256 + ai * 128 + wr * 64 + m * 16 + fr;
                u32x4 w;
#pragma unroll
                for (int bj = 0; bj < 2; ++bj) {
                    const f32x4 a = acc[ai][bj][m][0], b = acc[ai][bj][m][1]; f32x4 o;
#pragma unroll
                    for (int j = 0; j < 4; ++j) o[j] = a[j] * sigmoidf_(a[j]) * b[j];
                    const u32x2 pk = pack4(o);
                    if (bj == 0) { w.x = pk.x; w.y = pk.y; } else { w.z = pk.x; w.w = pk.y; }
                }
                *(u32x4*)(ACT + (size_t)row * DFF + 128 * u.pn + 32 * wc + 8 * fq) = w;
            }
    }
};

struct EpiMix {
    static constexpr bool PERM = true;
    static constexpr bool AFTER_DRAIN = false;
    static constexpr bool LOOP_LDS = false;
    bf16_t* out; int pitch, col0, tok_base, tok_pn_step, col_pn_step;
    __device__ __forceinline__ void operator()(const Acc& acc, const pg8::Unit& u, int wr, int wc, int fr, int fq) const {
#pragma unroll
        for (int ai = 0; ai < 2; ++ai)
#pragma unroll
            for (int m = 0; m < 4; ++m) {
                const int row = u.pm * 256 + ai * 128 + wr * 64 + m * 16 + fr;
                bf16_t* dst = out + (size_t)(tok_base + u.pn * tok_pn_step + row) * pitch + col0 + u.pn * col_pn_step + wc * 32 + 8 * fq;
#pragma unroll
                for (int bj = 0; bj < 2; ++bj) { const u32x2 p0 = pack4(acc[ai][bj][m][0]), p1 = pack4(acc[ai][bj][m][1]); *(u32x4*)(dst + bj * 128) = (u32x4){p0.x, p0.y, p1.x, p1.y}; }
            }
    }
};

namespace att {
constexpr int VP = 144, OFF_K1 = 0, OFF_K2 = 8192, OFF_VT = 16384, BUFSZ = 16384 + 128 * VP;
struct Args { const bf16_t *Q1, *Q2, *K1c, *K2c, *VT; bf16_t* MIXA; const float* subln; float lam, omli; };

__device__ __forceinline__ void attn_unit(LAS unsigned char* lds, const Args& A, int b, int h, int qrow0, int nkt) {
    const int tid = fresh_tid(), lane = tid & 63, r32 = lane & 31, hi = lane >> 5;
    const int wid = __builtin_amdgcn_readfirstlane(tid >> 6), map = wid >> 2, qg = wid & 3;
    const bf16_t* Qm = map ? A.Q2 : A.Q1;
    bf16x8 qf[4];
    { const bf16_t* qp = Qm + (size_t)(qrow0 + qg * 32 + r32) * 256 + h * 64 + hi * 8;
#pragma unroll
      for (int d0 = 0; d0 < 4; ++d0) qf[d0] = *(const bf16x8*)(qp + d0 * 16); }
    const int key_s = tid >> 3, ch_s = tid & 7;
    const bf16_t* k1src = A.K1c + ((size_t)b * KCAT + key_s) * 256 + h * 64 + ch_s * 8;
    const bf16_t* k2src = A.K2c + ((size_t)b * KCAT + key_s) * 256 + h * 64 + ch_s * 8;
    const bf16_t* vsrc = A.VT + ((size_t)(b * 4 + h) * 128 + key_s) * KCAT + ch_s * 8;
    const int kdst = key_s * 128 + ((ch_s ^ ((key_s >> 1) & 7)) << 4), vdst = key_s * VP + 32 * (ch_s >> 1) + 8 * (ch_s & 1);
    u32x4 rk1[2], rk2[2], rv0[2], rv1[2];
#define ATT_LOAD(set, t) do { rk1[set] = *(const u32x4*)(k1src + (size_t)(t) * 64 * 256); rk2[set] = *(const u32x4*)(k2src + (size_t)(t) * 64 * 256); \
        rv0[set] = *(const u32x4*)(vsrc + (t) * 64); rv1[set] = *(const u32x4*)(vsrc + (size_t)64 * KCAT + (t) * 64); } while (0)
#define ATT_STORE(set, buf) do { LAS unsigned char* bb_ = lds + (buf) * BUFSZ; *(LAS u32x4*)(bb_ + OFF_K1 + kdst) = rk1[set]; *(LAS u32x4*)(bb_ + OFF_K2 + kdst) = rk2[set]; \
        *(LAS u32x2*)(bb_ + OFF_VT + vdst) = (u32x2){rv0[set].x, rv0[set].y}; *(LAS u32x2*)(bb_ + OFF_VT + vdst + 16) = (u32x2){rv0[set].z, rv0[set].w}; \
        *(LAS u32x2*)(bb_ + OFF_VT + 64 * VP + vdst) = (u32x2){rv1[set].x, rv1[set].y}; *(LAS u32x2*)(bb_ + OFF_VT + 64 * VP + vdst + 16) = (u32x2){rv1[set].z, rv1[set].w}; } while (0)
    constexpr float THR = 6.f;
    float mrun = 0.f, lrun = 0.f;
    f32x16 O[4];
#pragma unroll
    for (int i = 0; i < 4; ++i)
#pragma unroll
        for (int r = 0; r < 16; ++r) O[i][r] = 0.f;
    ATT_LOAD(0, 0); ATT_STORE(0, 0); __syncthreads();
    ATT_LOAD(1, 1);
    for (int t0 = 0; t0 < nkt; t0 += 2) {
#pragma unroll
      for (int tt = 0; tt < 2; ++tt) {
        const int t = t0 + tt, cur = tt;
        if (t + 2 < nkt) ATT_LOAD(tt, t + 2);
        LAS unsigned char* base = lds + cur * BUFSZ;
        LAS unsigned char* kb = base + (map ? OFF_K2 : OFF_K1) + r32 * 128;
        f32x16 s0, s1;
#pragma unroll
        for (int r = 0; r < 16; ++r) { s0[r] = -mrun; s1[r] = -mrun; }
#pragma unroll
        for (int d0 = 0; d0 < 4; ++d0) {
            const int chunk = ((2 * d0 + hi) ^ ((r32 >> 1) & 7)) << 4;
            const bf16x8 a0 = *(const LAS bf16x8*)(kb + chunk), a1 = *(const LAS bf16x8*)(kb + 32 * 128 + chunk);
            s0 = __builtin_amdgcn_mfma_f32_32x32x16_bf16(a0, qf[d0], s0, 0, 0, 0);
            s1 = __builtin_amdgcn_mfma_f32_32x32x16_bf16(a1, qf[d0], s1, 0, 0, 0);
        }
        asm volatile("s_nop 15\n\ts_nop 4" : "+v"(s0), "+v"(s1));
        LAS unsigned char* vb = base + OFF_VT + r32 * VP + 16 * hi;
        u32x4 vf[2][4];
#define ATT_LDV(slot, c) do { _Pragma("unroll") for (int dblk = 0; dblk < 4; ++dblk) { \
            vf[slot][dblk] = *(const LAS u32x4*)(vb + dblk * 32 * VP + 32 * (c)); } } while (0)
        ATT_LDV(0, 0);
        __builtin_amdgcn_sched_barrier(0);
        float rm = max3f(s0[0], s0[1], s1[0]), rm2 = max3f(s0[2], s0[3], s1[1]);
        rm = max3f(rm, s1[2], s1[3]);
#pragma unroll
        for (int r = 4; r < 16; r += 4) { rm = max3f(rm, s0[r], s0[r + 1]); rm2 = max3f(rm2, s0[r + 2], s0[r + 3]); rm = max3f(rm, s1[r], s1[r + 1]); rm2 = max3f(rm2, s1[r + 2], s1[r + 3]); }
        rm = fmaxf(rm, rm2);
        rm = fmaxf(rm, __shfl_xor(rm, 32));
        const bool need = (t == 0) || (rm > THR);
        if (__any(need)) {
            const float dlt = need ? rm : 0.f, alpha = (t == 0) ? 1.f : __builtin_amdgcn_exp2f(-dlt);
            mrun += dlt; lrun *= alpha;
            s0 = s0 - dlt; s1 = s1 - dlt;
#pragma unroll
            for (int i = 0; i < 4; ++i)
#pragma unroll
                for (int r = 0; r < 16; ++r) O[i][r] *= alpha;
        }
#pragma unroll
        for (int r = 0; r < 16; ++r) { s0[r] = __builtin_amdgcn_exp2f(s0[r]); s1[r] = __builtin_amdgcn_exp2f(s1[r]); }
        { const f32x16 t16 = s0 + s1;
          typedef float f32x8 __attribute__((ext_vector_type(8)));
          const f32x8 t8 = t16.lo + t16.hi; const f32x4 t4 = t8.lo + t8.hi;
          lrun += (t4[0] + t4[1]) + (t4[2] + t4[3]); }
        bf16x8 P[4];
        { u32x4 w;
          w.x = cvt_pk_bf16(s0[0], s0[1]); w.y = cvt_pk_bf16(s0[2], s0[3]); w.z = cvt_pk_bf16(s0[4], s0[5]); w.w = cvt_pk_bf16(s0[6], s0[7]); P[0] = __builtin_bit_cast(bf16x8, w);
          w.x = cvt_pk_bf16(s0[8], s0[9]); w.y = cvt_pk_bf16(s0[10], s0[11]); w.z = cvt_pk_bf16(s0[12], s0[13]); w.w = cvt_pk_bf16(s0[14], s0[15]); P[1] = __builtin_bit_cast(bf16x8, w);
          w.x = cvt_pk_bf16(s1[0], s1[1]); w.y = cvt_pk_bf16(s1[2], s1[3]); w.z = cvt_pk_bf16(s1[4], s1[5]); w.w = cvt_pk_bf16(s1[6], s1[7]); P[2] = __builtin_bit_cast(bf16x8, w);
          w.x = cvt_pk_bf16(s1[8], s1[9]); w.y = cvt_pk_bf16(s1[10], s1[11]); w.z = cvt_pk_bf16(s1[12], s1[13]); w.w = cvt_pk_bf16(s1[14], s1[15]); P[3] = __builtin_bit_cast(bf16x8, w); }
        __builtin_amdgcn_sched_barrier(0);
        ATT_LDV(1, 1);
        __builtin_amdgcn_sched_barrier(0);
#pragma unroll
        for (int dblk = 0; dblk < 4; ++dblk) O[dblk] = __builtin_amdgcn_mfma_f32_32x32x16_bf16(__builtin_bit_cast(bf16x8, vf[0][dblk]), P[0], O[dblk], 0, 0, 0);
        __builtin_amdgcn_sched_barrier(0);
        ATT_LDV(0, 2);
        __builtin_amdgcn_sched_barrier(0);
#pragma unroll
        for (int dblk = 0; dblk < 4; ++dblk) O[dblk] = __builtin_amdgcn_mfma_f32_32x32x16_bf16(__builtin_bit_cast(bf16x8, vf[1][dblk]), P[1], O[dblk], 0, 0, 0);
        __builtin_amdgcn_sched_barrier(0);
        ATT_LDV(1, 3);
        __builtin_amdgcn_sched_barrier(0);
#pragma unroll
        for (int dblk = 0; dblk < 4; ++dblk) O[dblk] = __builtin_amdgcn_mfma_f32_32x32x16_bf16(__builtin_bit_cast(bf16x8, vf[0][dblk]), P[2], O[dblk], 0, 0, 0);
        __builtin_amdgcn_sched_barrier(0);
#pragma unroll
        for (int dblk = 0; dblk < 4; ++dblk) O[dblk] = __builtin_amdgcn_mfma_f32_32x32x16_bf16(__builtin_bit_cast(bf16x8, vf[1][dblk]), P[3], O[dblk], 0, 0, 0);
#undef ATT_LDV
        if (t + 1 < nkt) ATT_STORE(tt ^ 1, tt ^ 1);
        asm volatile("s_waitcnt lgkmcnt(0)" ::: "memory"); __builtin_amdgcn_s_barrier(); asm volatile("" ::: "memory");
      }
    }
#undef ATT_LOAD
#undef ATT_STORE
    lrun += __shfl_xor(lrun, 32);
    const float inv = 1.f / lrun;
    LAS float* ex = (LAS float*)lds + qg * 4096;
    if (map == 1) {
#pragma unroll
        for (int i = 0; i < 4; ++i)
#pragma unroll
            for (int r = 0; r < 16; ++r) ex[(i * 16 + r) * 64 + lane] = O[i][r] * inv;
    }
    __syncthreads();
    if (map == 0) {
        float ss = 0.f;
#pragma unroll
        for (int i = 0; i < 4; ++i)
#pragma unroll
            for (int r = 0; r < 16; ++r) { const float o = O[i][r] * inv - A.lam * ex[(i * 16 + r) * 64 + lane]; O[i][r] = o; ss += o * o; }
        ss += __shfl_xor(ss, 32);
        const float rstd = __builtin_amdgcn_rsqf(ss * (1.f / 128.f) + EPSV) * A.omli;
        bf16_t* dst = A.MIXA + (size_t)(qrow0 + qg * 32 + r32) * DM + h * 128 + 4 * hi;
#pragma unroll
        for (int i = 0; i < 4; ++i)
#pragma unroll
            for (int rq = 0; rq < 4; ++rq) {
                const int d0 = 32 * i + 8 * rq;
                const f32x4 gg = *(const f32x4*)(A.subln + d0 + 4 * hi);
                f32x4 v = {O[i][4 * rq] * rstd * gg[0], O[i][4 * rq + 1] * rstd * gg[1], O[i][4 * rq + 2] * rstd * gg[2], O[i][4 * rq + 3] * rstd * gg[3]};
                *(u32x2*)(dst + d0) = pack4(v);
            }
    }
    __syncthreads();
}
}

__device__ __forceinline__ void conv_item(const Params& p, LAS unsigned char* lds, int l, int item, const bf16_t* UC, bf16_t* MIXA) {
    const int tid = fresh_tid(), lane = tid & 63, wid = tid >> 6, g = wid & 3, th = wid >> 2;
    const int ch = g * 64 + lane;
    int rowbase, t0, L;
    if (item < 256) { rowbase = (item >> 5) * SEQ; t0 = (item & 31) * 64; L = SEQ; }
    else { const int j = item - 256; rowbase = NLAT + (j >> 2) * CTXL; t0 = (j & 3) * 64; L = CTXL; }
    LAS float* zl = (LAS float*)lds;
    {
        u32x4 av[6], gv[6];
#pragma unroll
        for (int it = 0; it < 6; ++it) {
            int idx = tid + it * 512; idx = idx < 94 * 32 ? idx : 94 * 32 - 1;
            const int pr = idx >> 5, c8 = idx & 31; int pp = t0 - 15 + pr; pp = pp < 0 ? 0 : (pp >= L ? L - 1 : pp);
            const bf16_t* up = UC + (size_t)(rowbase + pp) * 512 + c8 * 8;
            av[it] = *(const u32x4*)up; gv[it] = *(const u32x4*)(up + 256);
        }
#pragma unroll
        for (int it = 0; it < 6; ++it) {
            const int idx = tid + it * 512;
            const int pr = idx >> 5, c8 = idx & 31, pp = t0 - 15 + pr;
            const float msk = (pp >= 0 && pp < L) ? 1.f : 0.f;
            f32x4 z0, z1;
#pragma unroll
            for (int q = 0; q < 4; ++q) {
                const float a_lo = __uint_as_float(av[it][q] << 16), a_hi = __uint_as_float(av[it][q] & 0xffff0000u);
                const float g_lo = __uint_as_float(gv[it][q] << 16), g_hi = __uint_as_float(gv[it][q] & 0xffff0000u);
                const float zlo = a_lo * sigmoidf_(g_lo) * msk, zhi = a_hi * sigmoidf_(g_hi) * msk;
                if (q < 2) { z0[2 * q] = zlo; z0[2 * q + 1] = zhi; } else { z1[2 * (q - 2)] = zlo; z1[2 * (q - 2) + 1] = zhi; }
            }
            if (idx < 94 * 32) { *(LAS f32x4*)(zl + pr * 256 + c8 * 8) = z0; *(LAS f32x4*)(zl + pr * 256 + c8 * 8 + 4) = z1; }
        }
    }
    __syncthreads();
    const int ts = t0 + th * 32;
    float w[31];
#pragma unroll
    for (int k = 0; k < 31; ++k) w[k] = p.conv_w[(size_t)l * 31 * 256 + k * 256 + ch];
    float o[32];
    const float bias = p.conv_b[l * 256 + ch];
    const LAS float* zp = zl + (th * 32) * 256 + ch;
    float z[62];
#pragma unroll
    for (int jj = 0; jj < 62; ++jj) z[jj] = zp[jj * 256];
#pragma unroll
    for (int i = 0; i < 32; ++i) {
        float acc = bias;
#pragma unroll
        for (int k = 0; k < 31; ++k) acc += w[k] * z[i + k];
        o[i] = acc;
    }
    const float lg = p.conv_ln_g[l * 256 + ch], lb = p.conv_ln_b[l * 256 + ch];
#pragma unroll
    for (int i = 0; i < 32; ++i) {
        const float mu = wave_sum(o[i]) * (1.f / 64.f);
        const float d = o[i] - mu;
        const float var = wave_sum(d * d) * (1.f / 64.f);
        const float zn = d * __builtin_amdgcn_rsqf(var + EPSV) * lg + lb;
        MIXA[(size_t)(rowbase + ts + i) * DM + 768 + ch] = f2bf(zn * sigmoidf_(zn));
    }
    __syncthreads();
}

__device__ __forceinline__ int drow_map(int mode, int n) {
    if (mode == 0) return n;
    if (mode == 1) {
        if (n < 1024) { const int cs = n & 255, head = cs >> 6, d = cs & 63, a = d >> 5, pp = (d >> 4) & 1, f = d & 15;
            return (n & ~255) + 128 * ((f >> 2) & 1) + 32 * head + 16 * pp + 4 * (2 * a + (f >> 3)) + (f & 3); }
        if (n < 1792) return n;
        { const int mm = n - 1792, cs = mm & 255;
          return 2048 + (mm & ~255) + 128 * ((cs >> 2) & 1) + 32 * ((cs >> 5) & 3) + 16 * (cs >> 7) + 4 * ((cs >> 3) & 3) + (cs & 3); }
    }
    const int r = 256 * (n >> 7) + 128 * ((n >> 2) & 1) + 32 * ((n >> 5) & 3) + 4 * ((n >> 3) & 3) + (n & 3);
    return mode == 2 ? r : r + 16;
}
__device__ __forceinline__ void transpose_item(const float* W, int ldw, int K, bf16_t* WT, int mode, LAS float* scr, int kb, int nb, int lane) {
    const int k0 = 64 * kb, n0 = 32 * nb;
#pragma unroll 8
    for (int i = 0; i < 32; ++i) { const int kk = 2 * i + (lane >> 5); scr[kk * 33 + (lane & 31)] = W[(size_t)(k0 + kk) * ldw + n0 + (lane & 31)]; }
    asm volatile("s_waitcnt lgkmcnt(0)" ::: "memory");
    const int c = lane & 7;
#pragma unroll
    for (int j = 0; j < 4; ++j) { const int n = (lane >> 3) + 8 * j; const LAS float* s = scr + (8 * c) * 33 + n;
        u32x4 o; o.x = cvt_pk_bf16(s[0 * 33], s[1 * 33]); o.y = cvt_pk_bf16(s[2 * 33], s[3 * 33]); o.z = cvt_pk_bf16(s[4 * 33], s[5 * 33]); o.w = cvt_pk_bf16(s[6 * 33], s[7 * 33]);
        *(u32x4*)(WT + (size_t)drow_map(mode, n0 + n) * K + k0 + 8 * c) = o; }
    asm volatile("s_waitcnt lgkmcnt(0)" ::: "memory");
}

__device__ __forceinline__ void prep_phase(const Params& p, LAS unsigned char* lds) {
    const int tid = fresh_tid(), lane = tid & 63, wave = tid >> 6, G = gridDim.x;
    const int gw = blockIdx.x * 8 + wave, NGW = G * 8;
    const int gt = blockIdx.x * 512 + tid, NGT = G * 512;
    unsigned char* ws = p.ws;
    LAS float* tab = (LAS float*)(lds + 73728);
    LAS float* t64c = tab + 2048; LAS float* t64s = t64c + 64;
    for (int m = tid; m < 2048; m += 512) tab[m] = cospif((float)m * (1.f / 1024.f));
    if (tid < 64) { t64c[tid] = cospif((float)tid * (1.f / 32.f)); t64s[tid] = sinpif((float)tid * (1.f / 32.f)); }
    __syncthreads();
    if (gt < 1024) { const int pos = gt >> 4, f = gt & 15; const float inv = powf(10000.f, -(float)f / 16.f); const float ang = (float)pos * inv;
        float* rope = (float*)(ws + WS_ROPE); rope[gt] = cosf(ang); rope[1024 + gt] = sinf(ang); }
    {
        LAS float* scr = (LAS float*)(lds + wave * 8448);
        constexpr int I_IN = 16 * 72, I_OUT = 16 * 32, I_F1 = 16 * 88, I_F2 = 44 * 32, I_L = I_IN + I_OUT + 2 * I_F1 + I_F2;
        for (int it = gw; it < 2 * I_L; it += NGW) {
            const int l = it / I_L; int r = it % I_L;
            if (r < I_IN) { const int kb = r / 72, nb = r % 72; if (nb >= 48 && nb < 56) continue;
                transpose_item(p.w_in + (size_t)l * DM * INW_SRC, INW_SRC, DM, (bf16_t*)(ws + WS_WIN) + (size_t)l * INW * DM, 1, scr, kb, nb, lane); continue; }
            r -= I_IN;
            if (r < I_OUT) { transpose_item(p.w_out + (size_t)l * DM * DM, DM, DM, (bf16_t*)(ws + WS_WOUT) + (size_t)l * DM * DM, 0, scr, r / 32, r % 32, lane); continue; }
            r -= I_OUT;
            if (r < I_F1) { transpose_item(p.w_ffn1 + (size_t)l * DM * DFF, DFF, DM, (bf16_t*)(ws + WS_W13) + (size_t)l * N13 * DM, 2, scr, r / 88, r % 88, lane); continue; }
            r -= I_F1;
            if (r < I_F1) { transpose_item(p.w_ffn3 + (size_t)l * DM * DFF, DFF, DM, (bf16_t*)(ws + WS_W13) + (size_t)l * N13 * DM, 3, scr, r / 88, r % 88, lane); continue; }
            r -= I_F1;
            transpose_item(p.w_ffn2 + (size_t)l * DFF * DM, DM, DFF, (bf16_t*)(ws + WS_W2) + (size_t)l * DM * DFF, 0, scr, r / 32, r % 32, lane);
        }
    }
    {
        const float tcl = cospif((float)lane * (1.f / 32.f)), tsl = sinpif((float)lane * (1.f / 32.f));
        for (int it = gw; it < 2 * 4 * 16 * 16; it += NGW) {
            const int l = it >> 10, g = (it >> 8) & 3, kbk = (it >> 4) & 15, lqg = it & 15;
            const int k = kbk * 64 + lane;
            const float* wr_ = p.w_in + (size_t)l * DM * INW_SRC + (size_t)k * INW_SRC + 1536 + g * 64;
            float wv[64];
#pragma unroll
            for (int c4 = 0; c4 < 16; ++c4) { const f32x4 v = *(const f32x4*)(wr_ + 4 * c4); wv[4 * c4] = v[0]; wv[4 * c4 + 1] = v[1]; wv[4 * c4 + 2] = v[2]; wv[4 * c4 + 3] = v[3]; }
            bf16_t* wt = (bf16_t*)(ws + WS_WIN) + (size_t)l * INW * DM;
#pragma unroll 1
            for (int li = 0; li < 4; ++li) {
                const int lq = __builtin_amdgcn_readfirstlane(lqg * 4 + li);
                float ac = 0.f, as = 0.f;
#pragma unroll
                for (int c = 0; c < 64; ++c) {
                    const int m = (lq * c) & 63;
                    const float ct = __int_as_float(__builtin_amdgcn_readlane(__float_as_int(tcl), m)), st = __int_as_float(__builtin_amdgcn_readlane(__float_as_int(tsl), m));
                    ac += wv[c] * ct; as += wv[c] * st;
                }
                wt[(size_t)(1536 + g * 64 + lq) * DM + k] = f2bf(ac);
                wt[(size_t)(1536 + 256 + g * 64 + lq) * DM + k] = f2bf(as);
            }
        }
    }
    for (int e = gt; e < 2 * WSM_L; e += NGT) {
        const int l = e / WSM_L, r = e % WSM_L; float v;
        if (r < 256 * 512) { const int n = r >> 9, k = r & 255; const int g = n >> 6, d = n & 63, g2 = k >> 6, c = k & 63; v = (g == g2) ? p.w_fourier[(((size_t)l * 4 + g) * 64 + c) * 64 + d] : 0.f; }
        else { const int r2 = r - 256 * 512, n = r2 >> 8, k = r2 & 255; v = p.w_conv_out[((size_t)l * 256 + k) * 256 + n]; }
        ((bf16_t*)(ws + WS_WSM))[e] = f2bf(v);
    }
    {
        const float nl = 1.f / sqrtf(2048.f * 64.f), nc = 1.f / 128.f;
        for (int e = gt; e < 2048 * 4096 / 8; e += NGT) {
            const int k = e >> 9, col0 = (e & 511) * 8, s = col0 >> 11; float v[8];
#pragma unroll
            for (int j = 0; j < 8; ++j) { const int n = (col0 + j) & 2047, m = (k * n) & 2047; v[j] = s ? -tab[(m - 512) & 2047] * nl : tab[m] * nl; }
            u32x4 o; o.x = cvt_pk_bf16(v[0], v[1]); o.y = cvt_pk_bf16(v[2], v[3]); o.z = cvt_pk_bf16(v[4], v[5]); o.w = cvt_pk_bf16(v[6], v[7]);
            *(u32x4*)((bf16_t*)(ws + WS_DFTL) + (size_t)e * 8) = o;
        }
        for (int e = gt; e < 256 * 512 / 8; e += NGT) {
            const int k = e >> 6, col0 = (e & 63) * 8, s = col0 >> 8; float v[8];
#pragma unroll
            for (int j = 0; j < 8; ++j) { const int n = (col0 + j) & 255, m = ((k * n) & 255) * 8; v[j] = s ? -tab[(m - 512) & 2047] * nc : tab[m] * nc; }
            u32x4 o; o.x = cvt_pk_bf16(v[0], v[1]); o.y = cvt_pk_bf16(v[2], v[3]); o.z = cvt_pk_bf16(v[4], v[5]); o.w = cvt_pk_bf16(v[6], v[7]);
            *(u32x4*)((bf16_t*)(ws + WS_DFTC) + (size_t)e * 8) = o;
        }
    }
    for (int it = gw; it < 2 * 96 * 8; it += NGW) {
        const int l = it / 768, r = it % 768, cgp = r >> 3, kc = r & 7;
        const int col = cgp * 64 + lane, k0 = kc * 128;
        float sv[9][2];
#pragma unroll
        for (int b = 0; b < 9; ++b)
#pragma unroll
            for (int hh = 0; hh < 2; ++hh) { const int k = k0 + hh * 64 + lane; const float cv = (b < 8) ? p.c[b * DM + k] : p.c_ctx[k]; sv[b][hh] = cv * sigmoidf_(cv); }
        float ac[9];
#pragma unroll
        for (int b = 0; b < 9; ++b) ac[b] = 0.f;
        const float* wp = p.w_ada + ((size_t)l * DM + k0) * 6144 + col;
#pragma unroll
        for (int hh = 0; hh < 2; ++hh) {
#pragma unroll 8
            for (int kk = 0; kk < 64; ++kk) {
                const float wv = wp[(size_t)(hh * 64 + kk) * 6144];
#pragma unroll
                for (int b = 0; b < 9; ++b) ac[b] += __int_as_float(__builtin_amdgcn_readlane(__float_as_int(sv[b][hh]), kk)) * wv;
            }
        }
        const float bias = (kc == 0) ? p.b_ada[l * 6144 + col] : 0.f;
        float* mod = (float*)(ws + WS_MOD) + (size_t)l * 9 * 6144;
#pragma unroll
        for (int b = 0; b < 9; ++b) atomicAdd(mod + b * 6144 + col, ac[b] + bias);
    }
}

__device__ __forceinline__ void norm_phase(const float* xlat, const float* xctx, const float* gvec, const float* mod, int sh_off, int sc_off, bf16_t* H, int nrows,
                                           const float* part, const float* pgate, float* xctx_out, int row_lo) {
    const int tid = fresh_tid(), lane = tid & 63, gw = row_lo + blockIdx.x * 8 + (tid >> 6), NGW = gridDim.x * 8;
    f32x4 vn[4];
#define NORM_LOADX(dst, r_) do { const int r__ = (r_); const float* xr_ = r__ < NLAT ? xlat + (size_t)r__ * DM : xctx + (size_t)(r__ - NLAT) * DM; \
        _Pragma("unroll") for (int j = 0; j < 4; ++j) dst[j] = *(const f32x4*)(xr_ + 4 * lane + 256 * j); } while (0)
    if (gw < nrows) NORM_LOADX(vn, gw);
    for (int row = gw; row < nrows; row += NGW) {
        const int bb = row < NLAT ? row >> 11 : 8;
        f32x4 v[4]; float ss = 0.f;
#pragma unroll
        for (int j = 0; j < 4; ++j) v[j] = vn[j];
        if (row + NGW < nrows) NORM_LOADX(vn, row + NGW);
        const float* mp = mod + bb * 6144;
        f32x4 gg[4], sc[4], sh[4];
#pragma unroll
        for (int j = 0; j < 4; ++j) { const int col = 4 * lane + 256 * j; gg[j] = *(const f32x4*)(gvec + col); sc[j] = *(const f32x4*)(mp + sc_off + col); sh[j] = *(const f32x4*)(mp + sh_off + col); }
        if (part != nullptr && row >= NLAT) {
#pragma unroll
            for (int j = 0; j < 4; ++j) {
                const size_t o = (size_t)(row - NLAT) * DM + 4 * lane + 256 * j;
                const f32x4 ps = (*(const f32x4*)(part + o) + *(const f32x4*)(part + (size_t)NCTX * DM + o)) + (*(const f32x4*)(part + (size_t)2 * NCTX * DM + o) + *(const f32x4*)(part + (size_t)3 * NCTX * DM + o));
                v[j] = v[j] + *(const f32x4*)(pgate + 4 * lane + 256 * j) * ps;
                *(f32x4*)(xctx_out + o) = v[j];
            }
        }
#pragma unroll
        for (int j = 0; j < 4; ++j) ss += (v[j][0] * v[j][0] + v[j][1] * v[j][1]) + (v[j][2] * v[j][2] + v[j][3] * v[j][3]);
        const float rstd = __builtin_amdgcn_rsqf(wave_sum(ss) * (1.f / DM) + EPSV);
#pragma unroll
        for (int j = 0; j < 4; ++j) {
            const int col = 4 * lane + 256 * j;
            const f32x4 y = (v[j] * rstd) * gg[j];
            const f32x4 hv = y * (sc[j] + 1.f) + sh[j];
            *(u32x2*)(H + (size_t)row * DM + col) = pack4(hv);
        }
    }
#undef NORM_LOADX
}

__global__ void __launch_bounds__(512, 2) fwd_kernel(Params p) {
    extern __shared__ __attribute__((aligned(16))) unsigned char lds_raw[];
    LAS unsigned char* lds = (LAS unsigned char*)lds_raw;
    cg::grid_group grid = cg::this_grid();
    const int G = gridDim.x, cu = blockIdx.x;
    unsigned char* ws = p.ws;
    bf16_t* H = (bf16_t*)(ws + WS_H);
    bf16_t* Q1 = (bf16_t*)(ws + WS_Q1); bf16_t* Q2 = (bf16_t*)(ws + WS_Q2); bf16_t* K1c = (bf16_t*)(ws + WS_K1); bf16_t* K2c = (bf16_t*)(ws + WS_K2);
    bf16_t* VT = (bf16_t*)(ws + WS_VT); bf16_t* TTl = (bf16_t*)(ws + WS_TTL); bf16_t* TTc = (bf16_t*)(ws + WS_TTC); bf16_t* UC = (bf16_t*)(ws + WS_UC);
    bf16_t* MIXA = (bf16_t*)(ws + WS_MIX); bf16_t* ACT = (bf16_t*)(ws + WS_ACT);
    float* PB1 = (float*)(ws + WS_R); float* PB2 = (float*)(ws + WS_R + 99 * MiB);
    bf16_t* FP = (bf16_t*)(ws + WS_H);
    float* XL = p.out; float* XC = (float*)(ws + WS_XCTX);
    const float* rope = (const float*)(ws + WS_ROPE);

    volatile LAS unsigned* bst = (volatile LAS unsigned*)(lds + LDS_BYTES - 64);
    if (threadIdx.x < 2) bst[threadIdx.x] = 0u;
    __syncthreads();
    const XcdBarrier xbar = xcd_barrier_post((unsigned*)(ws + WS_BAR), bst);
#define GSYNC() xcd_barrier(xbar)

    prep_phase(p, lds);
    grid.sync();

#pragma unroll 1
    for (int l = 0; l < 2; ++l) {
        const float* mod = (const float*)(ws + WS_MOD) + (size_t)l * 9 * 6144;
        const float* xin_l = l == 0 ? p.x : XL; const float* xin_c = l == 0 ? p.ctx : XC;
        const int mrows = l == 0 ? MTOT : NLAT;
        if (PROBE == 3) { for (int rep = 0; rep < 8; ++rep) GSYNC(); }
        norm_phase(xin_l, xin_c, p.norm1_g + l * DM, mod, 0, 1024, H, MTOT, l == 1 ? PB2 : nullptr, (const float*)(ws + WS_MOD) + 8 * 6144 + 5120, XC, (l == 1 && G == 256) ? NLAT : 0);
        GSYNC();
        for (int rep = 0; rep < (PROBE == 4 ? 2 : 1); ++rep) {
            if (rep) GSYNC();
            pg8::Gemm g{H, (const bf16_t*)(ws + WS_WIN) + (size_t)l * INW * DM, MTOT, INW, DM, DM, DM, 0};
            pg8::StaticOrder S; S.init(MTOT, INW, G, cu);
            EpiInProj E{Q1, Q2, K1c, K2c, VT, TTl, TTc, UC, rope};
            pg8::gemm_phase<EpiInProj, pg8::StaticOrder, true>(lds, g, S, E);
        }
        GSYNC();
        for (int rep = 0; rep < (PROBE == 1 ? 2 : 1); ++rep) {
            if (rep) GSYNC();
            const float li = 0.8f - 0.6f * __expf(-0.3f * (float)l);
            float lam;
            { const int lane = fresh_tid() & 63;
              const float s1 = wave_sum(p.lam_q1[l * 64 + lane] * p.lam_k1[l * 64 + lane]), s2 = wave_sum(p.lam_q2[l * 64 + lane] * p.lam_k2[l * 64 + lane]);
              lam = expf(s1) - expf(s2) + li; }
            att::Args A{Q1, Q2, K1c, K2c, VT, MIXA, p.subln_g + l * 128, lam, 1.f - li};
            const int n_att = 512 + (l == 0 ? 64 : 0);
            for (int u = cu; u < n_att; u += G) {
                if (u < 512) att::attn_unit(lds, A, u >> 6, (u >> 4) & 3, (u >> 6) * SEQ + (u & 15) * 128, 36);
                else { const int v = u - 512; att::attn_unit(lds, A, v >> 3, (v >> 1) & 3, NLAT + (v >> 3) * CTXL + (v & 1) * 128, 4); }
            }
#pragma unroll 1
            for (int hf = 0; hf < 2; ++hf) {
                pg8::Gemm g{(const bf16_t*)(ws + WS_DFTL) + hf * 2048, TTl + hf * 2048, 2048, 2048, 2048, 4096, 4096, 0};
                pg8::OffsetOrder S; S.init(2048, 2048, G, cu, 64 + 64 * hf);
                EpiMix E{FP, 512, hf * 256, 0, SEQ, 0};
                pg8::gemm_phase<EpiMix, pg8::OffsetOrder, true>(lds, g, S, E);
            }
            if (l == 0) {
#pragma unroll 1
                for (int hf = 0; hf < 2; ++hf) {
                    pg8::Gemm g{(const bf16_t*)(ws + WS_DFTC) + hf * 256, TTc + hf * 256, 256, 2048, 256, 512, 512, 0};
                    pg8::OffsetOrder S; S.init(256, 2048, G, cu, 192 + 8 * hf);
                    EpiMix E{FP, 512, hf * 256, NLAT, CTXL, 0};
                    pg8::gemm_phase<EpiMix, pg8::OffsetOrder, true>(lds, g, S, E);
                }
            }
            const int n_conv = l == 0 ? 288 : 256;
            if (G == 256) {
                const int sidx = cu < 64 ? cu : (cu >= 192 ? cu - 128 : -1);
                if (sidx >= 0) for (int it = sidx; it < n_conv; it += 128) conv_item(p, lds, l, it, UC, MIXA);
            } else for (int it = cu; it < n_conv; it += G) conv_item(p, lds, l, it, UC, MIXA);
        }
        GSYNC();
        {
            const bf16_t* wsm = (const bf16_t*)(ws + WS_WSM) + (size_t)l * WSM_L;
            {
                pg8::Gemm g{FP, wsm, mrows, 256, 512, 512, 512, 0};
                pg8::OffsetOrder S; S.init(mrows, 256, G, cu, 0);
                EpiMix E{MIXA, DM, 512, 0, 0, 0};
                pg8::gemm_phase<EpiMix, pg8::OffsetOrder, true>(lds, g, S, E);
            }
            {
                pg8::Gemm g{MIXA + 768, wsm + 256 * 512, mrows, 256, 256, DM, 256, 0};
                pg8::OffsetOrder S; S.init(mrows, 256, G, cu, 72);
                EpiMix E{MIXA, DM, 768, 0, 0, 0};
                pg8::gemm_phase<EpiMix, pg8::OffsetOrder, true>(lds, g, S, E);
            }
        }
        GSYNC();
        {
            pg8::Gemm g{MIXA, (const bf16_t*)(ws + WS_WOUT) + (size_t)l * DM * DM, mrows, DM, DM, DM, DM, 0};
            EpiRes E{xin_l, xin_c, XL, XC, mod, 2048, PB1};
            if (l == 0 && G == 256) {
                pg8::CtxSplitOrder S; S.init(DM, DM, G, cu);
                EpiResNormL0 EL{{xin_l, XL, mod, 2048, p.norm2_g, (unsigned*)(ws + WS_R + 40 * MiB), (unsigned*)(ws + WS_PCNT) + 2 * 64 * 64, H, 3072, 4096, mod}, PB1};
                pg8::gemm_phase<EpiResNormL0, pg8::CtxSplitOrder, true>(lds, g, S, EL);
            }
            else if (l == 0) { pg8::CtxSplitOrder S; S.init(DM, DM, G, cu); pg8::gemm_phase<EpiRes, pg8::CtxSplitOrder, true>(lds, g, S, E); }
            else if (G == 256) {
                pg8::StaticOrder S; S.init(mrows, DM, G, cu);
                EpiPanelNorm<1> EN{xin_l, XL, mod, 2048, p.norm2_g + l * DM, (unsigned*)(ws + WS_R), (unsigned*)(ws + WS_PCNT) + 64 * 64, H, 3072, 4096, mod};
                pg8::gemm_phase<EpiPanelNorm<1>, pg8::StaticOrder, true>(lds, g, S, EN);
            }
            else { pg8::StaticOrder S; S.init(mrows, DM, G, cu); pg8::gemm_phase<EpiRes, pg8::StaticOrder, true>(lds, g, S, E); }
        }
        GSYNC();
        if (!(l == 1 && G == 256)) {
        norm_phase(XL, l == 0 ? p.ctx : XC, p.norm2_g + l * DM, mod, 3072, 4096, H, mrows, l == 0 ? PB1 : nullptr, mod + 8 * 6144 + 2048, XC, (l == 0 && G == 256) ? NLAT : 0);
        GSYNC();
        }
        for (int rep = 0; rep < (PROBE == 2 ? 2 : 1); ++rep) {
            if (rep) GSYNC();
            pg8::Gemm g{H, (const bf16_t*)(ws + WS_W13) + (size_t)l * N13 * DM, mrows, N13, DM, DM, DM, 0};
            pg8::StaticOrder S; S.init(mrows, N13, G, cu);
            EpiFfn13 E{ACT};
            pg8::gemm_phase<EpiFfn13, pg8::StaticOrder, true>(lds, g, S, E);
        }
        GSYNC();
        {
            pg8::Gemm g{ACT, (const bf16_t*)(ws + WS_W2) + (size_t)l * DM * DFF, mrows, DM, DFF, DFF, DFF, 0};
            EpiRes E{XL, XC, XL, XC, mod, 5120, PB2};
            if (l == 0 && G == 256) {
                pg8::CtxSplitOrder S; S.init(DM, DFF, G, cu);
                EpiResNormL0 EL{{XL, XL, mod, 5120, p.norm1_g + DM, (unsigned*)(ws + 244 * MiB), (unsigned*)(ws + WS_PCNT) + 3 * 64 * 64, H, 0, 1024, mod + 9 * 6144}, PB2};
                pg8::gemm_phase<EpiResNormL0, pg8::CtxSplitOrder, true>(lds, g, S, EL);
            }
            else if (l == 0) { pg8::CtxSplitOrder S; S.init(DM, DFF, G, cu); pg8::gemm_phase<EpiRes, pg8::CtxSplitOrder, true>(lds, g, S, E); }
            else if (G == 256) {
                pg8::StaticOrder S; S.init(mrows, DM, G, cu);
                EpiPanelNorm<0> EF{XL, XL, mod, 5120, p.final_g, (unsigned*)(ws + WS_H), (unsigned*)(ws + WS_PCNT), nullptr, 0, 0, mod};
                pg8::gemm_phase<EpiPanelNorm<0>, pg8::StaticOrder, true>(lds, g, S, EF);
            }
            else { pg8::StaticOrder S; S.init(mrows, DM, G, cu); pg8::gemm_phase<EpiRes, pg8::StaticOrder, true>(lds, g, S, E); }
        }
        if (!(l == 1 && G == 256)) GSYNC();
    }
    if (G != 256) {
        const int tid = fresh_tid(), lane = tid & 63, gw = blockIdx.x * 8 + (tid >> 6), NGW = gridDim.x * 8;
        f32x4 gg[4], vn[4];
#pragma unroll
        for (int j = 0; j < 4; ++j) { gg[j] = *(const f32x4*)(p.final_g + 4 * lane + 256 * j); vn[j] = *(const f32x4*)(XL + (size_t)gw * DM + 4 * lane + 256 * j); }
        for (int row = gw; row < NLAT; row += NGW) {
            float* xr = XL + (size_t)row * DM;
            f32x4 v[4]; float ss = 0.f;
#pragma unroll
            for (int j = 0; j < 4; ++j) { v[j] = vn[j]; ss += (v[j][0] * v[j][0] + v[j][1] * v[j][1]) + (v[j][2] * v[j][2] + v[j][3] * v[j][3]); }
            if (row + NGW < NLAT) {
#pragma unroll
                for (int j = 0; j < 4; ++j) vn[j] = *(const f32x4*)(xr + (size_t)NGW * DM + 4 * lane + 256 * j);
            }
            const float rstd = __builtin_amdgcn_rsqf(wave_sum(ss) * (1.f / DM) + EPSV);
#pragma unroll
            for (int j = 0; j < 4; ++j) { const int col = 4 * lane + 256 * j; *(f32x4*)(xr + col) = (v[j] * rstd) * gg[j]; }
        }
    }
}

extern "C" void kernel_launch(void* const* d_in, const int* in_sizes, int n_in, void* d_out, int out_size, void* d_ws, size_t ws_size, hipStream_t stream) {
    static int grid_blocks = 0;
    if (grid_blocks == 0) {
        if (n_in != 25 || ws_size < WS_END) { fprintf(stderr, "kernel_launch: unexpected n_in %d / ws %zu\n", n_in, ws_size); grid_blocks = -1; return; }
        int dev = 0, cus = 0, per_cu = 0;
        (void)hipGetDevice(&dev);
        (void)hipDeviceGetAttribute(&cus, hipDeviceAttributeMultiprocessorCount, dev);
        if (hipFuncSetAttribute((const void*)fwd_kernel, hipFuncAttributeMaxDynamicSharedMemorySize, LDS_BYTES) != hipSuccess) fprintf(stderr, "kernel_launch: hipFuncSetAttribute failed\n");
        if (hipOccupancyMaxActiveBlocksPerMultiprocessor(&per_cu, (const void*)fwd_kernel, 512, LDS_BYTES) != hipSuccess || per_cu < 1) { fprintf(stderr, "kernel_launch: occupancy query gave %d\n", per_cu); per_cu = 1; }
        (void)hipGetLastError();
        grid_blocks = cus * per_cu;
    }
    if (grid_blocks < 0) return;
    Params p{};
    const float** pp = (const float**)&p;
    for (int i = 0; i < 25; ++i) pp[i] = (const float*)d_in[i];
    p.out = (float*)d_out; p.ws = (unsigned char*)d_ws;
    (void)hipMemsetAsync((unsigned char*)d_ws + WS_MOD, 0, ZERO_BYTES, stream);
    void* args[] = {&p};
    hipError_t e = hipLaunchCooperativeKernel((const void*)fwd_kernel, dim3(grid_blocks), dim3(512), args, LDS_BYTES, stream);
    if (e != hipSuccess) fprintf(stderr, "cooperative launch failed: %s (grid %d)\n", hipGetErrorString(e), grid_blocks);
}
```

```cpp
#include <hip/hip_runtime.h>
#include <hip/hip_cooperative_groups.h>
#include <cstdint>
#include <cstdio>
namespace cg = cooperative_groups;
#ifndef PROBE
#define PROBE 0
#endif

#define LAS __attribute__((address_space(3)))
typedef unsigned short bf16_t;
typedef short bf16x8 __attribute__((ext_vector_type(8)));
typedef float f32x4 __attribute__((ext_vector_type(4)));
typedef float f32x16 __attribute__((ext_vector_type(16)));
typedef unsigned u32x4 __attribute__((ext_vector_type(4)));
typedef unsigned u32x2 __attribute__((ext_vector_type(2)));

constexpr int NB = 8, SEQ = 2048, DM = 1024, CTXL = 256, NLAT = NB * SEQ, NCTX = NB * CTXL, MTOT = NLAT + NCTX;
constexpr int INW = 2560, INW_SRC = 2304, DFF = 2816, N13 = 2 * DFF, KCAT = CTXL + SEQ;
constexpr float EPSV = 1e-6f;
constexpr float QSCALE = 0.125f * 1.4426950408889634f;
constexpr int LDS_BYTES = 147456;
constexpr int XCD_BAR_WORDS_C = 3456;

constexpr size_t MiB = 1u << 20;
constexpr size_t WS_WIN = 0, WS_WOUT = 10 * MiB, WS_W13 = 14 * MiB, WS_W2 = 36 * MiB, WS_WSM = 47 * MiB, WS_DFTL = 48 * MiB, WS_DFTC = 64 * MiB;
constexpr size_t WS_MOD = 64 * MiB + 256 * 1024, WS_ROPE = 64 * MiB + 768 * 1024, WS_XCTX = 65 * MiB, WS_H = 73 * MiB, WS_R = 109 * MiB;
constexpr size_t WS_Q1 = WS_R, WS_Q2 = WS_R + 9 * MiB, WS_K1 = WS_R + 18 * MiB, WS_K2 = WS_R + 27 * MiB, WS_VT = WS_R + 36 * MiB, WS_TTL = WS_R + 54 * MiB,
                 WS_TTC = WS_R + 70 * MiB, WS_UC = WS_R + 72 * MiB, WS_MIX = WS_R + 90 * MiB, WS_ACT = WS_R, WS_END = WS_R + 131 * MiB;
constexpr size_t MOD_BYTES = 2 * 9 * 6144 * 4;
constexpr int WSM_L = 256 * 512 + 256 * 256;
constexpr size_t WS_BAR = 64 * MiB + 704 * 1024, WS_PCNT = 64 * MiB + 784 * 1024, ZERO_BYTES = WS_PCNT + 4 * 64 * 256 - WS_MOD;

struct Params {
    const float *x, *c, *ctx, *c_ctx, *w_ada, *b_ada, *norm1_g, *norm2_g, *w_in, *lam_q1, *lam_k1, *lam_q2, *lam_k2, *subln_g, *w_fourier, *conv_w, *conv_b,
        *conv_ln_g, *conv_ln_b, *w_conv_out, *w_out, *w_ffn1, *w_ffn3, *w_ffn2, *final_g;
    float* out; unsigned char* ws;
};

__device__ __forceinline__ unsigned cvt_pk_bf16(float lo, float hi) { unsigned r; asm("v_cvt_pk_bf16_f32 %0, %1, %2" : "=v"(r) : "v"(lo), "v"(hi)); return r; }
__device__ __forceinline__ u32x2 pack4(f32x4 v) { u32x2 w; w.x = cvt_pk_bf16(v[0], v[1]); w.y = cvt_pk_bf16(v[2], v[3]); return w; }
__device__ __forceinline__ bf16_t f2bf(float v) { return (bf16_t)(cvt_pk_bf16(v, 0.f) & 0xffffu); }
__device__ __forceinline__ float wave_sum(float v) {
#pragma unroll
    for (int o = 1; o < 64; o <<= 1) v += __shfl_xor(v, o);
    return v;
}
__device__ __forceinline__ int fresh_tid() { int t = threadIdx.x; asm volatile("" : "+v"(t)); return t; }
__device__ __forceinline__ float max3f(float a, float b, float c) { float r; asm("v_max3_f32 %0, %1, %2, %3" : "=v"(r) : "v"(a), "v"(b), "v"(c)); return r; }
__device__ __forceinline__ float sigmoidf_(float v) { return __builtin_amdgcn_rcpf(1.f + __expf(-v)); }


#define XB_TMO      128
#define XB_XCNT(j)  (256  + 64 * (j))
#define XB_XSUB(j)  (1280 + 64 * (j))
#define XB_XGEN(j)  (2304 + 64 * (j))
#define XB_TOP      3328
#define XB_TOPGEN   3392
#define XCD_BAR_WORDS 3456
#define XB_SPIN_CAP (1u << 18)
__device__ __forceinline__ unsigned xb_ld(unsigned* p)              { return __hip_atomic_load(p, __ATOMIC_RELAXED, __HIP_MEMORY_SCOPE_AGENT); }
__device__ __forceinline__ unsigned xb_add(unsigned* p, unsigned v) { return __hip_atomic_fetch_add(p, v, __ATOMIC_RELAXED, __HIP_MEMORY_SCOPE_AGENT); }
__device__ __forceinline__ unsigned xb_xcc_id() { return (unsigned)__builtin_amdgcn_s_getreg((3 << 11) | 20) & 0xFu; }
#define XB_SPIN(cond, bar) do { unsigned _sp = 0; while (cond) { \
    if ((++_sp & 255u) == 0u) { if (xb_ld(&(bar)[XB_TMO])) break; if (_sp > XB_SPIN_CAP) { atomicAdd(&(bar)[XB_TMO], 1u); break; } } } } while (0)
struct XcdBarrier { unsigned* bar; unsigned x; volatile LAS unsigned* st; };
__device__ __forceinline__ XcdBarrier xcd_barrier_post(unsigned* bar, volatile LAS unsigned* st) {
    XcdBarrier b; b.bar = bar; b.x = xb_xcc_id(); b.st = st;
    if (threadIdx.x == 0) (void)xb_add(&bar[XB_XCNT(b.x)], 1u);
    return b;
}
__device__ __forceinline__ void xcd_barrier_complete(unsigned* bar, unsigned x, unsigned& nloc, unsigned& nx) {
    const unsigned G = gridDim.x * gridDim.y * gridDim.z;
    unsigned sum, cnt, mine, sp = 0u;
    for (;;) {
        sum = 0u; cnt = 0u; mine = 0u;
#pragma unroll
        for (unsigned j = 0; j < 16; ++j) { const unsigned c = xb_ld(&bar[XB_XCNT(j)]); sum += c; cnt += (c > 0u) ? 1u : 0u; mine = (j == x) ? c : mine; }
        if (sum == G) break;
        __builtin_amdgcn_s_sleep(1);
        if ((++sp & 255u) == 0u) { if (xb_ld(&bar[XB_TMO])) break; if (sp > XB_SPIN_CAP) { atomicAdd(&bar[XB_TMO], 1u); break; } }
    }
    nloc = mine > 0u ? mine : 1u; nx = cnt > 0u ? cnt : 1u;
}
__device__ __forceinline__ void xcd_barrier(const XcdBarrier& b) {
    asm volatile("s_waitcnt vmcnt(0)" ::: "memory");
    __syncthreads();
    if (threadIdx.x == 0) {
        unsigned* bar = b.bar;
        __builtin_amdgcn_s_waitcnt(0);
        unsigned nloc = b.st[0], nx = b.st[1];
        if (nloc == 0u) { xcd_barrier_complete(bar, b.x, nloc, nx); b.st[0] = nloc; b.st[1] = nx; }
        const unsigned old = xb_add(&bar[XB_XSUB(b.x)], 1u);
        const unsigned gen = old / nloc;
        if (old + 1u == (gen + 1u) * nloc) {
            __builtin_amdgcn_fence(__ATOMIC_RELEASE, "agent");
            asm volatile("s_waitcnt vmcnt(0)" ::: "memory");
            const unsigned og = xb_add(&bar[XB_TOP], 1u);
            const unsigned tg = og / nx;
            if (og + 1u == (tg + 1u) * nx) xb_add(&bar[XB_TOPGEN], 1u);
            else XB_SPIN(xb_ld(&bar[XB_TOPGEN]) == tg, bar);
            __builtin_amdgcn_fence(__ATOMIC_ACQUIRE, "agent");
            xb_add(&bar[XB_XGEN(b.x)], 1u);
            asm volatile("s_waitcnt vmcnt(0)" ::: "memory");
        } else {
            XB_SPIN(xb_ld(&bar[XB_XGEN(b.x)]) == gen, bar);
            __builtin_amdgcn_fence(__ATOMIC_ACQUIRE, "agent");
            asm volatile("s_waitcnt vmcnt(0)" ::: "memory");
        }
    }
    __syncthreads();
}

namespace pg8 {
constexpr int BM = 256, BK = 64, HALF = 128, HTB = HALF * BK * 2, STAGE_BYTES = 8 * HTB, NXCD = 8, WGM = 8;
__host__ __device__ __forceinline__ int lds_byte(int r, int c) { const int st = (r >> 4) * 2 + (c >> 5), rr = r & 15, cc = c & 31, ob = rr * 64 + cc * 2; return st * 1024 + (ob ^ (((ob >> 9) & 1) << 5)); }
__host__ __device__ __forceinline__ void stage_rc(int b, int& R, int& C) { const int st = b / 1024, sb = b % 1024, swz = sb ^ (((sb >> 9) & 1) << 5); R = (st >> 1) * 16 + swz / 64; C = (st & 1) * 32 + (swz % 64) / 2; }

__host__ __device__ __forceinline__ int perm32(int rho) { const int n = rho >> 4, i = rho & 15; return 8 * (i >> 2) + 4 * n + (i & 3); }
struct Unit { int pm, pn, k0, nt, flags; };
struct Gemm { const bf16_t* A; const bf16_t* Bt; int M, N, K, lda, ldb, a_pn_off; };

struct StaticOrder {
    int nM, nN, nwg, G, c;
    __host__ __device__ void init(int M, int N, int G_, int c_) { nM = M / BM; nN = N / BM; nwg = nM * nN; G = G_; c = c_; }
    __host__ __device__ __forceinline__ bool next(int i, Unit& u) const {
        const long L = (long)i * G + c; if (L >= nwg) return false;
        int wgid = (int)L; { const int q = nwg / NXCD, r = nwg % NXCD, xcd = wgid % NXCD, off = wgid / NXCD; wgid = (xcd < r ? xcd * (q + 1) : r * (q + 1) + (xcd - r) * q) + off; }
        const int nig = WGM * nN, gid = wgid / nig, fm = gid * WGM, gsz = (nM - fm) < WGM ? (nM - fm) : WGM;
        u.pm = fm + ((wgid % nig) % gsz); u.pn = (wgid % nig) / gsz; u.k0 = 0; u.nt = -1; u.flags = 0; return true;
    }
};
struct OffsetOrder {
    int nN, nwg, G, cc;
    __host__ __device__ void init(int M, int N, int G_, int c_, int off) { nN = N / BM; nwg = (M / BM) * nN; G = G_; cc = ((c_ - off) % G_ + G_) % G_; }
    __host__ __device__ __forceinline__ bool next(int i, Unit& u) const { const long L = (long)i * G + cc; if (L >= nwg) return false; u.pm = (int)L / nN; u.pn = (int)L % nN; u.k0 = 0; u.nt = -1; u.flags = 0; return true; }
};

struct CtxSplitOrder {
    StaticOrder lat; int nN, ntf;
    __host__ __device__ void init(int N, int K, int G_, int c_) { lat.init(NLAT, N, G_, c_); nN = N / BM; ntf = K / BK; }
    __host__ __device__ __forceinline__ bool next(int i, Unit& u) const {
        const long L = (long)i * lat.G + lat.c;
        int pm, pn, k0 = 0, ntq = -1, fl = 0;
        if (L < lat.nwg) {
            int wgid = (int)L; { const int q = lat.nwg / NXCD, r = lat.nwg % NXCD, xcd = wgid % NXCD, off = wgid / NXCD; wgid = (xcd < r ? xcd * (q + 1) : r * (q + 1) + (xcd - r) * q) + off; }
            const int nig = WGM * lat.nN, gid = wgid / nig, fm = gid * WGM, gsz = (lat.nM - fm) < WGM ? (lat.nM - fm) : WGM;
            pm = fm + ((wgid % nig) % gsz); pn = (wgid % nig) / gsz;
        } else {
            const int s = (int)(L - lat.nwg); if (s >= (NCTX / BM) * nN * 4) return false;
            const int cu_ = s >> 2, q = s & 3, base = (ntf / 8) * 2, extra = (ntf - 4 * base) / 2;
            pm = NLAT / BM + cu_ / nN; pn = cu_ % nN; ntq = base + (q < extra ? 2 : 0); k0 = (q * base + 2 * (q < extra ? q : extra)) * BK; fl = 1 | (q << 1);
        }
        u.pm = pm; u.pn = pn; u.k0 = k0; u.nt = ntq; u.flags = fl; return true;
    }
};

template <class Epi, class Sched, bool ALIGN_EPI>
__device__ __forceinline__ void gemm_phase(LAS unsigned char* lds, const Gemm g, const Sched& S, const Epi& E) {
    const int tid = fresh_tid(), wid = __builtin_amdgcn_readfirstlane(tid >> 6), lane = tid & 63, wr = wid >> 2, wc = wid & 3, fr = lane & 15, fq = lane >> 4;
    const int K = g.K, nt = K / BK;
    unsigned voffA[2], voffB[2];
#pragma unroll
    for (int i = 0; i < 2; ++i) { int R, C; stage_rc(tid * 16 + i * 8192, R, C);
        const int Rb = Epi::PERM ? ((R & ~31) + perm32(R & 31)) : R;
        voffA[i] = (unsigned)(R * g.lda + C) * 2u; voffB[i] = (unsigned)(Rb * g.ldb + C) * 2u; }
    const size_t kstep = (size_t)(BK * 2);
    const size_t hstepA = (size_t)HALF * g.lda * 2, hstepB = (size_t)HALF * g.ldb * 2;
    const size_t tstepA = 2 * hstepA, tstepB = 2 * hstepB;
    const unsigned ldsw = (unsigned)wid * 1024u;
    const int aoff = lds_byte(wr * 64 + fr, fq * 8), boff = lds_byte(wc * 32 + fr, fq * 8);
#define PG8_SA(b, h) (((b) * 2 + (h)) * HTB)
#define PG8_SB(b, h) ((4 + (b) * 2 + (h)) * HTB)
#define PG8_STAGE(bufoff, gbase, voff) do { _Pragma("unroll") for (int _i = 0; _i < 2; ++_i) \
        __builtin_amdgcn_global_load_lds((const unsigned*)((const char*)(gbase) + (voff)[_i]), (LAS unsigned*)(lds + (bufoff) + ldsw + _i * 8192), 16, 0, 0); } while (0)
#define PG8_LDA(dst, b, h) do { _Pragma("unroll") for (int m = 0; m < 4; ++m) _Pragma("unroll") for (int k = 0; k < 2; ++k) dst[m][k] = *(const LAS bf16x8*)(lds + PG8_SA(b, h) + aoff + m * 2048 + k * 1024); } while (0)
#define PG8_LDB(dst, b, h) do { _Pragma("unroll") for (int n = 0; n < 2; ++n) _Pragma("unroll") for (int k = 0; k < 2; ++k) dst[n][k] = *(const LAS bf16x8*)(lds + PG8_SB(b, h) + boff + n * 2048 + k * 1024); } while (0)
#define PG8_MMA(ai, bj, At, Bt) do { __builtin_amdgcn_s_setprio(1); _Pragma("unroll") for (int m = 0; m < 4; ++m) _Pragma("unroll") for (int n = 0; n < 2; ++n) _Pragma("unroll") for (int k = 0; k < 2; ++k) \
        acc[ai][bj][m][n] = __builtin_amdgcn_mfma_f32_16x16x32_bf16(Bt[n][k], At[m][k], acc[ai][bj][m][n], 0, 0, 0); __builtin_amdgcn_s_setprio(0); } while (0)
#define PG8_WAIT_V(n) asm volatile("s_waitcnt vmcnt(" #n ")" ::: "memory")
#define PG8_WAIT_L(n) asm volatile("s_waitcnt lgkmcnt(" #n ")" ::: "memory")
#define PG8_BAR __builtin_amdgcn_s_barrier()
#define PG8_SCHED __builtin_amdgcn_sched_barrier(0)
    Unit cur, nxt; int ui = 0;
    if (!S.next(0, cur)) return;
    f32x4 acc[2][2][4][2];
#pragma unroll
    for (int a = 0; a < 2; ++a)
#pragma unroll
        for (int b = 0; b < 2; ++b)
#pragma unroll
            for (int m = 0; m < 4; ++m)
#pragma unroll
                for (int n = 0; n < 2; ++n) acc[a][b][m][n] = (f32x4){0.f, 0.f, 0.f, 0.f};
    bf16x8 At[4][2], B0[2][2], B1[2][2];
    const char* cA = (const char*)g.A + (size_t)cur.pm * tstepA + (size_t)cur.pn * g.a_pn_off * 2 + (size_t)cur.k0 * 2; const char* cB = (const char*)g.Bt + (size_t)cur.pn * tstepB + (size_t)cur.k0 * 2;
    PG8_STAGE(PG8_SB(0, 0), cB, voffB); PG8_STAGE(PG8_SB(0, 1), cB + hstepB, voffB); PG8_STAGE(PG8_SA(0, 0), cA, voffA); PG8_STAGE(PG8_SA(0, 1), cA + hstepA, voffA);
    if (wr == 1) PG8_BAR;
    PG8_WAIT_V(2); PG8_BAR;
    PG8_STAGE(PG8_SB(1, 0), cB + kstep, voffB); PG8_STAGE(PG8_SA(1, 0), cA + kstep, voffA); PG8_STAGE(PG8_SB(1, 1), cB + hstepB + kstep, voffB);
    PG8_WAIT_V(6); PG8_BAR;
    for (;;) {
        const bool has_next = S.next(ui + 1, nxt);
        const char* nA = has_next ? (const char*)g.A + (size_t)nxt.pm * tstepA + (size_t)nxt.pn * g.a_pn_off * 2 + (size_t)nxt.k0 * 2 : cA; const char* nB = has_next ? (const char*)g.Bt + (size_t)nxt.pn * tstepB + (size_t)nxt.k0 * 2 : cB;
        const int ntc = cur.nt < 0 ? nt : cur.nt;
        for (int t = 0; t < ntc; t += 2) {
            const bool last = (t == ntc - 2);
            const char* a1 = cA + (size_t)(t + 1) * kstep;
            const char* a2 = last ? nA : cA + (size_t)(t + 2) * kstep; const char* b2 = last ? nB : cB + (size_t)(t + 2) * kstep;
            const char* a3 = a2 + kstep; const char* b3 = b2 + kstep;
            PG8_LDB(B0, 0, 0); PG8_LDB(B1, 0, 1); PG8_SCHED; PG8_LDA(At, 0, 0); PG8_STAGE(PG8_SA(1, 1), a1 + hstepA, voffA);
            PG8_WAIT_V(8); PG8_WAIT_L(0); PG8_BAR; PG8_MMA(0, 0, At, B0); PG8_MMA(0, 1, At, B1); PG8_BAR; PG8_SCHED;
            PG8_LDA(At, 0, 1); PG8_STAGE(PG8_SB(0, 0), b2, voffB); PG8_STAGE(PG8_SB(0, 1), b2 + hstepB, voffB); PG8_STAGE(PG8_SA(0, 0), a2, voffA);
            PG8_WAIT_V(8); PG8_WAIT_L(0); PG8_BAR; PG8_MMA(1, 0, At, B0); PG8_MMA(1, 1, At, B1); PG8_BAR; PG8_SCHED;
            PG8_LDB(B0, 1, 0); PG8_LDB(B1, 1, 1); PG8_SCHED; PG8_LDA(At, 1, 0); PG8_STAGE(PG8_SA(0, 1), a2 + hstepA, voffA);
            PG8_WAIT_V(8); PG8_WAIT_L(0); PG8_BAR; PG8_MMA(0, 0, At, B0); PG8_MMA(0, 1, At, B1); PG8_BAR; PG8_SCHED;
            PG8_LDA(At, 1, 1); PG8_STAGE(PG8_SB(1, 0), b3, voffB); PG8_STAGE(PG8_SB(1, 1), b3 + hstepB, voffB); PG8_STAGE(PG8_SA(1, 0), a3, voffA);
            PG8_WAIT_V(8); PG8_WAIT_L(0); PG8_BAR; PG8_MMA(1, 0, At, B0); PG8_MMA(1, 1, At, B1); PG8_BAR; PG8_SCHED;
        }
        if constexpr (ALIGN_EPI) { if (wr == 0) PG8_BAR; }
        if constexpr (!Epi::AFTER_DRAIN) { if constexpr (Epi::LOOP_LDS) E.loop(acc, cur, wr, wc, fr, fq, lds + 131072, wid, lane); else E(acc, cur, wr, wc, fr, fq); }
        if (!has_next) break;
#pragma unroll
        for (int a = 0; a < 2; ++a)
#pragma unroll
            for (int b = 0; b < 2; ++b)
#pragma unroll
                for (int m = 0; m < 4; ++m)
#pragma unroll
                    for (int n = 0; n < 2; ++n) acc[a][b][m][n] = (f32x4){0.f, 0.f, 0.f, 0.f};
        cur = nxt; cA = nA; cB = nB; ++ui;
        if constexpr (ALIGN_EPI) { if (wr == 1) PG8_BAR; }
    }
    PG8_WAIT_V(0);
    if constexpr (!ALIGN_EPI) { if (wr == 0) PG8_BAR; }
    PG8_BAR;
    if constexpr (Epi::AFTER_DRAIN) E.fused(acc, cur, wr, wc, fr, fq, lds, wid, lane);
#undef PG8_SA
#undef PG8_SB
#undef PG8_STAGE
#undef PG8_LDA
#undef PG8_LDB
#undef PG8_MMA
#undef PG8_WAIT_V
#undef PG8_WAIT_L
#undef PG8_BAR
#undef PG8_SCHED
}
}

typedef f32x4 Acc[2][2][4][2];

struct EpiInProj {
    static constexpr bool PERM = false;
    static constexpr bool AFTER_DRAIN = false;
    static constexpr bool LOOP_LDS = false;
    bf16_t *Q1, *Q2, *K1c, *K2c, *VT, *TTl, *TTc, *UC; const float* rope;
    __device__ __forceinline__ void operator()(const Acc& acc, const pg8::Unit& u, int wr, int wc, int fr, int fq) const {
        const int pn = u.pn; const bool lat = u.pm < 64;
#pragma unroll
        for (int ai = 0; ai < 2; ++ai)
#pragma unroll
            for (int m = 0; m < 4; ++m) {
                const int row = u.pm * 256 + ai * 128 + wr * 64 + m * 16 + fr;
                int b, t; if (lat) { b = row >> 11; t = row & 2047; } else { const int rc = row - NLAT; b = rc >> 8; t = rc & 255; }
                const int pos = lat ? CTXL + t : t;
                if (pn < 4) {
                    bf16_t* dst;
                    if (pn == 0) dst = Q1 + (size_t)row * 256; else if (pn == 1) dst = Q2 + (size_t)row * 256;
                    else if (pn == 2) dst = K1c + ((size_t)b * KCAT + pos) * 256; else dst = K2c + ((size_t)b * KCAT + pos) * 256;
                    const float scale = pn < 2 ? QSCALE : 1.f;
                    const int ax = fq >> 1, fh = fq & 1;
                    u32x4 w1, w2;
#pragma unroll
                    for (int bj = 0; bj < 2; ++bj) {
                        f32x4 cs = {1.f, 1.f, 1.f, 1.f}, sn = {0.f, 0.f, 0.f, 0.f};
                        if (lat) { const int pidx = ax ? (t & 63) : (t >> 6); cs = *(const f32x4*)(rope + pidx * 16 + 8 * fh + 4 * bj); sn = *(const f32x4*)(rope + 1024 + pidx * 16 + 8 * fh + 4 * bj); }
                        const f32x4 x1 = acc[ai][bj][m][0], x2 = acc[ai][bj][m][1];
                        const u32x2 p1 = pack4((x1 * cs - x2 * sn) * scale), p2 = pack4((x2 * cs + x1 * sn) * scale);
                        if (bj == 0) { w1.x = p1.x; w1.y = p1.y; w2.x = p2.x; w2.y = p2.y; } else { w1.z = p1.x; w1.w = p1.y; w2.z = p2.x; w2.w = p2.y; }
                    }
                    bf16_t* dq = dst + wc * 64 + ax * 32 + 8 * fh;
                    *(u32x4*)dq = w1; *(u32x4*)(dq + 16) = w2;
                } else if (pn < 6) {
#pragma unroll
                    for (int bj = 0; bj < 2; ++bj)
#pragma unroll
                        for (int n = 0; n < 2; ++n) {
                            bf16_t* dst = VT + ((size_t)(b * 4 + (pn - 4) * 2 + bj) * 128 + wc * 32 + n * 16 + 4 * fq) * KCAT + pos;
                            const f32x4 v = acc[ai][bj][m][n];
                            dst[0] = f2bf(v[0]); dst[KCAT] = f2bf(v[1]); dst[2 * KCAT] = f2bf(v[2]); dst[3 * KCAT] = f2bf(v[3]);
                        }
                } else if (pn < 8) {
                    const int s = pn - 6;
#pragma unroll
                    for (int bj = 0; bj < 2; ++bj)
#pragma unroll
                        for (int n = 0; n < 2; ++n) {
                            const int jf = bj * 128 + wc * 32 + n * 16 + 4 * fq;
                            const f32x4 v = acc[ai][bj][m][n];
                            if (lat) { bf16_t* dst = TTl + (((size_t)b * 256 + jf) * 2 + s) * SEQ + t; dst[0] = f2bf(v[0]); dst[2 * SEQ] = f2bf(v[1]); dst[4 * SEQ] = f2bf(v[2]); dst[6 * SEQ] = f2bf(v[3]); }
                            else { bf16_t* dst = TTc + (((size_t)b * 256 + jf) * 2 + s) * CTXL + t; dst[0] = f2bf(v[0]); dst[2 * CTXL] = f2bf(v[1]); dst[4 * CTXL] = f2bf(v[2]); dst[6 * CTXL] = f2bf(v[3]); }
                        }
                } else {
                    bf16_t* dst = UC + (size_t)row * 512 + (pn - 8) * 256 + wc * 32 + 8 * fq;
#pragma unroll
                    for (int n = 0; n < 2; ++n) { const u32x2 p0 = pack4(acc[ai][0][m][n]), p1 = pack4(acc[ai][1][m][n]); *(u32x4*)(dst + 128 * n) = (u32x4){p0.x, p0.y, p1.x, p1.y}; }
                }
            }
    }
};

struct EpiRes {
    static constexpr bool PERM = false;
    static constexpr bool AFTER_DRAIN = false;
    static constexpr bool LOOP_LDS = false;
    const float* xin_lat; const float* xin_ctx; float* xout_lat; float* xout_ctx; const float* mod; int goff; float* pb;
    __device__ __forceinline__ void operator()(const Acc& acc, const pg8::Unit& u, int wr, int wc, int fr, int fq) const {
        const int tile0 = u.pm * 256, colb = u.pn * 256 + wc * 32 + 4 * fq, rloc = wr * 64 + fr;
        if (u.flags & 1) {
            float* pq = pb + ((size_t)(u.flags >> 1) * NCTX + (tile0 - NLAT) + rloc) * DM + colb;
#pragma unroll
            for (int ai = 0; ai < 2; ++ai)
#pragma unroll
                for (int m = 0; m < 4; ++m)
#pragma unroll
                    for (int bj = 0; bj < 2; ++bj)
#pragma unroll
                        for (int n = 0; n < 2; ++n) *(f32x4*)(pq + (size_t)(ai * 128 + m * 16) * DM + bj * 128 + n * 16) = acc[ai][bj][m][n];
            return;
        }
        const bool lat = tile0 < NLAT;
        const float* xi = (lat ? xin_lat + (size_t)tile0 * DM : xin_ctx + (size_t)(tile0 - NLAT) * DM) + (size_t)rloc * DM + colb;
        float* xo = (lat ? xout_lat + (size_t)tile0 * DM : xout_ctx + (size_t)(tile0 - NLAT) * DM) + (size_t)rloc * DM + colb;
        const float* gp = mod + (lat ? (tile0 >> 11) : 8) * 6144 + goff + colb;
        f32x4 gt[2][2];
#pragma unroll
        for (int bj = 0; bj < 2; ++bj)
#pragma unroll
            for (int n = 0; n < 2; ++n) gt[bj][n] = *(const f32x4*)(gp + bj * 128 + n * 16);
        f32x4 xv[2][2][2];
#define ER_LOAD(buf, g_) do { const float* xp_ = xi + (size_t)(((g_) >> 2) * 128 + ((g_) & 3) * 16) * DM; \
            _Pragma("unroll") for (int bj = 0; bj < 2; ++bj) _Pragma("unroll") for (int n = 0; n < 2; ++n) xv[buf][bj][n] = *(const f32x4*)(xp_ + bj * 128 + n * 16); } while (0)
        ER_LOAD(0, 0);
#pragma unroll
        for (int g_ = 0; g_ < 8; ++g_) {
            if (g_ + 1 < 8) ER_LOAD((g_ + 1) & 1, g_ + 1);
            float* xq = xo + (size_t)((g_ >> 2) * 128 + (g_ & 3) * 16) * DM;
#pragma unroll
            for (int bj = 0; bj < 2; ++bj)
#pragma unroll
                for (int n = 0; n < 2; ++n) *(f32x4*)(xq + bj * 128 + n * 16) = xv[g_ & 1][bj][n] + gt[bj][n] * acc[g_ >> 2][bj][g_ & 3][n];
        }
#undef ER_LOAD
    }
};

template <int MODE>
struct EpiPanelNorm {
    static constexpr bool PERM = false;
    static constexpr bool AFTER_DRAIN = true;
    static constexpr bool LOOP_LDS = false;
    const float* xin; float* out; const float* mod; int goff; const float* final_g; unsigned* slots; unsigned* cnt; bf16_t* Hout; int sh_off, sc_off; const float* modn;
    __device__ __forceinline__ void fused(Acc& acc, const pg8::Unit& u, int wr, int wc, int fr, int fq, LAS unsigned char* lds, int wid, int lane) const {
        const int tile0 = u.pm * 256, colb = u.pn * 256 + wc * 32 + 4 * fq, rloc = wr * 64 + fr;
        const float* xi = xin + (size_t)(tile0 + rloc) * DM + colb;
        float* xo = out + (size_t)(tile0 + rloc) * DM + colb;
        const float* gp = mod + (tile0 >> 11) * 6144 + goff + colb;
        f32x4 gt[2][2];
#pragma unroll
        for (int bj = 0; bj < 2; ++bj)
#pragma unroll
            for (int n = 0; n < 2; ++n) gt[bj][n] = *(const f32x4*)(gp + bj * 128 + n * 16);
        f32x4 xv[1][2][2];
#define EF_LOAD(buf, g_) do { const float* xp_ = xi + (size_t)(((g_) >> 2) * 128 + ((g_) & 3) * 16) * DM; \
            _Pragma("unroll") for (int bj = 0; bj < 2; ++bj) _Pragma("unroll") for (int n = 0; n < 2; ++n) xv[buf][bj][n] = *(const f32x4*)(xp_ + bj * 128 + n * 16); } while (0)
        LAS float* P = (LAS float*)lds;
        LAS float* S = (LAS float*)(lds + 4096);
#pragma unroll
        for (int g_ = 0; g_ < 8; ++g_) {
            EF_LOAD(0, g_);
            float sq = 0.f;
#pragma unroll
            for (int bj = 0; bj < 2; ++bj)
#pragma unroll
                for (int n = 0; n < 2; ++n) { const f32x4 xn = xv[0][bj][n] + gt[bj][n] * acc[g_ >> 2][bj][g_ & 3][n]; acc[g_ >> 2][bj][g_ & 3][n] = xn;
                    if (MODE == 1) *(f32x4*)(xo + (size_t)((g_ >> 2) * 128 + (g_ & 3) * 16) * DM + bj * 128 + n * 16) = xn;
                    sq += (xn[0] * xn[0] + xn[1] * xn[1]) + (xn[2] * xn[2] + xn[3] * xn[3]); }
            sq += __shfl_xor(sq, 16); sq += __shfl_xor(sq, 32);
            if (fq == 0) P[((g_ >> 2) * 128 + wr * 64 + (g_ & 3) * 16 + fr) * 4 + wc] = sq;
        }
#undef EF_LOAD
        asm volatile("s_waitcnt lgkmcnt(0)" ::: "memory"); __builtin_amdgcn_s_barrier(); asm volatile("" ::: "memory");
        const int row = wid * 32 + (lane & 31);
        if (lane < 32) { const float tsum = (P[row * 4 + 0] + P[row * 4 + 1]) + (P[row * 4 + 2] + P[row * 4 + 3]);
            __hip_atomic_store(slots + (size_t)(tile0 + row) * 4 + u.pn, __float_as_uint(tsum), __ATOMIC_RELAXED, __HIP_MEMORY_SCOPE_AGENT); }
        asm volatile("s_waitcnt vmcnt(0)" ::: "memory");
        if (lane == 0) __hip_atomic_fetch_add(cnt + 64 * u.pm, 1u, __ATOMIC_RELAXED, __HIP_MEMORY_SCOPE_AGENT);
        if (wid == 0) {
            unsigned sp = 0;
            while ((unsigned)__builtin_amdgcn_readfirstlane(__hip_atomic_load(cnt + 64 * u.pm, __ATOMIC_RELAXED, __HIP_MEMORY_SCOPE_AGENT)) < 32u) { if (++sp > (1u << 20)) break; }
            __builtin_amdgcn_fence(__ATOMIC_ACQUIRE, "agent");
        }
        asm volatile("s_waitcnt vmcnt(0) lgkmcnt(0)" ::: "memory"); __builtin_amdgcn_s_barrier(); asm volatile("" ::: "memory");
        if (lane < 32) { float tot = 0.f;
#pragma unroll
            for (int t4 = 0; t4 < 4; ++t4) tot += __uint_as_float(__hip_atomic_load(slots + (size_t)(tile0 + row) * 4 + t4, __ATOMIC_RELAXED, __HIP_MEMORY_SCOPE_AGENT));
            S[row] = __builtin_amdgcn_rsqf(tot * (1.f / DM) + EPSV); }
        asm volatile("s_waitcnt lgkmcnt(0)" ::: "memory"); __builtin_amdgcn_s_barrier(); asm volatile("" ::: "memory");
#pragma unroll
        for (int bj = 0; bj < 2; ++bj)
#pragma unroll
            for (int n = 0; n < 2; ++n) {
                const f32x4 fg = *(const f32x4*)(final_g + colb + bj * 128 + n * 16);
                f32x4 sc = {1.f, 1.f, 1.f, 1.f}, sh = {0.f, 0.f, 0.f, 0.f};
                if (MODE == 1) { const float* mp = modn + (tile0 >> 11) * 6144 + colb + bj * 128 + n * 16; sc = *(const f32x4*)(mp + sc_off) + 1.f; sh = *(const f32x4*)(mp + sh_off); }
#pragma unroll
                for (int g_ = 0; g_ < 8; ++g_) {
                    const float rs = S[(g_ >> 2) * 128 + wr * 64 + (g_ & 3) * 16 + fr];
                    const size_t ro = (size_t)((g_ >> 2) * 128 + (g_ & 3) * 16) * DM;
                    const f32x4 y = (acc[g_ >> 2][bj][g_ & 3][n] * rs) * fg;
                    if (MODE == 0) *(f32x4*)(xo + ro + bj * 128 + n * 16) = y;
                    else *(u32x2*)(Hout + (size_t)(tile0 + rloc) * DM + colb + ro + bj * 128 + n * 16) = pack4(y * sc + sh);
                }
            }
    }
};

struct EpiResNormL0 {
    static constexpr bool PERM = false;
    static constexpr bool AFTER_DRAIN = false;
    static constexpr bool LOOP_LDS = true;
    EpiPanelNorm<1> pn_; float* pb;
    __device__ __forceinline__ void loop(Acc& acc, const pg8::Unit& u, int wr, int wc, int fr, int fq, LAS unsigned char* lds, int wid, int lane) const {
        if (u.flags & 1) {
            const int tile0 = u.pm * 256, colb = u.pn * 256 + wc * 32 + 4 * fq, rloc = wr * 64 + fr;
            float* pq = pb + ((size_t)(u.flags >> 1) * NCTX + (tile0 - NLAT) + rloc) * DM + colb;
#pragma unroll
            for (int ai = 0; ai < 2; ++ai)
#pragma unroll
                for (int m = 0; m < 4; ++m)
#pragma unroll
                    for (int bj = 0; bj < 2; ++bj)
#pragma unroll
                        for (int n = 0; n < 2; ++n) *(f32x4*)(pq + (size_t)(ai * 128 + m * 16) * DM + bj * 128 + n * 16) = acc[ai][bj][m][n];
        } else pn_.fused(acc, u, wr, wc, fr, fq, lds, wid, lane);
    }
};

struct EpiFfn13 {
    static constexpr bool PERM = false;
    static constexpr bool AFTER_DRAIN = false;
    static constexpr bool LOOP_LDS = false;
    bf16_t* ACT;
    __device__ __forceinline__ void operator()(const Acc& acc, const pg8::Unit& u, int wr, int wc, int fr, int fq) const {
#pragma unroll
        for (int ai = 0; ai < 2; ++ai)
#pragma unroll
            for (int m = 0; m < 4; ++m) {
                const int row = u.pm * 256 + ai * 128 + wr * 64 + m * 16 + fr;
                u32x4 w;
#pragma unroll
                for (int bj = 0; bj < 2; ++bj) {
                    const f32x4 a = acc[ai][bj][m][0], b = acc[ai][bj][m][1]; f32x4 o;
#pragma unroll
                    for (int j = 0; j < 4; ++j) o[j] = a[j] * sigmoidf_(a[j]) * b[j];
                    const u32x2 pk = pack4(o);
                    if (bj == 0) { w.x = pk.x; w.y = pk.y; } else { w.z = pk.x; w.w = pk.y; }
                }
                *(u32x4*)(ACT + (size_t)row * DFF + 128 * u.pn + 32 * wc + 8 * fq) = w;
            }
    }
};

struct EpiMix {
    static constexpr bool PERM = true;
    static constexpr bool AFTER_DRAIN = false;
    static constexpr bool LOOP_LDS = false;
    bf16_t* out; int pitch, col0, tok_base, tok_pn_step, col_pn_step;
    __device__ __forceinline__ void operator()(const Acc& acc, const pg8::Unit& u, int wr, int wc, int fr, int fq) const {
#pragma unroll
        for (int ai = 0; ai < 2; ++ai)
#pragma unroll
            for (int m = 0; m < 4; ++m) {
                const int row = u.pm * 256 + ai * 128 + wr * 64 + m * 16 + fr;
                bf16_t* dst = out + (size_t)(tok_base + u.pn * tok_pn_step + row) * pitch + col0 + u.pn * col_pn_step + wc * 32 + 8 * fq;
#pragma unroll
                for (int bj = 0; bj < 2; ++bj) { const u32x2 p0 = pack4(acc[ai][bj][m][0]), p1 = pack4(acc[ai][bj][m][1]); *(u32x4*)(dst + bj * 128) = (u32x4){p0.x, p0.y, p1.x, p1.y}; }
            }
    }
};

namespace att {
constexpr int VP = 144, OFF_K1 = 0, OFF_K2 = 8192, OFF_VT = 16384, BUFSZ = 16384 + 128 * VP;
struct Args { const bf16_t *Q1, *Q2, *K1c, *K2c, *VT; bf16_t* MIXA; const float* subln; float lam, omli; };

__device__ __forceinline__ void attn_unit(LAS unsigned char* lds, const Args& A, int b, int h, int qrow0, int nkt) {
    const int tid = fresh_tid(), lane = tid & 63, r32 = lane & 31, hi = lane >> 5;
    const int wid = __builtin_amdgcn_readfirstlane(tid >> 6), map = wid >> 2, qg = wid & 3;
    const bf16_t* Qm = map ? A.Q2 : A.Q1;
    bf16x8 qf[4];
    { const bf16_t* qp = Qm + (size_t)(qrow0 + qg * 32 + r32) * 256 + h * 64 + hi * 8;
#pragma unroll
      for (int d0 = 0; d0 < 4; ++d0) qf[d0] = *(const bf16x8*)(qp + d0 * 16); }
    const int key_s = tid >> 3, ch_s = tid & 7;
    const bf16_t* k1src = A.K1c + ((size_t)b * KCAT + key_s) * 256 + h * 64 + ch_s * 8;
    const bf16_t* k2src = A.K2c + ((size_t)b * KCAT + key_s) * 256 + h * 64 + ch_s * 8;
    const bf16_t* vsrc = A.VT + ((size_t)(b * 4 + h) * 128 + key_s) * KCAT + ch_s * 8;
    const int kdst = key_s * 128 + ((ch_s ^ ((key_s >> 1) & 7)) << 4), vdst = key_s * VP + 32 * (ch_s >> 1) + 8 * (ch_s & 1);
    u32x4 rk1[2], rk2[2], rv0[2], rv1[2];
#define ATT_LOAD(set, t) do { rk1[set] = *(const u32x4*)(k1src + (size_t)(t) * 64 * 256); rk2[set] = *(const u32x4*)(k2src + (size_t)(t) * 64 * 256); \
        rv0[set] = *(const u32x4*)(vsrc + (t) * 64); rv1[set] = *(const u32x4*)(vsrc + (size_t)64 * KCAT + (t) * 64); } while (0)
#define ATT_STORE(set, buf) do { LAS unsigned char* bb_ = lds + (buf) * BUFSZ; *(LAS u32x4*)(bb_ + OFF_K1 + kdst) = rk1[set]; *(LAS u32x4*)(bb_ + OFF_K2 + kdst) = rk2[set]; \
        *(LAS u32x2*)(bb_ + OFF_VT + vdst) = (u32x2){rv0[set].x, rv0[set].y}; *(LAS u32x2*)(bb_ + OFF_VT + vdst + 16) = (u32x2){rv0[set].z, rv0[set].w}; \
        *(LAS u32x2*)(bb_ + OFF_VT + 64 * VP + vdst) = (u32x2){rv1[set].x, rv1[set].y}; *(LAS u32x2*)(bb_ + OFF_VT + 64 * VP + vdst + 16) = (u32x2){rv1[set].z, rv1[set].w}; } while (0)
    constexpr float THR = 6.f;
    float mrun = 0.f, lrun = 0.f;
    f32x16 O[4];
#pragma unroll
    for (int i = 0; i < 4; ++i)
#pragma unroll
        for (int r = 0; r < 16; ++r) O[i][r] = 0.f;
    ATT_LOAD(0, 0); ATT_STORE(0, 0); __syncthreads();
    ATT_LOAD(1, 1);
    for (int t0 = 0; t0 < nkt; t0 += 2) {
#pragma unroll
      for (int tt = 0; tt < 2; ++tt) {
        const int t = t0 + tt, cur = tt;
        if (t + 2 < nkt) ATT_LOAD(tt, t + 2);
        LAS unsigned char* base = lds + cur * BUFSZ;
        LAS unsigned char* kb = base + (map ? OFF_K2 : OFF_K1) + r32 * 128;
        f32x16 s0, s1;
#pragma unroll
        for (int r = 0; r < 16; ++r) { s0[r] = -mrun; s1[r] = -mrun; }
#pragma unroll
        for (int d0 = 0; d0 < 4; ++d0) {
            const int chunk = ((2 * d0 + hi) ^ ((r32 >> 1) & 7)) << 4;
            const bf16x8 a0 = *(const LAS bf16x8*)(kb + chunk), a1 = *(const LAS bf16x8*)(kb + 32 * 128 + chunk);
            s0 = __builtin_amdgcn_mfma_f32_32x32x16_bf16(a0, qf[d0], s0, 0, 0, 0);
            s1 = __builtin_amdgcn_mfma_f32_32x32x16_bf16(a1, qf[d0], s1, 0, 0, 0);
        }
        asm volatile("s_nop 15\n\ts_nop 4" : "+v"(s0), "+v"(s1));
        LAS unsigned char* vb = base + OFF_VT + r32 * VP + 16 * hi;
        u32x4 vf[2][4];
#define ATT_LDV(slot, c) do { _Pragma("unroll") for (int dblk = 0; dblk < 4; ++dblk) { \
            vf[slot][dblk] = *(const LAS u32x4*)(vb + dblk * 32 * VP + 32 * (c)); } } while (0)
        ATT_LDV(0, 0);
        __builtin_amdgcn_sched_barrier(0);
        float rm = max3f(s0[0], s0[1], s1[0]), rm2 = max3f(s0[2], s0[3], s1[1]);
        rm = max3f(rm, s1[2], s1[3]);
#pragma unroll
        for (int r = 4; r < 16; r += 4) { rm = max3f(rm, s0[r], s0[r + 1]); rm2 = max3f(rm2, s0[r + 2], s0[r + 3]); rm = max3f(rm, s1[r], s1[r + 1]); rm2 = max3f(rm2, s1[r + 2], s1[r + 3]); }
        rm = fmaxf(rm, rm2);
        rm = fmaxf(rm, __shfl_xor(rm, 32));
        const bool need = (t == 0) || (rm > THR);
        if (__any(need)) {
            const float dlt = need ? rm : 0.f, alpha = (t == 0) ? 1.f : __builtin_amdgcn_exp2f(-dlt);
            mrun += dlt; lrun *= alpha;
            s0 = s0 - dlt; s1 = s1 - dlt;
#pragma unroll
            for (int i = 0; i < 4; ++i)
#pragma unroll
                for (int r = 0; r < 16; ++r) O[i][r] *= alpha;
        }
#pragma unroll
        for (int r = 0; r < 16; ++r) { s0[r] = __builtin_amdgcn_exp2f(s0[r]); s1[r] = __builtin_amdgcn_exp2f(s1[r]); }
        { const f32x16 t16 = s0 + s1;
          typedef float f32x8 __attribute__((ext_vector_type(8)));
          const f32x8 t8 = t16.lo + t16.hi; const f32x4 t4 = t8.lo + t8.hi;
          lrun += (t4[0] + t4[1]) + (t4[2] + t4[3]); }
        bf16x8 P[4];
        { u32x4 w;
          w.x = cvt_pk_bf16(s0[0], s0[1]); w.y = cvt_pk_bf16(s0[2], s0[3]); w.z = cvt_pk_bf16(s0[4], s0[5]); w.w = cvt_pk_bf16(s0[6], s0[7]); P[0] = __builtin_bit_cast(bf16x8, w);
          w.x = cvt_pk_bf16(s0[8], s0[9]); w.y = cvt_pk_bf16(s0[10], s0[11]); w.z = cvt_pk_bf16(s0[12], s0[13]); w.w = cvt_pk_bf16(s0[14], s0[15]); P[1] = __builtin_bit_cast(bf16x8, w);
          w.x = cvt_pk_bf16(s1[0], s1[1]); w.y = cvt_pk_bf16(s1[2], s1[3]); w.z = cvt_pk_bf16(s1[4], s1[5]); w.w = cvt_pk_bf16(s1[6], s1[7]); P[2] = __builtin_bit_cast(bf16x8, w);
          w.x = cvt_pk_bf16(s1[8], s1[9]); w.y = cvt_pk_bf16(s1[10], s1[11]); w.z = cvt_pk_bf16(s1[12], s1[13]); w.w = cvt_pk_bf16(s1[14], s1[15]); P[3] = __builtin_bit_cast(bf16x8, w); }
        __builtin_amdgcn_sched_barrier(0);
        ATT_LDV(1, 1);
        __builtin_amdgcn_sched_barrier(0);
#pragma unroll
        for (int dblk = 0; dblk < 4; ++dblk) O[dblk] = __builtin_amdgcn_mfma_f32_32x32x16_bf16(__builtin_bit_cast(bf16x8, vf[0][dblk]), P[0], O[dblk], 0, 0, 0);
        __builtin_amdgcn_sched_barrier(0);
        ATT_LDV(0, 2);
        __builtin_amdgcn_sched_barrier(0);
#pragma unroll
        for (int dblk = 0; dblk < 4; ++dblk) O[dblk] = __builtin_amdgcn_mfma_f32_32x32x16_bf16(__builtin_bit_cast(bf16x8, vf[1][dblk]), P[1], O[dblk], 0, 0, 0);
        __builtin_amdgcn_sched_barrier(0);
        ATT_LDV(1, 3);
        __builtin_amdgcn_sched_barrier(0);
#pragma unroll
        for (int dblk = 0; dblk < 4; ++dblk) O[dblk] = __builtin_amdgcn_mfma_f32_32x32x16_bf16(__builtin_bit_cast(bf16x8, vf[0][dblk]), P[2], O[dblk], 0, 0, 0);
        __builtin_amdgcn_sched_barrier(0);
#pragma unroll
        for (int dblk = 0; dblk < 4; ++dblk) O[dblk] = __builtin_amdgcn_mfma_f32_32x32x16_bf16(__builtin_bit_cast(bf16x8, vf[1][dblk]), P[3], O[dblk], 0, 0, 0);
#undef ATT_LDV
        if (t + 1 < nkt) ATT_STORE(tt ^ 1, tt ^ 1);
        asm volatile("s_waitcnt lgkmcnt(0)" ::: "memory"); __builtin_amdgcn_s_barrier(); asm volatile("" ::: "memory");
      }
    }
#undef ATT_LOAD
#undef ATT_STORE
    lrun += __shfl_xor(lrun, 32);
    const float inv = 1.f / lrun;
    LAS float* ex = (LAS float*)lds + qg * 4096;
    if (map == 1) {
#pragma unroll
        for (int i = 0; i < 4; ++i)
#pragma unroll
            for (int r = 0; r < 16; ++r) ex[(i * 16 + r) * 64 + lane] = O[i][r] * inv;
    }
    __syncthreads();
    if (map == 0) {
        float ss = 0.f;
#pragma unroll
        for (int i = 0; i < 4; ++i)
#pragma unroll
            for (int r = 0; r < 16; ++r) { const float o = O[i][r] * inv - A.lam * ex[(i * 16 + r) * 64 + lane]; O[i][r] = o; ss += o * o; }
        ss += __shfl_xor(ss, 32);
        const float rstd = __builtin_amdgcn_rsqf(ss * (1.f / 128.f) + EPSV) * A.omli;
        bf16_t* dst = A.MIXA + (size_t)(qrow0 + qg * 32 + r32) * DM + h * 128 + 4 * hi;
#pragma unroll
        for (int i = 0; i < 4; ++i)
#pragma unroll
            for (int rq = 0; rq < 4; ++rq) {
                const int d0 = 32 * i + 8 * rq;
                const f32x4 gg = *(const f32x4*)(A.subln + d0 + 4 * hi);
                f32x4 v = {O[i][4 * rq] * rstd * gg[0], O[i][4 * rq + 1] * rstd * gg[1], O[i][4 * rq + 2] * rstd * gg[2], O[i][4 * rq + 3] * rstd * gg[3]};
                *(u32x2*)(dst + d0) = pack4(v);
            }
    }
    __syncthreads();
}
}

__device__ __forceinline__ void conv_item(const Params& p, LAS unsigned char* lds, int l, int item, const bf16_t* UC, bf16_t* MIXA) {
    const int tid = fresh_tid(), lane = tid & 63, wid = tid >> 6, g = wid & 3, th = wid >> 2;
    const int ch = g * 64 + lane;
    int rowbase, t0, L;
    if (item < 256) { rowbase = (item >> 5) * SEQ; t0 = (item & 31) * 64; L = SEQ; }
    else { const int j = item - 256; rowbase = NLAT + (j >> 2) * CTXL; t0 = (j & 3) * 64; L = CTXL; }
    LAS float* zl = (LAS float*)lds;
    {
        u32x4 av[6], gv[6];
#pragma unroll
        for (int it = 0; it < 6; ++it) {
            int idx = tid + it * 512; idx = idx < 94 * 32 ? idx : 94 * 32 - 1;
            const int pr = idx >> 5, c8 = idx & 31; int pp = t0 - 15 + pr; pp = pp < 0 ? 0 : (pp >= L ? L - 1 : pp);
            const bf16_t* up = UC + (size_t)(rowbase + pp) * 512 + c8 * 8;
            av[it] = *(const u32x4*)up; gv[it] = *(const u32x4*)(up + 256);
        }
#pragma unroll
        for (int it = 0; it < 6; ++it) {
            const int idx = tid + it * 512;
            const int pr = idx >> 5, c8 = idx & 31, pp = t0 - 15 + pr;
            const float msk = (pp >= 0 && pp < L) ? 1.f : 0.f;
            f32x4 z0, z1;
#pragma unroll
            for (int q = 0; q < 4; ++q) {
                const float a_lo = __uint_as_float(av[it][q] << 16), a_hi = __uint_as_float(av[it][q] & 0xffff0000u);
                const float g_lo = __uint_as_float(gv[it][q] << 16), g_hi = __uint_as_float(gv[it][q] & 0xffff0000u);
                const float zlo = a_lo * sigmoidf_(g_lo) * msk, zhi = a_hi * sigmoidf_(g_hi) * msk;
                if (q < 2) { z0[2 * q] = zlo; z0[2 * q + 1] = zhi; } else { z1[2 * (q - 2)] = zlo; z1[2 * (q - 2) + 1] = zhi; }
            }
            if (idx < 94 * 32) { *(LAS f32x4*)(zl + pr * 256 + c8 * 8) = z0; *(LAS f32x4*)(zl + pr * 256 + c8 * 8 + 4) = z1; }
        }
    }
    __syncthreads();
    const int ts = t0 + th * 32;
    float w[31];
#pragma unroll
    for (int k = 0; k < 31; ++k) w[k] = p.conv_w[(size_t)l * 31 * 256 + k * 256 + ch];
    float o[32];
    const float bias = p.conv_b[l * 256 + ch];
    const LAS float* zp = zl + (th * 32) * 256 + ch;
    float z[62];
#pragma unroll
    for (int jj = 0; jj < 62; ++jj) z[jj] = zp[jj * 256];
#pragma unroll
    for (int i = 0; i < 32; ++i) {
        float acc = bias;
#pragma unroll
        for (int k = 0; k < 31; ++k) acc += w[k] * z[i + k];
        o[i] = acc;
    }
    const float lg = p.conv_ln_g[l * 256 + ch], lb = p.conv_ln_b[l * 256 + ch];
#pragma unroll
    for (int i = 0; i < 32; ++i) {
        const float mu = wave_sum(o[i]) * (1.f / 64.f);
        const float d = o[i] - mu;
        const float var = wave_sum(d * d) * (1.f / 64.f);
        const float zn = d * __builtin_amdgcn_rsqf(var + EPSV) * lg + lb;
        MIXA[(size_t)(rowbase + ts + i) * DM + 768 + ch] = f2bf(zn * sigmoidf_(zn));
    }
    __syncthreads();
}

__device__ __forceinline__ int drow_map(int mode, int n) {
    if (mode == 0) return n;
    if (mode == 1) {
        if (n < 1024) { const int cs = n & 255, head = cs >> 6, d = cs & 63, a = d >> 5, pp = (d >> 4) & 1, f = d & 15;
            return (n & ~255) + 128 * ((f >> 2) & 1) + 32 * head + 16 * pp + 4 * (2 * a + (f >> 3)) + (f & 3); }
        if (n < 1792) return n;
        { const int mm = n - 1792, cs = mm & 255;
          return 2048 + (mm & ~255) + 128 * ((cs >> 2) & 1) + 32 * ((cs >> 5) & 3) + 16 * (cs >> 7) + 4 * ((cs >> 3) & 3) + (cs & 3); }
    }
    const int r = 256 * (n >> 7) + 128 * ((n >> 2) & 1) + 32 * ((n >> 5) & 3) + 4 * ((n >> 3) & 3) + (n & 3);
    return mode == 2 ? r : r + 16;
}
__device__ __forceinline__ void transpose_item(const float* W, int ldw, int K, bf16_t* WT, int mode, LAS float* scr, int kb, int nb, int lane) {
    const int k0 = 64 * kb, n0 = 32 * nb;
#pragma unroll 8
    for (int i = 0; i < 32; ++i) { const int kk = 2 * i + (lane >> 5); scr[kk * 33 + (lane & 31)] = W[(size_t)(k0 + kk) * ldw + n0 + (lane & 31)]; }
    asm volatile("s_waitcnt lgkmcnt(0)" ::: "memory");
    const int c = lane & 7;
#pragma unroll
    for (int j = 0; j < 4; ++j) { const int n = (lane >> 3) + 8 * j; const LAS float* s = scr + (8 * c) * 33 + n;
        u32x4 o; o.x = cvt_pk_bf16(s[0 * 33], s[1 * 33]); o.y = cvt_pk_bf16(s[2 * 33], s[3 * 33]); o.z = cvt_pk_bf16(s[4 * 33], s[5 * 33]); o.w = cvt_pk_bf16(s[6 * 33], s[7 * 33]);
        *(u32x4*)(WT + (size_t)drow_map(mode, n0 + n) * K + k0 + 8 * c) = o; }
    asm volatile("s_waitcnt lgkmcnt(0)" ::: "memory");
}

__device__ __forceinline__ void prep_phase(const Params& p, LAS unsigned char* lds) {
    const int tid = fresh_tid(), lane = tid & 63, wave = tid >> 6, G = gridDim.x;
    const int gw = blockIdx.x * 8 + wave, NGW = G * 8;
    const int gt = blockIdx.x * 512 + tid, NGT = G * 512;
    unsigned char* ws = p.ws;
    LAS float* tab = (LAS float*)(lds + 73728);
    LAS float* t64c = tab + 2048; LAS float* t64s = t64c + 64;
    for (int m = tid; m < 2048; m += 512) tab[m] = cospif((float)m * (1.f / 1024.f));
    if (tid < 64) { t64c[tid] = cospif((float)tid * (1.f / 32.f)); t64s[tid] = sinpif((float)tid * (1.f / 32.f)); }
    __syncthreads();
    if (gt < 1024) { const int pos = gt >> 4, f = gt & 15; const float inv = powf(10000.f, -(float)f / 16.f); const float ang = (float)pos * inv;
        float* rope = (float*)(ws + WS_ROPE); rope[gt] = cosf(ang); rope[1024 + gt] = sinf(ang); }
    {
        LAS float* scr = (LAS float*)(lds + wave * 8448);
        constexpr int I_IN = 16 * 72, I_OUT = 16 * 32, I_F1 = 16 * 88, I_F2 = 44 * 32, I_L = I_IN + I_OUT + 2 * I_F1 + I_F2;
        for (int it = gw; it < 2 * I_L; it += NGW) {
            const int l = it / I_L; int r = it % I_L;
            if (r < I_IN) { const int kb = r / 72, nb = r % 72; if (nb >= 48 && nb < 56) continue;
                transpose_item(p.w_in + (size_t)l * DM * INW_SRC, INW_SRC, DM, (bf16_t*)(ws + WS_WIN) + (size_t)l * INW * DM, 1, scr, kb, nb, lane); continue; }
            r -= I_IN;
            if (r < I_OUT) { transpose_item(p.w_out + (size_t)l * DM * DM, DM, DM, (bf16_t*)(ws + WS_WOUT) + (size_t)l * DM * DM, 0, scr, r / 32, r % 32, lane); continue; }
            r -= I_OUT;
            if (r < I_F1) { transpose_item(p.w_ffn1 + (size_t)l * DM * DFF, DFF, DM, (bf16_t*)(ws + WS_W13) + (size_t)l * N13 * DM, 2, scr, r / 88, r % 88, lane); continue; }
            r -= I_F1;
            if (r < I_F1) { transpose_item(p.w_ffn3 + (size_t)l * DM * DFF, DFF, DM, (bf16_t*)(ws + WS_W13) + (size_t)l * N13 * DM, 3, scr, r / 88, r % 88, lane); continue; }
            r -= I_F1;
            transpose_item(p.w_ffn2 + (size_t)l * DFF * DM, DM, DFF, (bf16_t*)(ws + WS_W2) + (size_t)l * DM * DFF, 0, scr, r / 32, r % 32, lane);
        }
    }
    {
        const float tcl = cospif((float)lane * (1.f / 32.f)), tsl = sinpif((float)lane * (1.f / 32.f));
        for (int it = gw; it < 2 * 4 * 16 * 16; it += NGW) {
            const int l = it >> 10, g = (it >> 8) & 3, kbk = (it >> 4) & 15, lqg = it & 15;
            const int k = kbk * 64 + lane;
            const float* wr_ = p.w_in + (size_t)l * DM * INW_SRC + (size_t)k * INW_SRC + 1536 + g * 64;
            float wv[64];
#pragma unroll
            for (int c4 = 0; c4 < 16; ++c4) { const f32x4 v = *(const f32x4*)(wr_ + 4 * c4); wv[4 * c4] = v[0]; wv[4 * c4 + 1] = v[1]; wv[4 * c4 + 2] = v[2]; wv[4 * c4 + 3] = v[3]; }
            bf16_t* wt = (bf16_t*)(ws + WS_WIN) + (size_t)l * INW * DM;
#pragma unroll 1
            for (int li = 0; li < 4; ++li) {
                const int lq = __builtin_amdgcn_readfirstlane(lqg * 4 + li);
                float ac = 0.f, as = 0.f;
#pragma unroll
                for (int c = 0; c < 64; ++c) {
                    const int m = (lq * c) & 63;
                    const float ct = __int_as_float(__builtin_amdgcn_readlane(__float_as_int(tcl), m)), st = __int_as_float(__builtin_amdgcn_readlane(__float_as_int(tsl), m));
                    ac += wv[c] * ct; as += wv[c] * st;
                }
                wt[(size_t)(1536 + g * 64 + lq) * DM + k] = f2bf(ac);
                wt[(size_t)(1536 + 256 + g * 64 + lq) * DM + k] = f2bf(as);
            }
        }
    }
    for (int e = gt; e < 2 * WSM_L; e += NGT) {
        const int l = e / WSM_L, r = e % WSM_L; float v;
        if (r < 256 * 512) { const int n = r >> 9, k = r & 255; const int g = n >> 6, d = n & 63, g2 = k >> 6, c = k & 63; v = (g == g2) ? p.w_fourier[(((size_t)l * 4 + g) * 64 + c) * 64 + d] : 0.f; }
        else { const int r2 = r - 256 * 512, n = r2 >> 8, k = r2 & 255; v = p.w_conv_out[((size_t)l * 256 + k) * 256 + n]; }
        ((bf16_t*)(ws + WS_WSM))[e] = f2bf(v);
    }
    {
        const float nl = 1.f / sqrtf(2048.f * 64.f), nc = 1.f / 128.f;
        for (int e = gt; e < 2048 * 4096 / 8; e += NGT) {
            const int k = e >> 9, col0 = (e & 511) * 8, s = col0 >> 11; float v[8];
#pragma unroll
            for (int j = 0; j < 8; ++j) { const int n = (col0 + j) & 2047, m = (k * n) & 2047; v[j] = s ? -tab[(m - 512) & 2047] * nl : tab[m] * nl; }
            u32x4 o; o.x = cvt_pk_bf16(v[0], v[1]); o.y = cvt_pk_bf16(v[2], v[3]); o.z = cvt_pk_bf16(v[4], v[5]); o.w = cvt_pk_bf16(v[6], v[7]);
            *(u32x4*)((bf16_t*)(ws + WS_DFTL) + (size_t)e * 8) = o;
        }
        for (int e = gt; e < 256 * 512 / 8; e += NGT) {
            const int k = e >> 6, col0 = (e & 63) * 8, s = col0 >> 8; float v[8];
#pragma unroll
            for (int j = 0; j < 8; ++j) { const int n = (col0 + j) & 255, m = ((k * n) & 255) * 8; v[j] = s ? -tab[(m - 512) & 2047] * nc : tab[m] * nc; }
            u32x4 o; o.x = cvt_pk_bf16(v[0], v[1]); o.y = cvt_pk_bf16(v[2], v[3]); o.z = cvt_pk_bf16(v[4], v[5]); o.w = cvt_pk_bf16(v[6], v[7]);
            *(u32x4*)((bf16_t*)(ws + WS_DFTC) + (size_t)e * 8) = o;
        }
    }
    for (int it = gw; it < 2 * 96 * 8; it += NGW) {
        const int l = it / 768, r = it % 768, cgp = r >> 3, kc = r & 7;
        const int col = cgp * 64 + lane, k0 = kc * 128;
        float sv[9][2];
#pragma unroll
        for (int b = 0; b < 9; ++b)
#pragma unroll
            for (int hh = 0; hh < 2; ++hh) { const int k = k0 + hh * 64 + lane; const float cv = (b < 8) ? p.c[b * DM + k] : p.c_ctx[k]; sv[b][hh] = cv * sigmoidf_(cv); }
        float ac[9];
#pragma unroll
        for (int b = 0; b < 9; ++b) ac[b] = 0.f;
        const float* wp = p.w_ada + ((size_t)l * DM + k0) * 6144 + col;
#pragma unroll
        for (int hh = 0; hh < 2; ++hh) {
#pragma unroll 8
            for (int kk = 0; kk < 64; ++kk) {
                const float wv = wp[(size_t)(hh * 64 + kk) * 6144];
#pragma unroll
                for (int b = 0; b < 9; ++b) ac[b] += __int_as_float(__builtin_amdgcn_readlane(__float_as_int(sv[b][hh]), kk)) * wv;
            }
        }
        const float bias = (kc == 0) ? p.b_ada[l * 6144 + col] : 0.f;
        float* mod = (float*)(ws + WS_MOD) + (size_t)l * 9 * 6144;
#pragma unroll
        for (int b = 0; b < 9; ++b) atomicAdd(mod + b * 6144 + col, ac[b] + bias);
    }
}

__device__ __forceinline__ void norm_phase(const float* xlat, const float* xctx, const float* gvec, const float* mod, int sh_off, int sc_off, bf16_t* H, int nrows,
                                           const float* part, const float* pgate, float* xctx_out, int row_lo) {
    const int tid = fresh_tid(), lane = tid & 63, gw = row_lo + blockIdx.x * 8 + (tid >> 6), NGW = gridDim.x * 8;
    f32x4 vn[4];
#define NORM_LOADX(dst, r_) do { const int r__ = (r_); const float* xr_ = r__ < NLAT ? xlat + (size_t)r__ * DM : xctx + (size_t)(r__ - NLAT) * DM; \
        _Pragma("unroll") for (int j = 0; j < 4; ++j) dst[j] = *(const f32x4*)(xr_ + 4 * lane + 256 * j); } while (0)
    if (gw < nrows) NORM_LOADX(vn, gw);
    for (int row = gw; row < nrows; row += NGW) {
        const int bb = row < NLAT ? row >> 11 : 8;
        f32x4 v[4]; float ss = 0.f;
#pragma unroll
        for (int j = 0; j < 4; ++j) v[j] = vn[j];
        if (row + NGW < nrows) NORM_LOADX(vn, row + NGW);
        const float* mp = mod + bb * 6144;
        f32x4 gg[4], sc[4], sh[4];
#pragma unroll
        for (int j = 0; j < 4; ++j) { const int col = 4 * lane + 256 * j; gg[j] = *(const f32x4*)(gvec + col); sc[j] = *(const f32x4*)(mp + sc_off + col); sh[j] = *(const f32x4*)(mp + sh_off + col); }
        if (part != nullptr && row >= NLAT) {
#pragma unroll
            for (int j = 0; j < 4; ++j) {
                const size_t o = (size_t)(row - NLAT) * DM + 4 * lane + 256 * j;
                const f32x4 ps = (*(const f32x4*)(part + o) + *(const f32x4*)(part + (size_t)NCTX * DM + o)) + (*(const f32x4*)(part + (size_t)2 * NCTX * DM + o) + *(const f32x4*)(part + (size_t)3 * NCTX * DM + o));
                v[j] = v[j] + *(const f32x4*)(pgate + 4 * lane + 256 * j) * ps;
                *(f32x4*)(xctx_out + o) = v[j];
            }
        }
#pragma unroll
        for (int j = 0; j < 4; ++j) ss += (v[j][0] * v[j][0] + v[j][1] * v[j][1]) + (v[j][2] * v[j][2] + v[j][3] * v[j][3]);
        const float rstd = __builtin_amdgcn_rsqf(wave_sum(ss) * (1.f / DM) + EPSV);
#pragma unroll
        for (int j = 0; j < 4; ++j) {
            const int col = 4 * lane + 256 * j;
            const f32x4 y = (v[j] * rstd) * gg[j];
            const f32x4 hv = y * (sc[j] + 1.f) + sh[j];
            *(u32x2*)(H + (size_t)row * DM + col) = pack4(hv);
        }
    }
#undef NORM_LOADX
}

__global__ void __launch_bounds__(512, 2) fwd_kernel(Params p) {
    extern __shared__ __attribute__((aligned(16))) unsigned char lds_raw[];
    LAS unsigned char* lds = (LAS unsigned char*)lds_raw;
    cg::grid_group grid = cg::this_grid();
    const int G = gridDim.x, cu = blockIdx.x;
    unsigned char* ws = p.ws;
    bf16_t* H = (bf16_t*)(ws + WS_H);
    bf16_t* Q1 = (bf16_t*)(ws + WS_Q1); bf16_t* Q2 = (bf16_t*)(ws + WS_Q2); bf16_t* K1c = (bf16_t*)(ws + WS_K1); bf16_t* K2c = (bf16_t*)(ws + WS_K2);
    bf16_t* VT = (bf16_t*)(ws + WS_VT); bf16_t* TTl = (bf16_t*)(ws + WS_TTL); bf16_t* TTc = (bf16_t*)(ws + WS_TTC); bf16_t* UC = (bf16_t*)(ws + WS_UC);
    bf16_t* MIXA = (bf16_t*)(ws + WS_MIX); bf16_t* ACT = (bf16_t*)(ws + WS_ACT);
    float* PB1 = (float*)(ws + WS_R); float* PB2 = (float*)(ws + WS_R + 99 * MiB);
    bf16_t* FP = (bf16_t*)(ws + WS_H);
    float* XL = p.out; float* XC = (float*)(ws + WS_XCTX);
    const float* rope = (const float*)(ws + WS_ROPE);

    volatile LAS unsigned* bst = (volatile LAS unsigned*)(lds + LDS_BYTES - 64);
    if (threadIdx.x < 2) bst[threadIdx.x] = 0u;
    __syncthreads();
    const XcdBarrier xbar = xcd_barrier_post((unsigned*)(ws + WS_BAR), bst);
#define GSYNC() xcd_barrier(xbar)

    prep_phase(p, lds);
    grid.sync();

#pragma unroll 1
    for (int l = 0; l < 2; ++l) {
        const float* mod = (const float*)(ws + WS_MOD) + (size_t)l * 9 * 6144;
        const float* xin_l = l == 0 ? p.x : XL; const float* xin_c = l == 0 ? p.ctx : XC;
        const int mrows = l == 0 ? MTOT : NLAT;
        if (PROBE == 3) { for (int rep = 0; rep < 8; ++rep) GSYNC(); }
        norm_phase(xin_l, xin_c, p.norm1_g + l * DM, mod, 0, 1024, H, MTOT, l == 1 ? PB2 : nullptr, (const float*)(ws + WS_MOD) + 8 * 6144 + 5120, XC, (l == 1 && G == 256) ? NLAT : 0);
        GSYNC();
        for (int rep = 0; rep < (PROBE == 4 ? 2 : 1); ++rep) {
            if (rep) GSYNC();
            pg8::Gemm g{H, (const bf16_t*)(ws + WS_WIN) + (size_t)l * INW * DM, MTOT, INW, DM, DM, DM, 0};
            pg8::StaticOrder S; S.init(MTOT, INW, G, cu);
            EpiInProj E{Q1, Q2, K1c, K2c, VT, TTl, TTc, UC, rope};
            pg8::gemm_phase<EpiInProj, pg8::StaticOrder, true>(lds, g, S, E);
        }
        GSYNC();
        for (int rep = 0; rep < (PROBE == 1 ? 2 : 1); ++rep) {
            if (rep) GSYNC();
            const float li = 0.8f - 0.6f * __expf(-0.3f * (float)l);
            float lam;
            { const int lane = fresh_tid() & 63;
              const float s1 = wave_sum(p.lam_q1[l * 64 + lane] * p.lam_k1[l * 64 + lane]), s2 = wave_sum(p.lam_q2[l * 64 + lane] * p.lam_k2[l * 64 + lane]);
              lam = expf(s1) - expf(s2) + li; }
            att::Args A{Q1, Q2, K1c, K2c, VT, MIXA, p.subln_g + l * 128, lam, 1.f - li};
            const int n_att = 512 + (l == 0 ? 64 : 0);
            for (int u = cu; u < n_att; u += G) {
                if (u < 512) att::attn_unit(lds, A, u >> 6, (u >> 4) & 3, (u >> 6) * SEQ + (u & 15) * 128, 36);
                else { const int v = u - 512; att::attn_unit(lds, A, v >> 3, (v >> 1) & 3, NLAT + (v >> 3) * CTXL + (v & 1) * 128, 4); }
            }
#pragma unroll 1
            for (int hf = 0; hf < 2; ++hf) {
                pg8::Gemm g{(const bf16_t*)(ws + WS_DFTL) + hf * 2048, TTl + hf * 2048, 2048, 2048, 2048, 4096, 4096, 0};
                pg8::OffsetOrder S; S.init(2048, 2048, G, cu, 64 + 64 * hf);
                EpiMix E{FP, 512, hf * 256, 0, SEQ, 0};
                pg8::gemm_phase<EpiMix, pg8::OffsetOrder, true>(lds, g, S, E);
            }
            if (l == 0) {
#pragma unroll 1
                for (int hf = 0; hf < 2; ++hf) {
                    pg8::Gemm g{(const bf16_t*)(ws + WS_DFTC) + hf * 256, TTc + hf * 256, 256, 2048, 256, 512, 512, 0};
                    pg8::OffsetOrder S; S.init(256, 2048, G, cu, 192 + 8 * hf);
                    EpiMix E{FP, 512, hf * 256, NLAT, CTXL, 0};
                    pg8::gemm_phase<EpiMix, pg8::OffsetOrder, true>(lds, g, S, E);
                }
            }
            const int n_conv = l == 0 ? 288 : 256;
            if (G == 256) {
                const int sidx = cu < 64 ? cu : (cu >= 192 ? cu - 128 : -1);
                if (sidx >= 0) for (int it = sidx; it < n_conv; it += 128) conv_item(p, lds, l, it, UC, MIXA);
            } else for (int it = cu; it < n_conv; it += G) conv_item(p, lds, l, it, UC, MIXA);
        }
        GSYNC();
        {
            const bf16_t* wsm = (const bf16_t*)(ws + WS_WSM) + (size_t)l * WSM_L;
            {
                pg8::Gemm g{FP, wsm, mrows, 256, 512, 512, 512, 0};
                pg8::OffsetOrder S; S.init(mrows, 256, G, cu, 0);
                EpiMix E{MIXA, DM, 512, 0, 0, 0};
                pg8::gemm_phase<EpiMix, pg8::OffsetOrder, true>(lds, g, S, E);
            }
            {
                pg8::Gemm g{MIXA + 768, wsm + 256 * 512, mrows, 256, 256, DM, 256, 0};
                pg8::OffsetOrder S; S.init(mrows, 256, G, cu, 72);
                EpiMix E{MIXA, DM, 768, 0, 0, 0};
                pg8::gemm_phase<EpiMix, pg8::OffsetOrder, true>(lds, g, S, E);
            }
        }
        GSYNC();
        {
            pg8::Gemm g{MIXA, (const bf16_t*)(ws + WS_WOUT) + (size_t)l * DM * DM, mrows, DM, DM, DM, DM, 0};
            EpiRes E{xin_l, xin_c, XL, XC, mod, 2048, PB1};
            if (l == 0 && G == 256) {
                pg8::CtxSplitOrder S; S.init(DM, DM, G, cu);
                EpiResNormL0 EL{{xin_l, XL, mod, 2048, p.norm2_g, (unsigned*)(ws + WS_R + 40 * MiB), (unsigned*)(ws + WS_PCNT) + 2 * 64 * 64, H, 3072, 4096, mod}, PB1};
                pg8::gemm_phase<EpiResNormL0, pg8::CtxSplitOrder, true>(lds, g, S, EL);
            }
            else if (l == 0) { pg8::CtxSplitOrder S; S.init(DM, DM, G, cu); pg8::gemm_phase<EpiRes, pg8::CtxSplitOrder, true>(lds, g, S, E); }
            else if (G == 256) {
                pg8::StaticOrder S; S.init(mrows, DM, G, cu);
                EpiPanelNorm<1> EN{xin_l, XL, mod, 2048, p.norm2_g + l * DM, (unsigned*)(ws + WS_R), (unsigned*)(ws + WS_PCNT) + 64 * 64, H, 3072, 4096, mod};
                pg8::gemm_phase<EpiPanelNorm<1>, pg8::StaticOrder, true>(lds, g, S, EN);
            }
            else { pg8::StaticOrder S; S.init(mrows, DM, G, cu); pg8::gemm_phase<EpiRes, pg8::StaticOrder, true>(lds, g, S, E); }
        }
        GSYNC();
        if (!(l == 1 && G == 256)) {
        norm_phase(XL, l == 0 ? p.ctx : XC, p.norm2_g + l * DM, mod, 3072, 4096, H, mrows, l == 0 ? PB1 : nullptr, mod + 8 * 6144 + 2048, XC, (l == 0 && G == 256) ? NLAT : 0);
        GSYNC();
        }
        for (int rep = 0; rep < (PROBE == 2 ? 2 : 1); ++rep) {
            if (rep) GSYNC();
            pg8::Gemm g{H, (const bf16_t*)(ws + WS_W13) + (size_t)l * N13 * DM, mrows, N13, DM, DM, DM, 0};
            pg8::StaticOrder S; S.init(mrows, N13, G, cu);
            EpiFfn13 E{ACT};
            pg8::gemm_phase<EpiFfn13, pg8::StaticOrder, true>(lds, g, S, E);
        }
        GSYNC();
        {
            pg8::Gemm g{ACT, (const bf16_t*)(ws + WS_W2) + (size_t)l * DM * DFF, mrows, DM, DFF, DFF, DFF, 0};
            EpiRes E{XL, XC, XL, XC, mod, 5120, PB2};
            if (l == 0 && G == 256) {
                pg8::CtxSplitOrder S; S.init(DM, DFF, G, cu);
                EpiResNormL0 EL{{XL, XL, mod, 5120, p.norm1_g + DM, (unsigned*)(ws + 244 * MiB), (unsigned*)(ws + WS_PCNT) + 3 * 64 * 64, H, 0, 1024, mod + 9 * 6144}, PB2};
                pg8::gemm_phase<EpiResNormL0, pg8::CtxSplitOrder, true>(lds, g, S, EL);
            }
            else if (l == 0) { pg8::CtxSplitOrder S; S.init(DM, DFF, G, cu); pg8::gemm_phase<EpiRes, pg8::CtxSplitOrder, true>(lds, g, S, E); }
            else if (G == 256) {
                pg8::StaticOrder S; S.init(mrows, DM, G, cu);
                EpiPanelNorm<0> EF{XL, XL, mod, 5120, p.final_g, (unsigned*)(ws + WS_H), (unsigned*)(ws + WS_PCNT), nullptr, 0, 0, mod};
                pg8::gemm_phase<EpiPanelNorm<0>, pg8::StaticOrder, true>(lds, g, S, EF);
            }
            else { pg8::StaticOrder S; S.init(mrows, DM, G, cu); pg8::gemm_phase<EpiRes, pg8::StaticOrder, true>(lds, g, S, E); }
        }
        if (!(l == 1 && G == 256)) GSYNC();
    }
    if (G != 256) {
        const int tid = fresh_tid(), lane = tid & 63, gw = blockIdx.x * 8 + (tid >> 6), NGW = gridDim.x * 8;
        f32x4 gg[4], vn[4];
#pragma unroll
        for (int j = 0; j < 4; ++j) { gg[j] = *(const f32x4*)(p.final_g + 4 * lane + 256 * j); vn[j] = *(const f32x4*)(XL + (size_t)gw * DM + 4 * lane + 256 * j); }
        for (int row = gw; row < NLAT; row += NGW) {
            float* xr = XL + (size_t)row * DM;
            f32x4 v[4]; float ss = 0.f;
#pragma unroll
            for (int j = 0; j < 4; ++j) { v[j] = vn[j]; ss += (v[j][0] * v[j][0] + v[j][1] * v[j][1]) + (v[j][2] * v[j][2] + v[j][3] * v[j][3]); }
            if (row + NGW < NLAT) {
#pragma unroll
                for (int j = 0; j < 4; ++j) vn[j] = *(const f32x4*)(xr + (size_t)NGW * DM + 4 * lane + 256 * j);
            }
            const float rstd = __builtin_amdgcn_rsqf(wave_sum(ss) * (1.f / DM) + EPSV);
#pragma unroll
            for (int j = 0; j < 4; ++j) { const int col = 4 * lane + 256 * j; *(f32x4*)(xr + col) = (v[j] * rstd) * gg[j]; }
        }
    }
}

extern "C" void kernel_launch(void* const* d_in, const int* in_sizes, int n_in, void* d_out, int out_size, void* d_ws, size_t ws_size, hipStream_t stream) {
    static int grid_blocks = 0;
    if (grid_blocks == 0) {
        if (n_in != 25 || ws_size < WS_END) { fprintf(stderr, "kernel_launch: unexpected n_in %d / ws %zu\n", n_in, ws_size); grid_blocks = -1; return; }
        int dev = 0, cus = 0, per_cu = 0;
        (void)hipGetDevice(&dev);
        (void)hipDeviceGetAttribute(&cus, hipDeviceAttributeMultiprocessorCount, dev);
        if (hipFuncSetAttribute((const void*)fwd_kernel, hipFuncAttributeMaxDynamicSharedMemorySize, LDS_BYTES) != hipSuccess) fprintf(stderr, "kernel_launch: hipFuncSetAttribute failed\n");
        if (hipOccupancyMaxActiveBlocksPerMultiprocessor(&per_cu, (const void*)fwd_kernel, 512, LDS_BYTES) != hipSuccess || per_cu < 1) { fprintf(stderr, "kernel_launch: occupancy query gave %d\n", per_cu); per_cu = 1; }
        (void)hipGetLastError();
        grid_blocks = cus * per_cu;
    }
    if (grid_blocks < 0) return;
    Params p{};
    const float** pp = (const float**)&p;
    for (int i = 0; i < 25; ++i) pp[i] = (const float*)d_in[i];
    p.out = (float*)d_out; p.ws = (unsigned char*)d_ws;
    (void)hipMemsetAsync((unsigned char*)d_ws + WS_MOD, 0, ZERO_BYTES, stream);
    void* args[] = {&p};
    hipError_t e = hipLaunchCooperativeKernel((const void*)fwd_kernel, dim3(grid_blocks), dim3(512), args, LDS_BYTES, stream);
    if (e != hipSuccess) fprintf(stderr, "cooperative launch failed: %s (grid %d)\n", hipGetErrorString(e), grid_blocks);
}
```

```cpp
#include <hip/hip_runtime.h>
#include <hip/hip_cooperative_groups.h>
#include <cstdint>
#include <cstdio>
namespace cg = cooperative_groups;
#ifndef PROBE
#define PROBE 0
#endif

#define LAS __attribute__((address_space(3)))
typedef unsigned short bf16_t;
typedef short bf16x8 __attribute__((ext_vector_type(8)));
typedef float f32x4 __attribute__((ext_vector_type(4)));
typedef float f32x16 __attribute__((ext_vector_type(16)));
typedef unsigned u32x4 __attribute__((ext_vector_type(4)));
typedef unsigned u32x2 __attribute__((ext_vector_type(2)));

constexpr int NB = 8, SEQ = 2048, DM = 1024, CTXL = 256, NLAT = NB * SEQ, NCTX = NB * CTXL, MTOT = NLAT + NCTX;
constexpr int INW = 2560, INW_SRC = 2304, DFF = 2816, N13 = 2 * DFF, KCAT = CTXL + SEQ;
constexpr float EPSV = 1e-6f;
constexpr float QSCALE = 0.125f * 1.4426950408889634f;
constexpr int LDS_BYTES = 147456;
constexpr int XCD_BAR_WORDS_C = 3456;

constexpr size_t MiB = 1u << 20;
constexpr size_t WS_WIN = 0, WS_WOUT = 10 * MiB, WS_W13 = 14 * MiB, WS_W2 = 36 * MiB, WS_WSM = 47 * MiB, WS_DFTL = 48 * MiB, WS_DFTC = 64 * MiB;
constexpr size_t WS_MOD = 64 * MiB + 256 * 1024, WS_ROPE = 64 * MiB + 768 * 1024, WS_XCTX = 65 * MiB, WS_H = 73 * MiB, WS_R = 109 * MiB;
constexpr size_t WS_Q1 = WS_R, WS_Q2 = WS_R + 9 * MiB, WS_K1 = WS_R + 18 * MiB, WS_K2 = WS_R + 27 * MiB, WS_VT = WS_R + 36 * MiB, WS_TTL = WS_R + 54 * MiB,
                 WS_TTC = WS_R + 70 * MiB, WS_UC = WS_R + 72 * MiB, WS_MIX = WS_R + 90 * MiB, WS_ACT = WS_R, WS_END = WS_R + 131 * MiB;
constexpr size_t MOD_BYTES = 2 * 9 * 6144 * 4;
constexpr int WSM_L = 256 * 512 + 256 * 256;
constexpr size_t WS_BAR = 64 * MiB + 704 * 1024, WS_PCNT = 64 * MiB + 784 * 1024, ZERO_BYTES = WS_PCNT + 4 * 64 * 256 - WS_MOD;

struct Params {
    const float *x, *c, *ctx, *c_ctx, *w_ada, *b_ada, *norm1_g, *norm2_g, *w_in, *lam_q1, *lam_k1, *lam_q2, *lam_k2, *subln_g, *w_fourier, *conv_w, *conv_b,
        *conv_ln_g, *conv_ln_b, *w_conv_out, *w_out, *w_ffn1, *w_ffn3, *w_ffn2, *final_g;
    float* out; unsigned char* ws;
};

__device__ __forceinline__ unsigned cvt_pk_bf16(float lo, float hi) { unsigned r; asm("v_cvt_pk_bf16_f32 %0, %1, %2" : "=v"(r) : "v"(lo), "v"(hi)); return r; }
__device__ __forceinline__ u32x2 pack4(f32x4 v) { u32x2 w; w.x = cvt_pk_bf16(v[0], v[1]); w.y = cvt_pk_bf16(v[2], v[3]); return w; }
__device__ __forceinline__ bf16_t f2bf(float v) { return (bf16_t)(cvt_pk_bf16(v, 0.f) & 0xffffu); }
__device__ __forceinline__ float wave_sum(float v) {
#pragma unroll
    for (int o = 1; o < 64; o <<= 1) v += __shfl_xor(v, o);
    return v;
}
__device__ __forceinline__ int fresh_tid() { int t = threadIdx.x; asm volatile("" : "+v"(t)); return t; }
__device__ __forceinline__ float max3f(float a, float b, float c) { float r; asm("v_max3_f32 %0, %1, %2, %3" : "=v"(r) : "v"(a), "v"(b), "v"(c)); return r; }
__device__ __forceinline__ float sigmoidf_(float v) { return __builtin_amdgcn_rcpf(1.f + __expf(-v)); }


#define XB_TMO      128
#define XB_XCNT(j)  (256  + 64 * (j))
#define XB_XSUB(j)  (1280 + 64 * (j))
#define XB_XGEN(j)  (2304 + 64 * (j))
#define XB_TOP      3328
#define XB_TOPGEN   3392
#define XCD_BAR_WORDS 3456
#define XB_SPIN_CAP (1u << 18)
__device__ __forceinline__ unsigned xb_ld(unsigned* p)              { return __hip_atomic_load(p, __ATOMIC_RELAXED, __HIP_MEMORY_SCOPE_AGENT); }
__device__ __forceinline__ unsigned xb_add(unsigned* p, unsigned v) { return __hip_atomic_fetch_add(p, v, __ATOMIC_RELAXED, __HIP_MEMORY_SCOPE_AGENT); }
__device__ __forceinline__ unsigned xb_xcc_id() { return (unsigned)__builtin_amdgcn_s_getreg((3 << 11) | 20) & 0xFu; }
#define XB_SPIN(cond, bar) do { unsigned _sp = 0; while (cond) { \
    if ((++_sp & 255u) == 0u) { if (xb_ld(&(bar)[XB_TMO])) break; if (_sp > XB_SPIN_CAP) { atomicAdd(&(bar)[XB_TMO], 1u); break; } } } } while (0)
struct XcdBarrier { unsigned* bar; unsigned x; volatile LAS unsigned* st; };
__device__ __forceinline__ XcdBarrier xcd_barrier_post(unsigned* bar, volatile LAS unsigned* st) {
    XcdBarrier b; b.bar = bar; b.x = xb_xcc_id(); b.st = st;
    if (threadIdx.x == 0) (void)xb_add(&bar[XB_XCNT(b.x)], 1u);
    return b;
}
__device__ __forceinline__ void xcd_barrier_complete(unsigned* bar, unsigned x, unsigned& nloc, unsigned& nx) {
    const unsigned G = gridDim.x * gridDim.y * gridDim.z;
    unsigned sum, cnt, mine, sp = 0u;
    for (;;) {
        sum = 0u; cnt = 0u; mine = 0u;
#pragma unroll
        for (unsigned j = 0; j < 16; ++j) { const unsigned c = xb_ld(&bar[XB_XCNT(j)]); sum += c; cnt += (c > 0u) ? 1u : 0u; mine = (j == x) ? c : mine; }
        if (sum == G) break;
        __builtin_amdgcn_s_sleep(1);
        if ((++sp & 255u) == 0u) { if (xb_ld(&bar[XB_TMO])) break; if (sp > XB_SPIN_CAP) { atomicAdd(&bar[XB_TMO], 1u); break; } }
    }
    nloc = mine > 0u ? mine : 1u; nx = cnt > 0u ? cnt : 1u;
}
__device__ __forceinline__ void xcd_barrier(const XcdBarrier& b) {
    asm volatile("s_waitcnt vmcnt(0)" ::: "memory");
    __syncthreads();
    if (threadIdx.x == 0) {
        unsigned* bar = b.bar;
        __builtin_amdgcn_s_waitcnt(0);
        unsigned nloc = b.st[0], nx = b.st[1];
        if (nloc == 0u) { xcd_barrier_complete(bar, b.x, nloc, nx); b.st[0] = nloc; b.st[1] = nx; }
        const unsigned old = xb_add(&bar[XB_XSUB(b.x)], 1u);
        const unsigned gen = old / nloc;
        if (old + 1u == (gen + 1u) * nloc) {
            __builtin_amdgcn_fence(__ATOMIC_RELEASE, "agent");
            asm volatile("s_waitcnt vmcnt(0)" ::: "memory");
            const unsigned og = xb_add(&bar[XB_TOP], 1u);
            const unsigned tg = og / nx;
            if (og + 1u == (tg + 1u) * nx) xb_add(&bar[XB_TOPGEN], 1u);
            else XB_SPIN(xb_ld(&bar[XB_TOPGEN]) == tg, bar);
            __builtin_amdgcn_fence(__ATOMIC_ACQUIRE, "agent");
            xb_add(&bar[XB_XGEN(b.x)], 1u);
            asm volatile("s_waitcnt vmcnt(0)" ::: "memory");
        } else {
            XB_SPIN(xb_ld(&bar[XB_XGEN(b.x)]) == gen, bar);
            __builtin_amdgcn_fence(__ATOMIC_ACQUIRE, "agent");
            asm volatile("s_waitcnt vmcnt(0)" ::: "memory");
        }
    }
    __syncthreads();
}

namespace pg8 {
constexpr int BM = 256, BK = 64, HALF = 128, HTB = HALF * BK * 2, STAGE_BYTES = 8 * HTB, NXCD = 8, WGM = 8;
__host__ __device__ __forceinline__ int lds_byte(int r, int c) { const int st = (r >> 4) * 2 + (c >> 5), rr = r & 15, cc = c & 31, ob = rr * 64 + cc * 2; return st * 1024 + (ob ^ (((ob >> 9) & 1) << 5)); }
__host__ __device__ __forceinline__ void stage_rc(int b, int& R, int& C) { const int st = b / 1024, sb = b % 1024, swz = sb ^ (((sb >> 9) & 1) << 5); R = (st >> 1) * 16 + swz / 64; C = (st & 1) * 32 + (swz % 64) / 2; }

__host__ __device__ __forceinline__ int perm32(int rho) { const int n = rho >> 4, i = rho & 15; return 8 * (i >> 2) + 4 * n + (i & 3); }
struct Unit { int pm, pn, k0, nt, flags; };
struct Gemm { const bf16_t* A; const bf16_t* Bt; int M, N, K, lda, ldb, a_pn_off; };

struct StaticOrder {
    int nM, nN, nwg, G, c;
    __host__ __device__ void init(int M, int N, int G_, int c_) { nM = M / BM; nN = N / BM; nwg = nM * nN; G = G_; c = c_; }
    __host__ __device__ __forceinline__ bool next(int i, Unit& u) const {
        const long L = (long)i * G + c; if (L >= nwg) return false;
        int wgid = (int)L; { const int q = nwg / NXCD, r = nwg % NXCD, xcd = wgid % NXCD, off = wgid / NXCD; wgid = (xcd < r ? xcd * (q + 1) : r * (q + 1) + (xcd - r) * q) + off; }
        const int nig = WGM * nN, gid = wgid / nig, fm = gid * WGM, gsz = (nM - fm) < WGM ? (nM - fm) : WGM;
        u.pm = fm + ((wgid % nig) % gsz); u.pn = (wgid % nig) / gsz; u.k0 = 0; u.nt = -1; u.flags = 0; return true;
    }
};
struct OffsetOrder {
    int nN, nwg, G, cc;
    __host__ __device__ void init(int M, int N, int G_, int c_, int off) { nN = N / BM; nwg = (M / BM) * nN; G = G_; cc = ((c_ - off) % G_ + G_) % G_; }
    __host__ __device__ __forceinline__ bool next(int i, Unit& u) const { const long L = (long)i * G + cc; if (L >= nwg) return false; u.pm = (int)L / nN; u.pn = (int)L % nN; u.k0 = 0; u.nt = -1; u.flags = 0; return true; }
};

struct CtxSplitOrder {
    StaticOrder lat; int nN, ntf;
    __host__ __device__ void init(int N, int K, int G_, int c_) { lat.init(NLAT, N, G_, c_); nN = N / BM; ntf = K / BK; }
    __host__ __device__ __forceinline__ bool next(int i, Unit& u) const {
        const long L = (long)i * lat.G + lat.c;
        int pm, pn, k0 = 0, ntq = -1, fl = 0;
        if (L < lat.nwg) {
            int wgid = (int)L; { const int q = lat.nwg / NXCD, r = lat.nwg % NXCD, xcd = wgid % NXCD, off = wgid / NXCD; wgid = (xcd < r ? xcd * (q + 1) : r * (q + 1) + (xcd - r) * q) + off; }
            const int nig = WGM * lat.nN, gid = wgid / nig, fm = gid * WGM, gsz = (lat.nM - fm) < WGM ? (lat.nM - fm) : WGM;
            pm = fm + ((wgid % nig) % gsz); pn = (wgid % nig) / gsz;
        } else {
            const int s = (int)(L - lat.nwg); if (s >= (NCTX / BM) * nN * 4) return false;
            const int cu_ = s >> 2, q = s & 3, base = (ntf / 8) * 2, extra = (ntf - 4 * base) / 2;
            pm = NLAT / BM + cu_ / nN; pn = cu_ % nN; ntq = base + (q < extra ? 2 : 0); k0 = (q * base + 2 * (q < extra ? q : extra)) * BK; fl = 1 | (q << 1);
        }
        u.pm = pm; u.pn = pn; u.k0 = k0; u.nt = ntq; u.flags = fl; return true;
    }
};

template <class Epi, class Sched, bool ALIGN_EPI>
__device__ __forceinline__ void gemm_phase(LAS unsigned char* lds, const Gemm g, const Sched& S, const Epi& E) {
    const int tid = fresh_tid(), wid = __builtin_amdgcn_readfirstlane(tid >> 6), lane = tid & 63, wr = wid >> 2, wc = wid & 3, fr = lane & 15, fq = lane >> 4;
    const int K = g.K, nt = K / BK;
    unsigned voffA[2], voffB[2];
#pragma unroll
    for (int i = 0; i < 2; ++i) { int R, C; stage_rc(tid * 16 + i * 8192, R, C);
        const int Rb = Epi::PERM ? ((R & ~31) + perm32(R & 31)) : R;
        voffA[i] = (unsigned)(R * g.lda + C) * 2u; voffB[i] = (unsigned)(Rb * g.ldb + C) * 2u; }
    const size_t kstep = (size_t)(BK * 2);
    const size_t hstepA = (size_t)HALF * g.lda * 2, hstepB = (size_t)HALF * g.ldb * 2;
    const size_t tstepA = 2 * hstepA, tstepB = 2 * hstepB;
    const unsigned ldsw = (unsigned)wid * 1024u;
    const int aoff = lds_byte(wr * 64 + fr, fq * 8), boff = lds_byte(wc * 32 + fr, fq * 8);
#define PG8_SA(b, h) (((b) * 2 + (h)) * HTB)
#define PG8_SB(b, h) ((4 + (b) * 2 + (h)) * HTB)
#define PG8_STAGE(bufoff, gbase, voff) do { _Pragma("unroll") for (int _i = 0; _i < 2; ++_i) \
        __builtin_amdgcn_global_load_lds((const unsigned*)((const char*)(gbase) + (voff)[_i]), (LAS unsigned*)(lds + (bufoff) + ldsw + _i * 8192), 16, 0, 0); } while (0)
#define PG8_LDA(dst, b, h) do { _Pragma("unroll") for (int m = 0; m < 4; ++m) _Pragma("unroll") for (int k = 0; k < 2; ++k) dst[m][k] = *(const LAS bf16x8*)(lds + PG8_SA(b, h) + aoff + m * 2048 + k * 1024); } while (0)
#define PG8_LDB(dst, b, h) do { _Pragma("unroll") for (int n = 0; n < 2; ++n) _Pragma("unroll") for (int k = 0; k < 2; ++k) dst[n][k] = *(const LAS bf16x8*)(lds + PG8_SB(b, h) + boff + n * 2048 + k * 1024); } while (0)
#define PG8_MMA(ai, bj, At, Bt) do { __builtin_amdgcn_s_setprio(1); _Pragma("unroll") for (int m = 0; m < 4; ++m) _Pragma("unroll") for (int n = 0; n < 2; ++n) _Pragma("unroll") for (int k = 0; k < 2; ++k) \
        acc[ai][bj][m][n] = __builtin_amdgcn_mfma_f32_16x16x32_bf16(Bt[n][k], At[m][k], acc[ai][bj][m][n], 0, 0, 0); __builtin_amdgcn_s_setprio(0); } while (0)
#define PG8_WAIT_V(n) asm volatile("s_waitcnt vmcnt(" #n ")" ::: "memory")
#define PG8_WAIT_L(n) asm volatile("s_waitcnt lgkmcnt(" #n ")" ::: "memory")
#define PG8_BAR __builtin_amdgcn_s_barrier()
#define PG8_SCHED __builtin_amdgcn_sched_barrier(0)
    Unit cur, nxt; int ui = 0;
    if (!S.next(0, cur)) return;
    f32x4 acc[2][2][4][2];
#pragma unroll
    for (int a = 0; a < 2; ++a)
#pragma unroll
        for (int b = 0; b < 2; ++b)
#pragma unroll
            for (int m = 0; m < 4; ++m)
#pragma unroll
                for (int n = 0; n < 2; ++n) acc[a][b][m][n] = (f32x4){0.f, 0.f, 0.f, 0.f};
    bf16x8 At[4][2], B0[2][2], B1[2][2];
    const char* cA = (const char*)g.A + (size_t)cur.pm * tstepA + (size_t)cur.pn * g.a_pn_off * 2 + (size_t)cur.k0 * 2; const char* cB = (const char*)g.Bt + (size_t)cur.pn * tstepB + (size_t)cur.k0 * 2;
    PG8_STAGE(PG8_SB(0, 0), cB, voffB); PG8_STAGE(PG8_SB(0, 1), cB + hstepB, voffB); PG8_STAGE(PG8_SA(0, 0), cA, voffA); PG8_STAGE(PG8_SA(0, 1), cA + hstepA, voffA);
    if (wr == 1) PG8_BAR;
    PG8_WAIT_V(2); PG8_BAR;
    PG8_STAGE(PG8_SB(1, 0), cB + kstep, voffB); PG8_STAGE(PG8_SA(1, 0), cA + kstep, voffA); PG8_STAGE(PG8_SB(1, 1), cB + hstepB + kstep, voffB);
    PG8_WAIT_V(6); PG8_BAR;
    for (;;) {
        const bool has_next = S.next(ui + 1, nxt);
        const char* nA = has_next ? (const char*)g.A + (size_t)nxt.pm * tstepA + (size_t)nxt.pn * g.a_pn_off * 2 + (size_t)nxt.k0 * 2 : cA; const char* nB = has_next ? (const char*)g.Bt + (size_t)nxt.pn * tstepB + (size_t)nxt.k0 * 2 : cB;
        const int ntc = cur.nt < 0 ? nt : cur.nt;
        for (int t = 0; t < ntc; t += 2) {
            const bool last = (t == ntc - 2);
            const char* a1 = cA + (size_t)(t + 1) * kstep;
            const char* a2 = last ? nA : cA + (size_t)(t + 2) * kstep; const char* b2 = last ? nB : cB + (size_t)(t + 2) * kstep;
            const char* a3 = a2 + kstep; const char* b3 = b2 + kstep;
            PG8_LDB(B0, 0, 0); PG8_LDB(B1, 0, 1); PG8_SCHED; PG8_LDA(At, 0, 0); PG8_STAGE(PG8_SA(1, 1), a1 + hstepA, voffA);
            PG8_WAIT_V(8); PG8_WAIT_L(0); PG8_BAR; PG8_MMA(0, 0, At, B0); PG8_MMA(0, 1, At, B1); PG8_BAR; PG8_SCHED;
            PG8_LDA(At, 0, 1); PG8_STAGE(PG8_SB(0, 0), b2, voffB); PG8_STAGE(PG8_SB(0, 1), b2 + hstepB, voffB); PG8_STAGE(PG8_SA(0, 0), a2, voffA);
            PG8_WAIT_V(8); PG8_WAIT_L(0); PG8_BAR; PG8_MMA(1, 0, At, B0); PG8_MMA(1, 1, At, B1); PG8_BAR; PG8_SCHED;
            PG8_LDB(B0, 1, 0); PG8_LDB(B1, 1, 1); PG8_SCHED; PG8_LDA(At, 1, 0); PG8_STAGE(PG8_SA(0, 1), a2 + hstepA, voffA);
            PG8_WAIT_V(8); PG8_WAIT_L(0); PG8_BAR; PG8_MMA(0, 0, At, B0); PG8_MMA(0, 1, At, B1); PG8_BAR; PG8_SCHED;
            PG8_LDA(At, 1, 1); PG8_STAGE(PG8_SB(1, 0), b3, voffB); PG8_STAGE(PG8_SB(1, 1), b3 + hstepB, voffB); PG8_STAGE(PG8_SA(1, 0), a3, voffA);
            PG8_WAIT_V(8); PG8_WAIT_L(0); PG8_BAR; PG8_MMA(1, 0, At, B0); PG8_MMA(1, 1, At, B1); PG8_BAR; PG8_SCHED;
        }
        if constexpr (ALIGN_EPI) { if (wr == 0) PG8_BAR; }
        if constexpr (!Epi::AFTER_DRAIN) { if constexpr (Epi::LOOP_LDS) E.loop(acc, cur, wr, wc, fr, fq, lds + 131072, wid, lane); else E(acc, cur, wr, wc, fr, fq); }
        if (!has_next) break;
#pragma unroll
        for (int a = 0; a < 2; ++a)
#pragma unroll
            for (int b = 0; b < 2; ++b)
#pragma unroll
                for (int m = 0; m < 4; ++m)
#pragma unroll
                    for (int n = 0; n < 2; ++n) acc[a][b][m][n] = (f32x4){0.f, 0.f, 0.f, 0.f};
        cur = nxt; cA = nA; cB = nB; ++ui;
        if constexpr (ALIGN_EPI) { if (wr == 1) PG8_BAR; }
    }
    PG8_WAIT_V(0);
    if constexpr (!ALIGN_EPI) { if (wr == 0) PG8_BAR; }
    PG8_BAR;
    if constexpr (Epi::AFTER_DRAIN) E.fused(acc, cur, wr, wc, fr, fq, lds, wid, lane);
#undef PG8_SA
#undef PG8_SB
#undef PG8_STAGE
#undef PG8_LDA
#undef PG8_LDB
#undef PG8_MMA
#undef PG8_WAIT_V
#undef PG8_WAIT_L
#undef PG8_BAR
#undef PG8_SCHED
}
}

typedef f32x4 Acc[2][2][4][2];

struct EpiInProj {
    static constexpr bool PERM = false;
    static constexpr bool AFTER_DRAIN = false;
    static constexpr bool LOOP_LDS = false;
    bf16_t *Q1, *Q2, *K1c, *K2c, *VT, *TTl, *TTc, *UC; const float* rope;
    __device__ __forceinline__ void operator()(const Acc& acc, const pg8::Unit& u, int wr, int wc, int fr, int fq) const {
        const int pn = u.pn; const bool lat = u.pm < 64;
#pragma unroll
        for (int ai = 0; ai < 2; ++ai)
#pragma unroll
            for (int m = 0; m < 4; ++m) {
                const int row = u.pm * 256 + ai * 128 + wr * 64 + m * 16 + fr;
                int b, t; if (lat) { b = row >> 11; t = row & 2047; } else { const int rc = row - NLAT; b = rc >> 8; t = rc & 255; }
                const int pos = lat ? CTXL + t : t;
                if (pn < 4) {
                    bf16_t* dst;
                    if (pn == 0) dst = Q1 + (size_t)row * 256; else if (pn == 1) dst = Q2 + (size_t)row * 256;
                    else if (pn == 2) dst = K1c + ((size_t)b * KCAT + pos) * 256; else dst = K2c + ((size_t)b * KCAT + pos) * 256;
                    const float scale = pn < 2 ? QSCALE : 1.f;
                    const int ax = fq >> 1, fh = fq & 1;
                    u32x4 w1, w2;
#pragma unroll
                    for (int bj = 0; bj < 2; ++bj) {
                        f32x4 cs = {1.f, 1.f, 1.f, 1.f}, sn = {0.f, 0.f, 0.f, 0.f};
                        if (lat) { const int pidx = ax ? (t & 63) : (t >> 6); cs = *(const f32x4*)(rope + pidx * 16 + 8 * fh + 4 * bj); sn = *(const f32x4*)(rope + 1024 + pidx * 16 + 8 * fh + 4 * bj); }
                        const f32x4 x1 = acc[ai][bj][m][0], x2 = acc[ai][bj][m][1];
                        const u32x2 p1 = pack4((x1 * cs - x2 * sn) * scale), p2 = pack4((x2 * cs + x1 * sn) * scale);
                        if (bj == 0) { w1.x = p1.x; w1.y = p1.y; w2.x = p2.x; w2.y = p2.y; } else { w1.z = p1.x; w1.w = p1.y; w2.z = p2.x; w2.w = p2.y; }
                    }
                    bf16_t* dq = dst + wc * 64 + ax * 32 + 8 * fh;
                    *(u32x4*)dq = w1; *(u32x4*)(dq + 16) = w2;
                } else if (pn < 6) {
#pragma unroll
                    for (int bj = 0; bj < 2; ++bj)
#pragma unroll
                        for (int n = 0; n < 2; ++n) {
                            bf16_t* dst = VT + ((size_t)(b * 4 + (pn - 4) * 2 + bj) * 128 + wc * 32 + n * 16 + 4 * fq) * KCAT + pos;
                            const f32x4 v = acc[ai][bj][m][n];
                            dst[0] = f2bf(v[0]); dst[KCAT] = f2bf(v[1]); dst[2 * KCAT] = f2bf(v[2]); dst[3 * KCAT] = f2bf(v[3]);
                        }
                } else if (pn < 8) {
                    const int s = pn - 6;
#pragma unroll
                    for (int bj = 0; bj < 2; ++bj)
#pragma unroll
                        for (int n = 0; n < 2; ++n) {
                            const int jf = bj * 128 + wc * 32 + n * 16 + 4 * fq;
                            const f32x4 v = acc[ai][bj][m][n];
                            if (lat) { bf16_t* dst = TTl + (((size_t)b * 256 + jf) * 2 + s) * SEQ + t; dst[0] = f2bf(v[0]); dst[2 * SEQ] = f2bf(v[1]); dst[4 * SEQ] = f2bf(v[2]); dst[6 * SEQ] = f2bf(v[3]); }
                            else { bf16_t* dst = TTc + (((size_t)b * 256 + jf) * 2 + s) * CTXL + t; dst[0] = f2bf(v[0]); dst[2 * CTXL] = f2bf(v[1]); dst[4 * CTXL] = f2bf(v[2]); dst[6 * CTXL] = f2bf(v[3]); }
                        }
                } else {
                    bf16_t* dst = UC + (size_t)row * 512 + (pn - 8) * 256 + wc * 32 + 8 * fq;
#pragma unroll
                    for (int n = 0; n < 2; ++n) { const u32x2 p0 = pack4(acc[ai][0][m][n]), p1 = pack4(acc[ai][1][m][n]); *(u32x4*)(dst + 128 * n) = (u32x4){p0.x, p0.y, p1.x, p1.y}; }
                }
            }
    }
};

struct EpiRes {
    static constexpr bool PERM = false;
    static constexpr bool AFTER_DRAIN = false;
    static constexpr bool LOOP_LDS = false;
    const float* xin_lat; const float* xin_ctx; float* xout_lat; float* xout_ctx; const float* mod; int goff; float* pb;
    __device__ __forceinline__ void operator()(const Acc& acc, const pg8::Unit& u, int wr, int wc, int fr, int fq) const {
        const int tile0 = u.pm * 256, colb = u.pn * 256 + wc * 32 + 4 * fq, rloc = wr * 64 + fr;
        if (u.flags & 1) {
            float* pq = pb + ((size_t)(u.flags >> 1) * NCTX + (tile0 - NLAT) + rloc) * DM + colb;
#pragma unroll
            for (int ai = 0; ai < 2; ++ai)
#pragma unroll
                for (int m = 0; m < 4; ++m)
#pragma unroll
                    for (int bj = 0; bj < 2; ++bj)
#pragma unroll
                        for (int n = 0; n < 2; ++n) *(f32x4*)(pq + (size_t)(ai * 128 + m * 16) * DM + bj * 128 + n * 16) = acc[ai][bj][m][n];
            return;
        }
        const bool lat = tile0 < NLAT;
        const float* xi = (lat ? xin_lat + (size_t)tile0 * DM : xin_ctx + (size_t)(tile0 - NLAT) * DM) + (size_t)rloc * DM + colb;
        float* xo = (lat ? xout_lat + (size_t)tile0 * DM : xout_ctx + (size_t)(tile0 - NLAT) * DM) + (size_t)rloc * DM + colb;
        const float* gp = mod + (lat ? (tile0 >> 11) : 8) * 6144 + goff + colb;
        f32x4 gt[2][2];
#pragma unroll
        for (int bj = 0; bj < 2; ++bj)
#pragma unroll
            for (int n = 0; n < 2; ++n) gt[bj][n] = *(const f32x4*)(gp + bj * 128 + n * 16);
        f32x4 xv[2][2][2];
#define ER_LOAD(buf, g_) do { const float* xp_ = xi + (size_t)(((g_) >> 2) * 128 + ((g_) & 3) * 16) * DM; \
            _Pragma("unroll") for (int bj = 0; bj < 2; ++bj) _Pragma("unroll") for (int n = 0; n < 2; ++n) xv[buf][bj][n] = *(const f32x4*)(xp_ + bj * 128 + n * 16); } while (0)
        ER_LOAD(0, 0);
#pragma unroll
        for (int g_ = 0; g_ < 8; ++g_) {
            if (g_ + 1 < 8) ER_LOAD((g_ + 1) & 1, g_ + 1);
            float* xq = xo + (size_t)((g_ >> 2) * 128 + (g_ & 3) * 16) * DM;
#pragma unroll
            for (int bj = 0; bj < 2; ++bj)
#pragma unroll
                for (int n = 0; n < 2; ++n) *(f32x4*)(xq + bj * 128 + n * 16) = xv[g_ & 1][bj][n] + gt[bj][n] * acc[g_ >> 2][bj][g_ & 3][n];
        }
#undef ER_LOAD
    }
};

template <int MODE>
struct EpiPanelNorm {
    static constexpr bool PERM = true;
    static constexpr bool AFTER_DRAIN = true;
    static constexpr bool LOOP_LDS = false;
    const float* xin; float* out; const float* mod; int goff; const float* final_g; unsigned* slots; unsigned* cnt; bf16_t* Hout; int sh_off, sc_off; const float* modn;
    __device__ __forceinline__ void fused(Acc& acc, const pg8::Unit& u, int wr, int wc, int fr, int fq, LAS unsigned char* lds, int wid, int lane) const {
        const int tile0 = u.pm * 256, colb = u.pn * 256 + wc * 32 + 8 * fq, rloc = wr * 64 + fr;
        const float* xi = xin + (size_t)(tile0 + rloc) * DM + colb;
        float* xo = out + (size_t)(tile0 + rloc) * DM + colb;
        const float* gp = mod + (tile0 >> 11) * 6144 + goff + colb;
        f32x4 gt[2][2];
#pragma unroll
        for (int bj = 0; bj < 2; ++bj)
#pragma unroll
            for (int n = 0; n < 2; ++n) gt[bj][n] = *(const f32x4*)(gp + bj * 128 + n * 4);
        f32x4 xv[1][2][2];
#define EF_LOAD(buf, g_) do { const float* xp_ = xi + (size_t)(((g_) >> 2) * 128 + ((g_) & 3) * 16) * DM; \
            _Pragma("unroll") for (int bj = 0; bj < 2; ++bj) _Pragma("unroll") for (int n = 0; n < 2; ++n) xv[buf][bj][n] = *(const f32x4*)(xp_ + bj * 128 + n * 4); } while (0)
        LAS float* P = (LAS float*)lds;
        LAS float* S = (LAS float*)(lds + 4096);
#pragma unroll
        for (int g_ = 0; g_ < 8; ++g_) {
            EF_LOAD(0, g_);
            float sq = 0.f;
#pragma unroll
            for (int bj = 0; bj < 2; ++bj)
#pragma unroll
                for (int n = 0; n < 2; ++n) { const f32x4 xn = xv[0][bj][n] + gt[bj][n] * acc[g_ >> 2][bj][g_ & 3][n]; acc[g_ >> 2][bj][g_ & 3][n] = xn;
                    if (MODE == 1) *(f32x4*)(xo + (size_t)((g_ >> 2) * 128 + (g_ & 3) * 16) * DM + bj * 128 + n * 4) = xn;
                    sq += (xn[0] * xn[0] + xn[1] * xn[1]) + (xn[2] * xn[2] + xn[3] * xn[3]); }
            sq += __shfl_xor(sq, 16); sq += __shfl_xor(sq, 32);
            if (fq == 0) P[((g_ >> 2) * 128 + wr * 64 + (g_ & 3) * 16 + fr) * 4 + wc] = sq;
        }
#undef EF_LOAD
        asm volatile("s_waitcnt lgkmcnt(0)" ::: "memory"); __builtin_amdgcn_s_barrier(); asm volatile("" ::: "memory");
        const int row = wid * 32 + (lane & 31);
        if (lane < 32) { const float tsum = (P[row * 4 + 0] + P[row * 4 + 1]) + (P[row * 4 + 2] + P[row * 4 + 3]);
            __hip_atomic_store(slots + (size_t)(tile0 + row) * 4 + u.pn, __float_as_uint(tsum), __ATOMIC_RELAXED, __HIP_MEMORY_SCOPE_AGENT); }
        asm volatile("s_waitcnt vmcnt(0)" ::: "memory");
        if (lane == 0) __hip_atomic_fetch_add(cnt + 64 * u.pm, 1u, __ATOMIC_RELAXED, __HIP_MEMORY_SCOPE_AGENT);
        if (wid == 0) {
            unsigned sp = 0;
            while ((unsigned)__builtin_amdgcn_readfirstlane(__hip_atomic_load(cnt + 64 * u.pm, __ATOMIC_RELAXED, __HIP_MEMORY_SCOPE_AGENT)) < 32u) { if (++sp > (1u << 20)) break; }
            __builtin_amdgcn_fence(__ATOMIC_ACQUIRE, "agent");
        }
        asm volatile("s_waitcnt vmcnt(0) lgkmcnt(0)" ::: "memory"); __builtin_amdgcn_s_barrier(); asm volatile("" ::: "memory");
        if (lane < 32) { float tot = 0.f;
#pragma unroll
            for (int t4 = 0; t4 < 4; ++t4) tot += __uint_as_float(__hip_atomic_load(slots + (size_t)(tile0 + row) * 4 + t4, __ATOMIC_RELAXED, __HIP_MEMORY_SCOPE_AGENT));
            S[row] = __builtin_amdgcn_rsqf(tot * (1.f / DM) + EPSV); }
        asm volatile("s_waitcnt lgkmcnt(0)" ::: "memory"); __builtin_amdgcn_s_barrier(); asm volatile("" ::: "memory");
#pragma unroll
        for (int bj = 0; bj < 2; ++bj) {
            f32x4 fg[2], sc[2], sh[2];
#pragma unroll
            for (int n = 0; n < 2; ++n) { fg[n] = *(const f32x4*)(final_g + colb + bj * 128 + n * 4); sc[n] = (f32x4){1.f, 1.f, 1.f, 1.f}; sh[n] = (f32x4){0.f, 0.f, 0.f, 0.f};
                if (MODE == 1) { const float* mp = modn + (tile0 >> 11) * 6144 + colb + bj * 128 + n * 4; sc[n] = *(const f32x4*)(mp + sc_off) + 1.f; sh[n] = *(const f32x4*)(mp + sh_off); } }
#pragma unroll
            for (int g_ = 0; g_ < 8; ++g_) {
                const float rs = S[(g_ >> 2) * 128 + wr * 64 + (g_ & 3) * 16 + fr];
                const size_t ro = (size_t)((g_ >> 2) * 128 + (g_ & 3) * 16) * DM;
                const f32x4 y0 = (acc[g_ >> 2][bj][g_ & 3][0] * rs) * fg[0], y1 = (acc[g_ >> 2][bj][g_ & 3][1] * rs) * fg[1];
                if (MODE == 0) { *(f32x4*)(xo + ro + bj * 128) = y0; *(f32x4*)(xo + ro + bj * 128 + 4) = y1; }
                else { const u32x2 p0 = pack4(y0 * sc[0] + sh[0]), p1 = pack4(y1 * sc[1] + sh[1]);
                    *(u32x4*)(Hout + (size_t)(tile0 + rloc) * DM + colb + ro + bj * 128) = (u32x4){p0.x, p0.y, p1.x, p1.y}; }
            }
        }
    }
};

struct EpiResNormL0 {
    static constexpr bool PERM = true;
    static constexpr bool AFTER_DRAIN = false;
    static constexpr bool LOOP_LDS = true;
    EpiPanelNorm<1> pn_; float* pb;
    __device__ __forceinline__ void loop(Acc& acc, const pg8::Unit& u, int wr, int wc, int fr, int fq, LAS unsigned char* lds, int wid, int lane) const {
        if (u.flags & 1) {
            const int tile0 = u.pm * 256, colb = u.pn * 256 + wc * 32 + 8 * fq, rloc = wr * 64 + fr;
            float* pq = pb + ((size_t)(u.flags >> 1) * NCTX + (tile0 - NLAT) + rloc) * DM + colb;
#pragma unroll
            for (int ai = 0; ai < 2; ++ai)
#pragma unroll
                for (int m = 0; m < 4; ++m)
#pragma unroll
                    for (int bj = 0; bj < 2; ++bj)
#pragma unroll
                        for (int n = 0; n < 2; ++n) *(f32x4*)(pq + (size_t)(ai * 128 + m * 16) * DM + bj * 128 + n * 4) = acc[ai][bj][m][n];
        } else pn_.fused(acc, u, wr, wc, fr, fq, lds, wid, lane);
    }
};

struct EpiFfn13 {
    static constexpr bool PERM = false;
    static constexpr bool AFTER_DRAIN = false;
    static constexpr bool LOOP_LDS = false;
    bf16_t* ACT;
    __device__ __forceinline__ void operator()(const Acc& acc, const pg8::Unit& u, int wr, int wc, int fr, int fq) const {
#pragma unroll
        for (int ai = 0; ai < 2; ++ai)
#pragma unroll
            for (int m = 0; m < 4; ++m) {
                const int row = u.pm * 256 + ai * 128 + wr * 64 + m * 16 + fr;
                u32x4 w;
#pragma unroll
                for (int bj = 0; bj < 2; ++bj) {
                    const f32x4 a = acc[ai][bj][m][0], b = acc[ai][bj][m][1]; f32x4 o;
#pragma unroll
                    for (int j = 0; j < 4; ++j) o[j] = a[j] * sigmoidf_(a[j]) * b[j];
                    const u32x2 pk = pack4(o);
                    if (bj == 0) { w.x = pk.x; w.y = pk.y; } else { w.z = pk.x; w.w = pk.y; }
                }
                *(u32x4*)(ACT + (size_t)row * DFF + 128 * u.pn + 32 * wc + 8 * fq) = w;
            }
    }
};

struct EpiMix {
    static constexpr bool PERM = true;
    static constexpr bool AFTER_DRAIN = false;
    static constexpr bool LOOP_LDS = false;
    bf16_t* out; int pitch, col0, tok_base, tok_pn_step, col_pn_step;
    __device__ __forceinline__ void operator()(const Acc& acc, const pg8::Unit& u, int wr, int wc, int fr, int fq) const {
#pragma unroll
        for (int ai = 0; ai < 2; ++ai)
#pragma unroll
            for (int m = 0; m < 4; ++m) {
                const int row = u.pm * 256 + ai * 128 + wr * 64 + m * 16 + fr;
                bf16_t* dst = out + (size_t)(tok_base + u.pn * tok_pn_step + row) * pitch + col0 + u.pn * col_pn_step + wc * 32 + 8 * fq;
#pragma unroll
                for (int bj = 0; bj < 2; ++bj) { const u32x2 p0 = pack4(acc[ai][bj][m][0]), p1 = pack4(acc[ai][bj][m][1]); *(u32x4*)(dst + bj * 128) = (u32x4){p0.x, p0.y, p1.x, p1.y}; }
            }
    }
};

namespace att {
constexpr int VP = 144, OFF_K1 = 0, OFF_K2 = 8192, OFF_VT = 16384, BUFSZ = 16384 + 128 * VP;
struct Args { const bf16_t *Q1, *Q2, *K1c, *K2c, *VT; bf16_t* MIXA; const float* subln; float lam, omli; };

__device__ __forceinline__ void attn_unit(LAS unsigned char* lds, const Args& A, int b, int h, int qrow0, int nkt) {
    const int tid = fresh_tid(), lane = tid & 63, r32 = lane & 31, hi = lane >> 5;
    const int wid = __builtin_amdgcn_readfirstlane(tid >> 6), map = wid >> 2, qg = wid & 3;
    const bf16_t* Qm = map ? A.Q2 : A.Q1;
    bf16x8 qf[4];
    { const bf16_t* qp = Qm + (size_t)(qrow0 + qg * 32 + r32) * 256 + h * 64 + hi * 8;
#pragma unroll
      for (int d0 = 0; d0 < 4; ++d0) qf[d0] = *(const bf16x8*)(qp + d0 * 16); }
    const int key_s = tid >> 3, ch_s = tid & 7;
    const bf16_t* k1src = A.K1c + ((size_t)b * KCAT + key_s) * 256 + h * 64 + ch_s * 8;
    const bf16_t* k2src = A.K2c + ((size_t)b * KCAT + key_s) * 256 + h * 64 + ch_s * 8;
    const bf16_t* vsrc = A.VT + ((size_t)(b * 4 + h) * 128 + key_s) * KCAT + ch_s * 8;
    const int kdst = key_s * 128 + ((ch_s ^ ((key_s >> 1) & 7)) << 4), vdst = key_s * VP + 32 * (ch_s >> 1) + 8 * (ch_s & 1);
    u32x4 rk1[2], rk2[2], rv0[2], rv1[2];
#define ATT_LOAD(set, t) do { rk1[set] = *(const u32x4*)(k1src + (size_t)(t) * 64 * 256); rk2[set] = *(const u32x4*)(k2src + (size_t)(t) * 64 * 256); \
        rv0[set] = *(const u32x4*)(vsrc + (t) * 64); rv1[set] = *(const u32x4*)(vsrc + (size_t)64 * KCAT + (t) * 64); } while (0)
#define ATT_STORE(set, buf) do { LAS unsigned char* bb_ = lds + (buf) * BUFSZ; *(LAS u32x4*)(bb_ + OFF_K1 + kdst) = rk1[set]; *(LAS u32x4*)(bb_ + OFF_K2 + kdst) = rk2[set]; \
        *(LAS u32x2*)(bb_ + OFF_VT + vdst) = (u32x2){rv0[set].x, rv0[set].y}; *(LAS u32x2*)(bb_ + OFF_VT + vdst + 16) = (u32x2){rv0[set].z, rv0[set].w}; \
        *(LAS u32x2*)(bb_ + OFF_VT + 64 * VP + vdst) = (u32x2){rv1[set].x, rv1[set].y}; *(LAS u32x2*)(bb_ + OFF_VT + 64 * VP + vdst + 16) = (u32x2){rv1[set].z, rv1[set].w}; } while (0)
    constexpr float THR = 6.f;
    float mrun = 0.f, lrun = 0.f;
    f32x16 O[4];
#pragma unroll
    for (int i = 0; i < 4; ++i)
#pragma unroll
        for (int r = 0; r < 16; ++r) O[i][r] = 0.f;
    ATT_LOAD(0, 0); ATT_STORE(0, 0); __syncthreads();
    ATT_LOAD(1, 1);
    for (int t0 = 0; t0 < nkt; t0 += 2) {
#pragma unroll
      for (int tt = 0; tt < 2; ++tt) {
        const int t = t0 + tt, cur = tt;
        if (t + 2 < nkt) ATT_LOAD(tt, t + 2);
        LAS unsigned char* base = lds + cur * BUFSZ;
        LAS unsigned char* kb = base + (map ? OFF_K2 : OFF_K1) + r32 * 128;
        f32x16 s0, s1;
#pragma unroll
        for (int r = 0; r < 16; ++r) { s0[r] = -mrun; s1[r] = -mrun; }
#pragma unroll
        for (int d0 = 0; d0 < 4; ++d0) {
            const int chunk = ((2 * d0 + hi) ^ ((r32 >> 1) & 7)) << 4;
            const bf16x8 a0 = *(const LAS bf16x8*)(kb + chunk), a1 = *(const LAS bf16x8*)(kb + 32 * 128 + chunk);
            s0 = __builtin_amdgcn_mfma_f32_32x32x16_bf16(a0, qf[d0], s0, 0, 0, 0);
            s1 = __builtin_amdgcn_mfma_f32_32x32x16_bf16(a1, qf[d0], s1, 0, 0, 0);
        }
        asm volatile("s_nop 15\n\ts_nop 4" : "+v"(s0), "+v"(s1));
        LAS unsigned char* vb = base + OFF_VT + r32 * VP + 16 * hi;
        u32x4 vf[2][4];
#define ATT_LDV(slot, c) do { _Pragma("unroll") for (int dblk = 0; dblk < 4; ++dblk) { \
            vf[slot][dblk] = *(const LAS u32x4*)(vb + dblk * 32 * VP + 32 * (c)); } } while (0)
        ATT_LDV(0, 0);
        __builtin_amdgcn_sched_barrier(0);
        float rm = max3f(s0[0], s0[1], s1[0]), rm2 = max3f(s0[2], s0[3], s1[1]);
        rm = max3f(rm, s1[2], s1[3]);
#pragma unroll
        for (int r = 4; r < 16; r += 4) { rm = max3f(rm, s0[r], s0[r + 1]); rm2 = max3f(rm2, s0[r + 2], s0[r + 3]); rm = max3f(rm, s1[r], s1[r + 1]); rm2 = max3f(rm2, s1[r + 2], s1[r + 3]); }
        rm = fmaxf(rm, rm2);
        rm = fmaxf(rm, __shfl_xor(rm, 32));
        const bool need = (t == 0) || (rm > THR);
        if (__any(need)) {
            const float dlt = need ? rm : 0.f, alpha = (t == 0) ? 1.f : __builtin_amdgcn_exp2f(-dlt);
            mrun += dlt; lrun *= alpha;
            s0 = s0 - dlt; s1 = s1 - dlt;
#pragma unroll
            for (int i = 0; i < 4; ++i)
#pragma unroll
                for (int r = 0; r < 16; ++r) O[i][r] *= alpha;
        }
#pragma unroll
        for (int r = 0; r < 16; ++r) { s0[r] = __builtin_amdgcn_exp2f(s0[r]); s1[r] = __builtin_amdgcn_exp2f(s1[r]); }
        { const f32x16 t16 = s0 + s1;
          typedef float f32x8 __attribute__((ext_vector_type(8)));
          const f32x8 t8 = t16.lo + t16.hi; const f32x4 t4 = t8.lo + t8.hi;
          lrun += (t4[0] + t4[1]) + (t4[2] + t4[3]); }
        bf16x8 P[4];
        { u32x4 w;
          w.x = cvt_pk_bf16(s0[0], s0[1]); w.y = cvt_pk_bf16(s0[2], s0[3]); w.z = cvt_pk_bf16(s0[4], s0[5]); w.w = cvt_pk_bf16(s0[6], s0[7]); P[0] = __builtin_bit_cast(bf16x8, w);
          w.x = cvt_pk_bf16(s0[8], s0[9]); w.y = cvt_pk_bf16(s0[10], s0[11]); w.z = cvt_pk_bf16(s0[12], s0[13]); w.w = cvt_pk_bf16(s0[14], s0[15]); P[1] = __builtin_bit_cast(bf16x8, w);
          w.x = cvt_pk_bf16(s1[0], s1[1]); w.y = cvt_pk_bf16(s1[2], s1[3]); w.z = cvt_pk_bf16(s1[4], s1[5]); w.w = cvt_pk_bf16(s1[6], s1[7]); P[2] = __builtin_bit_cast(bf16x8, w);
          w.x = cvt_pk_bf16(s1[8], s1[9]); w.y = cvt_pk_bf16(s1[10], s1[11]); w.z = cvt_pk_bf16(s1[12], s1[13]); w.w = cvt_pk_bf16(s1[14], s1[15]); P[3] = __builtin_bit_cast(bf16x8, w); }
        __builtin_amdgcn_sched_barrier(0);
        ATT_LDV(1, 1);
        __builtin_amdgcn_sched_barrier(0);
#pragma unroll
        for (int dblk = 0; dblk < 4; ++dblk) O[dblk] = __builtin_amdgcn_mfma_f32_32x32x16_bf16(__builtin_bit_cast(bf16x8, vf[0][dblk]), P[0], O[dblk], 0, 0, 0);
        __builtin_amdgcn_sched_barrier(0);
        ATT_LDV(0, 2);
        __builtin_amdgcn_sched_barrier(0);
#pragma unroll
        for (int dblk = 0; dblk < 4; ++dblk) O[dblk] = __builtin_amdgcn_mfma_f32_32x32x16_bf16(__builtin_bit_cast(bf16x8, vf[1][dblk]), P[1], O[dblk], 0, 0, 0);
        __builtin_amdgcn_sched_barrier(0);
        ATT_LDV(1, 3);
        __builtin_amdgcn_sched_barrier(0);
#pragma unroll
        for (int dblk = 0; dblk < 4; ++dblk) O[dblk] = __builtin_amdgcn_mfma_f32_32x32x16_bf16(__builtin_bit_cast(bf16x8, vf[0][dblk]), P[2], O[dblk], 0, 0, 0);
        __builtin_amdgcn_sched_barrier(0);
#pragma unroll
        for (int dblk = 0; dblk < 4; ++dblk) O[dblk] = __builtin_amdgcn_mfma_f32_32x32x16_bf16(__builtin_bit_cast(bf16x8, vf[1][dblk]), P[3], O[dblk], 0, 0, 0);
#undef ATT_LDV
        if (t + 1 < nkt) ATT_STORE(tt ^ 1, tt ^ 1);
        asm volatile("s_waitcnt lgkmcnt(0)" ::: "memory"); __builtin_amdgcn_s_barrier(); asm volatile("" ::: "memory");
      }
    }
#undef ATT_LOAD
#undef ATT_STORE
    lrun += __shfl_xor(lrun, 32);
    const float inv = 1.f / lrun;
    LAS float* ex = (LAS float*)lds + qg * 4096;
    if (map == 1) {
#pragma unroll
        for (int i = 0; i < 4; ++i)
#pragma unroll
            for (int r = 0; r < 16; ++r) ex[(i * 16 + r) * 64 + lane] = O[i][r] * inv;
    }
    __syncthreads();
    if (map == 0) {
        float ss = 0.f;
#pragma unroll
        for (int i = 0; i < 4; ++i)
#pragma unroll
            for (int r = 0; r < 16; ++r) { const float o = O[i][r] * inv - A.lam * ex[(i * 16 + r) * 64 + lane]; O[i][r] = o; ss += o * o; }
        ss += __shfl_xor(ss, 32);
        const float rstd = __builtin_amdgcn_rsqf(ss * (1.f / 128.f) + EPSV) * A.omli;
        bf16_t* dst = A.MIXA + (size_t)(qrow0 + qg * 32 + r32) * DM + h * 128 + 4 * hi;
#pragma unroll
        for (int i = 0; i < 4; ++i)
#pragma unroll
            for (int rq = 0; rq < 4; ++rq) {
                const int d0 = 32 * i + 8 * rq;
                const f32x4 gg = *(const f32x4*)(A.subln + d0 + 4 * hi);
                f32x4 v = {O[i][4 * rq] * rstd * gg[0], O[i][4 * rq + 1] * rstd * gg[1], O[i][4 * rq + 2] * rstd * gg[2], O[i][4 * rq + 3] * rstd * gg[3]};
                *(u32x2*)(dst + d0) = pack4(v);
            }
    }
    __syncthreads();
}
}

__device__ __forceinline__ void conv_item(const Params& p, LAS unsigned char* lds, int l, int item, const bf16_t* UC, bf16_t* MIXA) {
    const int tid = fresh_tid(), lane = tid & 63, wid = tid >> 6, g = wid & 3, th = wid >> 2;
    const int ch = g * 64 + lane;
    int rowbase, t0, L;
    if (item < 256) { rowbase = (item >> 5) * SEQ; t0 = (item & 31) * 64; L = SEQ; }
    else { const int j = item - 256; rowbase = NLAT + (j >> 2) * CTXL; t0 = (j & 3) * 64; L = CTXL; }
    LAS float* zl = (LAS float*)lds;
    {
        u32x4 av[6], gv[6];
#pragma unroll
        for (int it = 0; it < 6; ++it) {
            int idx = tid + it * 512; idx = idx < 94 * 32 ? idx : 94 * 32 - 1;
            const int pr = idx >> 5, c8 = idx & 31; int pp = t0 - 15 + pr; pp = pp < 0 ? 0 : (pp >= L ? L - 1 : pp);
            const bf16_t* up = UC + (size_t)(rowbase + pp) * 512 + c8 * 8;
            av[it] = *(const u32x4*)up; gv[it] = *(const u32x4*)(up + 256);
        }
#pragma unroll
        for (int it = 0; it < 6; ++it) {
            const int idx = tid + it * 512;
            const int pr = idx >> 5, c8 = idx & 31, pp = t0 - 15 + pr;
            const float msk = (pp >= 0 && pp < L) ? 1.f : 0.f;
            f32x4 z0, z1;
#pragma unroll
            for (int q = 0; q < 4; ++q) {
                const float a_lo = __uint_as_float(av[it][q] << 16), a_hi = __uint_as_float(av[it][q] & 0xffff0000u);
                const float g_lo = __uint_as_float(gv[it][q] << 16), g_hi = __uint_as_float(gv[it][q] & 0xffff0000u);
                const float zlo = a_lo * sigmoidf_(g_lo) * msk, zhi = a_hi * sigmoidf_(g_hi) * msk;
                if (q < 2) { z0[2 * q] = zlo; z0[2 * q + 1] = zhi; } else { z1[2 * (q - 2)] = zlo; z1[2 * (q - 2) + 1] = zhi; }
            }
            if (idx < 94 * 32) { *(LAS f32x4*)(zl + pr * 256 + c8 * 8) = z0; *(LAS f32x4*)(zl + pr * 256 + c8 * 8 + 4) = z1; }
        }
    }
    __syncthreads();
    const int ts = t0 + th * 32;
    float w[31];
#pragma unroll
    for (int k = 0; k < 31; ++k) w[k] = p.conv_w[(size_t)l * 31 * 256 + k * 256 + ch];
    float o[32];
    const float bias = p.conv_b[l * 256 + ch];
    const LAS float* zp = zl + (th * 32) * 256 + ch;
    float z[62];
#pragma unroll
    for (int jj = 0; jj < 62; ++jj) z[jj] = zp[jj * 256];
#pragma unroll
    for (int i = 0; i < 32; ++i) {
        float acc = bias;
#pragma unroll
        for (int k = 0; k < 31; ++k) acc += w[k] * z[i + k];
        o[i] = acc;
    }
    const float lg = p.conv_ln_g[l * 256 + ch], lb = p.conv_ln_b[l * 256 + ch];
#pragma unroll
    for (int i = 0; i < 32; ++i) {
        const float mu = wave_sum(o[i]) * (1.f / 64.f);
        const float d = o[i] - mu;
        const float var = wave_sum(d * d) * (1.f / 64.f);
        const float zn = d * __builtin_amdgcn_rsqf(var + EPSV) * lg + lb;
        MIXA[(size_t)(rowbase + ts + i) * DM + 768 + ch] = f2bf(zn * sigmoidf_(zn));
    }
    __syncthreads();
}

__device__ __forceinline__ int drow_map(int mode, int n) {
    if (mode == 0) return n;
    if (mode == 1) {
        if (n < 1024) { const int cs = n & 255, head = cs >> 6, d = cs & 63, a = d >> 5, pp = (d >> 4) & 1, f = d & 15;
            return (n & ~255) + 128 * ((f >> 2) & 1) + 32 * head + 16 * pp + 4 * (2 * a + (f >> 3)) + (f & 3); }
        if (n < 1792) return n;
        { const int mm = n - 1792, cs = mm & 255;
          return 2048 + (mm & ~255) + 128 * ((cs >> 2) & 1) + 32 * ((cs >> 5) & 3) + 16 * (cs >> 7) + 4 * ((cs >> 3) & 3) + (cs & 3); }
    }
    const int r = 256 * (n >> 7) + 128 * ((n >> 2) & 1) + 32 * ((n >> 5) & 3) + 4 * ((n >> 3) & 3) + (n & 3);
    return mode == 2 ? r : r + 16;
}
__device__ __forceinline__ void transpose_item(const float* W, int ldw, int K, bf16_t* WT, int mode, LAS float* scr, int kb, int nb, int lane) {
    const int k0 = 64 * kb, n0 = 32 * nb;
#pragma unroll 8
    for (int i = 0; i < 32; ++i) { const int kk = 2 * i + (lane >> 5); scr[kk * 33 + (lane & 31)] = W[(size_t)(k0 + kk) * ldw + n0 + (lane & 31)]; }
    asm volatile("s_waitcnt lgkmcnt(0)" ::: "memory");
    const int c = lane & 7;
#pragma unroll
    for (int j = 0; j < 4; ++j) { const int n = (lane >> 3) + 8 * j; const LAS float* s = scr + (8 * c) * 33 + n;
        u32x4 o; o.x = cvt_pk_bf16(s[0 * 33], s[1 * 33]); o.y = cvt_pk_bf16(s[2 * 33], s[3 * 33]); o.z = cvt_pk_bf16(s[4 * 33], s[5 * 33]); o.w = cvt_pk_bf16(s[6 * 33], s[7 * 33]);
        *(u32x4*)(WT + (size_t)drow_map(mode, n0 + n) * K + k0 + 8 * c) = o; }
    asm volatile("s_waitcnt lgkmcnt(0)" ::: "memory");
}

__device__ __forceinline__ void prep_phase(const Params& p, LAS unsigned char* lds) {
    const int tid = fresh_tid(), lane = tid & 63, wave = tid >> 6, G = gridDim.x;
    const int gw = blockIdx.x * 8 + wave, NGW = G * 8;
    const int gt = blockIdx.x * 512 + tid, NGT = G * 512;
    unsigned char* ws = p.ws;
    LAS float* tab = (LAS float*)(lds + 73728);
    LAS float* t64c = tab + 2048; LAS float* t64s = t64c + 64;
    for (int m = tid; m < 2048; m += 512) tab[m] = cospif((float)m * (1.f / 1024.f));
    if (tid < 64) { t64c[tid] = cospif((float)tid * (1.f / 32.f)); t64s[tid] = sinpif((float)tid * (1.f / 32.f)); }
    __syncthreads();
    if (gt < 1024) { const int pos = gt >> 4, f = gt & 15; const float inv = powf(10000.f, -(float)f / 16.f); const float ang = (float)pos * inv;
        float* rope = (float*)(ws + WS_ROPE); rope[gt] = cosf(ang); rope[1024 + gt] = sinf(ang); }
    {
        LAS float* scr = (LAS float*)(lds + wave * 8448);
        constexpr int I_IN = 16 * 72, I_OUT = 16 * 32, I_F1 = 16 * 88, I_F2 = 44 * 32, I_L = I_IN + I_OUT + 2 * I_F1 + I_F2;
        for (int it = gw; it < 2 * I_L; it += NGW) {
            const int l = it / I_L; int r = it % I_L;
            if (r < I_IN) { const int kb = r / 72, nb = r % 72; if (nb >= 48 && nb < 56) continue;
                transpose_item(p.w_in + (size_t)l * DM * INW_SRC, INW_SRC, DM, (bf16_t*)(ws + WS_WIN) + (size_t)l * INW * DM, 1, scr, kb, nb, lane); continue; }
            r -= I_IN;
            if (r < I_OUT) { transpose_item(p.w_out + (size_t)l * DM * DM, DM, DM, (bf16_t*)(ws + WS_WOUT) + (size_t)l * DM * DM, 0, scr, r / 32, r % 32, lane); continue; }
            r -= I_OUT;
            if (r < I_F1) { transpose_item(p.w_ffn1 + (size_t)l * DM * DFF, DFF, DM, (bf16_t*)(ws + WS_W13) + (size_t)l * N13 * DM, 2, scr, r / 88, r % 88, lane); continue; }
            r -= I_F1;
            if (r < I_F1) { transpose_item(p.w_ffn3 + (size_t)l * DM * DFF, DFF, DM, (bf16_t*)(ws + WS_W13) + (size_t)l * N13 * DM, 3, scr, r / 88, r % 88, lane); continue; }
            r -= I_F1;
            transpose_item(p.w_ffn2 + (size_t)l * DFF * DM, DM, DFF, (bf16_t*)(ws + WS_W2) + (size_t)l * DM * DFF, 0, scr, r / 32, r % 32, lane);
        }
    }
    {
        const float tcl = cospif((float)lane * (1.f / 32.f)), tsl = sinpif((float)lane * (1.f / 32.f));
        for (int it = gw; it < 2 * 4 * 16 * 16; it += NGW) {
            const int l = it >> 10, g = (it >> 8) & 3, kbk = (it >> 4) & 15, lqg = it & 15;
            const int k = kbk * 64 + lane;
            const float* wr_ = p.w_in + (size_t)l * DM * INW_SRC + (size_t)k * INW_SRC + 1536 + g * 64;
            float wv[64];
#pragma unroll
            for (int c4 = 0; c4 < 16; ++c4) { const f32x4 v = *(const f32x4*)(wr_ + 4 * c4); wv[4 * c4] = v[0]; wv[4 * c4 + 1] = v[1]; wv[4 * c4 + 2] = v[2]; wv[4 * c4 + 3] = v[3]; }
            bf16_t* wt = (bf16_t*)(ws + WS_WIN) + (size_t)l * INW * DM;
#pragma unroll 1
            for (int li = 0; li < 4; ++li) {
                const int lq = __builtin_amdgcn_readfirstlane(lqg * 4 + li);
                float ac = 0.f, as = 0.f;
#pragma unroll
                for (int c = 0; c < 64; ++c) {
                    const int m = (lq * c) & 63;
                    const float ct = __int_as_float(__builtin_amdgcn_readlane(__float_as_int(tcl), m)), st = __int_as_float(__builtin_amdgcn_readlane(__float_as_int(tsl), m));
                    ac += wv[c] * ct; as += wv[c] * st;
                }
                wt[(size_t)(1536 + g * 64 + lq) * DM + k] = f2bf(ac);
                wt[(size_t)(1536 + 256 + g * 64 + lq) * DM + k] = f2bf(as);
            }
        }
    }
    for (int e = gt; e < 2 * WSM_L; e += NGT) {
        const int l = e / WSM_L, r = e % WSM_L; float v;
        if (r < 256 * 512) { const int n = r >> 9, k = r & 255; const int g = n >> 6, d = n & 63, g2 = k >> 6, c = k & 63; v = (g == g2) ? p.w_fourier[(((size_t)l * 4 + g) * 64 + c) * 64 + d] : 0.f; }
        else { const int r2 = r - 256 * 512, n = r2 >> 8, k = r2 & 255; v = p.w_conv_out[((size_t)l * 256 + k) * 256 + n]; }
        ((bf16_t*)(ws + WS_WSM))[e] = f2bf(v);
    }
    {
        const float nl = 1.f / sqrtf(2048.f * 64.f), nc = 1.f / 128.f;
        for (int e = gt; e < 2048 * 4096 / 8; e += NGT) {
            const int k = e >> 9, col0 = (e & 511) * 8, s = col0 >> 11; float v[8];
#pragma unroll
            for (int j = 0; j < 8; ++j) { const int n = (col0 + j) & 2047, m = (k * n) & 2047; v[j] = s ? -tab[(m - 512) & 2047] * nl : tab[m] * nl; }
            u32x4 o; o.x = cvt_pk_bf16(v[0], v[1]); o.y = cvt_pk_bf16(v[2], v[3]); o.z = cvt_pk_bf16(v[4], v[5]); o.w = cvt_pk_bf16(v[6], v[7]);
            *(u32x4*)((bf16_t*)(ws + WS_DFTL) + (size_t)e * 8) = o;
        }
        for (int e = gt; e < 256 * 512 / 8; e += NGT) {
            const int k = e >> 6, col0 = (e & 63) * 8, s = col0 >> 8; float v[8];
#pragma unroll
            for (int j = 0; j < 8; ++j) { const int n = (col0 + j) & 255, m = ((k * n) & 255) * 8; v[j] = s ? -tab[(m - 512) & 2047] * nc : tab[m] * nc; }
            u32x4 o; o.x = cvt_pk_bf16(v[0], v[1]); o.y = cvt_pk_bf16(v[2], v[3]); o.z = cvt_pk_bf16(v[4], v[5]); o.w = cvt_pk_bf16(v[6], v[7]);
            *(u32x4*)((bf16_t*)(ws + WS_DFTC) + (size_t)e * 8) = o;
        }
    }
    for (int it = gw; it < 2 * 96 * 8; it += NGW) {
        const int l = it / 768, r = it % 768, cgp = r >> 3, kc = r & 7;
        const int col = cgp * 64 + lane, k0 = kc * 128;
        float sv[9][2];
#pragma unroll
        for (int b = 0; b < 9; ++b)
#pragma unroll
            for (int hh = 0; hh < 2; ++hh) { const int k = k0 + hh * 64 + lane; const float cv = (b < 8) ? p.c[b * DM + k] : p.c_ctx[k]; sv[b][hh] = cv * sigmoidf_(cv); }
        float ac[9];
#pragma unroll
        for (int b = 0; b < 9; ++b) ac[b] = 0.f;
        const float* wp = p.w_ada + ((size_t)l * DM + k0) * 6144 + col;
#pragma unroll
        for (int hh = 0; hh < 2; ++hh) {
#pragma unroll 8
            for (int kk = 0; kk < 64; ++kk) {
                const float wv = wp[(size_t)(hh * 64 + kk) * 6144];
#pragma unroll
                for (int b = 0; b < 9; ++b) ac[b] += __int_as_float(__builtin_amdgcn_readlane(__float_as_int(sv[b][hh]), kk)) * wv;
            }
        }
        const float bias = (kc == 0) ? p.b_ada[l * 6144 + col] : 0.f;
        float* mod = (float*)(ws + WS_MOD) + (size_t)l * 9 * 6144;
#pragma unroll
        for (int b = 0; b < 9; ++b) atomicAdd(mod + b * 6144 + col, ac[b] + bias);
    }
}

__device__ __forceinline__ void norm_phase(const float* xlat, const float* xctx, const float* gvec, const float* mod, int sh_off, int sc_off, bf16_t* H, int nrows,
                                           const float* part, const float* pgate, float* xctx_out, int row_lo) {
    const int tid = fresh_tid(), lane = tid & 63, gw = row_lo + blockIdx.x * 8 + (tid >> 6), NGW = gridDim.x * 8;
    f32x4 vn[4];
#define NORM_LOADX(dst, r_) do { const int r__ = (r_); const float* xr_ = r__ < NLAT ? xlat + (size_t)r__ * DM : xctx + (size_t)(r__ - NLAT) * DM; \
        _Pragma("unroll") for (int j = 0; j < 4; ++j) dst[j] = *(const f32x4*)(xr_ + 4 * lane + 256 * j); } while (0)
    if (gw < nrows) NORM_LOADX(vn, gw);
    for (int row = gw; row < nrows; row += NGW) {
        const int bb = row < NLAT ? row >> 11 : 8;
        f32x4 v[4]; float ss = 0.f;
#pragma unroll
        for (int j = 0; j < 4; ++j) v[j] = vn[j];
        if (row + NGW < nrows) NORM_LOADX(vn, row + NGW);
        const float* mp = mod + bb * 6144;
        f32x4 gg[4], sc[4], sh[4];
#pragma unroll
        for (int j = 0; j < 4; ++j) { const int col = 4 * lane + 256 * j; gg[j] = *(const f32x4*)(gvec + col); sc[j] = *(const f32x4*)(mp + sc_off + col); sh[j] = *(const f32x4*)(mp + sh_off + col); }
        if (part != nullptr && row >= NLAT) {
#pragma unroll
            for (int j = 0; j < 4; ++j) {
                const size_t o = (size_t)(row - NLAT) * DM + 4 * lane + 256 * j;
                const f32x4 ps = (*(const f32x4*)(part + o) + *(const f32x4*)(part + (size_t)NCTX * DM + o)) + (*(const f32x4*)(part + (size_t)2 * NCTX * DM + o) + *(const f32x4*)(part + (size_t)3 * NCTX * DM + o));
                v[j] = v[j] + *(const f32x4*)(pgate + 4 * lane + 256 * j) * ps;
                *(f32x4*)(xctx_out + o) = v[j];
            }
        }
#pragma unroll
        for (int j = 0; j < 4; ++j) ss += (v[j][0] * v[j][0] + v[j][1] * v[j][1]) + (v[j][2] * v[j][2] + v[j][3] * v[j][3]);
        const float rstd = __builtin_amdgcn_rsqf(wave_sum(ss) * (1.f / DM) + EPSV);
#pragma unroll
        for (int j = 0; j < 4; ++j) {
            const int col = 4 * lane + 256 * j;
            const f32x4 y = (v[j] * rstd) * gg[j];
            const f32x4 hv = y * (sc[j] + 1.f) + sh[j];
            *(u32x2*)(H + (size_t)row * DM + col) = pack4(hv);
        }
    }
#undef NORM_LOADX
}

__global__ void __launch_bounds__(512, 2) fwd_kernel(Params p) {
    extern __shared__ __attribute__((aligned(16))) unsigned char lds_raw[];
    LAS unsigned char* lds = (LAS unsigned char*)lds_raw;
    cg::grid_group grid = cg::this_grid();
    const int G = gridDim.x, cu = blockIdx.x;
    unsigned char* ws = p.ws;
    bf16_t* H = (bf16_t*)(ws + WS_H);
    bf16_t* Q1 = (bf16_t*)(ws + WS_Q1); bf16_t* Q2 = (bf16_t*)(ws + WS_Q2); bf16_t* K1c = (bf16_t*)(ws + WS_K1); bf16_t* K2c = (bf16_t*)(ws + WS_K2);
    bf16_t* VT = (bf16_t*)(ws + WS_VT); bf16_t* TTl = (bf16_t*)(ws + WS_TTL); bf16_t* TTc = (bf16_t*)(ws + WS_TTC); bf16_t* UC = (bf16_t*)(ws + WS_UC);
    bf16_t* MIXA = (bf16_t*)(ws + WS_MIX); bf16_t* ACT = (bf16_t*)(ws + WS_ACT);
    float* PB1 = (float*)(ws + WS_R); float* PB2 = (float*)(ws + WS_R + 99 * MiB);
    bf16_t* FP = (bf16_t*)(ws + WS_H);
    float* XL = p.out; float* XC = (float*)(ws + WS_XCTX);
    const float* rope = (const float*)(ws + WS_ROPE);

    volatile LAS unsigned* bst = (volatile LAS unsigned*)(lds + LDS_BYTES - 64);
    if (threadIdx.x < 2) bst[threadIdx.x] = 0u;
    __syncthreads();
    const XcdBarrier xbar = xcd_barrier_post((unsigned*)(ws + WS_BAR), bst);
#define GSYNC() xcd_barrier(xbar)

    prep_phase(p, lds);
    grid.sync();

#pragma unroll 1
    for (int l = 0; l < 2; ++l) {
        const float* mod = (const float*)(ws + WS_MOD) + (size_t)l * 9 * 6144;
        const float* xin_l = l == 0 ? p.x : XL; const float* xin_c = l == 0 ? p.ctx : XC;
        const int mrows = l == 0 ? MTOT : NLAT;
        if (PROBE == 3) { for (int rep = 0; rep < 8; ++rep) GSYNC(); }
        norm_phase(xin_l, xin_c, p.norm1_g + l * DM, mod, 0, 1024, H, MTOT, l == 1 ? PB2 : nullptr, (const float*)(ws + WS_MOD) + 8 * 6144 + 5120, XC, (l == 1 && G == 256) ? NLAT : 0);
        GSYNC();
        for (int rep = 0; rep < (PROBE == 4 ? 2 : 1); ++rep) {
            if (rep) GSYNC();
            pg8::Gemm g{H, (const bf16_t*)(ws + WS_WIN) + (size_t)l * INW * DM, MTOT, INW, DM, DM, DM, 0};
            pg8::StaticOrder S; S.init(MTOT, INW, G, cu);
            EpiInProj E{Q1, Q2, K1c, K2c, VT, TTl, TTc, UC, rope};
            pg8::gemm_phase<EpiInProj, pg8::StaticOrder, true>(lds, g, S, E);
        }
        GSYNC();
        for (int rep = 0; rep < (PROBE == 1 ? 2 : 1); ++rep) {
            if (rep) GSYNC();
            const float li = 0.8f - 0.6f * __expf(-0.3f * (float)l);
            float lam;
            { const int lane = fresh_tid() & 63;
              const float s1 = wave_sum(p.lam_q1[l * 64 + lane] * p.lam_k1[l * 64 + lane]), s2 = wave_sum(p.lam_q2[l * 64 + lane] * p.lam_k2[l * 64 + lane]);
              lam = expf(s1) - expf(s2) + li; }
            att::Args A{Q1, Q2, K1c, K2c, VT, MIXA, p.subln_g + l * 128, lam, 1.f - li};
            const int n_att = 512 + (l == 0 ? 64 : 0);
            for (int u = cu; u < n_att; u += G) {
                if (u < 512) att::attn_unit(lds, A, u >> 6, (u >> 4) & 3, (u >> 6) * SEQ + (u & 15) * 128, 36);
                else { const int v = u - 512; att::attn_unit(lds, A, v >> 3, (v >> 1) & 3, NLAT + (v >> 3) * CTXL + (v & 1) * 128, 4); }
            }
#pragma unroll 1
            for (int hf = 0; hf < 2; ++hf) {
                pg8::Gemm g{(const bf16_t*)(ws + WS_DFTL) + hf * 2048, TTl + hf * 2048, 2048, 2048, 2048, 4096, 4096, 0};
                pg8::OffsetOrder S; S.init(2048, 2048, G, cu, 64 + 64 * hf);
                EpiMix E{FP, 512, hf * 256, 0, SEQ, 0};
                pg8::gemm_phase<EpiMix, pg8::OffsetOrder, true>(lds, g, S, E);
            }
            if (l == 0) {
#pragma unroll 1
                for (int hf = 0; hf < 2; ++hf) {
                    pg8::Gemm g{(const bf16_t*)(ws + WS_DFTC) + hf * 256, TTc + hf * 256, 256, 2048, 256, 512, 512, 0};
                    pg8::OffsetOrder S; S.init(256, 2048, G, cu, 192 + 8 * hf);
                    EpiMix E{FP, 512, hf * 256, NLAT, CTXL, 0};
                    pg8::gemm_phase<EpiMix, pg8::OffsetOrder, true>(lds, g, S, E);
                }
            }
            const int n_conv = l == 0 ? 288 : 256;
            if (G == 256) {
                const int sidx = cu < 64 ? cu : (cu >= 192 ? cu - 128 : -1);
                if (sidx >= 0) for (int it = sidx; it < n_conv; it += 128) conv_item(p, lds, l, it, UC, MIXA);
            } else for (int it = cu; it < n_conv; it += G) conv_item(p, lds, l, it, UC, MIXA);
        }
        GSYNC();
        {
            const bf16_t* wsm = (const bf16_t*)(ws + WS_WSM) + (size_t)l * WSM_L;
            {
                pg8::Gemm g{FP, wsm, mrows, 256, 512, 512, 512, 0};
                pg8::OffsetOrder S; S.init(mrows, 256, G, cu, 0);
                EpiMix E{MIXA, DM, 512, 0, 0, 0};
                pg8::gemm_phase<EpiMix, pg8::OffsetOrder, true>(lds, g, S, E);
            }
            {
                pg8::Gemm g{MIXA + 768, wsm + 256 * 512, mrows, 256, 256, DM, 256, 0};
                pg8::OffsetOrder S; S.init(mrows, 256, G, cu, 72);
                EpiMix E{MIXA, DM, 768, 0, 0, 0};
                pg8::gemm_phase<EpiMix, pg8::OffsetOrder, true>(lds, g, S, E);
            }
        }
        GSYNC();
        {
            pg8::Gemm g{MIXA, (const bf16_t*)(ws + WS_WOUT) + (size_t)l * DM * DM, mrows, DM, DM, DM, DM, 0};
            EpiRes E{xin_l, xin_c, XL, XC, mod, 2048, PB1};
            if (l == 0 && G == 256) {
                pg8::CtxSplitOrder S; S.init(DM, DM, G, cu);
                EpiResNormL0 EL{{xin_l, XL, mod, 2048, p.norm2_g, (unsigned*)(ws + WS_R + 40 * MiB), (unsigned*)(ws + WS_PCNT) + 2 * 64 * 64, H, 3072, 4096, mod}, PB1};
                pg8::gemm_phase<EpiResNormL0, pg8::CtxSplitOrder, true>(lds, g, S, EL);
            }
            else if (l == 0) { pg8::CtxSplitOrder S; S.init(DM, DM, G, cu); pg8::gemm_phase<EpiRes, pg8::CtxSplitOrder, true>(lds, g, S, E); }
            else if (G == 256) {
                pg8::StaticOrder S; S.init(mrows, DM, G, cu);
                EpiPanelNorm<1> EN{xin_l, XL, mod, 2048, p.norm2_g + l * DM, (unsigned*)(ws + WS_R), (unsigned*)(ws + WS_PCNT) + 64 * 64, H, 3072, 4096, mod};
                pg8::gemm_phase<EpiPanelNorm<1>, pg8::StaticOrder, true>(lds, g, S, EN);
            }
            else { pg8::StaticOrder S; S.init(mrows, DM, G, cu); pg8::gemm_phase<EpiRes, pg8::StaticOrder, true>(lds, g, S, E); }
        }
        GSYNC();
        if (!(l == 1 && G == 256)) {
        norm_phase(XL, l == 0 ? p.ctx : XC, p.norm2_g + l * DM, mod, 3072, 4096, H, mrows, l == 0 ? PB1 : nullptr, mod + 8 * 6144 + 2048, XC, (l == 0 && G == 256) ? NLAT : 0);
        GSYNC();
        }
        for (int rep = 0; rep < (PROBE == 2 ? 2 : 1); ++rep) {
            if (rep) GSYNC();
            pg8::Gemm g{H, (const bf16_t*)(ws + WS_W13) + (size_t)l * N13 * DM, mrows, N13, DM, DM, DM, 0};
            pg8::StaticOrder S; S.init(mrows, N13, G, cu);
            EpiFfn13 E{ACT};
            pg8::gemm_phase<EpiFfn13, pg8::StaticOrder, true>(lds, g, S, E);
        }
        GSYNC();
        {
            pg8::Gemm g{ACT, (const bf16_t*)(ws + WS_W2) + (size_t)l * DM * DFF, mrows, DM, DFF, DFF, DFF, 0};
            EpiRes E{XL, XC, XL, XC, mod, 5120, PB2};
            if (l == 0 && G == 256) {
                pg8::CtxSplitOrder S; S.init(DM, DFF, G, cu);
                EpiResNormL0 EL{{XL, XL, mod, 5120, p.norm1_g + DM, (unsigned*)(ws + 244 * MiB), (unsigned*)(ws + WS_PCNT) + 3 * 64 * 64, H, 0, 1024, mod + 9 * 6144}, PB2};
                pg8::gemm_phase<EpiResNormL0, pg8::CtxSplitOrder, true>(lds, g, S, EL);
            }
            else if (l == 0) { pg8::CtxSplitOrder S; S.init(DM, DFF, G, cu); pg8::gemm_phase<EpiRes, pg8::CtxSplitOrder, true>(lds, g, S, E); }
            else if (G == 256) {
                pg8::StaticOrder S; S.init(mrows, DM, G, cu);
                EpiPanelNorm<0> EF{XL, XL, mod, 5120, p.final_g, (unsigned*)(ws + WS_H), (unsigned*)(ws + WS_PCNT), nullptr, 0, 0, mod};
                pg8::gemm_phase<EpiPanelNorm<0>, pg8::StaticOrder, true>(lds, g, S, EF);
            }
            else { pg8::StaticOrder S; S.init(mrows, DM, G, cu); pg8::gemm_phase<EpiRes, pg8::StaticOrder, true>(lds, g, S, E); }
        }
        if (!(l == 1 && G == 256)) GSYNC();
    }
    if (G != 256) {
        const int tid = fresh_tid(), lane = tid & 63, gw = blockIdx.x * 8 + (tid >> 6), NGW = gridDim.x * 8;
        f32x4 gg[4], vn[4];
#pragma unroll
        for (int j = 0; j < 4; ++j) { gg[j] = *(const f32x4*)(p.final_g + 4 * lane + 256 * j); vn[j] = *(const f32x4*)(XL + (size_t)gw * DM + 4 * lane + 256 * j); }
        for (int row = gw; row < NLAT; row += NGW) {
            float* xr = XL + (size_t)row * DM;
            f32x4 v[4]; float ss = 0.f;
#pragma unroll
            for (int j = 0; j < 4; ++j) { v[j] = vn[j]; ss += (v[j][0] * v[j][0] + v[j][1] * v[j][1]) + (v[j][2] * v[j][2] + v[j][3] * v[j][3]); }
            if (row + NGW < NLAT) {
#pragma unroll
                for (int j = 0; j < 4; ++j) vn[j] = *(const f32x4*)(xr + (size_t)NGW * DM + 4 * lane + 256 * j);
            }
            const float rstd = __builtin_amdgcn_rsqf(wave_sum(ss) * (1.f / DM) + EPSV);
#pragma unroll
            for (int j = 0; j < 4; ++j) { const int col = 4 * lane + 256 * j; *(f32x4*)(xr + col) = (v[j] * rstd) * gg[j]; }
        }
    }
}

extern "C" void kernel_launch(void* const* d_in, const int* in_sizes, int n_in, void* d_out, int out_size, void* d_ws, size_t ws_size, hipStream_t stream) {
    static int grid_blocks = 0;
    if (grid_blocks == 0) {
        if (n_in != 25 || ws_size < WS_END) { fprintf(stderr, "kernel_launch: unexpected n_in %d / ws %zu\n", n_in, ws_size); grid_blocks = -1; return; }
        int dev = 0, cus = 0, per_cu = 0;
        (void)hipGetDevice(&dev);
        (void)hipDeviceGetAttribute(&cus, hipDeviceAttributeMultiprocessorCount, dev);
        if (hipFuncSetAttribute((const void*)fwd_kernel, hipFuncAttributeMaxDynamicSharedMemorySize, LDS_BYTES) != hipSuccess) fprintf(stderr, "kernel_launch: hipFuncSetAttribute failed\n");
        if (hipOccupancyMaxActiveBlocksPerMultiprocessor(&per_cu, (const void*)fwd_kernel, 512, LDS_BYTES) != hipSuccess || per_cu < 1) { fprintf(stderr, "kernel_launch: occupancy query gave %d\n", per_cu); per_cu = 1; }
        (void)hipGetLastError();
        grid_blocks = cus * per_cu;
    }
    if (grid_blocks < 0) return;
    Params p{};
    const float** pp = (const float**)&p;
    for (int i = 0; i < 25; ++i) pp[i] = (const float*)d_in[i];
    p.out = (float*)d_out; p.ws = (unsigned char*)d_ws;
    (void)hipMemsetAsync((unsigned char*)d_ws + WS_MOD, 0, ZERO_BYTES, stream);
    void* args[] = {&p};
    hipError_t e = hipLaunchCooperativeKernel((const void*)fwd_kernel, dim3(grid_blocks), dim3(512), args, LDS_BYTES, stream);
    if (e != hipSuccess) fprintf(stderr, "cooperative launch failed: %s (grid %d)\n", hipGetErrorString(e), grid_blocks);
}
```

```cpp
#include <hip/hip_runtime.h>
#include <hip/hip_cooperative_groups.h>
#include <cstdint>
#include <cstdio>
namespace cg = cooperative_groups;
#ifndef PROBE
#define PROBE 0
#endif

#define LAS __attribute__((address_space(3)))
typedef unsigned short bf16_t;
typedef short bf16x8 __attribute__((ext_vector_type(8)));
typedef float f32x4 __attribute__((ext_vector_type(4)));
typedef float f32x16 __attribute__((ext_vector_type(16)));
typedef unsigned u32x4 __attribute__((ext_vector_type(4)));
typedef unsigned u32x2 __attribute__((ext_vector_type(2)));

constexpr int NB = 8, SEQ = 2048, DM = 1024, CTXL = 256, NLAT = NB * SEQ, NCTX = NB * CTXL, MTOT = NLAT + NCTX;
constexpr int INW = 2560, INW_SRC = 2304, DFF = 2816, N13 = 2 * DFF, KCAT = CTXL + SEQ;
constexpr float EPSV = 1e-6f;
constexpr float QSCALE = 0.125f * 1.4426950408889634f;
constexpr int LDS_BYTES = 147456;
constexpr int XCD_BAR_WORDS_C = 3456;

constexpr size_t MiB = 1u << 20;
constexpr size_t WS_WIN = 0, WS_WOUT = 10 * MiB, WS_W13 = 14 * MiB, WS_W2 = 36 * MiB, WS_WSM = 47 * MiB, WS_DFTL = 48 * MiB, WS_DFTC = 64 * MiB;
constexpr size_t WS_MOD = 64 * MiB + 256 * 1024, WS_ROPE = 64 * MiB + 768 * 1024, WS_XCTX = 65 * MiB, WS_H = 73 * MiB, WS_R = 109 * MiB;
constexpr size_t WS_Q1 = WS_R, WS_Q2 = WS_R + 9 * MiB, WS_K1 = WS_R + 18 * MiB, WS_K2 = WS_R + 27 * MiB, WS_VT = WS_R + 36 * MiB, WS_TTL = WS_R + 54 * MiB,
                 WS_TTC = WS_R + 70 * MiB, WS_UC = WS_R + 72 * MiB, WS_MIX = WS_R + 90 * MiB, WS_ACT = WS_R, WS_END = WS_R + 131 * MiB;
constexpr size_t MOD_BYTES = 2 * 9 * 6144 * 4;
constexpr int WSM_L = 256 * 512 + 256 * 256;
constexpr size_t WS_BAR = 64 * MiB + 704 * 1024, WS_PCNT = 64 * MiB + 784 * 1024, ZERO_BYTES = WS_PCNT + 4 * 64 * 256 - WS_MOD;

struct Params {
    const float *x, *c, *ctx, *c_ctx, *w_ada, *b_ada, *norm1_g, *norm2_g, *w_in, *lam_q1, *lam_k1, *lam_q2, *lam_k2, *subln_g, *w_fourier, *conv_w, *conv_b,
        *conv_ln_g, *conv_ln_b, *w_conv_out, *w_out, *w_ffn1, *w_ffn3, *w_ffn2, *final_g;
    float* out; unsigned char* ws;
};

__device__ __forceinline__ unsigned cvt_pk_bf16(float lo, float hi) { unsigned r; asm("v_cvt_pk_bf16_f32 %0, %1, %2" : "=v"(r) : "v"(lo), "v"(hi)); return r; }
__device__ __forceinline__ u32x2 pack4(f32x4 v) { u32x2 w; w.x = cvt_pk_bf16(v[0], v[1]); w.y = cvt_pk_bf16(v[2], v[3]); return w; }
__device__ __forceinline__ bf16_t f2bf(float v) { return (bf16_t)(cvt_pk_bf16(v, 0.f) & 0xffffu); }
__device__ __forceinline__ float wave_sum(float v) {
#pragma unroll
    for (int o = 1; o < 64; o <<= 1) v += __shfl_xor(v, o);
    return v;
}
__device__ __forceinline__ int fresh_tid() { int t = threadIdx.x; asm volatile("" : "+v"(t)); return t; }
__device__ __forceinline__ float max3f(float a, float b, float c) { float r; asm("v_max3_f32 %0, %1, %2, %3" : "=v"(r) : "v"(a), "v"(b), "v"(c)); return r; }
__device__ __forceinline__ float sigmoidf_(float v) { return __builtin_amdgcn_rcpf(1.f + __expf(-v)); }


#define XB_TMO      128
#define XB_XCNT(j)  (256  + 64 * (j))
#define XB_XSUB(j)  (1280 + 64 * (j))
#define XB_XGEN(j)  (2304 + 64 * (j))
#define XB_TOP      3328
#define XB_TOPGEN   3392
#define XCD_BAR_WORDS 3456
#define XB_SPIN_CAP (1u << 18)
__device__ __forceinline__ unsigned xb_ld(unsigned* p)              { return __hip_atomic_load(p, __ATOMIC_RELAXED, __HIP_MEMORY_SCOPE_AGENT); }
__device__ __forceinline__ unsigned xb_add(unsigned* p, unsigned v) { return __hip_atomic_fetch_add(p, v, __ATOMIC_RELAXED, __HIP_MEMORY_SCOPE_AGENT); }
__device__ __forceinline__ unsigned xb_xcc_id() { return (unsigned)__builtin_amdgcn_s_getreg((3 << 11) | 20) & 0xFu; }
#define XB_SPIN(cond, bar) do { unsigned _sp = 0; while (cond) { \
    if ((++_sp & 255u) == 0u) { if (xb_ld(&(bar)[XB_TMO])) break; if (_sp > XB_SPIN_CAP) { atomicAdd(&(bar)[XB_TMO], 1u); break; } } } } while (0)
struct XcdBarrier { unsigned* bar; unsigned x; volatile LAS unsigned* st; };
__device__ __forceinline__ XcdBarrier xcd_barrier_post(unsigned* bar, volatile LAS unsigned* st) {
    XcdBarrier b; b.bar = bar; b.x = xb_xcc_id(); b.st = st;
    if (threadIdx.x == 0) (void)xb_add(&bar[XB_XCNT(b.x)], 1u);
    return b;
}
__device__ __forceinline__ void xcd_barrier_complete(unsigned* bar, unsigned x, unsigned& nloc, unsigned& nx) {
    const unsigned G = gridDim.x * gridDim.y * gridDim.z;
    unsigned sum, cnt, mine, sp = 0u;
    for (;;) {
        sum = 0u; cnt = 0u; mine = 0u;
#pragma unroll
        for (unsigned j = 0; j < 16; ++j) { const unsigned c = xb_ld(&bar[XB_XCNT(j)]); sum += c; cnt += (c > 0u) ? 1u : 0u; mine = (j == x) ? c : mine; }
        if (sum == G) break;
        __builtin_amdgcn_s_sleep(1);
        if ((++sp & 255u) == 0u) { if (xb_ld(&bar[XB_TMO])) break; if (sp > XB_SPIN_CAP) { atomicAdd(&bar[XB_TMO], 1u); break; } }
    }
    nloc = mine > 0u ? mine : 1u; nx = cnt > 0u ? cnt : 1u;
}
__device__ __forceinline__ void xcd_barrier(const XcdBarrier& b) {
    asm volatile("s_waitcnt vmcnt(0)" ::: "memory");
    __syncthreads();
    if (threadIdx.x == 0) {
        unsigned* bar = b.bar;
        __builtin_amdgcn_s_waitcnt(0);
        unsigned nloc = b.st[0], nx = b.st[1];
        if (nloc == 0u) { xcd_barrier_complete(bar, b.x, nloc, nx); b.st[0] = nloc; b.st[1] = nx; }
        const unsigned old = xb_add(&bar[XB_XSUB(b.x)], 1u);
        const unsigned gen = old / nloc;
        if (old + 1u == (gen + 1u) * nloc) {
            __builtin_amdgcn_fence(__ATOMIC_RELEASE, "agent");
            asm volatile("s_waitcnt vmcnt(0)" ::: "memory");
            const unsigned og = xb_add(&bar[XB_TOP], 1u);
            const unsigned tg = og / nx;
            if (og + 1u == (tg + 1u) * nx) xb_add(&bar[XB_TOPGEN], 1u);
            else XB_SPIN(xb_ld(&bar[XB_TOPGEN]) == tg, bar);
            __builtin_amdgcn_fence(__ATOMIC_ACQUIRE, "agent");
            xb_add(&bar[XB_XGEN(b.x)], 1u);
            asm volatile("s_waitcnt vmcnt(0)" ::: "memory");
        } else {
            XB_SPIN(xb_ld(&bar[XB_XGEN(b.x)]) == gen, bar);
            __builtin_amdgcn_fence(__ATOMIC_ACQUIRE, "agent");
            asm volatile("s_waitcnt vmcnt(0)" ::: "memory");
        }
    }
    __syncthreads();
}

namespace pg8 {
constexpr int BM = 256, BK = 64, HALF = 128, HTB = HALF * BK * 2, STAGE_BYTES = 8 * HTB, NXCD = 8, WGM = 8;
__host__ __device__ __forceinline__ int lds_byte(int r, int c) { const int st = (r >> 4) * 2 + (c >> 5), rr = r & 15, cc = c & 31, ob = rr * 64 + cc * 2; return st * 1024 + (ob ^ (((ob >> 9) & 1) << 5)); }
__host__ __device__ __forceinline__ void stage_rc(int b, int& R, int& C) { const int st = b / 1024, sb = b % 1024, swz = sb ^ (((sb >> 9) & 1) << 5); R = (st >> 1) * 16 + swz / 64; C = (st & 1) * 32 + (swz % 64) / 2; }

__host__ __device__ __forceinline__ int perm32(int rho) { const int n = rho >> 4, i = rho & 15; return 8 * (i >> 2) + 4 * n + (i & 3); }
struct Unit { int pm, pn, k0, nt, flags; };
struct Gemm { const bf16_t* A; const bf16_t* Bt; int M, N, K, lda, ldb, a_pn_off; };

struct StaticOrder {
    int nM, nN, nwg, G, c;
    __host__ __device__ void init(int M, int N, int G_, int c_) { nM = M / BM; nN = N / BM; nwg = nM * nN; G = G_; c = c_; }
    __host__ __device__ __forceinline__ bool next(int i, Unit& u) const {
        const long L = (long)i * G + c; if (L >= nwg) return false;
        int wgid = (int)L; { const int q = nwg / NXCD, r = nwg % NXCD, xcd = wgid % NXCD, off = wgid / NXCD; wgid = (xcd < r ? xcd * (q + 1) : r * (q + 1) + (xcd - r) * q) + off; }
        const int nig = WGM * nN, gid = wgid / nig, fm = gid * WGM, gsz = (nM - fm) < WGM ? (nM - fm) : WGM;
        u.pm = fm + ((wgid % nig) % gsz); u.pn = (wgid % nig) / gsz; u.k0 = 0; u.nt = -1; u.flags = 0; return true;
    }
};
struct OffsetOrder {
    int nN, nwg, G, cc;
    __host__ __device__ void init(int M, int N, int G_, int c_, int off) { nN = N / BM; nwg = (M / BM) * nN; G = G_; cc = ((c_ - off) % G_ + G_) % G_; }
    __host__ __device__ __forceinline__ bool next(int i, Unit& u) const { const long L = (long)i * G + cc; if (L >= nwg) return false; u.pm = (int)L / nN; u.pn = (int)L % nN; u.k0 = 0; u.nt = -1; u.flags = 0; return true; }
};

struct CtxSplitOrder {
    StaticOrder lat; int nN, ntf;
    __host__ __device__ void init(int N, int K, int G_, int c_) { lat.init(NLAT, N, G_, c_); nN = N / BM; ntf = K / BK; }
    __host__ __device__ __forceinline__ bool next(int i, Unit& u) const {
        const long L = (long)i * lat.G + lat.c;
        int pm, pn, k0 = 0, ntq = -1, fl = 0;
        if (L < lat.nwg) {
            int wgid = (int)L; { const int q = lat.nwg / NXCD, r = lat.nwg % NXCD, xcd = wgid % NXCD, off = wgid / NXCD; wgid = (xcd < r ? xcd * (q + 1) : r * (q + 1) + (xcd - r) * q) + off; }
            const int nig = WGM * lat.nN, gid = wgid / nig, fm = gid * WGM, gsz = (lat.nM - fm) < WGM ? (lat.nM - fm) : WGM;
            pm = fm + ((wgid % nig) % gsz); pn = (wgid % nig) / gsz;
        } else {
            const int s = (int)(L - lat.nwg); if (s >= (NCTX / BM) * nN * 4) return false;
            const int cu_ = s >> 2, q = s & 3, base = (ntf / 8) * 2, extra = (ntf - 4 * base) / 2;
            pm = NLAT / BM + cu_ / nN; pn = cu_ % nN; ntq = base + (q < extra ? 2 : 0); k0 = (q * base + 2 * (q < extra ? q : extra)) * BK; fl = 1 | (q << 1);
        }
        u.pm = pm; u.pn = pn; u.k0 = k0; u.nt = ntq; u.flags = fl; return true;
    }
};

template <class Epi, class Sched, bool ALIGN_EPI>
__device__ __forceinline__ void gemm_phase(LAS unsigned char* lds, const Gemm g, const Sched& S, const Epi& E) {
    const int tid = fresh_tid(), wid = __builtin_amdgcn_readfirstlane(tid >> 6), lane = tid & 63, wr = wid >> 2, wc = wid & 3, fr = lane & 15, fq = lane >> 4;
    const int K = g.K, nt = K / BK;
    unsigned voffA[2], voffB[2];
#pragma unroll
    for (int i = 0; i < 2; ++i) { int R, C; stage_rc(tid * 16 + i * 8192, R, C);
        const int Rb = Epi::PERM ? ((R & ~31) + perm32(R & 31)) : R;
        voffA[i] = (unsigned)(R * g.lda + C) * 2u; voffB[i] = (unsigned)(Rb * g.ldb + C) * 2u; }
    const size_t kstep = (size_t)(BK * 2);
    const size_t hstepA = (size_t)HALF * g.lda * 2, hstepB = (size_t)HALF * g.ldb * 2;
    const size_t tstepA = 2 * hstepA, tstepB = 2 * hstepB;
    const unsigned ldsw = (unsigned)wid * 1024u;
    const int aoff = lds_byte(wr * 64 + fr, fq * 8), boff = lds_byte(wc * 32 + fr, fq * 8);
#define PG8_SA(b, h) (((b) * 2 + (h)) * HTB)
#define PG8_SB(b, h) ((4 + (b) * 2 + (h)) * HTB)
#define PG8_STAGE(bufoff, gbase, voff) do { _Pragma("unroll") for (int _i = 0; _i < 2; ++_i) \
        __builtin_amdgcn_global_load_lds((const unsigned*)((const char*)(gbase) + (voff)[_i]), (LAS unsigned*)(lds + (bufoff) + ldsw + _i * 8192), 16, 0, 0); } while (0)
#define PG8_LDA(dst, b, h) do { _Pragma("unroll") for (int m = 0; m < 4; ++m) _Pragma("unroll") for (int k = 0; k < 2; ++k) dst[m][k] = *(const LAS bf16x8*)(lds + PG8_SA(b, h) + aoff + m * 2048 + k * 1024); } while (0)
#define PG8_LDB(dst, b, h) do { _Pragma("unroll") for (int n = 0; n < 2; ++n) _Pragma("unroll") for (int k = 0; k < 2; ++k) dst[n][k] = *(const LAS bf16x8*)(lds + PG8_SB(b, h) + boff + n * 2048 + k * 1024); } while (0)
#define PG8_MMA(ai, bj, At, Bt) do { __builtin_amdgcn_s_setprio(1); _Pragma("unroll") for (int m = 0; m < 4; ++m) _Pragma("unroll") for (int n = 0; n < 2; ++n) _Pragma("unroll") for (int k = 0; k < 2; ++k) \
        acc[ai][bj][m][n] = __builtin_amdgcn_mfma_f32_16x16x32_bf16(Bt[n][k], At[m][k], acc[ai][bj][m][n], 0, 0, 0); __builtin_amdgcn_s_setprio(0); } while (0)
#define PG8_WAIT_V(n) asm volatile("s_waitcnt vmcnt(" #n ")" ::: "memory")
#define PG8_WAIT_L(n) asm volatile("s_waitcnt lgkmcnt(" #n ")" ::: "memory")
#define PG8_BAR __builtin_amdgcn_s_barrier()
#define PG8_SCHED __builtin_amdgcn_sched_barrier(0)
    Unit cur, nxt; int ui = 0;
    if (!S.next(0, cur)) return;
    f32x4 acc[2][2][4][2];
#pragma unroll
    for (int a = 0; a < 2; ++a)
#pragma unroll
        for (int b = 0; b < 2; ++b)
#pragma unroll
            for (int m = 0; m < 4; ++m)
#pragma unroll
                for (int n = 0; n < 2; ++n) acc[a][b][m][n] = (f32x4){0.f, 0.f, 0.f, 0.f};
    bf16x8 At[4][2], B0[2][2], B1[2][2];
    const char* cA = (const char*)g.A + (size_t)cur.pm * tstepA + (size_t)cur.pn * g.a_pn_off * 2 + (size_t)cur.k0 * 2; const char* cB = (const char*)g.Bt + (size_t)cur.pn * tstepB + (size_t)cur.k0 * 2;
    PG8_STAGE(PG8_SB(0, 0), cB, voffB); PG8_STAGE(PG8_SB(0, 1), cB + hstepB, voffB); PG8_STAGE(PG8_SA(0, 0), cA, voffA); PG8_STAGE(PG8_SA(0, 1), cA + hstepA, voffA);
    if (wr == 1) PG8_BAR;
    PG8_WAIT_V(2); PG8_BAR;
    PG8_STAGE(PG8_SB(1, 0), cB + kstep, voffB); PG8_STAGE(PG8_SA(1, 0), cA + kstep, voffA); PG8_STAGE(PG8_SB(1, 1), cB + hstepB + kstep, voffB);
    PG8_WAIT_V(6); PG8_BAR;
    for (;;) {
        const bool has_next = S.next(ui + 1, nxt);
        const char* nA = has_next ? (const char*)g.A + (size_t)nxt.pm * tstepA + (size_t)nxt.pn * g.a_pn_off * 2 + (size_t)nxt.k0 * 2 : cA; const char* nB = has_next ? (const char*)g.Bt + (size_t)nxt.pn * tstepB + (size_t)nxt.k0 * 2 : cB;
        const int ntc = cur.nt < 0 ? nt : cur.nt;
        for (int t = 0; t < ntc; t += 2) {
            const bool last = (t == ntc - 2);
            const char* a1 = cA + (size_t)(t + 1) * kstep;
            const char* a2 = last ? nA : cA + (size_t)(t + 2) * kstep; const char* b2 = last ? nB : cB + (size_t)(t + 2) * kstep;
            const char* a3 = a2 + kstep; const char* b3 = b2 + kstep;
            PG8_LDB(B0, 0, 0); PG8_LDB(B1, 0, 1); PG8_SCHED; PG8_LDA(At, 0, 0); PG8_STAGE(PG8_SA(1, 1), a1 + hstepA, voffA);
            PG8_WAIT_V(8); PG8_WAIT_L(0); PG8_BAR; PG8_MMA(0, 0, At, B0); PG8_MMA(0, 1, At, B1); PG8_BAR; PG8_SCHED;
            PG8_LDA(At, 0, 1); PG8_STAGE(PG8_SB(0, 0), b2, voffB); PG8_STAGE(PG8_SB(0, 1), b2 + hstepB, voffB); PG8_STAGE(PG8_SA(0, 0), a2, voffA);
            PG8_WAIT_V(8); PG8_WAIT_L(0); PG8_BAR; PG8_MMA(1, 0, At, B0); PG8_MMA(1, 1, At, B1); PG8_BAR; PG8_SCHED;
            PG8_LDB(B0, 1, 0); PG8_LDB(B1, 1, 1); PG8_SCHED; PG8_LDA(At, 1, 0); PG8_STAGE(PG8_SA(0, 1), a2 + hstepA, voffA);
            PG8_WAIT_V(8); PG8_WAIT_L(0); PG8_BAR; PG8_MMA(0, 0, At, B0); PG8_MMA(0, 1, At, B1); PG8_BAR; PG8_SCHED;
            PG8_LDA(At, 1, 1); PG8_STAGE(PG8_SB(1, 0), b3, voffB); PG8_STAGE(PG8_SB(1, 1), b3 + hstepB, voffB); PG8_STAGE(PG8_SA(1, 0), a3, voffA);
            PG8_WAIT_V(8); PG8_WAIT_L(0); PG8_BAR; PG8_MMA(1, 0, At, B0); PG8_MMA(1, 1, At, B1); PG8_BAR; PG8_SCHED;
        }
        if constexpr (ALIGN_EPI) { if (wr == 0) PG8_BAR; }
        if constexpr (!Epi::AFTER_DRAIN) { if constexpr (Epi::LOOP_LDS) E.loop(acc, cur, wr, wc, fr, fq, lds + 131072, wid, lane); else E(acc, cur, wr, wc, fr, fq); }
        if (!has_next) break;
#pragma unroll
        for (int a = 0; a < 2; ++a)
#pragma unroll
            for (int b = 0; b < 2; ++b)
#pragma unroll
                for (int m = 0; m < 4; ++m)
#pragma unroll
                    for (int n = 0; n < 2; ++n) acc[a][b][m][n] = (f32x4){0.f, 0.f, 0.f, 0.f};
        cur = nxt; cA = nA; cB = nB; ++ui;
        if constexpr (ALIGN_EPI) { if (wr == 1) PG8_BAR; }
    }
    PG8_WAIT_V(0);
    if constexpr (!ALIGN_EPI) { if (wr == 0) PG8_BAR; }
    PG8_BAR;
    if constexpr (Epi::AFTER_DRAIN) E.fused(acc, cur, wr, wc, fr, fq, lds, wid, lane);
#undef PG8_SA
#undef PG8_SB
#undef PG8_STAGE
#undef PG8_LDA
#undef PG8_LDB
#undef PG8_MMA
#undef PG8_WAIT_V
#undef PG8_WAIT_L
#undef PG8_BAR
#undef PG8_SCHED
}
}

typedef f32x4 Acc[2][2][4][2];

struct EpiInProj {
    static constexpr bool PERM = false;
    static constexpr bool AFTER_DRAIN = false;
    static constexpr bool LOOP_LDS = false;
    bf16_t *Q1, *Q2, *K1c, *K2c, *VT, *TTl, *TTc, *UC; const float* rope;
    __device__ __forceinline__ void operator()(const Acc& acc, const pg8::Unit& u, int wr, int wc, int fr, int fq) const {
        const int pn = u.pn; const bool lat = u.pm < 64;
#pragma unroll
        for (int ai = 0; ai < 2; ++ai)
#pragma unroll
            for (int m = 0; m < 4; ++m) {
                const int row = u.pm * 256 + ai * 128 + wr * 64 + m * 16 + fr;
                int b, t; if (lat) { b = row >> 11; t = row & 2047; } else { const int rc = row - NLAT; b = rc >> 8; t = rc & 255; }
                const int pos = lat ? CTXL + t : t;
                if (pn < 4) {
                    bf16_t* dst;
                    if (pn == 0) dst = Q1 + (size_t)row * 256; else if (pn == 1) dst = Q2 + (size_t)row * 256;
                    else if (pn == 2) dst = K1c + ((size_t)b * KCAT + pos) * 256; else dst = K2c + ((size_t)b * KCAT + pos) * 256;
                    const float scale = pn < 2 ? QSCALE : 1.f;
                    const int ax = fq >> 1, fh = fq & 1;
                    u32x4 w1, w2;
#pragma unroll
                    for (int bj = 0; bj < 2; ++bj) {
                        f32x4 cs = {1.f, 1.f, 1.f, 1.f}, sn = {0.f, 0.f, 0.f, 0.f};
                        if (lat) { const int pidx = ax ? (t & 63) : (t >> 6); cs = *(const f32x4*)(rope + pidx * 16 + 8 * fh + 4 * bj); sn = *(const f32x4*)(rope + 1024 + pidx * 16 + 8 * fh + 4 * bj); }
                        const f32x4 x1 = acc[ai][bj][m][0], x2 = acc[ai][bj][m][1];
                        const u32x2 p1 = pack4((x1 * cs - x2 * sn) * scale), p2 = pack4((x2 * cs + x1 * sn) * scale);
                        if (bj == 0) { w1.x = p1.x; w1.y = p1.y; w2.x = p2.x; w2.y = p2.y; } else { w1.z = p1.x; w1.w = p1.y; w2.z = p2.x; w2.w = p2.y; }
                    }
                    bf16_t* dq = dst + wc * 64 + ax * 32 + 8 * fh;
                    *(u32x4*)dq = w1; *(u32x4*)(dq + 16) = w2;
                } else if (pn < 6) {
#pragma unroll
                    for (int bj = 0; bj < 2; ++bj)
#pragma unroll
                        for (int n = 0; n < 2; ++n) {
                            bf16_t* dst = VT + ((size_t)(b * 4 + (pn - 4) * 2 + bj) * 128 + wc * 32 + n * 16 + 4 * fq) * KCAT + pos;
                            const f32x4 v = acc[ai][bj][m][n];
                            dst[0] = f2bf(v[0]); dst[KCAT] = f2bf(v[1]); dst[2 * KCAT] = f2bf(v[2]); dst[3 * KCAT] = f2bf(v[3]);
                        }
                } else if (pn < 8) {
                    const int s = pn - 6;
#pragma unroll
                    for (int bj = 0; bj < 2; ++bj)
#pragma unroll
                        for (int n = 0; n < 2; ++n) {
                            const int jf = bj * 128 + wc * 32 + n * 16 + 4 * fq;
                            const f32x4 v = acc[ai][bj][m][n];
                            if (lat) { bf16_t* dst = TTl + (((size_t)b * 256 + jf) * 2 + s) * SEQ + t; dst[0] = f2bf(v[0]); dst[2 * SEQ] = f2bf(v[1]); dst[4 * SEQ] = f2bf(v[2]); dst[6 * SEQ] = f2bf(v[3]); }
                            else { bf16_t* dst = TTc + (((size_t)b * 256 + jf) * 2 + s) * CTXL + t; dst[0] = f2bf(v[0]); dst[2 * CTXL] = f2bf(v[1]); dst[4 * CTXL] = f2bf(v[2]); dst[6 * CTXL] = f2bf(v[3]); }
                        }
                } else {
                    bf16_t* dst = UC + (size_t)row * 512 + (pn - 8) * 256 + wc * 32 + 8 * fq;
#pragma unroll
                    for (int n = 0; n < 2; ++n) { const u32x2 p0 = pack4(acc[ai][0][m][n]), p1 = pack4(acc[ai][1][m][n]); *(u32x4*)(dst + 128 * n) = (u32x4){p0.x, p0.y, p1.x, p1.y}; }
                }
            }
    }
};

struct EpiRes {
    static constexpr bool PERM = false;
    static constexpr bool AFTER_DRAIN = false;
    static constexpr bool LOOP_LDS = false;
    const float* xin_lat; const float* xin_ctx; float* xout_lat; float* xout_ctx; const float* mod; int goff; float* pb;
    __device__ __forceinline__ void operator()(const Acc& acc, const pg8::Unit& u, int wr, int wc, int fr, int fq) const {
        const int tile0 = u.pm * 256, colb = u.pn * 256 + wc * 32 + 4 * fq, rloc = wr * 64 + fr;
        if (u.flags & 1) {
            float* pq = pb + ((size_t)(u.flags >> 1) * NCTX + (tile0 - NLAT) + rloc) * DM + colb;
#pragma unroll
            for (int ai = 0; ai < 2; ++ai)
#pragma unroll
                for (int m = 0; m < 4; ++m)
#pragma unroll
                    for (int bj = 0; bj < 2; ++bj)
#pragma unroll
                        for (int n = 0; n < 2; ++n) *(f32x4*)(pq + (size_t)(ai * 128 + m * 16) * DM + bj * 128 + n * 16) = acc[ai][bj][m][n];
            return;
        }
        const bool lat = tile0 < NLAT;
        const float* xi = (lat ? xin_lat + (size_t)tile0 * DM : xin_ctx + (size_t)(tile0 - NLAT) * DM) + (size_t)rloc * DM + colb;
        float* xo = (lat ? xout_lat + (size_t)tile0 * DM : xout_ctx + (size_t)(tile0 - NLAT) * DM) + (size_t)rloc * DM + colb;
        const float* gp = mod + (lat ? (tile0 >> 11) : 8) * 6144 + goff + colb;
        f32x4 gt[2][2];
#pragma unroll
        for (int bj = 0; bj < 2; ++bj)
#pragma unroll
            for (int n = 0; n < 2; ++n) gt[bj][n] = *(const f32x4*)(gp + bj * 128 + n * 16);
        f32x4 xv[2][2][2];
#define ER_LOAD(buf, g_) do { const float* xp_ = xi + (size_t)(((g_) >> 2) * 128 + ((g_) & 3) * 16) * DM; \
            _Pragma("unroll") for (int bj = 0; bj < 2; ++bj) _Pragma("unroll") for (int n = 0; n < 2; ++n) xv[buf][bj][n] = *(const f32x4*)(xp_ + bj * 128 + n * 16); } while (0)
        ER_LOAD(0, 0);
#pragma unroll
        for (int g_ = 0; g_ < 8; ++g_) {
            if (g_ + 1 < 8) ER_LOAD((g_ + 1) & 1, g_ + 1);
            float* xq = xo + (size_t)((g_ >> 2) * 128 + (g_ & 3) * 16) * DM;
#pragma unroll
            for (int bj = 0; bj < 2; ++bj)
#pragma unroll
                for (int n = 0; n < 2; ++n) *(f32x4*)(xq + bj * 128 + n * 16) = xv[g_ & 1][bj][n] + gt[bj][n] * acc[g_ >> 2][bj][g_ & 3][n];
        }
#undef ER_LOAD
    }
};

template <int MODE>
struct EpiPanelNorm {
    static constexpr bool PERM = true;
    static constexpr bool AFTER_DRAIN = true;
    static constexpr bool LOOP_LDS = false;
    const float* xin; float* out; const float* mod; int goff; const float* final_g; unsigned* slots; unsigned* cnt; bf16_t* Hout; int sh_off, sc_off; const float* modn;
    __device__ __forceinline__ void fused(Acc& acc, const pg8::Unit& u, int wr, int wc, int fr, int fq, LAS unsigned char* lds, int wid, int lane) const {
        const int tile0 = u.pm * 256, colb = u.pn * 256 + wc * 32 + 8 * fq, rloc = wr * 64 + fr;
        const float* xi = xin + (size_t)(tile0 + rloc) * DM + colb;
        float* xo = out + (size_t)(tile0 + rloc) * DM + colb;
        const float* gp = mod + (tile0 >> 11) * 6144 + goff + colb;
        f32x4 gt[2][2];
#pragma unroll
        for (int bj = 0; bj < 2; ++bj)
#pragma unroll
            for (int n = 0; n < 2; ++n) gt[bj][n] = *(const f32x4*)(gp + bj * 128 + n * 4);
        f32x4 xv[1][2][2];
#define EF_LOAD(buf, g_) do { const float* xp_ = xi + (size_t)(((g_) >> 2) * 128 + ((g_) & 3) * 16) * DM; \
            _Pragma("unroll") for (int bj = 0; bj < 2; ++bj) _Pragma("unroll") for (int n = 0; n < 2; ++n) xv[buf][bj][n] = *(const f32x4*)(xp_ + bj * 128 + n * 4); } while (0)
        LAS float* P = (LAS float*)lds;
        LAS float* S = (LAS float*)(lds + 4096);
#pragma unroll
        for (int g_ = 0; g_ < 8; ++g_) {
            EF_LOAD(0, g_);
            float sq = 0.f;
#pragma unroll
            for (int bj = 0; bj < 2; ++bj)
#pragma unroll
                for (int n = 0; n < 2; ++n) { const f32x4 xn = xv[0][bj][n] + gt[bj][n] * acc[g_ >> 2][bj][g_ & 3][n]; acc[g_ >> 2][bj][g_ & 3][n] = xn;
                    if (MODE == 1) *(f32x4*)(xo + (size_t)((g_ >> 2) * 128 + (g_ & 3) * 16) * DM + bj * 128 + n * 4) = xn;
                    sq += (xn[0] * xn[0] + xn[1] * xn[1]) + (xn[2] * xn[2] + xn[3] * xn[3]); }
            sq += __shfl_xor(sq, 16); sq += __shfl_xor(sq, 32);
            if (fq == 0) P[((g_ >> 2) * 128 + wr * 64 + (g_ & 3) * 16 + fr) * 4 + wc] = sq;
        }
#undef EF_LOAD
        asm volatile("s_waitcnt lgkmcnt(0)" ::: "memory"); __builtin_amdgcn_s_barrier(); asm volatile("" ::: "memory");
        const int row = wid * 32 + (lane & 31);
        if (lane < 32) { const float tsum = (P[row * 4 + 0] + P[row * 4 + 1]) + (P[row * 4 + 2] + P[row * 4 + 3]);
            __hip_atomic_store(slots + (size_t)(tile0 + row) * 4 + u.pn, __float_as_uint(tsum), __ATOMIC_RELAXED, __HIP_MEMORY_SCOPE_AGENT); }
        asm volatile("s_waitcnt vmcnt(0)" ::: "memory");
        if (lane == 0) __hip_atomic_fetch_add(cnt + 64 * u.pm, 1u, __ATOMIC_RELAXED, __HIP_MEMORY_SCOPE_AGENT);
        if (wid == 0) {
            unsigned sp = 0;
            while ((unsigned)__builtin_amdgcn_readfirstlane(__hip_atomic_load(cnt + 64 * u.pm, __ATOMIC_RELAXED, __HIP_MEMORY_SCOPE_AGENT)) < 32u) { if (++sp > (1u << 20)) break; }
            __builtin_amdgcn_fence(__ATOMIC_ACQUIRE, "agent");
        }
        asm volatile("s_waitcnt vmcnt(0) lgkmcnt(0)" ::: "memory"); __builtin_amdgcn_s_barrier(); asm volatile("" ::: "memory");
        if (lane < 32) { float tot = 0.f;
#pragma unroll
            for (int t4 = 0; t4 < 4; ++t4) tot += __uint_as_float(__hip_atomic_load(slots + (size_t)(tile0 + row) * 4 + t4, __ATOMIC_RELAXED, __HIP_MEMORY_SCOPE_AGENT));
            S[row] = __builtin_amdgcn_rsqf(tot * (1.f / DM) + EPSV); }
        asm volatile("s_waitcnt lgkmcnt(0)" ::: "memory"); __builtin_amdgcn_s_barrier(); asm volatile("" ::: "memory");
#pragma unroll
        for (int bj = 0; bj < 2; ++bj) {
            f32x4 fg[2], sc[2], sh[2];
#pragma unroll
            for (int n = 0; n < 2; ++n) { fg[n] = *(const f32x4*)(final_g + colb + bj * 128 + n * 4); sc[n] = (f32x4){1.f, 1.f, 1.f, 1.f}; sh[n] = (f32x4){0.f, 0.f, 0.f, 0.f};
                if (MODE == 1) { const float* mp = modn + (tile0 >> 11) * 6144 + colb + bj * 128 + n * 4; sc[n] = *(const f32x4*)(mp + sc_off) + 1.f; sh[n] = *(const f32x4*)(mp + sh_off); } }
#pragma unroll
            for (int g_ = 0; g_ < 8; ++g_) {
                const float rs = S[(g_ >> 2) * 128 + wr * 64 + (g_ & 3) * 16 + fr];
                const size_t ro = (size_t)((g_ >> 2) * 128 + (g_ & 3) * 16) * DM;
                const f32x4 y0 = (acc[g_ >> 2][bj][g_ & 3][0] * rs) * fg[0], y1 = (acc[g_ >> 2][bj][g_ & 3][1] * rs) * fg[1];
                if (MODE == 0) { *(f32x4*)(xo + ro + bj * 128) = y0; *(f32x4*)(xo + ro + bj * 128 + 4) = y1; }
                else { const u32x2 p0 = pack4(y0 * sc[0] + sh[0]), p1 = pack4(y1 * sc[1] + sh[1]);
                    *(u32x4*)(Hout + (size_t)(tile0 + rloc) * DM + colb + ro + bj * 128) = (u32x4){p0.x, p0.y, p1.x, p1.y}; }
            }
        }
    }
};

struct EpiResNormL0 {
    static constexpr bool PERM = true;
    static constexpr bool AFTER_DRAIN = false;
    static constexpr bool LOOP_LDS = true;
    EpiPanelNorm<1> pn_; float* pb;
    __device__ __forceinline__ void loop(Acc& acc, const pg8::Unit& u, int wr, int wc, int fr, int fq, LAS unsigned char* lds, int wid, int lane) const {
        if (u.flags & 1) {
            const int tile0 = u.pm * 256, colb = u.pn * 256 + wc * 32 + 8 * fq, rloc = wr * 64 + fr;
            float* pq = pb + ((size_t)(u.flags >> 1) * NCTX + (tile0 - NLAT) + rloc) * DM + colb;
#pragma unroll
            for (int ai = 0; ai < 2; ++ai)
#pragma unroll
                for (int m = 0; m < 4; ++m)
#pragma unroll
                    for (int bj = 0; bj < 2; ++bj)
#pragma unroll
                        for (int n = 0; n < 2; ++n) *(f32x4*)(pq + (size_t)(ai * 128 + m * 16) * DM + bj * 128 + n * 4) = acc[ai][bj][m][n];
        } else pn_.fused(acc, u, wr, wc, fr, fq, lds, wid, lane);
    }
};

struct EpiFfn13 {
    static constexpr bool PERM = false;
    static constexpr bool AFTER_DRAIN = false;
    static constexpr bool LOOP_LDS = false;
    bf16_t* ACT;
    __device__ __forceinline__ void operator()(const Acc& acc, const pg8::Unit& u, int wr, int wc, int fr, int fq) const {
#pragma unroll
        for (int ai = 0; ai < 2; ++ai)
#pragma unroll
            for (int m = 0; m < 4; ++m) {
                const int row = u.pm * 256 + ai * 128 + wr * 64 + m * 16 + fr;
                u32x4 w;
#pragma unroll
                for (int bj = 0; bj < 2; ++bj) {
                    const f32x4 a = acc[ai][bj][m][0], b = acc[ai][bj][m][1]; f32x4 o;
#pragma unroll
                    for (int j = 0; j < 4; ++j) o[j] = a[j] * sigmoidf_(a[j]) * b[j];
                    const u32x2 pk = pack4(o);
                    if (bj == 0) { w.x = pk.x; w.y = pk.y; } else { w.z = pk.x; w.w = pk.y; }
                }
                *(u32x4*)(ACT + (size_t)row * DFF + 128 * u.pn + 32 * wc + 8 * fq) = w;
            }
    }
};

struct EpiMix {
    static constexpr bool PERM = true;
    static constexpr bool AFTER_DRAIN = false;
    static constexpr bool LOOP_LDS = false;
    bf16_t* out; int pitch, col0, tok_base, tok_pn_step, col_pn_step;
    __device__ __forceinline__ void operator()(const Acc& acc, const pg8::Unit& u, int wr, int wc, int fr, int fq) const {
#pragma unroll
        for (int ai = 0; ai < 2; ++ai)
#pragma unroll
            for (int m = 0; m < 4; ++m) {
                const int row = u.pm * 256 + ai * 128 + wr * 64 + m * 16 + fr;
                bf16_t* dst = out + (size_t)(tok_base + u.pn * tok_pn_step + row) * pitch + col0 + u.pn * col_pn_step + wc * 32 + 8 * fq;
#pragma unroll
                for (int bj = 0; bj < 2; ++bj) { const u32x2 p0 = pack4(acc[ai][bj][m][0]), p1 = pack4(acc[ai][bj][m][1]); *(u32x4*)(dst + bj * 128) = (u32x4){p0.x, p0.y, p1.x, p1.y}; }
            }
    }
};

namespace att {
constexpr int VP = 144, OFF_K1 = 0, OFF_K2 = 8192, OFF_VT = 16384, BUFSZ = 16384 + 128 * VP;
struct Args { const bf16_t *Q1, *Q2, *K1c, *K2c, *VT; bf16_t* MIXA; const float* subln; float lam, omli; };

__device__ __forceinline__ void attn_unit(LAS unsigned char* lds, const Args& A, int b, int h, int qrow0, int nkt) {
    const int tid = fresh_tid(), lane = tid & 63, r32 = lane & 31, hi = lane >> 5;
    const int wid = __builtin_amdgcn_readfirstlane(tid >> 6), map = wid >> 2, qg = wid & 3;
    const bf16_t* Qm = map ? A.Q2 : A.Q1;
    bf16x8 qf[4];
    { const bf16_t* qp = Qm + (size_t)(qrow0 + qg * 32 + r32) * 256 + h * 64 + hi * 8;
#pragma unroll
      for (int d0 = 0; d0 < 4; ++d0) qf[d0] = *(const bf16x8*)(qp + d0 * 16); }
    const int key_s = tid >> 3, ch_s = tid & 7;
    const bf16_t* k1src = A.K1c + ((size_t)b * KCAT + key_s) * 256 + h * 64 + ch_s * 8;
    const bf16_t* k2src = A.K2c + ((size_t)b * KCAT + key_s) * 256 + h * 64 + ch_s * 8;
    const bf16_t* vsrc = A.VT + ((size_t)(b * 4 + h) * 128 + key_s) * KCAT + ch_s * 8;
    const int kdst = key_s * 128 + ((ch_s ^ ((key_s >> 1) & 7)) << 4), vdst = key_s * VP + 32 * (ch_s >> 1) + 8 * (ch_s & 1);
    u32x4 rk1[2], rk2[2], rv0[2], rv1[2];
#define ATT_LOAD(set, t) do { rk1[set] = *(const u32x4*)(k1src + (size_t)(t) * 64 * 256); rk2[set] = *(const u32x4*)(k2src + (size_t)(t) * 64 * 256); \
        rv0[set] = *(const u32x4*)(vsrc + (t) * 64); rv1[set] = *(const u32x4*)(vsrc + (size_t)64 * KCAT + (t) * 64); } while (0)
#define ATT_STORE(set, buf) do { LAS unsigned char* bb_ = lds + (buf) * BUFSZ; *(LAS u32x4*)(bb_ + OFF_K1 + kdst) = rk1[set]; *(LAS u32x4*)(bb_ + OFF_K2 + kdst) = rk2[set]; \
        *(LAS u32x2*)(bb_ + OFF_VT + vdst) = (u32x2){rv0[set].x, rv0[set].y}; *(LAS u32x2*)(bb_ + OFF_VT + vdst + 16) = (u32x2){rv0[set].z, rv0[set].w}; \
        *(LAS u32x2*)(bb_ + OFF_VT + 64 * VP + vdst) = (u32x2){rv1[set].x, rv1[set].y}; *(LAS u32x2*)(bb_ + OFF_VT + 64 * VP + vdst + 16) = (u32x2){rv1[set].z, rv1[set].w}; } while (0)
    constexpr float THR = 6.f;
    float mrun = 0.f, lrun = 0.f;
    f32x16 O[4];
#pragma unroll
    for (int i = 0; i < 4; ++i)
#pragma unroll
        for (int r = 0; r < 16; ++r) O[i][r] = 0.f;
    ATT_LOAD(0, 0); ATT_STORE(0, 0); __syncthreads();
    ATT_LOAD(1, 1);
    for (int t0 = 0; t0 < nkt; t0 += 2) {
#pragma unroll
      for (int tt = 0; tt < 2; ++tt) {
        const int t = t0 + tt, cur = tt;
        if (t + 2 < nkt) ATT_LOAD(tt, t + 2);
        LAS unsigned char* base = lds + cur * BUFSZ;
        LAS unsigned char* kb = base + (map ? OFF_K2 : OFF_K1) + r32 * 128;
        f32x16 s0, s1;
#pragma unroll
        for (int r = 0; r < 16; ++r) { s0[r] = -mrun; s1[r] = -mrun; }
#pragma unroll
        for (int d0 = 0; d0 < 4; ++d0) {
            const int chunk = ((2 * d0 + hi) ^ ((r32 >> 1) & 7)) << 4;
            const bf16x8 a0 = *(const LAS bf16x8*)(kb + chunk), a1 = *(const LAS bf16x8*)(kb + 32 * 128 + chunk);
            s0 = __builtin_amdgcn_mfma_f32_32x32x16_bf16(a0, qf[d0], s0, 0, 0, 0);
            s1 = __builtin_amdgcn_mfma_f32_32x32x16_bf16(a1, qf[d0], s1, 0, 0, 0);
        }
        asm volatile("s_nop 15\n\ts_nop 4" : "+v"(s0), "+v"(s1));
        LAS unsigned char* vb = base + OFF_VT + r32 * VP + 16 * hi;
        u32x4 vf[2][4];
#define ATT_LDV(slot, c) do { _Pragma("unroll") for (int dblk = 0; dblk < 4; ++dblk) { \
            vf[slot][dblk] = *(const LAS u32x4*)(vb + dblk * 32 * VP + 32 * (c)); } } while (0)
        ATT_LDV(0, 0);
        __builtin_amdgcn_sched_barrier(0);
        float rm = max3f(s0[0], s0[1], s1[0]), rm2 = max3f(s0[2], s0[3], s1[1]);
        rm = max3f(rm, s1[2], s1[3]);
#pragma unroll
        for (int r = 4; r < 16; r += 4) { rm = max3f(rm, s0[r], s0[r + 1]); rm2 = max3f(rm2, s0[r + 2], s0[r + 3]); rm = max3f(rm, s1[r], s1[r + 1]); rm2 = max3f(rm2, s1[r + 2], s1[r + 3]); }
        rm = fmaxf(rm, rm2);
        rm = fmaxf(rm, __shfl_xor(rm, 32));
        const bool need = (t == 0) || (rm > THR);
        if (__any(need)) {
            const float dlt = need ? rm : 0.f, alpha = (t == 0) ? 1.f : __builtin_amdgcn_exp2f(-dlt);
            mrun += dlt; lrun *= alpha;
            s0 = s0 - dlt; s1 = s1 - dlt;
#pragma unroll
            for (int i = 0; i < 4; ++i)
#pragma unroll
                for (int r = 0; r < 16; ++r) O[i][r] *= alpha;
        }
#pragma unroll
        for (int r = 0; r < 16; ++r) { s0[r] = __builtin_amdgcn_exp2f(s0[r]); s1[r] = __builtin_amdgcn_exp2f(s1[r]); }
        { const f32x16 t16 = s0 + s1;
          typedef float f32x8 __attribute__((ext_vector_type(8)));
          const f32x8 t8 = t16.lo + t16.hi; const f32x4 t4 = t8.lo + t8.hi;
          lrun += (t4[0] + t4[1]) + (t4[2] + t4[3]); }
        bf16x8 P[4];
        { u32x4 w;
          w.x = cvt_pk_bf16(s0[0], s0[1]); w.y = cvt_pk_bf16(s0[2], s0[3]); w.z = cvt_pk_bf16(s0[4], s0[5]); w.w = cvt_pk_bf16(s0[6], s0[7]); P[0] = __builtin_bit_cast(bf16x8, w);
          w.x = cvt_pk_bf16(s0[8], s0[9]); w.y = cvt_pk_bf16(s0[10], s0[11]); w.z = cvt_pk_bf16(s0[12], s0[13]); w.w = cvt_pk_bf16(s0[14], s0[15]); P[1] = __builtin_bit_cast(bf16x8, w);
          w.x = cvt_pk_bf16(s1[0], s1[1]); w.y = cvt_pk_bf16(s1[2], s1[3]); w.z = cvt_pk_bf16(s1[4], s1[5]); w.w = cvt_pk_bf16(s1[6], s1[7]); P[2] = __builtin_bit_cast(bf16x8, w);
          w.x = cvt_pk_bf16(s1[8], s1[9]); w.y = cvt_pk_bf16(s1[10], s1[11]); w.z = cvt_pk_bf16(s1[12], s1[13]); w.w = cvt_pk_bf16(s1[14], s1[15]); P[3] = __builtin_bit_cast(bf16x8, w); }
        __builtin_amdgcn_sched_barrier(0);
        ATT_LDV(1, 1);
        __builtin_amdgcn_sched_barrier(0);
#pragma unroll
        for (int dblk = 0; dblk < 4; ++dblk) O[dblk] = __builtin_amdgcn_mfma_f32_32x32x16_bf16(__builtin_bit_cast(bf16x8, vf[0][dblk]), P[0], O[dblk], 0, 0, 0);
        __builtin_amdgcn_sched_barrier(0);
        ATT_LDV(0, 2);
        __builtin_amdgcn_sched_barrier(0);
#pragma unroll
        for (int dblk = 0; dblk < 4; ++dblk) O[dblk] = __builtin_amdgcn_mfma_f32_32x32x16_bf16(__builtin_bit_cast(bf16x8, vf[1][dblk]), P[1], O[dblk], 0, 0, 0);
        __builtin_amdgcn_sched_barrier(0);
        ATT_LDV(1, 3);
        __builtin_amdgcn_sched_barrier(0);
#pragma unroll
        for (int dblk = 0; dblk < 4; ++dblk) O[dblk] = __builtin_amdgcn_mfma_f32_32x32x16_bf16(__builtin_bit_cast(bf16x8, vf[0][dblk]), P[2], O[dblk], 0, 0, 0);
        __builtin_amdgcn_sched_barrier(0);
#pragma unroll
        for (int dblk = 0; dblk < 4; ++dblk) O[dblk] = __builtin_amdgcn_mfma_f32_32x32x16_bf16(__builtin_bit_cast(bf16x8, vf[1][dblk]), P[3], O[dblk], 0, 0, 0);
#undef ATT_LDV
        if (t + 1 < nkt) ATT_STORE(tt ^ 1, tt ^ 1);
        asm volatile("s_waitcnt lgkmcnt(0)" ::: "memory"); __builtin_amdgcn_s_barrier(); asm volatile("" ::: "memory");
      }
    }
#undef ATT_LOAD
#undef ATT_STORE
    lrun += __shfl_xor(lrun, 32);
    const float inv = 1.f / lrun;
    LAS float* ex = (LAS float*)lds + qg * 4096;
    if (map == 1) {
#pragma unroll
        for (int i = 0; i < 4; ++i)
#pragma unroll
            for (int r = 0; r < 16; ++r) ex[(i * 16 + r) * 64 + lane] = O[i][r] * inv;
    }
    __syncthreads();
    if (map == 0) {
        float ss = 0.f;
#pragma unroll
        for (int i = 0; i < 4; ++i)
#pragma unroll
            for (int r = 0; r < 16; ++r) { const float o = O[i][r] * inv - A.lam * ex[(i * 16 + r) * 64 + lane]; O[i][r] = o; ss += o * o; }
        ss += __shfl_xor(ss, 32);
        const float rstd = __builtin_amdgcn_rsqf(ss * (1.f / 128.f) + EPSV) * A.omli;
        bf16_t* dst = A.MIXA + (size_t)(qrow0 + qg * 32 + r32) * DM + h * 128 + 4 * hi;
#pragma unroll
        for (int i = 0; i < 4; ++i)
#pragma unroll
            for (int rq = 0; rq < 4; ++rq) {
                const int d0 = 32 * i + 8 * rq;
                const f32x4 gg = *(const f32x4*)(A.subln + d0 + 4 * hi);
                f32x4 v = {O[i][4 * rq] * rstd * gg[0], O[i][4 * rq + 1] * rstd * gg[1], O[i][4 * rq + 2] * rstd * gg[2], O[i][4 * rq + 3] * rstd * gg[3]};
                *(u32x2*)(dst + d0) = pack4(v);
            }
    }
    __syncthreads();
}
}

__device__ __forceinline__ void conv_item(const Params& p, LAS unsigned char* lds, int l, int item, const bf16_t* UC, bf16_t* MIXA) {
    const int tid = fresh_tid(), lane = tid & 63, wid = tid >> 6, g = wid & 3, th = wid >> 2;
    const int ch = g * 64 + lane;
    int rowbase, t0, L;
    if (item < 256) { rowbase = (item >> 5) * SEQ; t0 = (item & 31) * 64; L = SEQ; }
    else { const int j = item - 256; rowbase = NLAT + (j >> 2) * CTXL; t0 = (j & 3) * 64; L = CTXL; }
    LAS float* zl = (LAS float*)lds;
    {
        u32x4 av[6], gv[6];
#pragma unroll
        for (int it = 0; it < 6; ++it) {
            int idx = tid + it * 512; idx = idx < 94 * 32 ? idx : 94 * 32 - 1;
            const int pr = idx >> 5, c8 = idx & 31; int pp = t0 - 15 + pr; pp = pp < 0 ? 0 : (pp >= L ? L - 1 : pp);
            const bf16_t* up = UC + (size_t)(rowbase + pp) * 512 + c8 * 8;
            av[it] = *(const u32x4*)up; gv[it] = *(const u32x4*)(up + 256);
        }
#pragma unroll
        for (int it = 0; it < 6; ++it) {
            const int idx = tid + it * 512;
            const int pr = idx >> 5, c8 = idx & 31, pp = t0 - 15 + pr;
            const float msk = (pp >= 0 && pp < L) ? 1.f : 0.f;
            f32x4 z0, z1;
#pragma unroll
            for (int q = 0; q < 4; ++q) {
                const float a_lo = __uint_as_float(av[it][q] << 16), a_hi = __uint_as_float(av[it][q] & 0xffff0000u);
                const float g_lo = __uint_as_float(gv[it][q] << 16), g_hi = __uint_as_float(gv[it][q] & 0xffff0000u);
                const float zlo = a_lo * sigmoidf_(g_lo) * msk, zhi = a_hi * sigmoidf_(g_hi) * msk;
                if (q < 2) { z0[2 * q] = zlo; z0[2 * q + 1] = zhi; } else { z1[2 * (q - 2)] = zlo; z1[2 * (q - 2) + 1] = zhi; }
            }
            if (idx < 94 * 32) { *(LAS f32x4*)(zl + pr * 256 + c8 * 8) = z0; *(LAS f32x4*)(zl + pr * 256 + c8 * 8 + 4) = z1; }
        }
    }
    __syncthreads();
    const int ts = t0 + th * 32;
    float w[31];
#pragma unroll
    for (int k = 0; k < 31; ++k) w[k] = p.conv_w[(size_t)l * 31 * 256 + k * 256 + ch];
    float o[32];
    const float bias = p.conv_b[l * 256 + ch];
    const LAS float* zp = zl + (th * 32) * 256 + ch;
    float z[62];
#pragma unroll
    for (int jj = 0; jj < 62; ++jj) z[jj] = zp[jj * 256];
#pragma unroll
    for (int i = 0; i < 32; ++i) {
        float acc = bias;
#pragma unroll
        for (int k = 0; k < 31; ++k) acc += w[k] * z[i + k];
        o[i] = acc;
    }
    const float lg = p.conv_ln_g[l * 256 + ch], lb = p.conv_ln_b[l * 256 + ch];
#pragma unroll
    for (int i = 0; i < 32; ++i) {
        const float mu = wave_sum(o[i]) * (1.f / 64.f);
        const float d = o[i] - mu;
        const float var = wave_sum(d * d) * (1.f / 64.f);
        const float zn = d * __builtin_amdgcn_rsqf(var + EPSV) * lg + lb;
        MIXA[(size_t)(rowbase + ts + i) * DM + 768 + ch] = f2bf(zn * sigmoidf_(zn));
    }
    __syncthreads();
}

__device__ __forceinline__ int drow_map(int mode, int n) {
    if (mode == 0) return n;
    if (mode == 1) {
        if (n < 1024) { const int cs = n & 255, head = cs >> 6, d = cs & 63, a = d >> 5, pp = (d >> 4) & 1, f = d & 15;
            return (n & ~255) + 128 * ((f >> 2) & 1) + 32 * head + 16 * pp + 4 * (2 * a + (f >> 3)) + (f & 3); }
        if (n < 1792) return n;
        { const int mm = n - 1792, cs = mm & 255;
          return 2048 + (mm & ~255) + 128 * ((cs >> 2) & 1) + 32 * ((cs >> 5) & 3) + 16 * (cs >> 7) + 4 * ((cs >> 3) & 3) + (cs & 3); }
    }
    const int r = 256 * (n >> 7) + 128 * ((n >> 2) & 1) + 32 * ((n >> 5) & 3) + 4 * ((n >> 3) & 3) + (n & 3);
    return mode == 2 ? r : r + 16;
}
__device__ __forceinline__ void transpose_item(const float* W, int ldw, int K, bf16_t* WT, int mode, LAS float* scr, int kb, int nb, int lane) {
    const int k0 = 64 * kb, n0 = 32 * nb;
#pragma unroll 8
    for (int i = 0; i < 32; ++i) { const int kk = 2 * i + (lane >> 5); scr[kk * 33 + (lane & 31)] = W[(size_t)(k0 + kk) * ldw + n0 + (lane & 31)]; }
    asm volatile("s_waitcnt lgkmcnt(0)" ::: "memory");
    const int c = lane & 7;
#pragma unroll
    for (int j = 0; j < 4; ++j) { const int n = (lane >> 3) + 8 * j; const LAS float* s = scr + (8 * c) * 33 + n;
        u32x4 o; o.x = cvt_pk_bf16(s[0 * 33], s[1 * 33]); o.y = cvt_pk_bf16(s[2 * 33], s[3 * 33]); o.z = cvt_pk_bf16(s[4 * 33], s[5 * 33]); o.w = cvt_pk_bf16(s[6 * 33], s[7 * 33]);
        *(u32x4*)(WT + (size_t)drow_map(mode, n0 + n) * K + k0 + 8 * c) = o; }
    asm volatile("s_waitcnt lgkmcnt(0)" ::: "memory");
}

__device__ __forceinline__ void prep_phase(const Params& p, LAS unsigned char* lds) {
    const int tid = fresh_tid(), lane = tid & 63, wave = tid >> 6, G = gridDim.x;
    const int gw = blockIdx.x * 8 + wave, NGW = G * 8;
    const int gt = blockIdx.x * 512 + tid, NGT = G * 512;
    unsigned char* ws = p.ws;
    LAS float* tab = (LAS float*)(lds + 73728);
    LAS float* t64c = tab + 2048; LAS float* t64s = t64c + 64;
    for (int m = tid; m < 2048; m += 512) tab[m] = cospif((float)m * (1.f / 1024.f));
    if (tid < 64) { t64c[tid] = cospif((float)tid * (1.f / 32.f)); t64s[tid] = sinpif((float)tid * (1.f / 32.f)); }
    __syncthreads();
    if (gt < 1024) { const int pos = gt >> 4, f = gt & 15; const float inv = powf(10000.f, -(float)f / 16.f); const float ang = (float)pos * inv;
        float* rope = (float*)(ws + WS_ROPE); rope[gt] = cosf(ang); rope[1024 + gt] = sinf(ang); }
    {
        LAS float* scr = (LAS float*)(lds + wave * 8448);
        constexpr int I_IN = 16 * 72, I_OUT = 16 * 32, I_F1 = 16 * 88, I_F2 = 44 * 32, I_L = I_IN + I_OUT + 2 * I_F1 + I_F2;
        for (int it = gw; it < 2 * I_L; it += NGW) {
            const int l = it / I_L; int r = it % I_L;
            if (r < I_IN) { const int kb = r / 72, nb = r % 72; if (nb >= 48 && nb < 56) continue;
                transpose_item(p.w_in + (size_t)l * DM * INW_SRC, INW_SRC, DM, (bf16_t*)(ws + WS_WIN) + (size_t)l * INW * DM, 1, scr, kb, nb, lane); continue; }
            r -= I_IN;
            if (r < I_OUT) { transpose_item(p.w_out + (size_t)l * DM * DM, DM, DM, (bf16_t*)(ws + WS_WOUT) + (size_t)l * DM * DM, 0, scr, r / 32, r % 32, lane); continue; }
            r -= I_OUT;
            if (r < I_F1) { transpose_item(p.w_ffn1 + (size_t)l * DM * DFF, DFF, DM, (bf16_t*)(ws + WS_W13) + (size_t)l * N13 * DM, 2, scr, r / 88, r % 88, lane); continue; }
            r -= I_F1;
            if (r < I_F1) { transpose_item(p.w_ffn3 + (size_t)l * DM * DFF, DFF, DM, (bf16_t*)(ws + WS_W13) + (size_t)l * N13 * DM, 3, scr, r / 88, r % 88, lane); continue; }
            r -= I_F1;
            transpose_item(p.w_ffn2 + (size_t)l * DFF * DM, DM, DFF, (bf16_t*)(ws + WS_W2) + (size_t)l * DM * DFF, 0, scr, r / 32, r % 32, lane);
        }
    }
    {
        const float tcl = cospif((float)lane * (1.f / 32.f)), tsl = sinpif((float)lane * (1.f / 32.f));
        for (int it = gw; it < 2 * 4 * 16 * 16; it += NGW) {
            const int l = it >> 10, g = (it >> 8) & 3, kbk = (it >> 4) & 15, lqg = it & 15;
            const int k = kbk * 64 + lane;
            const float* wr_ = p.w_in + (size_t)l * DM * INW_SRC + (size_t)k * INW_SRC + 1536 + g * 64;
            float wv[64];
#pragma unroll
            for (int c4 = 0; c4 < 16; ++c4) { const f32x4 v = *(const f32x4*)(wr_ + 4 * c4); wv[4 * c4] = v[0]; wv[4 * c4 + 1] = v[1]; wv[4 * c4 + 2] = v[2]; wv[4 * c4 + 3] = v[3]; }
            bf16_t* wt = (bf16_t*)(ws + WS_WIN) + (size_t)l * INW * DM;
#pragma unroll 1
            for (int li = 0; li < 4; ++li) {
                const int lq = __builtin_amdgcn_readfirstlane(lqg * 4 + li);
                float ac = 0.f, as = 0.f;
#pragma unroll
                for (int c = 0; c < 64; ++c) {
                    const int m = (lq * c) & 63;
                    const float ct = __int_as_float(__builtin_amdgcn_readlane(__float_as_int(tcl), m)), st = __int_as_float(__builtin_amdgcn_readlane(__float_as_int(tsl), m));
                    ac += wv[c] * ct; as += wv[c] * st;
                }
                wt[(size_t)(1536 + g * 64 + lq) * DM + k] = f2bf(ac);
                wt[(size_t)(1536 + 256 + g * 64 + lq) * DM + k] = f2bf(as);
            }
        }
    }
    for (int e = gt; e < 2 * WSM_L; e += NGT) {
        const int l = e / WSM_L, r = e % WSM_L; float v;
        if (r < 256 * 512) { const int n = r >> 9, k = r & 255; const int g = n >> 6, d = n & 63, g2 = k >> 6, c = k & 63; v = (g == g2) ? p.w_fourier[(((size_t)l * 4 + g) * 64 + c) * 64 + d] : 0.f; }
        else { const int r2 = r - 256 * 512, n = r2 >> 8, k = r2 & 255; v = p.w_conv_out[((size_t)l * 256 + k) * 256 + n]; }
        ((bf16_t*)(ws + WS_WSM))[e] = f2bf(v);
    }
    {
        const float nl = 1.f / sqrtf(2048.f * 64.f), nc = 1.f / 128.f;
        for (int e = gt; e < 2048 * 4096 / 8; e += NGT) {
            const int k = e >> 9, col0 = (e & 511) * 8, s = col0 >> 11; float v[8];
#pragma unroll
            for (int j = 0; j < 8; ++j) { const int n = (col0 + j) & 2047, m = (k * n) & 2047; v[j] = s ? -tab[(m - 512) & 2047] * nl : tab[m] * nl; }
            u32x4 o; o.x = cvt_pk_bf16(v[0], v[1]); o.y = cvt_pk_bf16(v[2], v[3]); o.z = cvt_pk_bf16(v[4], v[5]); o.w = cvt_pk_bf16(v[6], v[7]);
            *(u32x4*)((bf16_t*)(ws + WS_DFTL) + (size_t)e * 8) = o;
        }
        for (int e = gt; e < 256 * 512 / 8; e += NGT) {
            const int k = e >> 6, col0 = (e & 63) * 8, s = col0 >> 8; float v[8];
#pragma unroll
            for (int j = 0; j < 8; ++j) { const int n = (col0 + j) & 255, m = ((k * n) & 255) * 8; v[j] = s ? -tab[(m - 512) & 2047] * nc : tab[m] * nc; }
            u32x4 o; o.x = cvt_pk_bf16(v[0], v[1]); o.y = cvt_pk_bf16(v[2], v[3]); o.z = cvt_pk_bf16(v[4], v[5]); o.w = cvt_pk_bf16(v[6], v[7]);
            *(u32x4*)((bf16_t*)(ws + WS_DFTC) + (size_t)e * 8) = o;
        }
    }
    for (int it = gw; it < 2 * 96 * 8; it += NGW) {
        const int l = it / 768, r = it % 768, cgp = r >> 3, kc = r & 7;
        const int col = cgp * 64 + lane, k0 = kc * 128;
        float sv[9][2];
#pragma unroll
        for (int b = 0; b < 9; ++b)
#pragma unroll
            for (int hh = 0; hh < 2; ++hh) { const int k = k0 + hh * 64 + lane; const float cv = (b < 8) ? p.c[b * DM + k] : p.c_ctx[k]; sv[b][hh] = cv * sigmoidf_(cv); }
        float ac[9];
#pragma unroll
        for (int b = 0; b < 9; ++b) ac[b] = 0.f;
        const float* wp = p.w_ada + ((size_t)l * DM + k0) * 6144 + col;
#pragma unroll
        for (int hh = 0; hh < 2; ++hh) {
#pragma unroll 8
            for (int kk = 0; kk < 64; ++kk) {
                const float wv = wp[(size_t)(hh * 64 + kk) * 6144];
#pragma unroll
                for (int b = 0; b < 9; ++b) ac[b] += __int_as_float(__builtin_amdgcn_readlane(__float_as_int(sv[b][hh]), kk)) * wv;
            }
        }
        const float bias = (kc == 0) ? p.b_ada[l * 6144 + col] : 0.f;
        float* mod = (float*)(ws + WS_MOD) + (size_t)l * 9 * 6144;
#pragma unroll
        for (int b = 0; b < 9; ++b) atomicAdd(mod + b * 6144 + col, ac[b] + bias);
    }
}

__device__ __forceinline__ void norm_phase(const float* xlat, const float* xctx, const float* gvec, const float* mod, int sh_off, int sc_off, bf16_t* H, int nrows,
                                           const float* part, const float* pgate, float* xctx_out, int row_lo) {
    const int tid = fresh_tid(), lane = tid & 63, gw = row_lo + blockIdx.x * 8 + (tid >> 6), NGW = gridDim.x * 8;
    f32x4 vn[4];
#define NORM_LOADX(dst, r_) do { const int r__ = (r_); const float* xr_ = r__ < NLAT ? xlat + (size_t)r__ * DM : xctx + (size_t)(r__ - NLAT) * DM; \
        _Pragma("unroll") for (int j = 0; j < 4; ++j) dst[j] = *(const f32x4*)(xr_ + 4 * lane + 256 * j); } while (0)
    if (gw < nrows) NORM_LOADX(vn, gw);
    for (int row = gw; row < nrows; row += NGW) {
        const int bb = row < NLAT ? row >> 11 : 8;
        f32x4 v[4]; float ss = 0.f;
#pragma unroll
        for (int j = 0; j < 4; ++j) v[j] = vn[j];
        if (row + NGW < nrows) NORM_LOADX(vn, row + NGW);
        const float* mp = mod + bb * 6144;
        f32x4 gg[4], sc[4], sh[4];
#pragma unroll
        for (int j = 0; j < 4; ++j) { const int col = 4 * lane + 256 * j; gg[j] = *(const f32x4*)(gvec + col); sc[j] = *(const f32x4*)(mp + sc_off + col); sh[j] = *(const f32x4*)(mp + sh_off + col); }
        if (part != nullptr && row >= NLAT) {
#pragma unroll
            for (int j = 0; j < 4; ++j) {
                const size_t o = (size_t)(row - NLAT) * DM + 4 * lane + 256 * j;
                const f32x4 ps = (*(const f32x4*)(part + o) + *(const f32x4*)(part + (size_t)NCTX * DM + o)) + (*(const f32x4*)(part + (size_t)2 * NCTX * DM + o) + *(const f32x4*)(part + (size_t)3 * NCTX * DM + o));
                v[j] = v[j] + *(const f32x4*)(pgate + 4 * lane + 256 * j) * ps;
                *(f32x4*)(xctx_out + o) = v[j];
            }
        }
#pragma unroll
        for (int j = 0; j < 4; ++j) ss += (v[j][0] * v[j][0] + v[j][1] * v[j][1]) + (v[j][2] * v[j][2] + v[j][3] * v[j][3]);
        const float rstd = __builtin_amdgcn_rsqf(wave_sum(ss) * (1.f / DM) + EPSV);
#pragma unroll
        for (int j = 0; j < 4; ++j) {
            const int col = 4 * lane + 256 * j;
            const f32x4 y = (v[j] * rstd) * gg[j];
            const f32x4 hv = y * (sc[j] + 1.f) + sh[j];
            *(u32x2*)(H + (size_t)row * DM + col) = pack4(hv);
        }
    }
#undef NORM_LOADX
}

__global__ void __launch_bounds__(512, 2) fwd_kernel(Params p) {
    extern __shared__ __attribute__((aligned(16))) unsigned char lds_raw[];
    LAS unsigned char* lds = (LAS unsigned char*)lds_raw;
    cg::grid_group grid = cg::this_grid();
    const int G = gridDim.x, cu = blockIdx.x;
    unsigned char* ws = p.ws;
    bf16_t* H = (bf16_t*)(ws + WS_H);
    bf16_t* Q1 = (bf16_t*)(ws + WS_Q1); bf16_t* Q2 = (bf16_t*)(ws + WS_Q2); bf16_t* K1c = (bf16_t*)(ws + WS_K1); bf16_t* K2c = (bf16_t*)(ws + WS_K2);
    bf16_t* VT = (bf16_t*)(ws + WS_VT); bf16_t* TTl = (bf16_t*)(ws + WS_TTL); bf16_t* TTc = (bf16_t*)(ws + WS_TTC); bf16_t* UC = (bf16_t*)(ws + WS_UC);
    bf16_t* MIXA = (bf16_t*)(ws + WS_MIX); bf16_t* ACT = (bf16_t*)(ws + WS_ACT);
    float* PB1 = (float*)(ws + WS_R); float* PB2 = (float*)(ws + WS_R + 99 * MiB);
    bf16_t* FP = (bf16_t*)(ws + WS_H);
    float* XL = p.out; float* XC = (float*)(ws + WS_XCTX);
    const float* rope = (const float*)(ws + WS_ROPE);

    volatile LAS unsigned* bst = (volatile LAS unsigned*)(lds + LDS_BYTES - 64);
    if (threadIdx.x < 2) bst[threadIdx.x] = 0u;
    __syncthreads();
    (void)xcd_barrier_post((unsigned*)(ws + WS_BAR), bst);
#define GSYNC() do { XcdBarrier b_; b_.bar = (unsigned*)(p.ws + WS_BAR); b_.x = xb_xcc_id(); b_.st = (volatile LAS unsigned*)(lds + LDS_BYTES - 64); xcd_barrier(b_); } while (0)

    prep_phase(p, lds);
    if (p.ws == nullptr) grid.sync();
    GSYNC();

#pragma unroll 1
    for (int l = 0; l < 2; ++l) {
        const float* mod = (const float*)(ws + WS_MOD) + (size_t)l * 9 * 6144;
        const float* xin_l = l == 0 ? p.x : XL; const float* xin_c = l == 0 ? p.ctx : XC;
        const int mrows = l == 0 ? MTOT : NLAT;
        if (PROBE == 3) { for (int rep = 0; rep < 8; ++rep) GSYNC(); }
        norm_phase(xin_l, xin_c, p.norm1_g + l * DM, mod, 0, 1024, H, MTOT, l == 1 ? PB2 : nullptr, (const float*)(ws + WS_MOD) + 8 * 6144 + 5120, XC, (l == 1 && G == 256) ? NLAT : 0);
        GSYNC();
        for (int rep = 0; rep < (PROBE == 4 ? 2 : 1); ++rep) {
            if (rep) GSYNC();
            pg8::Gemm g{H, (const bf16_t*)(ws + WS_WIN) + (size_t)l * INW * DM, MTOT, INW, DM, DM, DM, 0};
            pg8::StaticOrder S; S.init(MTOT, INW, G, cu);
            EpiInProj E{Q1, Q2, K1c, K2c, VT, TTl, TTc, UC, rope};
            pg8::gemm_phase<EpiInProj, pg8::StaticOrder, true>(lds, g, S, E);
        }
        GSYNC();
        for (int rep = 0; rep < (PROBE == 1 ? 2 : 1); ++rep) {
            if (rep) GSYNC();
            const float li = 0.8f - 0.6f * __expf(-0.3f * (float)l);
            float lam;
            { const int lane = fresh_tid() & 63;
              const float s1 = wave_sum(p.lam_q1[l * 64 + lane] * p.lam_k1[l * 64 + lane]), s2 = wave_sum(p.lam_q2[l * 64 + lane] * p.lam_k2[l * 64 + lane]);
              lam = expf(s1) - expf(s2) + li; }
            att::Args A{Q1, Q2, K1c, K2c, VT, MIXA, p.subln_g + l * 128, lam, 1.f - li};
            const int n_att = 512 + (l == 0 ? 64 : 0);
            for (int u = cu; u < n_att; u += G) {
                if (u < 512) att::attn_unit(lds, A, u >> 6, (u >> 4) & 3, (u >> 6) * SEQ + (u & 15) * 128, 36);
                else { const int v = u - 512; att::attn_unit(lds, A, v >> 3, (v >> 1) & 3, NLAT + (v >> 3) * CTXL + (v & 1) * 128, 4); }
            }
#pragma unroll 1
            for (int hf = 0; hf < 2; ++hf) {
                pg8::Gemm g{(const bf16_t*)(ws + WS_DFTL) + hf * 2048, TTl + hf * 2048, 2048, 2048, 2048, 4096, 4096, 0};
                pg8::OffsetOrder S; S.init(2048, 2048, G, cu, 64 + 64 * hf);
                EpiMix E{FP, 512, hf * 256, 0, SEQ, 0};
                pg8::gemm_phase<EpiMix, pg8::OffsetOrder, true>(lds, g, S, E);
            }
            if (l == 0) {
#pragma unroll 1
                for (int hf = 0; hf < 2; ++hf) {
                    pg8::Gemm g{(const bf16_t*)(ws + WS_DFTC) + hf * 256, TTc + hf * 256, 256, 2048, 256, 512, 512, 0};
                    pg8::OffsetOrder S; S.init(256, 2048, G, cu, 192 + 8 * hf);
                    EpiMix E{FP, 512, hf * 256, NLAT, CTXL, 0};
                    pg8::gemm_phase<EpiMix, pg8::OffsetOrder, true>(lds, g, S, E);
                }
            }
            const int n_conv = l == 0 ? 288 : 256;
            if (G == 256) {
                const int sidx = cu < 64 ? cu : (cu >= 192 ? cu - 128 : -1);
                if (sidx >= 0) for (int it = sidx; it < n_conv; it += 128) conv_item(p, lds, l, it, UC, MIXA);
            } else for (int it = cu; it < n_conv; it += G) conv_item(p, lds, l, it, UC, MIXA);
        }
        GSYNC();
        {
            const bf16_t* wsm = (const bf16_t*)(ws + WS_WSM) + (size_t)l * WSM_L;
            {
                pg8::Gemm g{FP, wsm, mrows, 256, 512, 512, 512, 0};
                pg8::OffsetOrder S; S.init(mrows, 256, G, cu, 0);
                EpiMix E{MIXA, DM, 512, 0, 0, 0};
                pg8::gemm_phase<EpiMix, pg8::OffsetOrder, true>(lds, g, S, E);
            }
            {
                pg8::Gemm g{MIXA + 768, wsm + 256 * 512, mrows, 256, 256, DM, 256, 0};
                pg8::OffsetOrder S; S.init(mrows, 256, G, cu, 72);
                EpiMix E{MIXA, DM, 768, 0, 0, 0};
                pg8::gemm_phase<EpiMix, pg8::OffsetOrder, true>(lds, g, S, E);
            }
        }
        GSYNC();
        {
            pg8::Gemm g{MIXA, (const bf16_t*)(ws + WS_WOUT) + (size_t)l * DM * DM, mrows, DM, DM, DM, DM, 0};
            EpiRes E{xin_l, xin_c, XL, XC, mod, 2048, PB1};
            if (l == 0 && G == 256) {
                pg8::CtxSplitOrder S; S.init(DM, DM, G, cu);
                EpiResNormL0 EL{{xin_l, XL, mod, 2048, p.norm2_g, (unsigned*)(ws + WS_R + 40 * MiB), (unsigned*)(ws + WS_PCNT) + 2 * 64 * 64, H, 3072, 4096, mod}, PB1};
                pg8::gemm_phase<EpiResNormL0, pg8::CtxSplitOrder, true>(lds, g, S, EL);
            }
            else if (l == 0) { pg8::CtxSplitOrder S; S.init(DM, DM, G, cu); pg8::gemm_phase<EpiRes, pg8::CtxSplitOrder, true>(lds, g, S, E); }
            else if (G == 256) {
                pg8::StaticOrder S; S.init(mrows, DM, G, cu);
                EpiPanelNorm<1> EN{xin_l, XL, mod, 2048, p.norm2_g + l * DM, (unsigned*)(ws + WS_R), (unsigned*)(ws + WS_PCNT) + 64 * 64, H, 3072, 4096, mod};
                pg8::gemm_phase<EpiPanelNorm<1>, pg8::StaticOrder, true>(lds, g, S, EN);
            }
            else { pg8::StaticOrder S; S.init(mrows, DM, G, cu); pg8::gemm_phase<EpiRes, pg8::StaticOrder, true>(lds, g, S, E); }
        }
        GSYNC();
        if (!(l == 1 && G == 256)) {
        norm_phase(XL, l == 0 ? p.ctx : XC, p.norm2_g + l * DM, mod, 3072, 4096, H, mrows, l == 0 ? PB1 : nullptr, mod + 8 * 6144 + 2048, XC, (l == 0 && G == 256) ? NLAT : 0);
        GSYNC();
        }
        for (int rep = 0; rep < (PROBE == 2 ? 2 : 1); ++rep) {
            if (rep) GSYNC();
            pg8::Gemm g{H, (const bf16_t*)(ws + WS_W13) + (size_t)l * N13 * DM, mrows, N13, DM, DM, DM, 0};
            pg8::StaticOrder S; S.init(mrows, N13, G, cu);
            EpiFfn13 E{ACT};
            pg8::gemm_phase<EpiFfn13, pg8::StaticOrder, true>(lds, g, S, E);
        }
        GSYNC();
        {
            pg8::Gemm g{ACT, (const bf16_t*)(ws + WS_W2) + (size_t)l * DM * DFF, mrows, DM, DFF, DFF, DFF, 0};
            EpiRes E{XL, XC, XL, XC, mod, 5120, PB2};
            if (l == 0 && G == 256) {
                pg8::CtxSplitOrder S; S.init(DM, DFF, G, cu);
                EpiResNormL0 EL{{XL, XL, mod, 5120, p.norm1_g + DM, (unsigned*)(ws + 244 * MiB), (unsigned*)(ws + WS_PCNT) + 3 * 64 * 64, H, 0, 1024, mod + 9 * 6144}, PB2};
                pg8::gemm_phase<EpiResNormL0, pg8::CtxSplitOrder, true>(lds, g, S, EL);
            }
            else if (l == 0) { pg8::CtxSplitOrder S; S.init(DM, DFF, G, cu); pg8::gemm_phase<EpiRes, pg8::CtxSplitOrder, true>(lds, g, S, E); }
            else if (G == 256) {
                pg8::StaticOrder S; S.init(mrows, DM, G, cu);
                EpiPanelNorm<0> EF{XL, XL, mod, 5120, p.final_g, (unsigned*)(ws + WS_H), (unsigned*)(ws + WS_PCNT), nullptr, 0, 0, mod};
                pg8::gemm_phase<EpiPanelNorm<0>, pg8::StaticOrder, true>(lds, g, S, EF);
            }
            else { pg8::StaticOrder S; S.init(mrows, DM, G, cu); pg8::gemm_phase<EpiRes, pg8::StaticOrder, true>(lds, g, S, E); }
        }
        if (!(l == 1 && G == 256)) GSYNC();
    }
    if (G != 256) {
        const int tid = fresh_tid(), lane = tid & 63, gw = blockIdx.x * 8 + (tid >> 6), NGW = gridDim.x * 8;
        f32x4 gg[4], vn[4];
#pragma unroll
        for (int j = 0; j < 4; ++j) { gg[j] = *(const f32x4*)(p.final_g + 4 * lane + 256 * j); vn[j] = *(const f32x4*)(XL + (size_t)gw * DM + 4 * lane + 256 * j); }
        for (int row = gw; row < NLAT; row += NGW) {
            float* xr = XL + (size_t)row * DM;
            f32x4 v[4]; float ss = 0.f;
#pragma unroll
            for (int j = 0; j < 4; ++j) { v[j] = vn[j]; ss += (v[j][0] * v[j][0] + v[j][1] * v[j][1]) + (v[j][2] * v[j][2] + v[j][3] * v[j][3]); }
            if (row + NGW < NLAT) {
#pragma unroll
                for (int j = 0; j < 4; ++j) vn[j] = *(const f32x4*)(xr + (size_t)NGW * DM + 4 * lane + 256 * j);
            }
            const float rstd = __builtin_amdgcn_rsqf(wave_sum(ss) * (1.f / DM) + EPSV);
#pragma unroll
            for (int j = 0; j < 4; ++j) { const int col = 4 * lane + 256 * j; *(f32x4*)(xr + col) = (v[j] * rstd) * gg[j]; }
        }
    }
}

extern "C" void kernel_launch(void* const* d_in, const int* in_sizes, int n_in, void* d_out, int out_size, void* d_ws, size_t ws_size, hipStream_t stream) {
    static int grid_blocks = 0;
    if (grid_blocks == 0) {
        if (n_in != 25 || ws_size < WS_END) { fprintf(stderr, "kernel_launch: unexpected n_in %d / ws %zu\n", n_in, ws_size); grid_blocks = -1; return; }
        int dev = 0, cus = 0, per_cu = 0;
        (void)hipGetDevice(&dev);
        (void)hipDeviceGetAttribute(&cus, hipDeviceAttributeMultiprocessorCount, dev);
        if (hipFuncSetAttribute((const void*)fwd_kernel, hipFuncAttributeMaxDynamicSharedMemorySize, LDS_BYTES) != hipSuccess) fprintf(stderr, "kernel_launch: hipFuncSetAttribute failed\n");
        if (hipOccupancyMaxActiveBlocksPerMultiprocessor(&per_cu, (const void*)fwd_kernel, 512, LDS_BYTES) != hipSuccess || per_cu < 1) { fprintf(stderr, "kernel_launch: occupancy query gave %d\n", per_cu); per_cu = 1; }
        (void)hipGetLastError();
        grid_blocks = cus * per_cu;
    }
    if (grid_blocks < 0) return;
    Params p{};
    const float** pp = (const float**)&p;
    for (int i = 0; i < 25; ++i) pp[i] = (const float*)d_in[i];
    p.out = (float*)d_out; p.ws = (unsigned char*)d_ws;
    (void)hipMemsetAsync((unsigned char*)d_ws + WS_MOD, 0, ZERO_BYTES, stream);
    void* args[] = {&p};
    hipError_t e = hipLaunchCooperativeKernel((const void*)fwd_kernel, dim3(grid_blocks), dim3(512), args, LDS_BYTES, stream);
    if (e != hipSuccess) fprintf(stderr, "cooperative launch failed: %s (grid %d)\n", hipGetErrorString(e), grid_blocks);
}
```
